# Optimizing an MI355X kernel written in HIP

```python
import math
import jax, jax.numpy as jnp
from jax import lax
import numpy as np

D_MODEL = 1024
BATCH = 16
SEQ = 4096
DEPTH = 2

D_MIX = D_MODEL
W_CONV = D_MIX // 4
W_CFM = D_MIX // 4
W_SSM = D_MIX // 4
W_ATT = D_MIX - W_CONV - W_CFM - W_SSM
SHORT_K = 3
CFM_K = 31
SSM_CH = 16
SSM_GROUPS = W_SSM // SSM_CH
SSM_STATE = 64
HEAD_DIM = 64
N_HEADS = W_ATT // HEAD_DIM
DILATED_CFG = ((128, 1), (512, 4), (2048, 16))
ROPE_THETA = 10000.0
D_FF = -(-8 * D_MODEL // (3 * 256)) * 256
PROJ_SPLITS = (W_CONV, W_CONV, W_CONV, W_CFM, W_CFM, W_SSM, W_ATT, W_ATT, W_ATT)
N_IN = sum(PROJ_SPLITS)
GROUP_SPLITS = (W_CONV, W_CFM, W_SSM, W_ATT)
EPS = 1e-6

kernel_name = 'hybrid_parallel_group_decoder'


def _split_points(sizes):
    pts, acc = [], 0
    for s in sizes[:-1]:
        acc += s
        pts.append(acc)
    return pts


def rmsnorm(x, g):
    xf = x.astype(jnp.float32)
    y = xf * lax.rsqrt(jnp.mean(xf * xf, axis=-1, keepdims=True) + EPS)
    return (y * g.astype(jnp.float32)).astype(x.dtype)


def layernorm(x, g, b):
    xf = x.astype(jnp.float32)
    mu = jnp.mean(xf, axis=-1, keepdims=True)
    xc = xf - mu
    var = jnp.mean(xc * xc, axis=-1, keepdims=True)
    y = xc * lax.rsqrt(var + EPS) * g.astype(jnp.float32) + b.astype(jnp.float32)
    return y.astype(x.dtype)


def causal_depthwise_conv(x, w):
    k, c = w.shape
    return lax.conv_general_dilated(
        x, w[:, None, :].astype(x.dtype), window_strides=(1,),
        padding=((k - 1, 0),), dimension_numbers=('NWC', 'WIO', 'NWC'),
        feature_group_count=c)


def rope(x):
    seq, hd = x.shape[1], x.shape[-1]
    inv = ROPE_THETA ** (-jnp.arange(0, hd, 2, dtype=jnp.float32) / hd)
    ang = jnp.arange(seq, dtype=jnp.float32)[:, None] * inv[None, :]
    cos = jnp.cos(ang)[None, :, None, :]
    sin = jnp.sin(ang)[None, :, None, :]
    xf = x.astype(jnp.float32)
    x1, x2 = xf[..., :hd // 2], xf[..., hd // 2:]
    return jnp.concatenate([x1 * cos - x2 * sin, x2 * cos + x1 * sin], axis=-1).astype(x.dtype)


def short_conv_mixer(h, gate_b, gate_c, w):
    return gate_b * causal_depthwise_conv(gate_c * h, w)


def conformer_conv_mixer(a, g, dw_w, dw_b, ln_g, ln_b):
    z = a * jax.nn.sigmoid(g)
    z = causal_depthwise_conv(z, dw_w) + dw_b.astype(z.dtype)
    z = layernorm(z, ln_g, ln_b)
    return jax.nn.silu(z)


def s5_mixer(u, a_re, a_im, log_dt, b_re, b_im, c_re, c_im, d_skip, w_glu):
    bsz, seq, _ = u.shape
    f32 = jnp.float32
    uf = u.astype(f32).reshape(bsz, seq, SSM_GROUPS, SSM_CH)
    dt = jnp.exp(log_dt.astype(f32))[:, None]
    ar, ai = a_re.astype(f32), a_im.astype(f32)
    mag = jnp.exp(ar * dt)
    lr, li = mag * jnp.cos(ai * dt), mag * jnp.sin(ai * dt)
    den = ar * ar + ai * ai
    nr, ni = lr - 1.0, li
    fr = (nr * ar + ni * ai) / den
    fi = (ni * ar - nr * ai) / den
    br, bi = b_re.astype(f32), b_im.astype(f32)
    bbar_re = fr[..., None] * br - fi[..., None] * bi
    bbar_im = fr[..., None] * bi + fi[..., None] * br
    xr = jnp.einsum('blgh,gph->blgp', uf, bbar_re)
    xi = jnp.einsum('blgh,gph->blgp', uf, bbar_im)
    a_full_r = jnp.broadcast_to(lr, xr.shape)
    a_full_i = jnp.broadcast_to(li, xr.shape)

    def combine(e1, e2):
        a1r, a1i, b1r, b1i = e1
        a2r, a2i, b2r, b2i = e2
        return (a2r * a1r - a2i * a1i, a2r * a1i + a2i * a1r,
                a2r * b1r - a2i * b1i + b2r, a2r * b1i + a2i * b1r + b2i)

    _, _, sr, si = lax.associative_scan(combine, (a_full_r, a_full_i, xr, xi), axis=1)
    y = (jnp.einsum('blgp,ghp->blgh', sr, c_re.astype(f32))
         - jnp.einsum('blgp,ghp->blgh', si, c_im.astype(f32)))
    y = y.reshape(bsz, seq, W_SSM) + d_skip.astype(f32) * uf.reshape(bsz, seq, W_SSM)
    z = jax.nn.gelu(y)
    gl = z @ w_glu.astype(f32)
    out = gl[..., :W_SSM] * jax.nn.sigmoid(gl[..., W_SSM:])
    return out.astype(u.dtype)


def dilated_window_attention(q, k, v, window, dilation):
    bsz, seq, nh, hd = q.shape
    n_keys = window // dilation
    blk = n_keys
    n = seq // dilation
    nb = -(-n // blk)
    pad = nb * blk - n

    def regroup(t):
        t = t.reshape(bsz, n, dilation, nh, hd).transpose(0, 2, 3, 1, 4)
        t = jnp.pad(t, ((0, 0), (0, 0), (0, 0), (0, pad), (0, 0)))
        return t.reshape(bsz, dilation, nh, nb, blk, hd)

    qb, kb, vb = regroup(q), regroup(k), regroup(v)

    def prev(t):
        return jnp.pad(t, ((0, 0), (0, 0), (0, 0), (1, 0), (0, 0), (0, 0)))[:, :, :, :-1]

    kk = jnp.concatenate([prev(kb), kb], axis=4)
    vv = jnp.concatenate([prev(vb), vb], axis=4)
    s = jnp.einsum('bdhnqe,bdhnke->bdhnqk', qb, kk,
                   preferred_element_type=jnp.float32) * (hd ** -0.5)
    bi = jnp.arange(nb)[:, None, None]
    qi = jnp.arange(blk)[None, :, None]
    kj = jnp.arange(2 * blk)[None, None, :]
    rel = blk + qi - kj
    valid = (rel >= 0) & (rel <= n_keys) & ((bi > 0) | (kj >= blk))
    s = jnp.where(valid, s, -jnp.inf)
    m = jnp.max(s, axis=-1, keepdims=True)
    p = jnp.exp(s - m)
    den = jnp.sum(p, axis=-1, keepdims=True)
    o = jnp.einsum('bdhnqk,bdhnke->bdhnqe', p, vv.astype(jnp.float32)) / den
    lse = (m + jnp.log(den))[..., 0]
    o = o.reshape(bsz, dilation, nh, nb * blk, hd)[:, :, :, :n]
    o = o.transpose(0, 3, 1, 2, 4).reshape(bsz, seq, nh, hd)
    lse = lse.reshape(bsz, dilation, nh, nb * blk)[:, :, :, :n]
    lse = lse.transpose(0, 3, 1, 2).reshape(bsz, seq, nh)
    return o, lse


def dilated_attention_mixer(q, k, v):
    bsz, seq, _ = q.shape
    q = rope(q.reshape(bsz, seq, N_HEADS, HEAD_DIM))
    k = rope(k.reshape(bsz, seq, N_HEADS, HEAD_DIM))
    v = v.reshape(bsz, seq, N_HEADS, HEAD_DIM)
    outs, lses = [], []
    for window, dilation in DILATED_CFG:
        o, lse = dilated_window_attention(q, k, v, window, dilation)
        outs.append(o)
        lses.append(lse)
    wts = jax.nn.softmax(jnp.stack(lses, axis=0), axis=0)
    o = jnp.sum(wts[..., None] * jnp.stack(outs, axis=0), axis=0)
    return o.reshape(bsz, seq, W_ATT).astype(q.dtype)


def setup_inputs(seed: int = 0) -> dict:
    key = jax.random.key(seed)
    ks = iter(jax.random.split(key, 32))
    f32 = jnp.float32

    def nrm(shape, scale):
        return jax.random.normal(next(ks), shape, f32) * scale

    x = nrm((BATCH, SEQ, D_MODEL), 1.0)
    norm_mix_g = 1.0 + nrm((DEPTH, D_MODEL), 0.02)
    w_in = nrm((DEPTH, D_MODEL, N_IN), D_MODEL ** -0.5)
    conv3_w = nrm((DEPTH, SHORT_K, W_CONV), SHORT_K ** -0.5)
    cfm_dw_w = nrm((DEPTH, CFM_K, W_CFM), CFM_K ** -0.5)
    cfm_dw_b = nrm((DEPTH, W_CFM), 0.02)
    cfm_ln_g = 1.0 + nrm((DEPTH, W_CFM), 0.02)
    cfm_ln_b = nrm((DEPTH, W_CFM), 0.02)
    n_idx = jnp.arange(SSM_STATE, dtype=f32)
    s5_a_re = -0.5 + nrm((DEPTH, SSM_GROUPS, SSM_STATE), 0.01)
    s5_a_im = math.pi * n_idx + nrm((DEPTH, SSM_GROUPS, SSM_STATE), 0.01)
    s5_log_dt = jax.random.uniform(next(ks), (DEPTH, SSM_GROUPS), f32,
                                   math.log(1e-3), math.log(1e-1))
    s5_b_re = nrm((DEPTH, SSM_GROUPS, SSM_STATE, SSM_CH), (2 * SSM_CH) ** -0.5)
    s5_b_im = nrm((DEPTH, SSM_GROUPS, SSM_STATE, SSM_CH), (2 * SSM_CH) ** -0.5)
    s5_c_re = nrm((DEPTH, SSM_GROUPS, SSM_CH, SSM_STATE), SSM_STATE ** -0.5)
    s5_c_im = nrm((DEPTH, SSM_GROUPS, SSM_CH, SSM_STATE), SSM_STATE ** -0.5)
    s5_d = nrm((DEPTH, W_SSM), 0.1)
    s5_glu_w = nrm((DEPTH, W_SSM, 2 * W_SSM), W_SSM ** -0.5)
    grp_norm_g = 1.0 + nrm((DEPTH, D_MIX), 0.02)
    w_out = nrm((DEPTH, D_MIX, D_MODEL), D_MIX ** -0.5)
    norm_ffn_g = 1.0 + nrm((DEPTH, D_MODEL), 0.02)
    w_gate = nrm((DEPTH, D_MODEL, D_FF), D_MODEL ** -0.5)
    w_up = nrm((DEPTH, D_MODEL, D_FF), D_MODEL ** -0.5)
    w_down = nrm((DEPTH, D_FF, D_MODEL), D_FF ** -0.5)
    final_norm_g = 1.0 + nrm((D_MODEL,), 0.02)
    return {'x': x, 'norm_mix_g': norm_mix_g, 'w_in': w_in, 'conv3_w': conv3_w,
            'cfm_dw_w': cfm_dw_w, 'cfm_dw_b': cfm_dw_b, 'cfm_ln_g': cfm_ln_g,
            'cfm_ln_b': cfm_ln_b, 's5_a_re': s5_a_re, 's5_a_im': s5_a_im,
            's5_log_dt': s5_log_dt, 's5_b_re': s5_b_re, 's5_b_im': s5_b_im,
            's5_c_re': s5_c_re, 's5_c_im': s5_c_im, 's5_d': s5_d, 's5_glu_w': s5_glu_w,
            'grp_norm_g': grp_norm_g, 'w_out': w_out, 'norm_ffn_g': norm_ffn_g,
            'w_gate': w_gate, 'w_up': w_up, 'w_down': w_down, 'final_norm_g': final_norm_g}


def reference(x, norm_mix_g, w_in, conv3_w, cfm_dw_w, cfm_dw_b, cfm_ln_g, cfm_ln_b,
              s5_a_re, s5_a_im, s5_log_dt, s5_b_re, s5_b_im, s5_c_re, s5_c_im, s5_d,
              s5_glu_w, grp_norm_g, w_out, norm_ffn_g, w_gate, w_up, w_down,
              final_norm_g):
    proj_pts = _split_points(PROJ_SPLITS)
    grp_pts = _split_points(GROUP_SPLITS)
    for layer in range(DEPTH):
        h = rmsnorm(x, norm_mix_g[layer])
        p = h @ w_in[layer]
        (c_h, c_b, c_c, f_a, f_g, s_u, a_q, a_k, a_v) = jnp.split(p, proj_pts, axis=-1)
        y_conv = short_conv_mixer(c_h, c_b, c_c, conv3_w[layer])
        y_cfm = conformer_conv_mixer(f_a, f_g, cfm_dw_w[layer], cfm_dw_b[layer],
                                     cfm_ln_g[layer], cfm_ln_b[layer])
        y_ssm = s5_mixer(s_u, s5_a_re[layer], s5_a_im[layer], s5_log_dt[layer],
                         s5_b_re[layer], s5_b_im[layer], s5_c_re[layer], s5_c_im[layer],
                         s5_d[layer], s5_glu_w[layer])
        y_att = dilated_attention_mixer(a_q, a_k, a_v)
        g_conv, g_cfm, g_ssm, g_att = jnp.split(grp_norm_g[layer], grp_pts)
        mixed = jnp.concatenate([rmsnorm(y_conv, g_conv), rmsnorm(y_cfm, g_cfm),
                                 rmsnorm(y_ssm, g_ssm), rmsnorm(y_att, g_att)], axis=-1)
        x = x + (mixed @ w_out[layer]).astype(x.dtype)
        h = rmsnorm(x, norm_ffn_g[layer])
        ff = jax.nn.silu(h @ w_gate[layer]) * (h @ w_up[layer])
        x = x + (ff @ w_down[layer]).astype(x.dtype)
    return rmsnorm(x, final_norm_g)
```

```cpp
#include <hip/hip_runtime.h>
#include <hip/hip_cooperative_groups.h>
#include <cstdio>
#include <cstdint>
namespace cg = cooperative_groups;
namespace pg8 {
#define PG8_LAS __attribute__((address_space(3)))
typedef unsigned short bf16_t;
typedef short bf16x8 __attribute__((ext_vector_type(8)));
typedef float f32x4 __attribute__((ext_vector_type(4)));
typedef unsigned u32x4 __attribute__((ext_vector_type(4)));
constexpr int BM = 256, BK = 64, HALF = 128, HTB = HALF * BK * 2  , STAGE_BYTES = 8 * HTB, NXCD = 8, WGM = 8;

__host__ __device__ __forceinline__ int lds_byte(int r, int c) { const int st = (r >> 4) * 2 + (c >> 5), rr = r & 15, cc = c & 31, ob = rr * 64 + cc * 2; return st * 1024 + (ob ^ (((ob >> 9) & 1) << 5)); }
__host__ __device__ __forceinline__ void stage_rc(int b, int& R, int& C) { const int st = b / 1024, sb = b % 1024, swz = sb ^ (((sb >> 9) & 1) << 5); R = (st >> 1) * 16 + swz / 64; C = (st & 1) * 32 + (swz % 64) / 2; }
__host__ __device__ __forceinline__ int perm32(int rho) { const int n = rho >> 4, i = rho & 15; return 8 * (i >> 2) + 4 * n + (i & 3); }

struct Unit { int pm, pn; };
struct Gemm { const bf16_t* A; const bf16_t* Bt; int M, N, K; };

struct StaticOrder {
    int nM, nN, nwg, G, c;
    __host__ __device__ void init(int M, int N, int G_, int c_) { nM = M / BM; nN = N / BM; nwg = nM * nN; G = G_; c = c_; }
    __host__ __device__ bool next(int i, Unit& u) const {
        const long L = (long)i * G + c; if (L >= nwg) return false;
        int wgid = (int)L; { const int q = nwg / NXCD, r = nwg % NXCD, xcd = wgid % NXCD, off = wgid / NXCD; wgid = (xcd < r ? xcd * (q + 1) : r * (q + 1) + (xcd - r) * q) + off; }
        const int nig = WGM * nN, gid = wgid / nig, fm = gid * WGM, gsz = (nM - fm) < WGM ? (nM - fm) : WGM;
        u.pm = fm + ((wgid % nig) % gsz); u.pn = (wgid % nig) / gsz; return true;
    }
    __device__ __forceinline__ void a_ready(const Unit&) const {}
    __device__ __forceinline__ void done(const Unit&) const {}
};

__device__ __forceinline__ unsigned cvt_pk_bf16(float lo, float hi) { unsigned r; asm volatile("v_cvt_pk_bf16_f32 %0, %1, %2" : "=v"(r) : "v"(lo), "v"(hi)); return r; }
typedef float f32x2 __attribute__((ext_vector_type(2)));
template <class Epi, class Sched, bool ALIGN_EPI = false, bool SP2 = false>
__device__ __forceinline__ void gemm_phase(PG8_LAS unsigned char* lds, const Gemm g, const Sched& S, const Epi& E) {
    const int tid = threadIdx.x, wid = __builtin_amdgcn_readfirstlane(tid >> 6), lane = tid & 63, wr = wid >> 2, wc = wid & 3, fr = lane & 15, fq = lane >> 4;
    const int K = g.K, nt = K / BK;
    unsigned voffA[2], voffB[2];
#pragma unroll
    for (int i = 0; i < 2; ++i) { int R, C; stage_rc(tid * 16 + i * 8192, R, C); const int Rb = Epi::PERM ? ((R & ~31) + perm32(R & 31)) : R;
        voffA[i] = (unsigned)(R * K + C) * 2u; voffB[i] = (unsigned)(Rb * K + C) * 2u; }
    const size_t kstep = (size_t)(BK * 2);
    const size_t hstep = (size_t)HALF * K * 2;
    const size_t tstep = 2 * hstep;
    const unsigned ldsw = (unsigned)wid * 1024u;
    const int aoff = lds_byte(wr * 64 + fr, fq * 8), boff = lds_byte(wc * 32 + fr, fq * 8);
#define PG8_SA(b, h) (((b) * 2 + (h)) * HTB)
#define PG8_SB(b, h) ((4 + (b) * 2 + (h)) * HTB)
#define PG8_STAGE(bufoff, gbase, voff) do { _Pragma("unroll") for (int _i = 0; _i < 2; ++_i) \
        __builtin_amdgcn_global_load_lds((const unsigned*)((const char*)(gbase) + (voff)[_i]), (PG8_LAS unsigned*)(lds + (bufoff) + ldsw + _i * 8192), 16, 0, 0); } while (0)
#define PG8_LDA(dst, b, h) do { _Pragma("unroll") for (int m = 0; m < 4; ++m) _Pragma("unroll") for (int k = 0; k < 2; ++k) dst[m][k] = *(const PG8_LAS bf16x8*)(lds + PG8_SA(b, h) + aoff + m * 2048 + k * 1024); } while (0)
#define PG8_LDB(dst, b, h) do { _Pragma("unroll") for (int n = 0; n < 2; ++n) _Pragma("unroll") for (int k = 0; k < 2; ++k) dst[n][k] = *(const PG8_LAS bf16x8*)(lds + PG8_SB(b, h) + boff + n * 2048 + k * 1024); } while (0)
#define PG8_MMA(ai, bj, At, Bt) do { __builtin_amdgcn_s_setprio(1); _Pragma("unroll") for (int m = 0; m < 4; ++m) _Pragma("unroll") for (int n = 0; n < 2; ++n) _Pragma("unroll") for (int k = 0; k < 2; ++k) \
        acc[ai][bj][m][n] = __builtin_amdgcn_mfma_f32_16x16x32_bf16(Bt[n][k], At[m][k], acc[ai][bj][m][n], 0, 0, 0); __builtin_amdgcn_s_setprio(0); } while (0)
#define PG8_WAIT_V(n) asm volatile("s_waitcnt vmcnt(" #n ")" ::: "memory")
#define PG8_WAIT_L(n) asm volatile("s_waitcnt lgkmcnt(" #n ")" ::: "memory")
#define PG8_BAR __builtin_amdgcn_s_barrier()
#define PG8_SCHED __builtin_amdgcn_sched_barrier(0)
    Unit cur, nxt; int ui = 0;
    if (!S.next(0, cur)) return;
    f32x4 acc[2][2][4][2];
#pragma unroll
    for (int a = 0; a < 2; ++a)
#pragma unroll
        for (int b = 0; b < 2; ++b)
#pragma unroll
            for (int m = 0; m < 4; ++m)
#pragma unroll
                for (int n = 0; n < 2; ++n) acc[a][b][m][n] = (f32x4){0.f, 0.f, 0.f, 0.f};
    bf16x8 At[4][2], B0[2][2], B1[2][2];
    const char* cA = (const char*)g.A + (size_t)cur.pm * tstep; const char* cB = (const char*)g.Bt + (size_t)cur.pn * tstep;
    S.a_ready(cur);
    if constexpr (SP2) {
        PG8_STAGE(PG8_SB(0, 0), cB, voffB); PG8_STAGE(PG8_SB(0, 1), cB + hstep, voffB); PG8_STAGE(PG8_SA(0, 0), cA, voffA); PG8_STAGE(PG8_SA(0, 1), cA + hstep, voffA);
        if (wr == 1) PG8_BAR;
        PG8_WAIT_V(2); PG8_BAR;
        PG8_STAGE(PG8_SB(1, 0), cB + kstep, voffB); PG8_STAGE(PG8_SA(1, 0), cA + kstep, voffA); PG8_STAGE(PG8_SB(1, 1), cB + hstep + kstep, voffB);
        PG8_WAIT_V(6); PG8_BAR;
    } else {
        PG8_STAGE(PG8_SB(0, 0), cB, voffB); PG8_STAGE(PG8_SA(0, 0), cA, voffA); PG8_STAGE(PG8_SB(0, 1), cB + hstep, voffB); PG8_STAGE(PG8_SA(0, 1), cA + hstep, voffA);
        if (wr == 1) PG8_BAR;
        PG8_WAIT_V(4); PG8_BAR;
        PG8_STAGE(PG8_SB(1, 0), cB + kstep, voffB); PG8_STAGE(PG8_SA(1, 0), cA + kstep, voffA); PG8_STAGE(PG8_SB(1, 1), cB + hstep + kstep, voffB);
        PG8_WAIT_V(6); PG8_BAR;
    }
    for (;;) {
        const bool has_next = S.next(ui + 1, nxt);
        const char* nA = has_next ? (const char*)g.A + (size_t)nxt.pm * tstep : cA; const char* nB = has_next ? (const char*)g.Bt + (size_t)nxt.pn * tstep : cB;
#pragma nounroll
        for (int t = 0; t < nt; t += 2) {
            const bool last = (t == nt - 2);
            const char* a1 = cA + (size_t)(t + 1) * kstep;
            const char* a2 = last ? nA : cA + (size_t)(t + 2) * kstep; const char* b2 = last ? nB : cB + (size_t)(t + 2) * kstep;
            const char* a3 = a2 + kstep; const char* b3 = b2 + kstep;
            if (last && has_next) S.a_ready(nxt);
            if constexpr (SP2) {
            PG8_LDB(B0, 0, 0); PG8_LDB(B1, 0, 1); PG8_SCHED; PG8_LDA(At, 0, 0); PG8_STAGE(PG8_SA(1, 1), a1 + hstep, voffA);
            PG8_WAIT_V(8); PG8_WAIT_L(0); PG8_BAR; PG8_MMA(0, 0, At, B0); PG8_MMA(0, 1, At, B1); PG8_BAR; PG8_SCHED;
            PG8_LDA(At, 0, 1); PG8_STAGE(PG8_SB(0, 0), b2, voffB); PG8_STAGE(PG8_SB(0, 1), b2 + hstep, voffB); PG8_STAGE(PG8_SA(0, 0), a2, voffA);
            PG8_WAIT_V(8); PG8_WAIT_L(0); PG8_BAR; PG8_MMA(1, 0, At, B0); PG8_MMA(1, 1, At, B1); PG8_BAR; PG8_SCHED;
            PG8_LDB(B0, 1, 0); PG8_LDB(B1, 1, 1); PG8_SCHED; PG8_LDA(At, 1, 0); PG8_STAGE(PG8_SA(0, 1), a2 + hstep, voffA);
            PG8_WAIT_V(8); PG8_WAIT_L(0); PG8_BAR; PG8_MMA(0, 0, At, B0); PG8_MMA(0, 1, At, B1); PG8_BAR; PG8_SCHED;
            PG8_LDA(At, 1, 1); PG8_STAGE(PG8_SB(1, 0), b3, voffB); PG8_STAGE(PG8_SB(1, 1), b3 + hstep, voffB); PG8_STAGE(PG8_SA(1, 0), a3, voffA);
            PG8_WAIT_V(8); PG8_WAIT_L(0); PG8_BAR; PG8_MMA(1, 0, At, B0); PG8_MMA(1, 1, At, B1); PG8_BAR; PG8_SCHED;
            } else {
            PG8_LDB(B0, 0, 0); PG8_SCHED; PG8_LDA(At, 0, 0); PG8_STAGE(PG8_SA(1, 1), a1 + hstep, voffA);
            PG8_WAIT_L(8); PG8_BAR; PG8_WAIT_L(0); PG8_MMA(0, 0, At, B0); PG8_BAR; PG8_SCHED;
            PG8_LDB(B1, 0, 1); PG8_STAGE(PG8_SB(0, 0), b2, voffB);
            PG8_BAR; PG8_WAIT_L(0); PG8_MMA(0, 1, At, B1); PG8_BAR;
            PG8_LDA(At, 0, 1); PG8_STAGE(PG8_SA(0, 0), a2, voffA);
            PG8_BAR; PG8_WAIT_L(0); PG8_MMA(1, 0, At, B0); PG8_BAR; PG8_SCHED;
            PG8_STAGE(PG8_SB(0, 1), b2 + hstep, voffB);
            PG8_WAIT_V(6); PG8_BAR; PG8_MMA(1, 1, At, B1); PG8_BAR;
            PG8_LDB(B0, 1, 0); PG8_SCHED; PG8_LDA(At, 1, 0); PG8_STAGE(PG8_SA(0, 1), a2 + hstep, voffA);
            PG8_WAIT_L(8); PG8_BAR; PG8_WAIT_L(0); PG8_MMA(0, 0, At, B0); PG8_BAR; PG8_SCHED;
            PG8_LDB(B1, 1, 1); PG8_STAGE(PG8_SB(1, 0), b3, voffB);
            PG8_BAR; PG8_WAIT_L(0); PG8_MMA(0, 1, At, B1); PG8_BAR;
            PG8_LDA(At, 1, 1); PG8_STAGE(PG8_SA(1, 0), a3, voffA);
            PG8_BAR; PG8_WAIT_L(0); PG8_MMA(1, 0, At, B0); PG8_BAR; PG8_SCHED;
            PG8_STAGE(PG8_SB(1, 1), b3 + hstep, voffB);
            PG8_WAIT_V(6); PG8_BAR; PG8_MMA(1, 1, At, B1); PG8_BAR;
            }
        }
        if constexpr (ALIGN_EPI) { if (wr == 0) PG8_BAR; }
        if constexpr (!Epi::AFTER_DRAIN) { E(acc, cur, wr, wc, fr, fq); S.done(cur); }
        if (!has_next) break;
#pragma unroll
        for (int a = 0; a < 2; ++a)
#pragma unroll
            for (int b = 0; b < 2; ++b)
#pragma unroll
                for (int m = 0; m < 4; ++m)
#pragma unroll
                    for (int n = 0; n < 2; ++n) acc[a][b][m][n] = (f32x4){0.f, 0.f, 0.f, 0.f};
        cur = nxt; cA = nA; cB = nB; ++ui;
        if constexpr (ALIGN_EPI) { if (wr == 1) PG8_BAR; }
    }
    PG8_WAIT_V(0);
    if constexpr (!ALIGN_EPI) { if (wr == 0) PG8_BAR; }
    PG8_BAR;
    if constexpr (Epi::AFTER_DRAIN) { E.fused(acc, cur, wr, wc, fr, fq, lds, wid, lane); S.done(cur); }
#undef PG8_SA
#undef PG8_SB
#undef PG8_STAGE
#undef PG8_LDA
#undef PG8_LDB
#undef PG8_MMA
#undef PG8_WAIT_V
#undef PG8_WAIT_L
#undef PG8_BAR
#undef PG8_SCHED
}
}

#define LAS __attribute__((address_space(3)))
typedef unsigned short bf16_t;
typedef short bf16x8 __attribute__((ext_vector_type(8)));
typedef short s16x4 __attribute__((ext_vector_type(4)));
typedef float f32x4 __attribute__((ext_vector_type(4)));
typedef float f32x16 __attribute__((ext_vector_type(16)));
typedef unsigned u32x4 __attribute__((ext_vector_type(4)));
typedef unsigned u32x2 __attribute__((ext_vector_type(2)));
typedef float f32x2v __attribute__((ext_vector_type(2)));
typedef __bf16 bf16x2v __attribute__((ext_vector_type(2)));

constexpr int NT = 65536, SEQ = 4096, DMODEL = 1024, NIN = 2304, DFF = 2816;
constexpr float EPS = 1e-6f;
constexpr float C2 = 0.125f * 1.4426950408889634f;
constexpr size_t MiB = (size_t)1 << 20;
constexpr size_t W_IN = 0, W_OUT = W_IN + (size_t)NIN * 1024 * 2, W_GU = W_OUT + (size_t)1024 * 1024 * 2, W_DN = W_GU + (size_t)2 * DFF * 1024 * 2,
                 W_GLU = W_DN + (size_t)1024 * DFF * 2, W_LAYER = 24 * MiB;
static_assert(W_GLU + 512 * 256 * 2 <= W_LAYER, "weight block");
constexpr size_t WS_W = 0, WS_ROPE = 48 * MiB, WS_H = 64 * MiB, WS_P = 192 * MiB, WS_YC = 544 * MiB, WS_ZB = 640 * MiB, WS_OB = 672 * MiB, WS_ST = 768 * MiB, WS_END = 776 * MiB;
constexpr int LDS_BYTES = 147456;
constexpr int NTHREADS = 512;

struct Args {
    const float* in[24];
    float* out;
    unsigned char* ws;
    int ph_lo, ph_hi;
};

__device__ __forceinline__ unsigned pk2(float lo, float hi) { f32x2v v = {lo, hi}; bf16x2v b = __builtin_convertvector(v, bf16x2v); return __builtin_bit_cast(unsigned, b); }
__device__ __forceinline__ float bflo(unsigned u) { return __uint_as_float(u << 16); }
__device__ __forceinline__ float bfhi(unsigned u) { return __uint_as_float(u & 0xffff0000u); }
__device__ __forceinline__ float wave_sum(float v) {
#pragma unroll
    for (int o = 1; o < 64; o <<= 1) v += __shfl_xor(v, o);
    return v;
}
__device__ __forceinline__ float sigmoidf_(float x) { return 1.f / (1.f + __expf(-x)); }
__device__ __forceinline__ float gelu_tanh(float y) {
    const float a = 0.7978845608028654f * (y + 0.044715f * y * y * y);
    const float t = 1.f - 2.f / (__expf(2.f * a) + 1.f);
    return 0.5f * y * (1.f + t);
}
#define WAVE_LDS_SYNC() asm volatile("s_waitcnt lgkmcnt(0)" ::: "memory")

struct EpiIn {
    static constexpr bool PERM = true, AFTER_DRAIN = false;
    bf16_t* O; const float* ropec; const float* ropes;
    __device__ __forceinline__ void operator()(const f32x4 (&acc)[2][2][4][2], const pg8::Unit& u, int wr, int wc, int fr, int fq) const {
        const int row0 = u.pm * 256 + wr * 64 + fr;
        if (u.pn == 6 || u.pn == 7) {
            const float sc = (u.pn == 6) ? C2 : 1.f;
            const int dimb = 16 * (wc & 1) + 4 * fq;
#pragma unroll
            for (int ai = 0; ai < 2; ++ai)
#pragma unroll
                for (int m = 0; m < 4; ++m) {
                    const int row = row0 + ai * 128 + m * 16; const int pos = row & (SEQ - 1);
                    const f32x4 cs = *(const f32x4*)(ropec + pos * 32 + dimb), sn = *(const f32x4*)(ropes + pos * 32 + dimb);
                    bf16_t* rowp = O + (size_t)row * NIN + u.pn * 256 + 64 * (wc >> 1) + dimb;
#pragma unroll
                    for (int bj = 0; bj < 2; ++bj) {
                        const f32x4 x1 = acc[ai][bj][m][0] * sc, x2 = acc[ai][bj][m][1] * sc;
                        const f32x4 o1 = x1 * cs - x2 * sn, o2 = x2 * cs + x1 * sn;
                        u32x2 w1, w2; w1.x = pk2(o1[0], o1[1]); w1.y = pk2(o1[2], o1[3]); w2.x = pk2(o2[0], o2[1]); w2.y = pk2(o2[2], o2[3]);
                        *(u32x2*)(rowp + bj * 128) = w1; *(u32x2*)(rowp + bj * 128 + 32) = w2;
                    }
                }
        } else {
#pragma unroll
            for (int ai = 0; ai < 2; ++ai)
#pragma unroll
                for (int m = 0; m < 4; ++m) {
                    bf16_t* rowp = O + (size_t)(row0 + ai * 128 + m * 16) * NIN + u.pn * 256 + wc * 32 + 8 * fq;
#pragma unroll
                    for (int bj = 0; bj < 2; ++bj) {
                        const f32x4 v0 = acc[ai][bj][m][0], v1 = acc[ai][bj][m][1];
                        u32x4 w; w.x = pk2(v0[0], v0[1]); w.y = pk2(v0[2], v0[3]); w.z = pk2(v1[0], v1[1]); w.w = pk2(v1[2], v1[3]);
                        *(u32x4*)(rowp + bj * 128) = w;
                    }
                }
        }
    }
};
struct EpiRes {
    static constexpr bool PERM = true, AFTER_DRAIN = false;
    const float* res; float* out;
    __device__ __forceinline__ void operator()(const f32x4 (&acc)[2][2][4][2], const pg8::Unit& u, int wr, int wc, int fr, int fq) const {
        const int row0 = u.pm * 256 + wr * 64 + fr, col0 = u.pn * 256 + wc * 32 + 8 * fq;
#pragma unroll
        for (int ai = 0; ai < 2; ++ai)
#pragma unroll
            for (int m = 0; m < 4; ++m) {
                const size_t off = (size_t)(row0 + ai * 128 + m * 16) * DMODEL + col0;
#pragma unroll
                for (int bj = 0; bj < 2; ++bj) {
                    const f32x4 r0 = *(const f32x4*)(res + off + bj * 128), r1 = *(const f32x4*)(res + off + bj * 128 + 4);
                    *(f32x4*)(out + off + bj * 128) = r0 + acc[ai][bj][m][0];
                    *(f32x4*)(out + off + bj * 128 + 4) = r1 + acc[ai][bj][m][1];
                }
            }
    }
};
template <int MODE  > struct EpiGate {
    static constexpr bool PERM = true, AFTER_DRAIN = false;
    bf16_t* O; int ldc; int coff;
    __device__ __forceinline__ void operator()(const f32x4 (&acc)[2][2][4][2], const pg8::Unit& u, int wr, int wc, int fr, int fq) const {
        const int row0 = u.pm * 256 + wr * 64 + fr, col0 = coff + u.pn * 128 + wc * 32 + 8 * fq;
#pragma unroll
        for (int ai = 0; ai < 2; ++ai)
#pragma unroll
            for (int m = 0; m < 4; ++m) {
                float r[8];
#pragma unroll
                for (int n = 0; n < 2; ++n)
#pragma unroll
                    for (int j = 0; j < 4; ++j) {
                        const float a = acc[ai][0][m][n][j], b = acc[ai][1][m][n][j];
                        r[4 * n + j] = (MODE == 0) ? (a * sigmoidf_(a)) * b : a * sigmoidf_(b);
                    }
                u32x4 w; w.x = pk2(r[0], r[1]); w.y = pk2(r[2], r[3]); w.z = pk2(r[4], r[5]); w.w = pk2(r[6], r[7]);
                *(u32x4*)(O + (size_t)(row0 + ai * 128 + m * 16) * ldc + col0) = w;
            }
    }
};

struct WMat { const float* src; const float* src2; int K, N, ldw, kind; bf16_t* dst; };
__device__ __forceinline__ void wconv_tile(LAS float* tile, const WMat& w, int t, int tid) {
    const int nkt = w.K / 64, jt = t / nkt, kt = t % nkt, j0 = jt * 64, k0 = kt * 64;
    {
        const int j = j0 + (tid & 63);
        const float* s = w.src; int col = j;
        if (w.kind == 1) {
            if (j >= 1536 && j < 2048) { const int ww = j & 63; col = (j & ~63) + 32 * ((ww >> 2) & 1) + 16 * (ww >> 5) + 4 * ((ww >> 3) & 3) + (ww & 3); }
        } else if (w.kind == 2) {
            const int pn = j >> 8, wi = j & 255; if (wi < 128) col = pn * 128 + wi; else { s = w.src2; col = pn * 128 + (wi - 128); }
        }
        const int kk = tid >> 6;
#pragma unroll
        for (int i = 0; i < 8; ++i) { const int k = kk + 8 * i; tile[k * 65 + (tid & 63)] = s[(size_t)(k0 + k) * w.ldw + col]; }
    }
    __syncthreads();
    {
        const int jr = tid >> 3, c = tid & 7; const LAS float* s = tile + (8 * c) * 65 + jr;
        u32x4 o; o.x = pk2(s[0], s[65]); o.y = pk2(s[2 * 65], s[3 * 65]); o.z = pk2(s[4 * 65], s[5 * 65]); o.w = pk2(s[6 * 65], s[7 * 65]);
        *(u32x4*)(w.dst + (size_t)(j0 + jr) * w.K + k0 + 8 * c) = o;
    }
    __syncthreads();
}

__device__ __forceinline__ void norm_rows_bf16(const float* X, const float* g, bf16_t* H, int gw, int ngw, int lane) {
    f32x4 gv[4];
#pragma unroll
    for (int j = 0; j < 4; ++j) gv[j] = ((const f32x4*)g)[lane + 64 * j];
    for (int m = gw; m < NT; m += ngw) {
        const f32x4* xr = (const f32x4*)(X + (size_t)m * DMODEL) + lane;
        f32x4 v[4]; float s = 0.f;
#pragma unroll
        for (int j = 0; j < 4; ++j) { v[j] = xr[64 * j]; s += (v[j].x * v[j].x + v[j].y * v[j].y) + (v[j].z * v[j].z + v[j].w * v[j].w); }
        const float rs = rsqrtf(wave_sum(s) * (1.f / DMODEL) + EPS);
        u32x2* o = (u32x2*)(H + (size_t)m * DMODEL) + lane;
#pragma unroll
        for (int j = 0; j < 4; ++j) { u32x2 w; w.x = pk2(v[j].x * rs * gv[j].x, v[j].y * rs * gv[j].y); w.y = pk2(v[j].z * rs * gv[j].z, v[j].w * rs * gv[j].w); o[64 * j] = w; }
    }
}
__device__ __forceinline__ void norm_rows_f32_inplace(float* X, const float* g, int gw, int ngw, int lane) {
    f32x4 gv[4];
#pragma unroll
    for (int j = 0; j < 4; ++j) gv[j] = ((const f32x4*)g)[lane + 64 * j];
    for (int m = gw; m < NT; m += ngw) {
        f32x4* xr = (f32x4*)(X + (size_t)m * DMODEL) + lane;
        f32x4 v[4]; float s = 0.f;
#pragma unroll
        for (int j = 0; j < 4; ++j) { v[j] = xr[64 * j]; s += (v[j].x * v[j].x + v[j].y * v[j].y) + (v[j].z * v[j].z + v[j].w * v[j].w); }
        const float rs = rsqrtf(wave_sum(s) * (1.f / DMODEL) + EPS);
#pragma unroll
        for (int j = 0; j < 4; ++j) xr[64 * j] = v[j] * rs * gv[j];
    }
}

__device__ __forceinline__ void conv_tile(LAS unsigned char* lds, const bf16_t* P, bf16_t* YC, const float* w3, const float* dww, const float* dwb, const float* lng, const float* lnb,
                                          int tix, int tid, int wid, int lane) {
    const int b = tix >> 7, t0 = (tix & 127) * 32;
    LAS float* ZT = (LAS float*)lds;
    LAS float* YT = (LAS float*)(lds + 63488);
    __syncthreads();
    for (int e = tid; e < 62 * 32; e += NTHREADS) {
        const int row = e >> 5, c8 = e & 31, t = t0 - 30 + row;
        f32x4 z0 = {0.f, 0.f, 0.f, 0.f}, z1 = z0;
        if (t >= 0) {
            const bf16_t* src = P + (size_t)(b * SEQ + t) * NIN + 768 + c8 * 8;
            const u32x4 a = *(const u32x4*)src, g = *(const u32x4*)(src + 256);
            z0[0] = bflo(a.x) * sigmoidf_(bflo(g.x)); z0[1] = bfhi(a.x) * sigmoidf_(bfhi(g.x)); z0[2] = bflo(a.y) * sigmoidf_(bflo(g.y)); z0[3] = bfhi(a.y) * sigmoidf_(bfhi(g.y));
            z1[0] = bflo(a.z) * sigmoidf_(bflo(g.z)); z1[1] = bfhi(a.z) * sigmoidf_(bfhi(g.z)); z1[2] = bflo(a.w) * sigmoidf_(bflo(g.w)); z1[3] = bfhi(a.w) * sigmoidf_(bfhi(g.w));
        }
        *(LAS f32x4*)(ZT + row * 256 + c8 * 8) = z0; *(LAS f32x4*)(ZT + row * 256 + c8 * 8 + 4) = z1;
    }
    {
        const int tl = tid >> 4, cgp = tid & 15, t = t0 + tl; const size_t tok = (size_t)b * SEQ + t;
#pragma unroll
        for (int half = 0; half < 2; ++half) {
            const int c0 = cgp * 16 + half * 8;
            const bf16_t* src = P + tok * NIN + c0;
            float g0[8], g1[8], g2[8], bb[8];
            { const u32x4 hh = *(const u32x4*)src, bv = *(const u32x4*)(src + 256), cc = *(const u32x4*)(src + 512);
              g2[0] = bflo(hh.x) * bflo(cc.x); g2[1] = bfhi(hh.x) * bfhi(cc.x); g2[2] = bflo(hh.y) * bflo(cc.y); g2[3] = bfhi(hh.y) * bfhi(cc.y);
              g2[4] = bflo(hh.z) * bflo(cc.z); g2[5] = bfhi(hh.z) * bfhi(cc.z); g2[6] = bflo(hh.w) * bflo(cc.w); g2[7] = bfhi(hh.w) * bfhi(cc.w);
              bb[0] = bflo(bv.x); bb[1] = bfhi(bv.x); bb[2] = bflo(bv.y); bb[3] = bfhi(bv.y); bb[4] = bflo(bv.z); bb[5] = bfhi(bv.z); bb[6] = bflo(bv.w); bb[7] = bfhi(bv.w); }
#pragma unroll
            for (int i = 0; i < 8; ++i) { g1[i] = 0.f; g0[i] = 0.f; }
            if (t >= 1) { const u32x4 hh = *(const u32x4*)(src - NIN), cc = *(const u32x4*)(src - NIN + 512);
              g1[0] = bflo(hh.x) * bflo(cc.x); g1[1] = bfhi(hh.x) * bfhi(cc.x); g1[2] = bflo(hh.y) * bflo(cc.y); g1[3] = bfhi(hh.y) * bfhi(cc.y);
              g1[4] = bflo(hh.z) * bflo(cc.z); g1[5] = bfhi(hh.z) * bfhi(cc.z); g1[6] = bflo(hh.w) * bflo(cc.w); g1[7] = bfhi(hh.w) * bfhi(cc.w); }
            if (t >= 2) { const u32x4 hh = *(const u32x4*)(src - 2 * NIN), cc = *(const u32x4*)(src - 2 * NIN + 512);
              g0[0] = bflo(hh.x) * bflo(cc.x); g0[1] = bfhi(hh.x) * bfhi(cc.x); g0[2] = bflo(hh.y) * bflo(cc.y); g0[3] = bfhi(hh.y) * bfhi(cc.y);
              g0[4] = bflo(hh.z) * bflo(cc.z); g0[5] = bfhi(hh.z) * bfhi(cc.z); g0[6] = bflo(hh.w) * bflo(cc.w); g0[7] = bfhi(hh.w) * bfhi(cc.w); }
            float y[8];
#pragma unroll
            for (int i = 0; i < 8; ++i) y[i] = bb[i] * (w3[c0 + i] * g0[i] + w3[256 + c0 + i] * g1[i] + w3[512 + c0 + i] * g2[i]);
            u32x4 w; w.x = pk2(y[0], y[1]); w.y = pk2(y[2], y[3]); w.z = pk2(y[4], y[5]); w.w = pk2(y[6], y[7]);
            *(u32x4*)(YC + tok * 768 + c0) = w;
        }
    }
    __syncthreads();
    {
        const int c = tid & 255, th = tid >> 8;
        float w[31];
#pragma unroll
        for (int k = 0; k < 31; ++k) w[k] = dww[k * 256 + c];
        const float bias = dwb[c];
        for (int j = 0; j < 16; ++j) {
            const int tl = th * 16 + j; float a = bias;
            const LAS float* zp = ZT + tl * 256 + c;
#pragma unroll
            for (int k = 0; k < 31; ++k) a += w[k] * zp[k * 256];
            YT[tl * 256 + c] = a;
        }
    }
    __syncthreads();
    {
        const f32x4 gg = ((const f32x4*)lng)[lane], bbv = ((const f32x4*)lnb)[lane];
#pragma unroll
        for (int q = 0; q < 4; ++q) {
            const int tl = wid * 4 + q;
            f32x4 v = *(const LAS f32x4*)(YT + tl * 256 + lane * 4);
            const float mean = wave_sum((v.x + v.y) + (v.z + v.w)) * (1.f / 256.f);
            v = v - mean;
            const float var = wave_sum((v.x * v.x + v.y * v.y) + (v.z * v.z + v.w * v.w)) * (1.f / 256.f);
            const float rs = rsqrtf(var + EPS);
            f32x4 y = v * rs * gg + bbv;
            y.x = y.x * sigmoidf_(y.x); y.y = y.y * sigmoidf_(y.y); y.z = y.z * sigmoidf_(y.z); y.w = y.w * sigmoidf_(y.w);
            u32x2 wv; wv.x = pk2(y.x, y.y); wv.y = pk2(y.z, y.w);
            *(u32x2*)(YC + ((size_t)b * SEQ + t0 + tl) * 768 + 256 + lane * 4) = wv;
        }
    }
}

__device__ __forceinline__ void ssm_load_chunk(LAS float* UW, const bf16_t* P, int b, int g, int ci, int lane) {
    const bf16_t* src = P + ((size_t)b * SEQ + ci * 64 + lane) * NIN + 1280 + g * 16;
    const u32x4 a = *(const u32x4*)src, c = *(const u32x4*)(src + 8);
    f32x4 f0 = {bflo(a.x), bfhi(a.x), bflo(a.y), bfhi(a.y)}, f1 = {bflo(a.z), bfhi(a.z), bflo(a.w), bfhi(a.w)};
    f32x4 f2 = {bflo(c.x), bfhi(c.x), bflo(c.y), bfhi(c.y)}, f3 = {bflo(c.z), bfhi(c.z), bflo(c.w), bfhi(c.w)};
    LAS f32x4* d = (LAS f32x4*)(UW + lane * 16);
    d[0] = f0; d[1] = f1; d[2] = f2; d[3] = f3;
}
__device__ __forceinline__ void ssm_item(LAS unsigned char* lds, const bf16_t* P, bf16_t* ZB, const float* a_re, const float* a_im, const float* log_dt, const float* b_re, const float* b_im,
                                         const float* c_re, const float* c_im, const float* d_skip, int item, int tid, int wid, int lane) {
    const int b = item >> 4, g = item & 15;
    LAS f32x2v* EST = (LAS f32x2v*)lds;
    LAS float* CM = (LAS float*)(lds + 32768);
    LAS float* UW = (LAS float*)(lds + 40960 + wid * 4096);
    LAS f32x2v* SB = (LAS f32x2v*)(lds + 73728 + wid * 8320);
    __syncthreads();
    const int p = lane;
    float lr, li, bre[16], bim[16];
    {
        const float dt = __expf(log_dt[g]);
        const float ar = a_re[g * 64 + p], ai = a_im[g * 64 + p];
        const float mag = __expf(ar * dt);
        lr = mag * cosf(ai * dt); li = mag * sinf(ai * dt);
        const float den = ar * ar + ai * ai, nr = lr - 1.f, ni = li;
        const float fr = (nr * ar + ni * ai) / den, fi = (ni * ar - nr * ai) / den;
        const f32x4* br4 = (const f32x4*)(b_re + (size_t)(g * 64 + p) * 16); const f32x4* bi4 = (const f32x4*)(b_im + (size_t)(g * 64 + p) * 16);
#pragma unroll
        for (int q = 0; q < 4; ++q) { const f32x4 r = br4[q], i = bi4[q];
#pragma unroll
            for (int j = 0; j < 4; ++j) { bre[4 * q + j] = fr * r[j] - fi * i[j]; bim[4 * q + j] = fr * i[j] + fi * r[j]; } }
    }
    for (int e = tid; e < 1024; e += NTHREADS) { const int pp = e >> 4, h = e & 15; CM[pp * 32 + h] = c_re[(size_t)(g * 16 + h) * 64 + pp]; CM[pp * 32 + 16 + h] = -c_im[(size_t)(g * 16 + h) * 64 + pp]; }
    for (int ci = wid; ci < 64; ci += 8) {
        ssm_load_chunk(UW, P, b, g, ci, lane);
        WAVE_LDS_SYNC();
        float sr = 0.f, si = 0.f;
        for (int t = 0; t < 64; ++t) {
            const LAS f32x4* u4 = (const LAS f32x4*)(UW + t * 16);
            float xr = 0.f, xi = 0.f;
#pragma unroll
            for (int q = 0; q < 4; ++q) { const f32x4 u = u4[q];
#pragma unroll
                for (int j = 0; j < 4; ++j) { xr += bre[4 * q + j] * u[j]; xi += bim[4 * q + j] * u[j]; } }
            const float nr = lr * sr - li * si + xr, ni = lr * si + li * sr + xi; sr = nr; si = ni;
        }
        f32x2v e = {sr, si}; EST[ci * 64 + p] = e;
        WAVE_LDS_SYNC();
    }
    __syncthreads();
    if (wid == 0) {
        float pr = lr, pi = li;
#pragma unroll
        for (int q = 0; q < 6; ++q) { const float nr = pr * pr - pi * pi, ni = 2.f * pr * pi; pr = nr; pi = ni; }
        float sr = 0.f, si = 0.f;
        for (int c = 0; c < 64; ++c) { const f32x2v e = EST[c * 64 + p]; f32x2v s = {sr, si}; EST[c * 64 + p] = s;
            const float nr = pr * sr - pi * si + e.x, ni = pr * si + pi * sr + e.y; sr = nr; si = ni; }
    }
    __syncthreads();
    const int tq = lane & 15, hq = lane >> 4;
    const f32x4 dsk = *(const f32x4*)(d_skip + g * 16 + 4 * hq);
    for (int ci = wid; ci < 64; ci += 8) {
        ssm_load_chunk(UW, P, b, g, ci, lane);
        WAVE_LDS_SYNC();
        const f32x2v s0 = EST[ci * 64 + p];
        float sr = s0.x, si = s0.y;
        for (int sub = 0; sub < 4; ++sub) {
            for (int tt = 0; tt < 16; ++tt) {
                const LAS f32x4* u4 = (const LAS f32x4*)(UW + (sub * 16 + tt) * 16);
                float xr = 0.f, xi = 0.f;
#pragma unroll
                for (int q = 0; q < 4; ++q) { const f32x4 u = u4[q];
#pragma unroll
                    for (int j = 0; j < 4; ++j) { xr += bre[4 * q + j] * u[j]; xi += bim[4 * q + j] * u[j]; } }
                const float nr = lr * sr - li * si + xr, ni = lr * si + li * sr + xi; sr = nr; si = ni;
                f32x2v s = {sr, si}; SB[tt * 65 + p] = s;
            }
            WAVE_LDS_SYNC();
            f32x4 acc = {0.f, 0.f, 0.f, 0.f};
#pragma unroll 8
            for (int pp = 0; pp < 64; ++pp) {
                const f32x2v s = SB[tq * 65 + pp];
                const f32x4 cr = *(const LAS f32x4*)(CM + pp * 32 + 4 * hq), cim = *(const LAS f32x4*)(CM + pp * 32 + 16 + 4 * hq);
                acc += cr * s.x + cim * s.y;
            }
            const int t = sub * 16 + tq;
            const f32x4 uu = *(const LAS f32x4*)(UW + t * 16 + 4 * hq);
            const f32x4 y = acc + dsk * uu;
            u32x2 w; w.x = pk2(gelu_tanh(y.x), gelu_tanh(y.y)); w.y = pk2(gelu_tanh(y.z), gelu_tanh(y.w));
            *(u32x2*)(ZB + ((size_t)b * SEQ + ci * 64 + t) * 256 + g * 16 + 4 * hq) = w;
            WAVE_LDS_SYNC();
        }
    }
}

constexpr int AT_ROWB = 144, AT_KOFF = 0, AT_VOFF = 384 * AT_ROWB;
__device__ __forceinline__ s16x4 vtr(const LAS unsigned char* p) { return __builtin_bit_cast(s16x4, __builtin_amdgcn_ds_read_tr16_b64_v4i16((LAS s16x4*)p)); }
__device__ __forceinline__ void attn_unit(LAS unsigned char* lds, const bf16_t* P, bf16_t* OB, f32x2v* ST, int u, int tid, int wid, int lane) {
    const int pat = u >> 10, rem = u & 1023, b = rem >> 6, head = (rem >> 4) & 3, ru = rem & 15;
    int d, r, ub;
    if (pat == 0) { d = 1; r = 0; ub = ru; } else if (pat == 1) { d = 4; r = ru & 3; ub = ru >> 2; } else { d = 16; r = ru; ub = 0; }
    const size_t rowbase = (size_t)b * SEQ + r;
    const int i0 = ub * 256 - 128;
    __syncthreads();
    for (int e = tid; e < 384 * 8; e += NTHREADS) {
        const int row = e >> 3, c = e & 7, si = i0 + row;
        if (si >= 0) {
            const bf16_t* src = P + (rowbase + (size_t)si * d) * NIN + head * 64 + c * 8;
            const u32x4 kv = *(const u32x4*)(src + 1792), vv = *(const u32x4*)(src + 2048);
            *(LAS u32x4*)(lds + AT_KOFF + row * AT_ROWB + c * 16) = kv;
            *(LAS u32x4*)(lds + AT_VOFF + row * AT_ROWB + c * 16) = vv;
        }
    }
    const int r32 = lane & 31, h = lane >> 5;
    const size_t qtok = rowbase + (size_t)(ub * 256 + 32 * wid + r32) * d;
    bf16x8 qf[4];
    { const bf16_t* qp = P + qtok * NIN + 1536 + head * 64 + 8 * h;
#pragma unroll
      for (int s = 0; s < 4; ++s) qf[s] = *(const bf16x8*)(qp + 16 * s); }
    __syncthreads();
    f32x16 sc[5];
    float mx = -1e30f;
    const float r32f = (float)r32, h4f = (float)(4 * h);
#pragma unroll
    for (int i = 0; i < 5; ++i) {
        const bool tv = (ub > 0) || (wid + i >= 4);
        f32x16 a;
        if (tv) {
#pragma unroll
            for (int q = 0; q < 16; ++q) a[q] = 0.f;
            const LAS unsigned char* kp = lds + AT_KOFF + (32 * wid + 32 * i + r32) * AT_ROWB + 16 * h;
#pragma unroll
            for (int s = 0; s < 4; ++s) { const bf16x8 kf = *(const LAS bf16x8*)(kp + 32 * s); a = __builtin_amdgcn_mfma_f32_32x32x16_bf16(kf, qf[s], a, 0, 0, 0); }
            if (i == 0 || i == 4) {
#pragma unroll
                for (int q = 0; q < 16; ++q) {
                    const float diff = ((float)((q & 3) + 8 * (q >> 2)) + h4f) - r32f;
                    a[q] = (i == 0) ? __builtin_fmaf(fminf(diff, 0.f), 1e30f, a[q]) : __builtin_fmaf(fmaxf(diff, 0.f), -1e30f, a[q]);
                }
            }
#pragma unroll
            for (int q = 0; q < 16; ++q) mx = fmaxf(mx, a[q]);
        } else {
#pragma unroll
            for (int q = 0; q < 16; ++q) a[q] = -1e30f;
        }
        sc[i] = a;
    }
    mx = fmaxf(mx, __shfl_xor(mx, 32));
    float l = 0.f;
#pragma unroll
    for (int i = 0; i < 5; ++i)
#pragma unroll
        for (int q = 0; q < 16; ++q) { const float pv = __builtin_amdgcn_exp2f(sc[i][q] - mx); sc[i][q] = pv; l += pv; }
    l += __shfl_xor(l, 32);
    f32x16 o0, o1;
#pragma unroll
    for (int q = 0; q < 16; ++q) { o0[q] = 0.f; o1[q] = 0.f; }
    const int i16 = lane & 15, q4 = i16 >> 2, p4 = i16 & 3, blk = (lane >> 4) & 1;
#pragma unroll
    for (int i = 0; i < 5; ++i) {
        const bool tv = (ub > 0) || (wid + i >= 4);
        if (tv) {
#pragma unroll
            for (int s2 = 0; s2 < 2; ++s2) {
                u32x4 pw; pw.x = pk2(sc[i][8 * s2], sc[i][8 * s2 + 1]); pw.y = pk2(sc[i][8 * s2 + 2], sc[i][8 * s2 + 3]); pw.z = pk2(sc[i][8 * s2 + 4], sc[i][8 * s2 + 5]); pw.w = pk2(sc[i][8 * s2 + 6], sc[i][8 * s2 + 7]);
                const bf16x8 pb = __builtin_bit_cast(bf16x8, pw);
                const LAS unsigned char* vp = lds + AT_VOFF + (32 * wid + 32 * i + 16 * s2 + 4 * h + q4) * AT_ROWB + 32 * blk + 8 * p4;
                const s16x4 lo0 = vtr(vp), hi0 = vtr(vp + 8 * AT_ROWB), lo1 = vtr(vp + 64), hi1 = vtr(vp + 8 * AT_ROWB + 64);
                const bf16x8 va0 = __builtin_shufflevector(lo0, hi0, 0, 1, 2, 3, 4, 5, 6, 7), va1 = __builtin_shufflevector(lo1, hi1, 0, 1, 2, 3, 4, 5, 6, 7);
                o0 = __builtin_amdgcn_mfma_f32_32x32x16_bf16(va0, pb, o0, 0, 0, 0);
                o1 = __builtin_amdgcn_mfma_f32_32x32x16_bf16(va1, pb, o1, 0, 0, 0);
            }
        }
    }
    const float inv = 1.f / l;
    bf16_t* op = OB + ((size_t)pat * NT + qtok) * 256 + head * 64 + 4 * h;
#pragma unroll
    for (int g4 = 0; g4 < 4; ++g4) {
        u32x2 w0, w1;
        w0.x = pk2(o0[4 * g4] * inv, o0[4 * g4 + 1] * inv); w0.y = pk2(o0[4 * g4 + 2] * inv, o0[4 * g4 + 3] * inv);
        w1.x = pk2(o1[4 * g4] * inv, o1[4 * g4 + 1] * inv); w1.y = pk2(o1[4 * g4 + 2] * inv, o1[4 * g4 + 3] * inv);
        *(u32x2*)(op + 8 * g4) = w0; *(u32x2*)(op + 32 + 8 * g4) = w1;
    }
    if (h == 0) { f32x2v st = {mx, l}; ST[(qtok * 4 + head) * 3 + pat] = st; }
}

__device__ __forceinline__ void combine_rows(const bf16_t* YC, const bf16_t* OB, const f32x2v* ST, const float* gn, bf16_t* H, int gw, int ngw, int lane) {
    f32x4 gv[4];
#pragma unroll
    for (int j = 0; j < 4; ++j) gv[j] = ((const f32x4*)gn)[lane + 64 * j];
    const int head = lane >> 4;
    for (int m = gw; m < NT; m += ngw) {
        f32x4 v[4];
#pragma unroll
        for (int j = 0; j < 3; ++j) { const u32x2 w = *((const u32x2*)(YC + (size_t)m * 768 + 256 * j) + lane); v[j] = (f32x4){bflo(w.x), bfhi(w.x), bflo(w.y), bfhi(w.y)}; }
        {
            const f32x2v s0 = ST[((size_t)m * 4 + head) * 3 + 0], s1 = ST[((size_t)m * 4 + head) * 3 + 1], s2 = ST[((size_t)m * 4 + head) * 3 + 2];
            const float M = fmaxf(s0.x, fmaxf(s1.x, s2.x));
            const float w0 = __builtin_amdgcn_exp2f(s0.x - M) * s0.y, w1 = __builtin_amdgcn_exp2f(s1.x - M) * s1.y, w2 = __builtin_amdgcn_exp2f(s2.x - M) * s2.y;
            const float iw = 1.f / (w0 + w1 + w2);
            const u32x2 a0 = *((const u32x2*)(OB + (size_t)m * 256) + lane), a1 = *((const u32x2*)(OB + ((size_t)NT + m) * 256) + lane), a2 = *((const u32x2*)(OB + ((size_t)2 * NT + m) * 256) + lane);
            f32x4 o;
            o.x = (w0 * bflo(a0.x) + w1 * bflo(a1.x) + w2 * bflo(a2.x)) * iw; o.y = (w0 * bfhi(a0.x) + w1 * bfhi(a1.x) + w2 * bfhi(a2.x)) * iw;
            o.z = (w0 * bflo(a0.y) + w1 * bflo(a1.y) + w2 * bflo(a2.y)) * iw; o.w = (w0 * bfhi(a0.y) + w1 * bfhi(a1.y) + w2 * bfhi(a2.y)) * iw;
            v[3] = o;
        }
#pragma unroll
        for (int j = 0; j < 4; ++j) {
            const float ss = wave_sum((v[j].x * v[j].x + v[j].y * v[j].y) + (v[j].z * v[j].z + v[j].w * v[j].w));
            const float rs = rsqrtf(ss * (1.f / 256.f) + EPS);
            u32x2 w; w.x = pk2(v[j].x * rs * gv[j].x, v[j].y * rs * gv[j].y); w.y = pk2(v[j].z * rs * gv[j].z, v[j].w * rs * gv[j].w);
            *((u32x2*)(H + (size_t)m * DMODEL + 256 * j) + lane) = w;
        }
    }
}

constexpr int NPHASE = 19;
struct Ctx { const Args* args; LAS unsigned char* lds; int tid, lane, wid, G, bx, gw, ngw; };
#define CAS __attribute__((address_space(4)))
#define LAUNDER(p) asm volatile("" : "+s"(p))
__device__ __forceinline__ void phase_body(const int ph, const CAS Args* ap, LAS unsigned char* lds, const int tid, const int lane, const int wid, const int G, const int bx) {
    const int gw = bx * 8 + wid, ngw = G * 8;
    unsigned char* ws = ap->ws;
    const float* x_in = ap->in[0];
    float* X = ap->out;
    bf16_t* Hb = (bf16_t*)(ws + WS_H); bf16_t* Pb = (bf16_t*)(ws + WS_P); bf16_t* YC = (bf16_t*)(ws + WS_YC); bf16_t* ZB = (bf16_t*)(ws + WS_ZB); bf16_t* OB = (bf16_t*)(ws + WS_OB);
    f32x2v* ST = (f32x2v*)(ws + WS_ST);
    float* ropec = (float*)(ws + WS_ROPE); float* ropes = ropec + SEQ * 32;
    if (ph == 0) {
        for (int it = bx; it < 2 * 2976; it += G) {
            const int layer = it / 2976; int t = it % 2976;
            unsigned char* wb = ws + WS_W + (size_t)layer * W_LAYER;
            WMat w;
            if (t < 576) { w = WMat{ap->in[2] + (size_t)layer * 1024 * NIN, nullptr, 1024, NIN, NIN, 1, (bf16_t*)(wb + W_IN)}; }
            else if ((t -= 576) < 256) { w = WMat{ap->in[18] + (size_t)layer * 1024 * 1024, nullptr, 1024, 1024, 1024, 0, (bf16_t*)(wb + W_OUT)}; }
            else if ((t -= 256) < 1408) { w = WMat{ap->in[20] + (size_t)layer * 1024 * DFF, ap->in[21] + (size_t)layer * 1024 * DFF, 1024, 2 * DFF, DFF, 2, (bf16_t*)(wb + W_GU)}; }
            else if ((t -= 1408) < 704) { w = WMat{ap->in[22] + (size_t)layer * DFF * 1024, nullptr, DFF, 1024, 1024, 0, (bf16_t*)(wb + W_DN)}; }
            else { t -= 704; w = WMat{ap->in[16] + (size_t)layer * 256 * 512, ap->in[16] + (size_t)layer * 256 * 512 + 256, 256, 512, 512, 2, (bf16_t*)(wb + W_GLU)}; }
            wconv_tile((LAS float*)lds, w, t, tid);
        }
        for (int e = bx * NTHREADS + tid; e < SEQ * 32; e += G * NTHREADS) {
            const int pos = e >> 5, i = e & 31;
            const double inv = (double)exp2f(-(float)i * (13.287712379549449f / 32.f));
            const float angf = (float)pos * (float)inv;
            double rev = (double)angf * 0.15915494309189535; rev -= floor(rev);
            ropec[e] = __builtin_amdgcn_cosf((float)rev); ropes[e] = __builtin_amdgcn_sinf((float)rev);
        }
        norm_rows_bf16(x_in, ap->in[1], Hb, gw, ngw, lane);
        return;
    }
    const int layer = (ph - 1) / 9, sub = (ph - 1) % 9;
    unsigned char* wb = ws + WS_W + (size_t)layer * W_LAYER;
    if (sub == 0) {
        pg8::Gemm g{Hb, (const bf16_t*)(wb + W_IN), NT, NIN, 1024}; pg8::StaticOrder S; S.init(NT, NIN, G, bx);
        EpiIn E{Pb, ropec, ropes};
        pg8::gemm_phase<EpiIn, pg8::StaticOrder, true, true>(lds, g, S, E);
    } else if (sub == 1) {
        for (int it = bx; it < 256; it += G)
            ssm_item(lds, Pb, ZB, ap->in[8] + layer * 1024, ap->in[9] + layer * 1024, ap->in[10] + layer * 16, ap->in[11] + (size_t)layer * 16384, ap->in[12] + (size_t)layer * 16384,
                     ap->in[13] + (size_t)layer * 16384, ap->in[14] + (size_t)layer * 16384, ap->in[15] + layer * 256, it, tid, wid, lane);
        LAUNDER(ap);
        for (int it = bx; it < 2048; it += G)
            conv_tile(lds, Pb, YC, ap->in[3] + layer * 768, ap->in[4] + layer * 31 * 256, ap->in[5] + layer * 256, ap->in[6] + layer * 256, ap->in[7] + layer * 256, it, tid, wid, lane);
        LAUNDER(ap);
        for (int it = bx; it < 3072; it += G) attn_unit(lds, Pb, OB, ST, it, tid, wid, lane);
        __syncthreads();
    } else if (sub == 2) {
        pg8::Gemm g{ZB, (const bf16_t*)(wb + W_GLU), NT, 512, 256}; pg8::StaticOrder S; S.init(NT, 512, G, bx);
        EpiGate<1> E{YC, 768, 512};
        pg8::gemm_phase<EpiGate<1>, pg8::StaticOrder, true, true>(lds, g, S, E);
    } else if (sub == 3) {
        combine_rows(YC, OB, ST, ap->in[17] + layer * 1024, Hb, gw, ngw, lane);
    } else if (sub == 4) {
        pg8::Gemm g{Hb, (const bf16_t*)(wb + W_OUT), NT, 1024, 1024}; pg8::StaticOrder S; S.init(NT, 1024, G, bx);
        EpiRes E{layer == 0 ? x_in : (const float*)X, X};
        pg8::gemm_phase<EpiRes, pg8::StaticOrder, true, true>(lds, g, S, E);
    } else if (sub == 5) {
        norm_rows_bf16(X, ap->in[19] + layer * 1024, Hb, gw, ngw, lane);
    } else if (sub == 6) {
        pg8::Gemm g{Hb, (const bf16_t*)(wb + W_GU), NT, 2 * DFF, 1024}; pg8::StaticOrder S; S.init(NT, 2 * DFF, G, bx);
        EpiGate<0> E{Pb, DFF, 0};
        pg8::gemm_phase<EpiGate<0>, pg8::StaticOrder, true, true>(lds, g, S, E);
    } else if (sub == 7) {
        pg8::Gemm g{Pb, (const bf16_t*)(wb + W_DN), NT, 1024, DFF}; pg8::StaticOrder S; S.init(NT, 1024, G, bx);
        EpiRes E{(const float*)X, X};
        pg8::gemm_phase<EpiRes, pg8::StaticOrder, true, true>(lds, g, S, E);
    } else {
        if (layer == 0) norm_rows_bf16(X, ap->in[1] + 1024, Hb, gw, ngw, lane);
        else norm_rows_f32_inplace(X, ap->in[23], gw, ngw, lane);
    }
}
__global__ void __launch_bounds__(NTHREADS, 2) fwd_megakernel(Args args) {
    extern __shared__ __attribute__((aligned(16))) unsigned char lds_raw[];
    LAS unsigned char* lds = (LAS unsigned char*)lds_raw;
    cg::grid_group grid = cg::this_grid();
    const int tid = threadIdx.x, lane = tid & 63, wid = __builtin_amdgcn_readfirstlane(tid >> 6);
    const int G = gridDim.x, bx = blockIdx.x;
    const int lo = args.ph_lo, hi = args.ph_hi;
    const CAS Args* ap = (const CAS Args*)__builtin_amdgcn_kernarg_segment_ptr();
#define PHASE(k) if (lo <= (k) && (k) < hi) { if ((k) > lo) grid.sync(); LAUNDER(ap); phase_body((k), ap, lds, tid, lane, wid, G, bx); }
    PHASE(0) PHASE(1) PHASE(2) PHASE(3) PHASE(4) PHASE(5) PHASE(6) PHASE(7) PHASE(8) PHASE(9)
    PHASE(10) PHASE(11) PHASE(12) PHASE(13) PHASE(14) PHASE(15) PHASE(16) PHASE(17) PHASE(18)
#undef PHASE
}

extern "C" void kernel_launch(void* const* d_in, const int* in_sizes, int n_in, void* d_out, int out_size, void* d_ws, size_t ws_size, hipStream_t stream) {
    static int grid_blocks = 0;
    if (grid_blocks == 0) {
        if (n_in != 24 || ws_size < WS_END) { fprintf(stderr, "kernel_launch: unexpected n_in %d / ws_size %zu\n", n_in, ws_size); grid_blocks = -1; return; }
        int dev = 0, cus = 0, per_cu = 0;
        hipGetDevice(&dev);
        hipDeviceGetAttribute(&cus, hipDeviceAttributeMultiprocessorCount, dev);
        if (hipFuncSetAttribute((const void*)fwd_megakernel, hipFuncAttributeMaxDynamicSharedMemorySize, LDS_BYTES) != hipSuccess) { fprintf(stderr, "kernel_launch: hipFuncSetAttribute failed\n"); grid_blocks = -1; return; }
        if (hipOccupancyMaxActiveBlocksPerMultiprocessor(&per_cu, (const void*)fwd_megakernel, NTHREADS, LDS_BYTES) != hipSuccess || per_cu < 1) { fprintf(stderr, "kernel_launch: occupancy query %d\n", per_cu); per_cu = 1; }
        (void)hipGetLastError();
        grid_blocks = cus * per_cu;
    }
    if (grid_blocks < 0) return;
    Args a{};
    for (int i = 0; i < 24; ++i) a.in[i] = (const float*)d_in[i];
    a.out = (float*)d_out; a.ws = (unsigned char*)d_ws; a.ph_lo = 0; a.ph_hi = NPHASE;
    void* kargs[] = {&a};
    hipError_t e = hipLaunchCooperativeKernel((const void*)fwd_megakernel, dim3(grid_blocks), dim3(NTHREADS), kargs, LDS_BYTES, stream);
    if (e != hipSuccess) fprintf(stderr, "cooperative launch failed: %s (grid %d)\n", hipGetErrorString(e), grid_blocks);
}
```

```cpp
#include <hip/hip_runtime.h>
#include <hip/hip_cooperative_groups.h>
#include <cstdio>
#include <cstdint>
namespace cg = cooperative_groups;
namespace pg8 {
#define PG8_LAS __attribute__((address_space(3)))
typedef unsigned short bf16_t;
typedef short bf16x8 __attribute__((ext_vector_type(8)));
typedef float f32x4 __attribute__((ext_vector_type(4)));
typedef unsigned u32x4 __attribute__((ext_vector_type(4)));
constexpr int BM = 256, BK = 64, HALF = 128, HTB = HALF * BK * 2  , STAGE_BYTES = 8 * HTB, NXCD = 8, WGM = 8;

__host__ __device__ __forceinline__ int lds_byte(int r, int c) { const int st = (r >> 4) * 2 + (c >> 5), rr = r & 15, cc = c & 31, ob = rr * 64 + cc * 2; return st * 1024 + (ob ^ (((ob >> 9) & 1) << 5)); }
__host__ __device__ __forceinline__ void stage_rc(int b, int& R, int& C) { const int st = b / 1024, sb = b % 1024, swz = sb ^ (((sb >> 9) & 1) << 5); R = (st >> 1) * 16 + swz / 64; C = (st & 1) * 32 + (swz % 64) / 2; }
__host__ __device__ __forceinline__ int perm32(int rho) { const int n = rho >> 4, i = rho & 15; return 8 * (i >> 2) + 4 * n + (i & 3); }

struct Unit { int pm, pn; };
struct Gemm { const bf16_t* A; const bf16_t* Bt; int M, N, K; };

struct StaticOrder {
    int nM, nN, nwg, G, c;
    __host__ __device__ void init(int M, int N, int G_, int c_) { nM = M / BM; nN = N / BM; nwg = nM * nN; G = G_; c = c_; }
    __host__ __device__ bool next(int i, Unit& u) const {
        const long L = (long)i * G + c; if (L >= nwg) return false;
        int wgid = (int)L; { const int q = nwg / NXCD, r = nwg % NXCD, xcd = wgid % NXCD, off = wgid / NXCD; wgid = (xcd < r ? xcd * (q + 1) : r * (q + 1) + (xcd - r) * q) + off; }
        const int nig = WGM * nN, gid = wgid / nig, fm = gid * WGM, gsz = (nM - fm) < WGM ? (nM - fm) : WGM;
        u.pm = fm + ((wgid % nig) % gsz); u.pn = (wgid % nig) / gsz; return true;
    }
    __device__ __forceinline__ void a_ready(const Unit&) const {}
    __device__ __forceinline__ void done(const Unit&) const {}
};

__device__ __forceinline__ unsigned cvt_pk_bf16(float lo, float hi) { unsigned r; asm volatile("v_cvt_pk_bf16_f32 %0, %1, %2" : "=v"(r) : "v"(lo), "v"(hi)); return r; }
typedef float f32x2 __attribute__((ext_vector_type(2)));
template <class Epi, class Sched, bool ALIGN_EPI = false, bool SP2 = false>
__device__ __forceinline__ void gemm_phase(PG8_LAS unsigned char* lds, const Gemm g, const Sched& S, const Epi& E) {
    const int tid = threadIdx.x, wid = __builtin_amdgcn_readfirstlane(tid >> 6), lane = tid & 63, wr = wid >> 2, wc = wid & 3, fr = lane & 15, fq = lane >> 4;
    const int K = g.K, nt = K / BK;
    unsigned voffA[2], voffB[2];
#pragma unroll
    for (int i = 0; i < 2; ++i) { int R, C; stage_rc(tid * 16 + i * 8192, R, C); const int Rb = Epi::PERM ? ((R & ~31) + perm32(R & 31)) : R;
        voffA[i] = (unsigned)(R * K + C) * 2u; voffB[i] = (unsigned)(Rb * K + C) * 2u; }
    const size_t kstep = (size_t)(BK * 2);
    const size_t hstep = (size_t)HALF * K * 2;
    const size_t tstep = 2 * hstep;
    const unsigned ldsw = (unsigned)wid * 1024u;
    const int aoff = lds_byte(wr * 64 + fr, fq * 8), boff = lds_byte(wc * 32 + fr, fq * 8);
#define PG8_SA(b, h) (((b) * 2 + (h)) * HTB)
#define PG8_SB(b, h) ((4 + (b) * 2 + (h)) * HTB)
#define PG8_STAGE(bufoff, gbase, voff) do { _Pragma("unroll") for (int _i = 0; _i < 2; ++_i) \
        __builtin_amdgcn_global_load_lds((const unsigned*)((const char*)(gbase) + (voff)[_i]), (PG8_LAS unsigned*)(lds + (bufoff) + ldsw + _i * 8192), 16, 0, 0); } while (0)
#define PG8_LDA(dst, b, h) do { _Pragma("unroll") for (int m = 0; m < 4; ++m) _Pragma("unroll") for (int k = 0; k < 2; ++k) dst[m][k] = *(const PG8_LAS bf16x8*)(lds + PG8_SA(b, h) + aoff + m * 2048 + k * 1024); } while (0)
#define PG8_LDB(dst, b, h) do { _Pragma("unroll") for (int n = 0; n < 2; ++n) _Pragma("unroll") for (int k = 0; k < 2; ++k) dst[n][k] = *(const PG8_LAS bf16x8*)(lds + PG8_SB(b, h) + boff + n * 2048 + k * 1024); } while (0)
#define PG8_MMA(ai, bj, At, Bt) do { __builtin_amdgcn_s_setprio(1); _Pragma("unroll") for (int m = 0; m < 4; ++m) _Pragma("unroll") for (int n = 0; n < 2; ++n) _Pragma("unroll") for (int k = 0; k < 2; ++k) \
        acc[ai][bj][m][n] = __builtin_amdgcn_mfma_f32_16x16x32_bf16(Bt[n][k], At[m][k], acc[ai][bj][m][n], 0, 0, 0); __builtin_amdgcn_s_setprio(0); } while (0)
#define PG8_WAIT_V(n) asm volatile("s_waitcnt vmcnt(" #n ")" ::: "memory")
#define PG8_WAIT_L(n) asm volatile("s_waitcnt lgkmcnt(" #n ")" ::: "memory")
#define PG8_BAR __builtin_amdgcn_s_barrier()
#define PG8_SCHED __builtin_amdgcn_sched_barrier(0)
    Unit cur, nxt; int ui = 0;
    if (!S.next(0, cur)) return;
    f32x4 acc[2][2][4][2];
#pragma unroll
    for (int a = 0; a < 2; ++a)
#pragma unroll
        for (int b = 0; b < 2; ++b)
#pragma unroll
            for (int m = 0; m < 4; ++m)
#pragma unroll
                for (int n = 0; n < 2; ++n) acc[a][b][m][n] = (f32x4){0.f, 0.f, 0.f, 0.f};
    bf16x8 At[4][2], B0[2][2], B1[2][2];
    const char* cA = (const char*)g.A + (size_t)cur.pm * tstep; const char* cB = (const char*)g.Bt + (size_t)cur.pn * tstep;
    S.a_ready(cur);
    if constexpr (SP2) {
        PG8_STAGE(PG8_SB(0, 0), cB, voffB); PG8_STAGE(PG8_SB(0, 1), cB + hstep, voffB); PG8_STAGE(PG8_SA(0, 0), cA, voffA); PG8_STAGE(PG8_SA(0, 1), cA + hstep, voffA);
        if (wr == 1) PG8_BAR;
        PG8_WAIT_V(2); PG8_BAR;
        PG8_STAGE(PG8_SB(1, 0), cB + kstep, voffB); PG8_STAGE(PG8_SA(1, 0), cA + kstep, voffA); PG8_STAGE(PG8_SB(1, 1), cB + hstep + kstep, voffB);
        PG8_WAIT_V(6); PG8_BAR;
    } else {
        PG8_STAGE(PG8_SB(0, 0), cB, voffB); PG8_STAGE(PG8_SA(0, 0), cA, voffA); PG8_STAGE(PG8_SB(0, 1), cB + hstep, voffB); PG8_STAGE(PG8_SA(0, 1), cA + hstep, voffA);
        if (wr == 1) PG8_BAR;
        PG8_WAIT_V(4); PG8_BAR;
        PG8_STAGE(PG8_SB(1, 0), cB + kstep, voffB); PG8_STAGE(PG8_SA(1, 0), cA + kstep, voffA); PG8_STAGE(PG8_SB(1, 1), cB + hstep + kstep, voffB);
        PG8_WAIT_V(6); PG8_BAR;
    }
    for (;;) {
        const bool has_next = S.next(ui + 1, nxt);
        const char* nA = has_next ? (const char*)g.A + (size_t)nxt.pm * tstep : cA; const char* nB = has_next ? (const char*)g.Bt + (size_t)nxt.pn * tstep : cB;
#pragma nounroll
        for (int t = 0; t < nt; t += 2) {
            const bool last = (t == nt - 2);
            const char* a1 = cA + (size_t)(t + 1) * kstep;
            const char* a2 = last ? nA : cA + (size_t)(t + 2) * kstep; const char* b2 = last ? nB : cB + (size_t)(t + 2) * kstep;
            const char* a3 = a2 + kstep; const char* b3 = b2 + kstep;
            if (last && has_next) S.a_ready(nxt);
            if constexpr (SP2) {
            PG8_LDB(B0, 0, 0); PG8_LDB(B1, 0, 1); PG8_SCHED; PG8_LDA(At, 0, 0); PG8_STAGE(PG8_SA(1, 1), a1 + hstep, voffA);
            PG8_WAIT_V(8); PG8_WAIT_L(0); PG8_BAR; PG8_MMA(0, 0, At, B0); PG8_MMA(0, 1, At, B1); PG8_BAR; PG8_SCHED;
            PG8_LDA(At, 0, 1); PG8_STAGE(PG8_SB(0, 0), b2, voffB); PG8_STAGE(PG8_SB(0, 1), b2 + hstep, voffB); PG8_STAGE(PG8_SA(0, 0), a2, voffA);
            PG8_WAIT_V(8); PG8_WAIT_L(0); PG8_BAR; PG8_MMA(1, 0, At, B0); PG8_MMA(1, 1, At, B1); PG8_BAR; PG8_SCHED;
            PG8_LDB(B0, 1, 0); PG8_LDB(B1, 1, 1); PG8_SCHED; PG8_LDA(At, 1, 0); PG8_STAGE(PG8_SA(0, 1), a2 + hstep, voffA);
            PG8_WAIT_V(8); PG8_WAIT_L(0); PG8_BAR; PG8_MMA(0, 0, At, B0); PG8_MMA(0, 1, At, B1); PG8_BAR; PG8_SCHED;
            PG8_LDA(At, 1, 1); PG8_STAGE(PG8_SB(1, 0), b3, voffB); PG8_STAGE(PG8_SB(1, 1), b3 + hstep, voffB); PG8_STAGE(PG8_SA(1, 0), a3, voffA);
            PG8_WAIT_V(8); PG8_WAIT_L(0); PG8_BAR; PG8_MMA(1, 0, At, B0); PG8_MMA(1, 1, At, B1); PG8_BAR; PG8_SCHED;
            } else {
            PG8_LDB(B0, 0, 0); PG8_SCHED; PG8_LDA(At, 0, 0); PG8_STAGE(PG8_SA(1, 1), a1 + hstep, voffA);
            PG8_WAIT_L(8); PG8_BAR; PG8_WAIT_L(0); PG8_MMA(0, 0, At, B0); PG8_BAR; PG8_SCHED;
            PG8_LDB(B1, 0, 1); PG8_STAGE(PG8_SB(0, 0), b2, voffB);
            PG8_BAR; PG8_WAIT_L(0); PG8_MMA(0, 1, At, B1); PG8_BAR;
            PG8_LDA(At, 0, 1); PG8_STAGE(PG8_SA(0, 0), a2, voffA);
            PG8_BAR; PG8_WAIT_L(0); PG8_MMA(1, 0, At, B0); PG8_BAR; PG8_SCHED;
            PG8_STAGE(PG8_SB(0, 1), b2 + hstep, voffB);
            PG8_WAIT_V(6); PG8_BAR; PG8_MMA(1, 1, At, B1); PG8_BAR;
            PG8_LDB(B0, 1, 0); PG8_SCHED; PG8_LDA(At, 1, 0); PG8_STAGE(PG8_SA(0, 1), a2 + hstep, voffA);
            PG8_WAIT_L(8); PG8_BAR; PG8_WAIT_L(0); PG8_MMA(0, 0, At, B0); PG8_BAR; PG8_SCHED;
            PG8_LDB(B1, 1, 1); PG8_STAGE(PG8_SB(1, 0), b3, voffB);
            PG8_BAR; PG8_WAIT_L(0); PG8_MMA(0, 1, At, B1); PG8_BAR;
            PG8_LDA(At, 1, 1); PG8_STAGE(PG8_SA(1, 0), a3, voffA);
            PG8_BAR; PG8_WAIT_L(0); PG8_MMA(1, 0, At, B0); PG8_BAR; PG8_SCHED;
            PG8_STAGE(PG8_SB(1, 1), b3 + hstep, voffB);
            PG8_WAIT_V(6); PG8_BAR; PG8_MMA(1, 1, At, B1); PG8_BAR;
            }
        }
        if constexpr (ALIGN_EPI) { if (wr == 0) PG8_BAR; }
        if constexpr (!Epi::AFTER_DRAIN) { E(acc, cur, wr, wc, fr, fq); S.done(cur); }
        if (!has_next) break;
#pragma unroll
        for (int a = 0; a < 2; ++a)
#pragma unroll
            for (int b = 0; b < 2; ++b)
#pragma unroll
                for (int m = 0; m < 4; ++m)
#pragma unroll
                    for (int n = 0; n < 2; ++n) acc[a][b][m][n] = (f32x4){0.f, 0.f, 0.f, 0.f};
        cur = nxt; cA = nA; cB = nB; ++ui;
        if constexpr (ALIGN_EPI) { if (wr == 1) PG8_BAR; }
    }
    PG8_WAIT_V(0);
    if constexpr (!ALIGN_EPI) { if (wr == 0) PG8_BAR; }
    PG8_BAR;
    if constexpr (Epi::AFTER_DRAIN) { E.fused(acc, cur, wr, wc, fr, fq, lds, wid, lane); S.done(cur); }
#undef PG8_SA
#undef PG8_SB
#undef PG8_STAGE
#undef PG8_LDA
#undef PG8_LDB
#undef PG8_MMA
#undef PG8_WAIT_V
#undef PG8_WAIT_L
#undef PG8_BAR
#undef PG8_SCHED
}
}
#ifndef REPEAT_MASK
#define REPEAT_MASK 0u
#endif
#ifndef EXTRA_SYNCS
#define EXTRA_SYNCS 0
#endif
#ifndef REP_SSM
#define REP_SSM 1
#endif
#ifndef REP_CONV
#define REP_CONV 1
#endif
#ifndef REP_ATTN
#define REP_ATTN 1
#endif

#define LAS __attribute__((address_space(3)))
typedef unsigned short bf16_t;
typedef short bf16x8 __attribute__((ext_vector_type(8)));
typedef short s16x4 __attribute__((ext_vector_type(4)));
typedef float f32x4 __attribute__((ext_vector_type(4)));
typedef float f32x16 __attribute__((ext_vector_type(16)));
typedef unsigned u32x4 __attribute__((ext_vector_type(4)));
typedef unsigned u32x2 __attribute__((ext_vector_type(2)));
typedef float f32x2v __attribute__((ext_vector_type(2)));
typedef __bf16 bf16x2v __attribute__((ext_vector_type(2)));

constexpr int NT = 65536, SEQ = 4096, DMODEL = 1024, NIN = 2304, DFF = 2816;
constexpr float EPS = 1e-6f;
constexpr float C2 = 0.125f * 1.4426950408889634f;
constexpr size_t MiB = (size_t)1 << 20;
constexpr size_t W_IN = 0, W_OUT = W_IN + (size_t)NIN * 1024 * 2, W_GU = W_OUT + (size_t)1024 * 1024 * 2, W_DN = W_GU + (size_t)2 * DFF * 1024 * 2,
                 W_GLU = W_DN + (size_t)1024 * DFF * 2, W_LAYER = 24 * MiB;
static_assert(W_GLU + 512 * 256 * 2 <= W_LAYER, "weight block");
constexpr size_t WS_W = 0, WS_ROPE = 48 * MiB, WS_H = 64 * MiB, WS_P = 192 * MiB, WS_YC = 544 * MiB, WS_ZB = 640 * MiB, WS_OB = 672 * MiB, WS_ST = 768 * MiB, WS_BAR = 776 * MiB, WS_END = 777 * MiB;
constexpr int LDS_BYTES = 147456;
constexpr int NTHREADS = 512;

struct Args {
    const float* in[24];
    float* out;
    unsigned char* ws;
    int ph_lo, ph_hi;
};

__device__ __forceinline__ unsigned pk2(float lo, float hi) { f32x2v v = {lo, hi}; bf16x2v b = __builtin_convertvector(v, bf16x2v); return __builtin_bit_cast(unsigned, b); }
__device__ __forceinline__ float bflo(unsigned u) { return __uint_as_float(u << 16); }
__device__ __forceinline__ float bfhi(unsigned u) { return __uint_as_float(u & 0xffff0000u); }
__device__ __forceinline__ float wave_sum(float v) {
#pragma unroll
    for (int o = 1; o < 64; o <<= 1) v += __shfl_xor(v, o);
    return v;
}
__device__ __forceinline__ float sigmoidf_(float x) { return 1.f / (1.f + __expf(-x)); }
__device__ __forceinline__ float gelu_tanh(float y) {
    const float a = 0.7978845608028654f * (y + 0.044715f * y * y * y);
    const float t = 1.f - 2.f / (__expf(2.f * a) + 1.f);
    return 0.5f * y * (1.f + t);
}
#define WAVE_LDS_SYNC() asm volatile("s_waitcnt lgkmcnt(0)" ::: "memory")

struct EpiIn {
    static constexpr bool PERM = true, AFTER_DRAIN = false;
    bf16_t* O; const float* ropec; const float* ropes;
    __device__ __forceinline__ void operator()(const f32x4 (&acc)[2][2][4][2], const pg8::Unit& u, int wr, int wc, int fr, int fq) const {
        const int row0 = u.pm * 256 + wr * 64 + fr;
        if (u.pn == 6 || u.pn == 7) {
            const float sc = (u.pn == 6) ? C2 : 1.f;
            const int dimb = 16 * (wc & 1) + 4 * fq;
#pragma unroll
            for (int ai = 0; ai < 2; ++ai)
#pragma unroll
                for (int m = 0; m < 4; ++m) {
                    const int row = row0 + ai * 128 + m * 16; const int pos = row & (SEQ - 1);
                    const f32x4 cs = *(const f32x4*)(ropec + pos * 32 + dimb), sn = *(const f32x4*)(ropes + pos * 32 + dimb);
                    bf16_t* rowp = O + (size_t)row * NIN + u.pn * 256 + 64 * (wc >> 1) + dimb;
#pragma unroll
                    for (int bj = 0; bj < 2; ++bj) {
                        const f32x4 x1 = acc[ai][bj][m][0] * sc, x2 = acc[ai][bj][m][1] * sc;
                        const f32x4 o1 = x1 * cs - x2 * sn, o2 = x2 * cs + x1 * sn;
                        u32x2 w1, w2; w1.x = pk2(o1[0], o1[1]); w1.y = pk2(o1[2], o1[3]); w2.x = pk2(o2[0], o2[1]); w2.y = pk2(o2[2], o2[3]);
                        *(u32x2*)(rowp + bj * 128) = w1; *(u32x2*)(rowp + bj * 128 + 32) = w2;
                    }
                }
        } else {
#pragma unroll
            for (int ai = 0; ai < 2; ++ai)
#pragma unroll
                for (int m = 0; m < 4; ++m) {
                    bf16_t* rowp = O + (size_t)(row0 + ai * 128 + m * 16) * NIN + u.pn * 256 + wc * 32 + 8 * fq;
#pragma unroll
                    for (int bj = 0; bj < 2; ++bj) {
                        const f32x4 v0 = acc[ai][bj][m][0], v1 = acc[ai][bj][m][1];
                        u32x4 w; w.x = pk2(v0[0], v0[1]); w.y = pk2(v0[2], v0[3]); w.z = pk2(v1[0], v1[1]); w.w = pk2(v1[2], v1[3]);
                        *(u32x4*)(rowp + bj * 128) = w;
                    }
                }
        }
    }
};
struct EpiRes {
    static constexpr bool PERM = true, AFTER_DRAIN = false;
    const float* res; float* out;
    __device__ __forceinline__ void operator()(const f32x4 (&acc)[2][2][4][2], const pg8::Unit& u, int wr, int wc, int fr, int fq) const {
        const int row0 = u.pm * 256 + wr * 64 + fr, col0 = u.pn * 256 + wc * 32 + 8 * fq;
#pragma unroll
        for (int ai = 0; ai < 2; ++ai)
#pragma unroll
            for (int m = 0; m < 4; ++m) {
                const size_t off = (size_t)(row0 + ai * 128 + m * 16) * DMODEL + col0;
#pragma unroll
                for (int bj = 0; bj < 2; ++bj) {
                    const f32x4 r0 = *(const f32x4*)(res + off + bj * 128), r1 = *(const f32x4*)(res + off + bj * 128 + 4);
                    *(f32x4*)(out + off + bj * 128) = r0 + acc[ai][bj][m][0];
                    *(f32x4*)(out + off + bj * 128 + 4) = r1 + acc[ai][bj][m][1];
                }
            }
    }
};
template <int MODE  > struct EpiGate {
    static constexpr bool PERM = true, AFTER_DRAIN = false;
    bf16_t* O; int ldc; int coff;
    __device__ __forceinline__ void operator()(const f32x4 (&acc)[2][2][4][2], const pg8::Unit& u, int wr, int wc, int fr, int fq) const {
        const int row0 = u.pm * 256 + wr * 64 + fr, col0 = coff + u.pn * 128 + wc * 32 + 8 * fq;
#pragma unroll
        for (int ai = 0; ai < 2; ++ai)
#pragma unroll
            for (int m = 0; m < 4; ++m) {
                float r[8];
#pragma unroll
                for (int n = 0; n < 2; ++n)
#pragma unroll
                    for (int j = 0; j < 4; ++j) {
                        const float a = acc[ai][0][m][n][j], b = acc[ai][1][m][n][j];
                        r[4 * n + j] = (MODE == 0) ? (a * sigmoidf_(a)) * b : a * sigmoidf_(b);
                    }
                u32x4 w; w.x = pk2(r[0], r[1]); w.y = pk2(r[2], r[3]); w.z = pk2(r[4], r[5]); w.w = pk2(r[6], r[7]);
                *(u32x4*)(O + (size_t)(row0 + ai * 128 + m * 16) * ldc + col0) = w;
            }
    }
};

struct WMat { const float* src; const float* src2; int K, N, ldw, kind; bf16_t* dst; };
__device__ __forceinline__ void wconv_tile(LAS float* tile, const WMat& w, int t, int tid) {
    const int nkt = w.K / 64, jt = t / nkt, kt = t % nkt, j0 = jt * 64, k0 = kt * 64;
    {
        const int j = j0 + (tid & 63);
        const float* s = w.src; int col = j;
        if (w.kind == 1) {
            if (j >= 1536 && j < 2048) { const int ww = j & 63; col = (j & ~63) + 32 * ((ww >> 2) & 1) + 16 * (ww >> 5) + 4 * ((ww >> 3) & 3) + (ww & 3); }
        } else if (w.kind == 2) {
            const int pn = j >> 8, wi = j & 255; if (wi < 128) col = pn * 128 + wi; else { s = w.src2; col = pn * 128 + (wi - 128); }
        }
        const int kk = tid >> 6;
#pragma unroll
        for (int i = 0; i < 8; ++i) { const int k = kk + 8 * i; tile[k * 65 + (tid & 63)] = s[(size_t)(k0 + k) * w.ldw + col]; }
    }
    __syncthreads();
    {
        const int jr = tid >> 3, c = tid & 7; const LAS float* s = tile + (8 * c) * 65 + jr;
        u32x4 o; o.x = pk2(s[0], s[65]); o.y = pk2(s[2 * 65], s[3 * 65]); o.z = pk2(s[4 * 65], s[5 * 65]); o.w = pk2(s[6 * 65], s[7 * 65]);
        *(u32x4*)(w.dst + (size_t)(j0 + jr) * w.K + k0 + 8 * c) = o;
    }
    __syncthreads();
}

__device__ __forceinline__ void norm_rows_bf16(const float* X, const float* g, bf16_t* H, int gw, int ngw, int lane) {
    f32x4 gv[4];
#pragma unroll
    for (int j = 0; j < 4; ++j) gv[j] = ((const f32x4*)g)[lane + 64 * j];
    for (int m = gw; m < NT; m += ngw) {
        const f32x4* xr = (const f32x4*)(X + (size_t)m * DMODEL) + lane;
        f32x4 v[4]; float s = 0.f;
#pragma unroll
        for (int j = 0; j < 4; ++j) { v[j] = xr[64 * j]; s += (v[j].x * v[j].x + v[j].y * v[j].y) + (v[j].z * v[j].z + v[j].w * v[j].w); }
        const float rs = rsqrtf(wave_sum(s) * (1.f / DMODEL) + EPS);
        u32x2* o = (u32x2*)(H + (size_t)m * DMODEL) + lane;
#pragma unroll
        for (int j = 0; j < 4; ++j) { u32x2 w; w.x = pk2(v[j].x * rs * gv[j].x, v[j].y * rs * gv[j].y); w.y = pk2(v[j].z * rs * gv[j].z, v[j].w * rs * gv[j].w); o[64 * j] = w; }
    }
}
__device__ __forceinline__ void norm_rows_f32_inplace(float* X, const float* g, int gw, int ngw, int lane) {
    f32x4 gv[4];
#pragma unroll
    for (int j = 0; j < 4; ++j) gv[j] = ((const f32x4*)g)[lane + 64 * j];
    for (int m = gw; m < NT; m += ngw) {
        f32x4* xr = (f32x4*)(X + (size_t)m * DMODEL) + lane;
        f32x4 v[4]; float s = 0.f;
#pragma unroll
        for (int j = 0; j < 4; ++j) { v[j] = xr[64 * j]; s += (v[j].x * v[j].x + v[j].y * v[j].y) + (v[j].z * v[j].z + v[j].w * v[j].w); }
        const float rs = rsqrtf(wave_sum(s) * (1.f / DMODEL) + EPS);
#pragma unroll
        for (int j = 0; j < 4; ++j) xr[64 * j] = v[j] * rs * gv[j];
    }
}

__device__ __forceinline__ void conv_tile(LAS unsigned char* lds, const bf16_t* P, bf16_t* YC, const float* w3, const float* dww, const float* dwb, const float* lng, const float* lnb,
                                          int tix, int tid, int wid, int lane) {
    const int b = tix >> 7, t0 = (tix & 127) * 32;
    LAS float* ZT = (LAS float*)lds;
    LAS float* YT = (LAS float*)(lds + 63488);
    __syncthreads();
    for (int e = tid; e < 62 * 32; e += NTHREADS) {
        const int row = e >> 5, c8 = e & 31, t = t0 - 30 + row;
        f32x4 z0 = {0.f, 0.f, 0.f, 0.f}, z1 = z0;
        if (t >= 0) {
            const bf16_t* src = P + (size_t)(b * SEQ + t) * NIN + 768 + c8 * 8;
            const u32x4 a = *(const u32x4*)src, g = *(const u32x4*)(src + 256);
            z0[0] = bflo(a.x) * sigmoidf_(bflo(g.x)); z0[1] = bfhi(a.x) * sigmoidf_(bfhi(g.x)); z0[2] = bflo(a.y) * sigmoidf_(bflo(g.y)); z0[3] = bfhi(a.y) * sigmoidf_(bfhi(g.y));
            z1[0] = bflo(a.z) * sigmoidf_(bflo(g.z)); z1[1] = bfhi(a.z) * sigmoidf_(bfhi(g.z)); z1[2] = bflo(a.w) * sigmoidf_(bflo(g.w)); z1[3] = bfhi(a.w) * sigmoidf_(bfhi(g.w));
        }
        *(LAS f32x4*)(ZT + row * 256 + c8 * 8) = z0; *(LAS f32x4*)(ZT + row * 256 + c8 * 8 + 4) = z1;
    }
    {
        const int tl = tid >> 4, cgp = tid & 15, t = t0 + tl; const size_t tok = (size_t)b * SEQ + t;
#pragma unroll
        for (int half = 0; half < 2; ++half) {
            const int c0 = cgp * 16 + half * 8;
            const bf16_t* src = P + tok * NIN + c0;
            float g0[8], g1[8], g2[8], bb[8];
            { const u32x4 hh = *(const u32x4*)src, bv = *(const u32x4*)(src + 256), cc = *(const u32x4*)(src + 512);
              g2[0] = bflo(hh.x) * bflo(cc.x); g2[1] = bfhi(hh.x) * bfhi(cc.x); g2[2] = bflo(hh.y) * bflo(cc.y); g2[3] = bfhi(hh.y) * bfhi(cc.y);
              g2[4] = bflo(hh.z) * bflo(cc.z); g2[5] = bfhi(hh.z) * bfhi(cc.z); g2[6] = bflo(hh.w) * bflo(cc.w); g2[7] = bfhi(hh.w) * bfhi(cc.w);
              bb[0] = bflo(bv.x); bb[1] = bfhi(bv.x); bb[2] = bflo(bv.y); bb[3] = bfhi(bv.y); bb[4] = bflo(bv.z); bb[5] = bfhi(bv.z); bb[6] = bflo(bv.w); bb[7] = bfhi(bv.w); }
#pragma unroll
            for (int i = 0; i < 8; ++i) { g1[i] = 0.f; g0[i] = 0.f; }
            if (t >= 1) { const u32x4 hh = *(const u32x4*)(src - NIN), cc = *(const u32x4*)(src - NIN + 512);
              g1[0] = bflo(hh.x) * bflo(cc.x); g1[1] = bfhi(hh.x) * bfhi(cc.x); g1[2] = bflo(hh.y) * bflo(cc.y); g1[3] = bfhi(hh.y) * bfhi(cc.y);
              g1[4] = bflo(hh.z) * bflo(cc.z); g1[5] = bfhi(hh.z) * bfhi(cc.z); g1[6] = bflo(hh.w) * bflo(cc.w); g1[7] = bfhi(hh.w) * bfhi(cc.w); }
            if (t >= 2) { const u32x4 hh = *(const u32x4*)(src - 2 * NIN), cc = *(const u32x4*)(src - 2 * NIN + 512);
              g0[0] = bflo(hh.x) * bflo(cc.x); g0[1] = bfhi(hh.x) * bfhi(cc.x); g0[2] = bflo(hh.y) * bflo(cc.y); g0[3] = bfhi(hh.y) * bfhi(cc.y);
              g0[4] = bflo(hh.z) * bflo(cc.z); g0[5] = bfhi(hh.z) * bfhi(cc.z); g0[6] = bflo(hh.w) * bflo(cc.w); g0[7] = bfhi(hh.w) * bfhi(cc.w); }
            float y[8];
#pragma unroll
            for (int i = 0; i < 8; ++i) y[i] = bb[i] * (w3[c0 + i] * g0[i] + w3[256 + c0 + i] * g1[i] + w3[512 + c0 + i] * g2[i]);
            u32x4 w; w.x = pk2(y[0], y[1]); w.y = pk2(y[2], y[3]); w.z = pk2(y[4], y[5]); w.w = pk2(y[6], y[7]);
            *(u32x4*)(YC + tok * 768 + c0) = w;
        }
    }
    __syncthreads();
    {
        const int c = tid & 255, th = tid >> 8;
        float w[31];
#pragma unroll
        for (int k = 0; k < 31; ++k) w[k] = dww[k * 256 + c];
        const float bias = dwb[c];
        for (int j = 0; j < 16; ++j) {
            const int tl = th * 16 + j; float a = bias;
            const LAS float* zp = ZT + tl * 256 + c;
#pragma unroll
            for (int k = 0; k < 31; ++k) a += w[k] * zp[k * 256];
            YT[tl * 256 + c] = a;
        }
    }
    __syncthreads();
    {
        const f32x4 gg = ((const f32x4*)lng)[lane], bbv = ((const f32x4*)lnb)[lane];
#pragma unroll
        for (int q = 0; q < 4; ++q) {
            const int tl = wid * 4 + q;
            f32x4 v = *(const LAS f32x4*)(YT + tl * 256 + lane * 4);
            const float mean = wave_sum((v.x + v.y) + (v.z + v.w)) * (1.f / 256.f);
            v = v - mean;
            const float var = wave_sum((v.x * v.x + v.y * v.y) + (v.z * v.z + v.w * v.w)) * (1.f / 256.f);
            const float rs = rsqrtf(var + EPS);
            f32x4 y = v * rs * gg + bbv;
            y.x = y.x * sigmoidf_(y.x); y.y = y.y * sigmoidf_(y.y); y.z = y.z * sigmoidf_(y.z); y.w = y.w * sigmoidf_(y.w);
            u32x2 wv; wv.x = pk2(y.x, y.y); wv.y = pk2(y.z, y.w);
            *(u32x2*)(YC + ((size_t)b * SEQ + t0 + tl) * 768 + 256 + lane * 4) = wv;
        }
    }
}

template <bool FULL> __device__ __forceinline__ void ssm_tile_scan(f32x16& xr, f32x16& xi, const float (&pw)[4][2], float& cr, float& ci, const bool hi) {
    const float l1r = pw[0][0], l1i = pw[0][1], l4r = pw[3][0], l4i = pw[3][1];
#pragma unroll
    for (int G = 0; G < 4; ++G)
#pragma unroll
        for (int j = 1; j < 4; ++j) { const int i = 4 * G + j; const float pr = xr[i - 1], pi = xi[i - 1]; xr[i] += l1r * pr - l1i * pi; xi[i] += l1r * pi + l1i * pr; }
    float cinr[4], cini[4];
#pragma unroll
    for (int G = 0; G < 4; ++G) {
        const float er = xr[4 * G + 3], ei = xi[4 * G + 3];
        const float orr = __shfl_xor(er, 32), oi = __shfl_xor(ei, 32);
        const float e0r = hi ? orr : er, e0i = hi ? oi : ei, e1r = hi ? er : orr, e1i = hi ? ei : oi;
        const float c1r = l4r * cr - l4i * ci + e0r, c1i = l4r * ci + l4i * cr + e0i;
        cinr[G] = hi ? c1r : cr; cini[G] = hi ? c1i : ci;
        const float c2r = l4r * c1r - l4i * c1i + e1r, c2i = l4r * c1i + l4i * c1r + e1i;
        cr = c2r; ci = c2i;
    }
    if (FULL) {
#pragma unroll
        for (int G = 0; G < 4; ++G)
#pragma unroll
            for (int j = 0; j < 4; ++j) { const int i = 4 * G + j; xr[i] += pw[j][0] * cinr[G] - pw[j][1] * cini[G]; xi[i] += pw[j][0] * cini[G] + pw[j][1] * cinr[G]; }
    }
}
constexpr int SSM_ROWB = 272;
__device__ __forceinline__ void ssm_item(LAS unsigned char* lds, const bf16_t* P, bf16_t* ZB, const float* a_re, const float* a_im, const float* log_dt, const float* b_re, const float* b_im,
                                         const float* c_re, const float* c_im, const float* d_skip, int item, int tid, int wid, int lane) {
    const int b = item >> 4, g = item & 15;
    const int r32 = lane & 31, h = lane >> 5; const bool hi = h != 0;
    LAS f32x2v* EW = (LAS f32x2v*)lds;
    LAS unsigned char* SBW = lds + 4096 + wid * (32 * SSM_ROWB);
    __syncthreads();
    float pw[2][4][2]; bf16x8 bfr[2][2];
#pragma unroll
    for (int tp = 0; tp < 2; ++tp) {
        const int p = r32 + 32 * tp;
        const float dt = __expf(log_dt[g]);
        const float ar = a_re[g * 64 + p], ai = a_im[g * 64 + p];
        const float mag = __expf(ar * dt);
        const float lr = mag * cosf(ai * dt), li = mag * sinf(ai * dt);
        const float den = ar * ar + ai * ai, nr = lr - 1.f, ni = li;
        const float fr = (nr * ar + ni * ai) / den, fi = (ni * ar - nr * ai) / den;
        const f32x4* br4 = (const f32x4*)(b_re + (size_t)(g * 64 + p) * 16 + 8 * h); const f32x4* bi4 = (const f32x4*)(b_im + (size_t)(g * 64 + p) * 16 + 8 * h);
        const f32x4 r0 = br4[0], r1 = br4[1], i0 = bi4[0], i1 = bi4[1];
        const f32x4 re0 = fr * r0 - fi * i0, re1 = fr * r1 - fi * i1, im0 = fr * i0 + fi * r0, im1 = fr * i1 + fi * r1;
        u32x4 wre, wim;
        wre.x = pk2(re0[0], re0[1]); wre.y = pk2(re0[2], re0[3]); wre.z = pk2(re1[0], re1[1]); wre.w = pk2(re1[2], re1[3]);
        wim.x = pk2(im0[0], im0[1]); wim.y = pk2(im0[2], im0[3]); wim.z = pk2(im1[0], im1[1]); wim.w = pk2(im1[2], im1[3]);
        bfr[tp][0] = __builtin_bit_cast(bf16x8, wre); bfr[tp][1] = __builtin_bit_cast(bf16x8, wim);
        pw[tp][0][0] = lr; pw[tp][0][1] = li;
#pragma unroll
        for (int j = 1; j < 4; ++j) { pw[tp][j][0] = pw[tp][j - 1][0] * lr - pw[tp][j - 1][1] * li; pw[tp][j][1] = pw[tp][j - 1][0] * li + pw[tp][j - 1][1] * lr; }
    }
    const int t16 = lane & 15, quad = lane >> 4;
    bf16x8 cfr[4];
#pragma unroll
    for (int s = 0; s < 4; ++s) {
        const f32x4 cr4 = *(const f32x4*)(c_re + (size_t)(g * 16 + t16) * 64 + 4 * quad + 16 * s), ci4 = *(const f32x4*)(c_im + (size_t)(g * 16 + t16) * 64 + 4 * quad + 16 * s);
        u32x4 w; w.x = pk2(cr4[0], -ci4[0]); w.y = pk2(cr4[1], -ci4[1]); w.z = pk2(cr4[2], -ci4[2]); w.w = pk2(cr4[3], -ci4[3]);
        cfr[s] = __builtin_bit_cast(bf16x8, w);
    }
    const f32x4 dsk = *(const f32x4*)(d_skip + g * 16 + 4 * quad);
    const size_t tok0 = (size_t)b * SEQ + (size_t)wid * 512;
    const bf16_t* ubase = P + tok0 * NIN + 1280 + g * 16;
    f32x16 zero16;
#pragma unroll
    for (int q = 0; q < 16; ++q) zero16[q] = 0.f;
    float cr[2] = {0.f, 0.f}, ci[2] = {0.f, 0.f};
    {
        bf16x8 ua = *(const bf16x8*)(ubase + (size_t)r32 * NIN + 8 * h);
        for (int mt = 0; mt < 16; ++mt) {
            const bf16x8 un = *(const bf16x8*)(ubase + (size_t)((mt < 15 ? mt + 1 : mt) * 32 + r32) * NIN + 8 * h);
#pragma unroll
            for (int tp = 0; tp < 2; ++tp) {
                f32x16 xr = __builtin_amdgcn_mfma_f32_32x32x16_bf16(ua, bfr[tp][0], zero16, 0, 0, 0);
                f32x16 xi = __builtin_amdgcn_mfma_f32_32x32x16_bf16(ua, bfr[tp][1], zero16, 0, 0, 0);
                ssm_tile_scan<false>(xr, xi, pw[tp], cr[tp], ci[tp], hi);
            }
            ua = un;
        }
    }
    if (!hi) { f32x2v e0 = {cr[0], ci[0]}, e1 = {cr[1], ci[1]}; EW[wid * 64 + r32] = e0; EW[wid * 64 + 32 + r32] = e1; }
    __syncthreads();
#pragma unroll
    for (int tp = 0; tp < 2; ++tp) {
        float qr = pw[tp][3][0], qi = pw[tp][3][1];
#pragma unroll
        for (int q = 0; q < 7; ++q) { const float nr = qr * qr - qi * qi, ni = 2.f * qr * qi; qr = nr; qi = ni; }
        float sr = 0.f, si = 0.f;
        for (int w = 0; w < wid; ++w) { const f32x2v e = EW[w * 64 + r32 + 32 * tp]; const float nr = qr * sr - qi * si + e.x, ni = qr * si + qi * sr + e.y; sr = nr; si = ni; }
        cr[tp] = sr; ci[tp] = si;
    }
    {
        bf16x8 ua = *(const bf16x8*)(ubase + (size_t)r32 * NIN + 8 * h);
        for (int mt = 0; mt < 16; ++mt) {
            const bf16x8 un = *(const bf16x8*)(ubase + (size_t)((mt < 15 ? mt + 1 : mt) * 32 + r32) * NIN + 8 * h);
            u32x2 uwv[2];
#pragma unroll
            for (int tt = 0; tt < 2; ++tt) uwv[tt] = *(const u32x2*)(P + (tok0 + mt * 32 + tt * 16 + t16) * NIN + 1280 + g * 16 + 4 * quad);
#pragma unroll
            for (int tp = 0; tp < 2; ++tp) {
                f32x16 xr = __builtin_amdgcn_mfma_f32_32x32x16_bf16(ua, bfr[tp][0], zero16, 0, 0, 0);
                f32x16 xi = __builtin_amdgcn_mfma_f32_32x32x16_bf16(ua, bfr[tp][1], zero16, 0, 0, 0);
                ssm_tile_scan<true>(xr, xi, pw[tp], cr[tp], ci[tp], hi);
#pragma unroll
                for (int i = 0; i < 16; ++i) {
                    const int t = (i & 3) + 8 * (i >> 2) + 4 * h;
                    *(LAS unsigned*)(SBW + t * SSM_ROWB + 4 * (r32 + 32 * tp)) = pk2(xr[i], xi[i]);
                }
            }
            WAVE_LDS_SYNC();
#pragma unroll
            for (int tt = 0; tt < 2; ++tt) {
                f32x4 acc = {0.f, 0.f, 0.f, 0.f};
#pragma unroll
                for (int s = 0; s < 4; ++s) {
                    const bf16x8 sf = *(const LAS bf16x8*)(SBW + (tt * 16 + t16) * SSM_ROWB + quad * 16 + 64 * s);
                    acc = __builtin_amdgcn_mfma_f32_16x16x32_bf16(cfr[s], sf, acc, 0, 0, 0);
                }
                const size_t tok = tok0 + mt * 32 + tt * 16 + t16;
                const u32x2 uw = uwv[tt];
                const f32x4 uu = {bflo(uw.x), bfhi(uw.x), bflo(uw.y), bfhi(uw.y)};
                const f32x4 y = acc + dsk * uu;
                u32x2 w; w.x = pk2(gelu_tanh(y.x), gelu_tanh(y.y)); w.y = pk2(gelu_tanh(y.z), gelu_tanh(y.w));
                *(u32x2*)(ZB + tok * 256 + g * 16 + 4 * quad) = w;
            }
            WAVE_LDS_SYNC();
            ua = un;
        }
    }
}

constexpr int AT_ROWB = 144, AT_KOFF = 0, AT_VOFF = 384 * AT_ROWB;
__device__ __forceinline__ s16x4 vtr(const LAS unsigned char* p) { return __builtin_bit_cast(s16x4, __builtin_amdgcn_ds_read_tr16_b64_v4i16((LAS s16x4*)p)); }
struct AttnU { int pat, head, d, ub; size_t rowbase; };
__device__ __forceinline__ AttnU attn_decode(int u) {
    AttnU U; const int rem = u & 1023, b = rem >> 6, ru = rem & 15; U.pat = u >> 10; U.head = (rem >> 4) & 3;
    int r;
    if (U.pat == 0) { U.d = 1; r = 0; U.ub = ru; } else if (U.pat == 1) { U.d = 4; r = ru & 3; U.ub = ru >> 2; } else { U.d = 16; r = ru; U.ub = 0; }
    U.rowbase = (size_t)b * SEQ + r; return U;
}
__device__ __forceinline__ void attn_issue(const bf16_t* P, const AttnU& U, int tid, int wid, int lane, u32x4 (&kreg)[6], u32x4 (&vreg)[6], bf16x8 (&qf)[4]) {
    const int i0 = U.ub * 256 - 128;
#pragma unroll
    for (int k = 0; k < 6; ++k) {
        const int e = tid + NTHREADS * k, row = e >> 3, c = e & 7; int si = i0 + row; si = si < 0 ? 0 : si;
        const bf16_t* src = P + (U.rowbase + (size_t)si * U.d) * NIN + U.head * 64 + c * 8;
        kreg[k] = *(const u32x4*)(src + 1792); vreg[k] = *(const u32x4*)(src + 2048);
    }
    const int r32 = lane & 31, h = lane >> 5;
    const size_t qtok = U.rowbase + (size_t)(U.ub * 256 + 32 * wid + r32) * U.d;
    const bf16_t* qp = P + qtok * NIN + 1536 + U.head * 64 + 8 * h;
#pragma unroll
    for (int s = 0; s < 4; ++s) qf[s] = *(const bf16x8*)(qp + 16 * s);
}
__device__ __forceinline__ void attn_to_lds(LAS unsigned char* lds, int tid, const u32x4 (&kreg)[6], const u32x4 (&vreg)[6]) {
#pragma unroll
    for (int k = 0; k < 6; ++k) {
        const int e = tid + NTHREADS * k, row = e >> 3, c = e & 7;
        *(LAS u32x4*)(lds + AT_KOFF + row * AT_ROWB + c * 16) = kreg[k];
        *(LAS u32x4*)(lds + AT_VOFF + row * AT_ROWB + c * 16) = vreg[k];
    }
}
__device__ __forceinline__ void attn_compute(LAS unsigned char* lds, const AttnU& U, const bf16x8 (&qf)[4], bf16_t* OB, f32x2v* ST, int wid, int lane) {
    const int pat = U.pat, head = U.head, ub = U.ub;
    const int r32 = lane & 31, h = lane >> 5;
    const size_t qtok = U.rowbase + (size_t)(ub * 256 + 32 * wid + r32) * U.d;
    f32x16 sc[5];
    float mx = -1e30f;
    const float r32f = (float)r32, h4f = (float)(4 * h);
#pragma unroll
    for (int i = 0; i < 5; ++i) {
        const bool tv = (ub > 0) || (wid + i >= 4);
        f32x16 a;
        if (tv) {
#pragma unroll
            for (int q = 0; q < 16; ++q) a[q] = 0.f;
            const LAS unsigned char* kp = lds + AT_KOFF + (32 * wid + 32 * i + r32) * AT_ROWB + 16 * h;
#pragma unroll
            for (int s = 0; s < 4; ++s) { const bf16x8 kf = *(const LAS bf16x8*)(kp + 32 * s); a = __builtin_amdgcn_mfma_f32_32x32x16_bf16(kf, qf[s], a, 0, 0, 0); }
            if (i == 0 || i == 4) {
#pragma unroll
                for (int q = 0; q < 16; ++q) {
                    const float diff = ((float)((q & 3) + 8 * (q >> 2)) + h4f) - r32f;
                    a[q] = (i == 0) ? __builtin_fmaf(fminf(diff, 0.f), 1e30f, a[q]) : __builtin_fmaf(fmaxf(diff, 0.f), -1e30f, a[q]);
                }
            }
#pragma unroll
            for (int q = 0; q < 16; ++q) mx = fmaxf(mx, a[q]);
        } else {
#pragma unroll
            for (int q = 0; q < 16; ++q) a[q] = -1e30f;
        }
        sc[i] = a;
    }
    mx = fmaxf(mx, __shfl_xor(mx, 32));
    float l = 0.f;
#pragma unroll
    for (int i = 0; i < 5; ++i)
#pragma unroll
        for (int q = 0; q < 16; ++q) { const float pv = __builtin_amdgcn_exp2f(sc[i][q] - mx); sc[i][q] = pv; l += pv; }
    l += __shfl_xor(l, 32);
    f32x16 o0, o1;
#pragma unroll
    for (int q = 0; q < 16; ++q) { o0[q] = 0.f; o1[q] = 0.f; }
    const int i16 = lane & 15, q4 = i16 >> 2, p4 = i16 & 3, blk = (lane >> 4) & 1;
#pragma unroll
    for (int i = 0; i < 5; ++i) {
        const bool tv = (ub > 0) || (wid + i >= 4);
        if (tv) {
#pragma unroll
            for (int s2 = 0; s2 < 2; ++s2) {
                u32x4 pw; pw.x = pk2(sc[i][8 * s2], sc[i][8 * s2 + 1]); pw.y = pk2(sc[i][8 * s2 + 2], sc[i][8 * s2 + 3]); pw.z = pk2(sc[i][8 * s2 + 4], sc[i][8 * s2 + 5]); pw.w = pk2(sc[i][8 * s2 + 6], sc[i][8 * s2 + 7]);
                const bf16x8 pb = __builtin_bit_cast(bf16x8, pw);
                const LAS unsigned char* vp = lds + AT_VOFF + (32 * wid + 32 * i + 16 * s2 + 4 * h + q4) * AT_ROWB + 32 * blk + 8 * p4;
                const s16x4 lo0 = vtr(vp), hi0 = vtr(vp + 8 * AT_ROWB), lo1 = vtr(vp + 64), hi1 = vtr(vp + 8 * AT_ROWB + 64);
                const bf16x8 va0 = __builtin_shufflevector(lo0, hi0, 0, 1, 2, 3, 4, 5, 6, 7), va1 = __builtin_shufflevector(lo1, hi1, 0, 1, 2, 3, 4, 5, 6, 7);
                o0 = __builtin_amdgcn_mfma_f32_32x32x16_bf16(va0, pb, o0, 0, 0, 0);
                o1 = __builtin_amdgcn_mfma_f32_32x32x16_bf16(va1, pb, o1, 0, 0, 0);
            }
        }
    }
    const float inv = 1.f / l;
    bf16_t* op = OB + ((size_t)pat * NT + qtok) * 256 + head * 64 + 4 * h;
#pragma unroll
    for (int g4 = 0; g4 < 4; ++g4) {
        u32x2 w0, w1;
        w0.x = pk2(o0[4 * g4] * inv, o0[4 * g4 + 1] * inv); w0.y = pk2(o0[4 * g4 + 2] * inv, o0[4 * g4 + 3] * inv);
        w1.x = pk2(o1[4 * g4] * inv, o1[4 * g4 + 1] * inv); w1.y = pk2(o1[4 * g4 + 2] * inv, o1[4 * g4 + 3] * inv);
        *(u32x2*)(op + 8 * g4) = w0; *(u32x2*)(op + 32 + 8 * g4) = w1;
    }
    if (h == 0) { f32x2v st = {mx, l}; ST[(qtok * 4 + head) * 3 + pat] = st; }
}

__device__ __forceinline__ void combine_rows(const bf16_t* YC, const bf16_t* OB, const f32x2v* ST, const float* gn, bf16_t* H, int gw, int ngw, int lane) {
    f32x4 gv[4];
#pragma unroll
    for (int j = 0; j < 4; ++j) gv[j] = ((const f32x4*)gn)[lane + 64 * j];
    const int head = lane >> 4;
    for (int m = gw; m < NT; m += ngw) {
        f32x4 v[4];
#pragma unroll
        for (int j = 0; j < 3; ++j) { const u32x2 w = *((const u32x2*)(YC + (size_t)m * 768 + 256 * j) + lane); v[j] = (f32x4){bflo(w.x), bfhi(w.x), bflo(w.y), bfhi(w.y)}; }
        {
            const f32x2v s0 = ST[((size_t)m * 4 + head) * 3 + 0], s1 = ST[((size_t)m * 4 + head) * 3 + 1], s2 = ST[((size_t)m * 4 + head) * 3 + 2];
            const float M = fmaxf(s0.x, fmaxf(s1.x, s2.x));
            const float w0 = __builtin_amdgcn_exp2f(s0.x - M) * s0.y, w1 = __builtin_amdgcn_exp2f(s1.x - M) * s1.y, w2 = __builtin_amdgcn_exp2f(s2.x - M) * s2.y;
            const float iw = 1.f / (w0 + w1 + w2);
            const u32x2 a0 = *((const u32x2*)(OB + (size_t)m * 256) + lane), a1 = *((const u32x2*)(OB + ((size_t)NT + m) * 256) + lane), a2 = *((const u32x2*)(OB + ((size_t)2 * NT + m) * 256) + lane);
            f32x4 o;
            o.x = (w0 * bflo(a0.x) + w1 * bflo(a1.x) + w2 * bflo(a2.x)) * iw; o.y = (w0 * bfhi(a0.x) + w1 * bfhi(a1.x) + w2 * bfhi(a2.x)) * iw;
            o.z = (w0 * bflo(a0.y) + w1 * bflo(a1.y) + w2 * bflo(a2.y)) * iw; o.w = (w0 * bfhi(a0.y) + w1 * bfhi(a1.y) + w2 * bfhi(a2.y)) * iw;
            v[3] = o;
        }
#pragma unroll
        for (int j = 0; j < 4; ++j) {
            const float ss = wave_sum((v[j].x * v[j].x + v[j].y * v[j].y) + (v[j].z * v[j].z + v[j].w * v[j].w));
            const float rs = rsqrtf(ss * (1.f / 256.f) + EPS);
            u32x2 w; w.x = pk2(v[j].x * rs * gv[j].x, v[j].y * rs * gv[j].y); w.y = pk2(v[j].z * rs * gv[j].z, v[j].w * rs * gv[j].w);
            *((u32x2*)(H + (size_t)m * DMODEL + 256 * j) + lane) = w;
        }
    }
}

#define XB_TMO      128
#define XB_XCNT(j)  (256  + 64 * (j))
#define XB_XSUB(j)  (1280 + 64 * (j))
#define XB_XGEN(j)  (2304 + 64 * (j))
#define XB_TOP      3328
#define XB_TOPGEN   3392
#define XCD_BAR_WORDS 3456
#define XB_SPIN_CAP (1u << 18)

__device__ __forceinline__ unsigned xb_ld(unsigned* p)              { return __hip_atomic_load(p, __ATOMIC_RELAXED, __HIP_MEMORY_SCOPE_AGENT); }
__device__ __forceinline__ unsigned xb_add(unsigned* p, unsigned v) { return __hip_atomic_fetch_add(p, v, __ATOMIC_RELAXED, __HIP_MEMORY_SCOPE_AGENT); }
__device__ __forceinline__ unsigned xb_xcc_id() { return (unsigned)__builtin_amdgcn_s_getreg((3 << 11) | 20) & 0xFu; }
#define XB_SPIN(cond, bar) do { unsigned _sp = 0; while (cond) { __builtin_amdgcn_s_sleep(1); \
    if ((++_sp & 255u) == 0u) { if (xb_ld(&(bar)[XB_TMO])) break; if (_sp > XB_SPIN_CAP) { atomicAdd(&(bar)[XB_TMO], 1u); break; } } } } while (0)

struct XcdBarrier {
    unsigned* bar; unsigned x;
    volatile LAS unsigned* st;
};

__device__ __forceinline__ XcdBarrier xcd_barrier_post(unsigned* bar, volatile LAS unsigned* st) {
    XcdBarrier b; b.bar = bar; b.x = xb_xcc_id(); b.st = st;
    if (threadIdx.x == 0) (void)xb_add(&bar[XB_XCNT(b.x)], 1u);
    return b;
}
__device__ __forceinline__ void xcd_barrier_complete(unsigned* bar, unsigned x, unsigned& nloc, unsigned& nx) {
    const unsigned G = gridDim.x * gridDim.y * gridDim.z;
    unsigned sum, cnt, mine, sp = 0u;
    for (;;) {
        sum = 0u; cnt = 0u; mine = 0u;
#pragma unroll
        for (unsigned j = 0; j < 16; ++j) { const unsigned c = xb_ld(&bar[XB_XCNT(j)]); sum += c; cnt += (c > 0u) ? 1u : 0u; mine = (j == x) ? c : mine; }
        if (sum == G) break;
        __builtin_amdgcn_s_sleep(1);
        if ((++sp & 255u) == 0u) { if (xb_ld(&bar[XB_TMO])) break; if (sp > XB_SPIN_CAP) { atomicAdd(&bar[XB_TMO], 1u); break; } }
    }
    nloc = mine > 0u ? mine : 1u; nx = cnt > 0u ? cnt : 1u;
}

__device__ __forceinline__ void xcd_barrier(const XcdBarrier& b) {
    asm volatile("s_waitcnt vmcnt(0)" ::: "memory");
    __syncthreads();
    if (threadIdx.x == 0) {
        unsigned* bar = b.bar;
        __builtin_amdgcn_s_waitcnt(0);
        unsigned nloc = b.st[0], nx = b.st[1];
        if (nloc == 0u) { xcd_barrier_complete(bar, b.x, nloc, nx); b.st[0] = nloc; b.st[1] = nx; }
        const unsigned old = xb_add(&bar[XB_XSUB(b.x)], 1u);
        const unsigned gen = old / nloc;
        if (old + 1u == (gen + 1u) * nloc) {
            __builtin_amdgcn_fence(__ATOMIC_RELEASE, "agent");
            asm volatile("s_waitcnt vmcnt(0)" ::: "memory");
            const unsigned og = xb_add(&bar[XB_TOP], 1u);
            const unsigned tg = og / nx;
            if (og + 1u == (tg + 1u) * nx) xb_add(&bar[XB_TOPGEN], 1u);
            else XB_SPIN(xb_ld(&bar[XB_TOPGEN]) == tg, bar);
            __builtin_amdgcn_fence(__ATOMIC_ACQUIRE, "agent");
            xb_add(&bar[XB_XGEN(b.x)], 1u);
            asm volatile("s_waitcnt vmcnt(0)" ::: "memory");
        } else {
            XB_SPIN(xb_ld(&bar[XB_XGEN(b.x)]) == gen, bar);
            __builtin_amdgcn_fence(__ATOMIC_ACQUIRE, "agent");
            asm volatile("s_waitcnt vmcnt(0)" ::: "memory");
        }
    }
    __syncthreads();
}

constexpr int NPHASE = 19;
struct Ctx { const Args* args; LAS unsigned char* lds; int tid, lane, wid, G, bx, gw, ngw; };
#define CAS __attribute__((address_space(4)))
#define LAUNDER(p) asm volatile("" : "+s"(p))
__device__ __forceinline__ void phase_body(const int ph, const CAS Args* ap, LAS unsigned char* lds, const int tid, const int lane, const int wid, const int G, const int bx) {
    const int gw = bx * 8 + wid, ngw = G * 8;
    unsigned char* ws = ap->ws;
    const float* x_in = ap->in[0];
    float* X = ap->out;
    bf16_t* Hb = (bf16_t*)(ws + WS_H); bf16_t* Pb = (bf16_t*)(ws + WS_P); bf16_t* YC = (bf16_t*)(ws + WS_YC); bf16_t* ZB = (bf16_t*)(ws + WS_ZB); bf16_t* OB = (bf16_t*)(ws + WS_OB);
    f32x2v* ST = (f32x2v*)(ws + WS_ST);
    float* ropec = (float*)(ws + WS_ROPE); float* ropes = ropec + SEQ * 32;
    if (ph == 0) {
        for (int it = bx; it < 2 * 2976; it += G) {
            const int layer = it / 2976; int t = it % 2976;
            unsigned char* wb = ws + WS_W + (size_t)layer * W_LAYER;
            WMat w;
            if (t < 576) { w = WMat{ap->in[2] + (size_t)layer * 1024 * NIN, nullptr, 1024, NIN, NIN, 1, (bf16_t*)(wb + W_IN)}; }
            else if ((t -= 576) < 256) { w = WMat{ap->in[18] + (size_t)layer * 1024 * 1024, nullptr, 1024, 1024, 1024, 0, (bf16_t*)(wb + W_OUT)}; }
            else if ((t -= 256) < 1408) { w = WMat{ap->in[20] + (size_t)layer * 1024 * DFF, ap->in[21] + (size_t)layer * 1024 * DFF, 1024, 2 * DFF, DFF, 2, (bf16_t*)(wb + W_GU)}; }
            else if ((t -= 1408) < 704) { w = WMat{ap->in[22] + (size_t)layer * DFF * 1024, nullptr, DFF, 1024, 1024, 0, (bf16_t*)(wb + W_DN)}; }
            else { t -= 704; w = WMat{ap->in[16] + (size_t)layer * 256 * 512, ap->in[16] + (size_t)layer * 256 * 512 + 256, 256, 512, 512, 2, (bf16_t*)(wb + W_GLU)}; }
            wconv_tile((LAS float*)lds, w, t, tid);
        }
        for (int e = bx * NTHREADS + tid; e < SEQ * 32; e += G * NTHREADS) {
            const int pos = e >> 5, i = e & 31;
            const double inv = (double)exp2f(-(float)i * (13.287712379549449f / 32.f));
            const float angf = (float)pos * (float)inv;
            double rev = (double)angf * 0.15915494309189535; rev -= floor(rev);
            ropec[e] = __builtin_amdgcn_cosf((float)rev); ropes[e] = __builtin_amdgcn_sinf((float)rev);
        }
        norm_rows_bf16(x_in, ap->in[1], Hb, gw, ngw, lane);
        return;
    }
    const int layer = (ph - 1) / 9, sub = (ph - 1) % 9;
    unsigned char* wb = ws + WS_W + (size_t)layer * W_LAYER;
    if (sub == 0) {
        pg8::Gemm g{Hb, (const bf16_t*)(wb + W_IN), NT, NIN, 1024}; pg8::StaticOrder S; S.init(NT, NIN, G, bx);
        EpiIn E{Pb, ropec, ropes};
        pg8::gemm_phase<EpiIn, pg8::StaticOrder, true, true>(lds, g, S, E);
    } else if (sub == 1) {
        for (int rep = 0; rep < REP_SSM; ++rep)
        for (int it = bx; it < 256; it += G)
            ssm_item(lds, Pb, ZB, ap->in[8] + layer * 1024, ap->in[9] + layer * 1024, ap->in[10] + layer * 16, ap->in[11] + (size_t)layer * 16384, ap->in[12] + (size_t)layer * 16384,
                     ap->in[13] + (size_t)layer * 16384, ap->in[14] + (size_t)layer * 16384, ap->in[15] + layer * 256, it, tid, wid, lane);
        LAUNDER(ap);
        for (int rep = 0; rep < REP_CONV; ++rep)
        for (int it = bx; it < 2048; it += G)
            conv_tile(lds, Pb, YC, ap->in[3] + layer * 768, ap->in[4] + layer * 31 * 256, ap->in[5] + layer * 256, ap->in[6] + layer * 256, ap->in[7] + layer * 256, it, tid, wid, lane);
        LAUNDER(ap);
        for (int rep = 0; rep < REP_ATTN; ++rep)
        {
            u32x4 kreg[6], vreg[6]; bf16x8 qn[4], qc[4];
            int it = bx;
            AttnU U = attn_decode(it < 3072 ? it : 0);
            if (it < 3072) attn_issue(Pb, U, tid, wid, lane, kreg, vreg, qn);
            for (; it < 3072; it += G) {
                __syncthreads();
                attn_to_lds(lds, tid, kreg, vreg);
#pragma unroll
                for (int s = 0; s < 4; ++s) qc[s] = qn[s];
                __syncthreads();
                const AttnU Uc = U;
                if (it + G < 3072) { U = attn_decode(it + G); attn_issue(Pb, U, tid, wid, lane, kreg, vreg, qn); }
                attn_compute(lds, Uc, qc, OB, ST, wid, lane);
            }
        }
        __syncthreads();
    } else if (sub == 2) {
        pg8::Gemm g{ZB, (const bf16_t*)(wb + W_GLU), NT, 512, 256}; pg8::StaticOrder S; S.init(NT, 512, G, bx);
        EpiGate<1> E{YC, 768, 512};
        pg8::gemm_phase<EpiGate<1>, pg8::StaticOrder, true, true>(lds, g, S, E);
    } else if (sub == 3) {
        combine_rows(YC, OB, ST, ap->in[17] + layer * 1024, Hb, gw, ngw, lane);
    } else if (sub == 4) {
        pg8::Gemm g{Hb, (const bf16_t*)(wb + W_OUT), NT, 1024, 1024}; pg8::StaticOrder S; S.init(NT, 1024, G, bx);
        EpiRes E{layer == 0 ? x_in : (const float*)X, X};
        pg8::gemm_phase<EpiRes, pg8::StaticOrder, true, true>(lds, g, S, E);
    } else if (sub == 5) {
        norm_rows_bf16(X, ap->in[19] + layer * 1024, Hb, gw, ngw, lane);
    } else if (sub == 6) {
        pg8::Gemm g{Hb, (const bf16_t*)(wb + W_GU), NT, 2 * DFF, 1024}; pg8::StaticOrder S; S.init(NT, 2 * DFF, G, bx);
        EpiGate<0> E{Pb, DFF, 0};
        pg8::gemm_phase<EpiGate<0>, pg8::StaticOrder, true, true>(lds, g, S, E);
    } else if (sub == 7) {
        pg8::Gemm g{Pb, (const bf16_t*)(wb + W_DN), NT, 1024, DFF}; pg8::StaticOrder S; S.init(NT, 1024, G, bx);
        EpiRes E{(const float*)X, X};
        pg8::gemm_phase<EpiRes, pg8::StaticOrder, true, true>(lds, g, S, E);
    } else {
        if (layer == 0) norm_rows_bf16(X, ap->in[1] + 1024, Hb, gw, ngw, lane);
        else norm_rows_f32_inplace(X, ap->in[23], gw, ngw, lane);
    }
}
__global__ void __launch_bounds__(NTHREADS, 2) fwd_megakernel(Args args) {
    extern __shared__ __attribute__((aligned(16))) unsigned char lds_raw[];
    LAS unsigned char* lds = (LAS unsigned char*)lds_raw;
    cg::grid_group grid = cg::this_grid();
    const int tid = threadIdx.x, lane = tid & 63, wid = __builtin_amdgcn_readfirstlane(tid >> 6);
    const int G = gridDim.x, bx = blockIdx.x;
    const int lo = args.ph_lo, hi = args.ph_hi;
    const CAS Args* ap = (const CAS Args*)__builtin_amdgcn_kernarg_segment_ptr();
    volatile LAS unsigned* bst = (volatile LAS unsigned*)(lds + LDS_BYTES - 64);
    if (tid == 0) { bst[0] = 0u; bst[1] = 0u; }
    __syncthreads();
    XcdBarrier xbar = xcd_barrier_post((unsigned*)(args.ws + WS_BAR), bst);
#define GSYNC(k) do { if ((k) == 1) grid.sync(); else xcd_barrier(xbar); } while (0)
#define PHASE(k) if (lo <= (k) && (k) < hi) { if ((k) > lo) GSYNC(k); LAUNDER(ap); phase_body((k), ap, lds, tid, lane, wid, G, bx); \
        if ((REPEAT_MASK >> (k)) & 1u) { xcd_barrier(xbar); LAUNDER(ap); phase_body((k), ap, lds, tid, lane, wid, G, bx); } \
        if ((k) == 0) { for (int es = 0; es < EXTRA_SYNCS; ++es) xcd_barrier(xbar); } }
    PHASE(0) PHASE(1) PHASE(2) PHASE(3) PHASE(4) PHASE(5) PHASE(6) PHASE(7) PHASE(8) PHASE(9)
    PHASE(10) PHASE(11) PHASE(12) PHASE(13) PHASE(14) PHASE(15) PHASE(16) PHASE(17) PHASE(18)
#undef PHASE
}

extern "C" void kernel_launch(void* const* d_in, const int* in_sizes, int n_in, void* d_out, int out_size, void* d_ws, size_t ws_size, hipStream_t stream) {
    static int grid_blocks = 0;
    if (grid_blocks == 0) {
        if (n_in != 24 || ws_size < WS_END) { fprintf(stderr, "kernel_launch: unexpected n_in %d / ws_size %zu\n", n_in, ws_size); grid_blocks = -1; return; }
        int dev = 0, cus = 0, per_cu = 0;
        hipGetDevice(&dev);
        hipDeviceGetAttribute(&cus, hipDeviceAttributeMultiprocessorCount, dev);
        if (hipFuncSetAttribute((const void*)fwd_megakernel, hipFuncAttributeMaxDynamicSharedMemorySize, LDS_BYTES) != hipSuccess) { fprintf(stderr, "kernel_launch: hipFuncSetAttribute failed\n"); grid_blocks = -1; return; }
        if (hipOccupancyMaxActiveBlocksPerMultiprocessor(&per_cu, (const void*)fwd_megakernel, NTHREADS, LDS_BYTES) != hipSuccess || per_cu < 1) { fprintf(stderr, "kernel_launch: occupancy query %d\n", per_cu); per_cu = 1; }
        (void)hipGetLastError();
        grid_blocks = cus * per_cu;
    }
    if (grid_blocks < 0) return;
    Args a{};
    for (int i = 0; i < 24; ++i) a.in[i] = (const float*)d_in[i];
    a.out = (float*)d_out; a.ws = (unsigned char*)d_ws; a.ph_lo = 0; a.ph_hi = NPHASE;
    if (hipMemsetAsync((char*)d_ws + WS_BAR, 0, 16384, stream) != hipSuccess) { fprintf(stderr, "kernel_launch: memset failed\n"); return; }
    void* kargs[] = {&a};
    hipError_t e = hipLaunchCooperativeKernel((const void*)fwd_megakernel, dim3(grid_blocks), dim3(NTHREADS), kargs, LDS_BYTES, stream);
    if (e != hipSuccess) fprintf(stderr, "cooperative launch failed: %s (grid %d)\n", hipGetErrorString(e), grid_blocks);
}
```

```cpp
#include <hip/hip_runtime.h>
#include <hip/hip_cooperative_groups.h>
#include <cstdio>
#include <cstdint>
namespace cg = cooperative_groups;
namespace pg8 {
#define PG8_LAS __attribute__((address_space(3)))
typedef unsigned short bf16_t;
typedef short bf16x8 __attribute__((ext_vector_type(8)));
typedef float f32x4 __attribute__((ext_vector_type(4)));
typedef unsigned u32x4 __attribute__((ext_vector_type(4)));
constexpr int BM = 256, BK = 64, HALF = 128, HTB = HALF * BK * 2  , STAGE_BYTES = 8 * HTB, NXCD = 8, WGM = 8;

__host__ __device__ __forceinline__ int lds_byte(int r, int c) { const int st = (r >> 4) * 2 + (c >> 5), rr = r & 15, cc = c & 31, ob = rr * 64 + cc * 2; return st * 1024 + (ob ^ (((ob >> 9) & 1) << 5)); }
__host__ __device__ __forceinline__ void stage_rc(int b, int& R, int& C) { const int st = b / 1024, sb = b % 1024, swz = sb ^ (((sb >> 9) & 1) << 5); R = (st >> 1) * 16 + swz / 64; C = (st & 1) * 32 + (swz % 64) / 2; }
__host__ __device__ __forceinline__ int perm32(int rho) { const int n = rho >> 4, i = rho & 15; return 8 * (i >> 2) + 4 * n + (i & 3); }

struct Unit { int pm, pn; };
struct Gemm { const bf16_t* A; const bf16_t* Bt; int M, N, K; };

struct StaticOrder {
    int nM, nN, nwg, G, c;
    __host__ __device__ void init(int M, int N, int G_, int c_) { nM = M / BM; nN = N / BM; nwg = nM * nN; G = G_; c = c_; }
    __host__ __device__ bool next(int i, Unit& u) const {
        const long L = (long)i * G + c; if (L >= nwg) return false;
        int wgid = (int)L; { const int q = nwg / NXCD, r = nwg % NXCD, xcd = wgid % NXCD, off = wgid / NXCD; wgid = (xcd < r ? xcd * (q + 1) : r * (q + 1) + (xcd - r) * q) + off; }
        const int nig = WGM * nN, gid = wgid / nig, fm = gid * WGM, gsz = (nM - fm) < WGM ? (nM - fm) : WGM;
        u.pm = fm + ((wgid % nig) % gsz); u.pn = (wgid % nig) / gsz; return true;
    }
    __device__ __forceinline__ void a_ready(const Unit&) const {}
    __device__ __forceinline__ void done(const Unit&) const {}
};

__device__ __forceinline__ unsigned cvt_pk_bf16(float lo, float hi) { unsigned r; asm volatile("v_cvt_pk_bf16_f32 %0, %1, %2" : "=v"(r) : "v"(lo), "v"(hi)); return r; }
typedef float f32x2 __attribute__((ext_vector_type(2)));
template <class Epi, class Sched, bool ALIGN_EPI = false, bool SP2 = false>
__device__ __forceinline__ void gemm_phase(PG8_LAS unsigned char* lds, const Gemm g, const Sched& S, const Epi& E) {
    const int tid = threadIdx.x, wid = __builtin_amdgcn_readfirstlane(tid >> 6), lane = tid & 63, wr = wid >> 2, wc = wid & 3, fr = lane & 15, fq = lane >> 4;
    const int K = g.K, nt = K / BK;
    unsigned voffA[2], voffB[2];
#pragma unroll
    for (int i = 0; i < 2; ++i) { int R, C; stage_rc(tid * 16 + i * 8192, R, C); const int Rb = Epi::PERM ? ((R & ~31) + perm32(R & 31)) : R;
        voffA[i] = (unsigned)(R * K + C) * 2u; voffB[i] = (unsigned)(Rb * K + C) * 2u; }
    const size_t kstep = (size_t)(BK * 2);
    const size_t hstep = (size_t)HALF * K * 2;
    const size_t tstep = 2 * hstep;
    const unsigned ldsw = (unsigned)wid * 1024u;
    const int aoff = lds_byte(wr * 64 + fr, fq * 8), boff = lds_byte(wc * 32 + fr, fq * 8);
#define PG8_SA(b, h) (((b) * 2 + (h)) * HTB)
#define PG8_SB(b, h) ((4 + (b) * 2 + (h)) * HTB)
#define PG8_STAGE(bufoff, gbase, voff) do { _Pragma("unroll") for (int _i = 0; _i < 2; ++_i) \
        __builtin_amdgcn_global_load_lds((const unsigned*)((const char*)(gbase) + (voff)[_i]), (PG8_LAS unsigned*)(lds + (bufoff) + ldsw + _i * 8192), 16, 0, 0); } while (0)
#define PG8_LDA(dst, b, h) do { _Pragma("unroll") for (int m = 0; m < 4; ++m) _Pragma("unroll") for (int k = 0; k < 2; ++k) dst[m][k] = *(const PG8_LAS bf16x8*)(lds + PG8_SA(b, h) + aoff + m * 2048 + k * 1024); } while (0)
#define PG8_LDB(dst, b, h) do { _Pragma("unroll") for (int n = 0; n < 2; ++n) _Pragma("unroll") for (int k = 0; k < 2; ++k) dst[n][k] = *(const PG8_LAS bf16x8*)(lds + PG8_SB(b, h) + boff + n * 2048 + k * 1024); } while (0)
#define PG8_MMA(ai, bj, At, Bt) do { __builtin_amdgcn_s_setprio(1); _Pragma("unroll") for (int m = 0; m < 4; ++m) _Pragma("unroll") for (int n = 0; n < 2; ++n) _Pragma("unroll") for (int k = 0; k < 2; ++k) \
        acc[ai][bj][m][n] = __builtin_amdgcn_mfma_f32_16x16x32_bf16(Bt[n][k], At[m][k], acc[ai][bj][m][n], 0, 0, 0); __builtin_amdgcn_s_setprio(0); } while (0)
#define PG8_WAIT_V(n) asm volatile("s_waitcnt vmcnt(" #n ")" ::: "memory")
#define PG8_WAIT_L(n) asm volatile("s_waitcnt lgkmcnt(" #n ")" ::: "memory")
#define PG8_BAR __builtin_amdgcn_s_barrier()
#define PG8_SCHED __builtin_amdgcn_sched_barrier(0)
    Unit cur, nxt; int ui = 0;
    if (!S.next(0, cur)) return;
    E.prime(cur);
    f32x4 acc[2][2][4][2];
#pragma unroll
    for (int a = 0; a < 2; ++a)
#pragma unroll
        for (int b = 0; b < 2; ++b)
#pragma unroll
            for (int m = 0; m < 4; ++m)
#pragma unroll
                for (int n = 0; n < 2; ++n) acc[a][b][m][n] = (f32x4){0.f, 0.f, 0.f, 0.f};
    bf16x8 At[4][2], B0[2][2], B1[2][2];
    const char* cA = (const char*)g.A + (size_t)cur.pm * tstep; const char* cB = (const char*)g.Bt + (size_t)cur.pn * tstep;
    S.a_ready(cur);
    if constexpr (SP2) {
        PG8_STAGE(PG8_SB(0, 0), cB, voffB); PG8_STAGE(PG8_SB(0, 1), cB + hstep, voffB); PG8_STAGE(PG8_SA(0, 0), cA, voffA); PG8_STAGE(PG8_SA(0, 1), cA + hstep, voffA);
        if (wr == 1) PG8_BAR;
        PG8_WAIT_V(2); PG8_BAR;
        PG8_STAGE(PG8_SB(1, 0), cB + kstep, voffB); PG8_STAGE(PG8_SA(1, 0), cA + kstep, voffA); PG8_STAGE(PG8_SB(1, 1), cB + hstep + kstep, voffB);
        PG8_WAIT_V(6); PG8_BAR;
    } else {
        PG8_STAGE(PG8_SB(0, 0), cB, voffB); PG8_STAGE(PG8_SA(0, 0), cA, voffA); PG8_STAGE(PG8_SB(0, 1), cB + hstep, voffB); PG8_STAGE(PG8_SA(0, 1), cA + hstep, voffA);
        if (wr == 1) PG8_BAR;
        PG8_WAIT_V(4); PG8_BAR;
        PG8_STAGE(PG8_SB(1, 0), cB + kstep, voffB); PG8_STAGE(PG8_SA(1, 0), cA + kstep, voffA); PG8_STAGE(PG8_SB(1, 1), cB + hstep + kstep, voffB);
        PG8_WAIT_V(6); PG8_BAR;
    }
    for (;;) {
        const bool has_next = S.next(ui + 1, nxt);
        const char* nA = has_next ? (const char*)g.A + (size_t)nxt.pm * tstep : cA; const char* nB = has_next ? (const char*)g.Bt + (size_t)nxt.pn * tstep : cB;
#pragma nounroll
        for (int t = 0; t < nt; t += 2) {
            const bool last = (t == nt - 2);
            const char* a1 = cA + (size_t)(t + 1) * kstep;
            const char* a2 = last ? nA : cA + (size_t)(t + 2) * kstep; const char* b2 = last ? nB : cB + (size_t)(t + 2) * kstep;
            const char* a3 = a2 + kstep; const char* b3 = b2 + kstep;
            if (last && has_next) S.a_ready(nxt);
            if constexpr (SP2) {
            PG8_LDB(B0, 0, 0); PG8_LDB(B1, 0, 1); PG8_SCHED; PG8_LDA(At, 0, 0); PG8_STAGE(PG8_SA(1, 1), a1 + hstep, voffA);
            PG8_WAIT_V(8); PG8_WAIT_L(0); PG8_BAR; PG8_MMA(0, 0, At, B0); PG8_MMA(0, 1, At, B1); PG8_BAR; PG8_SCHED;
            PG8_LDA(At, 0, 1); PG8_STAGE(PG8_SB(0, 0), b2, voffB); PG8_STAGE(PG8_SB(0, 1), b2 + hstep, voffB); PG8_STAGE(PG8_SA(0, 0), a2, voffA);
            PG8_WAIT_V(8); PG8_WAIT_L(0); PG8_BAR; PG8_MMA(1, 0, At, B0); PG8_MMA(1, 1, At, B1); PG8_BAR; PG8_SCHED;
            PG8_LDB(B0, 1, 0); PG8_LDB(B1, 1, 1); PG8_SCHED; PG8_LDA(At, 1, 0); PG8_STAGE(PG8_SA(0, 1), a2 + hstep, voffA);
            PG8_WAIT_V(8); PG8_WAIT_L(0); PG8_BAR; PG8_MMA(0, 0, At, B0); PG8_MMA(0, 1, At, B1); PG8_BAR; PG8_SCHED;
            PG8_LDA(At, 1, 1); PG8_STAGE(PG8_SB(1, 0), b3, voffB); PG8_STAGE(PG8_SB(1, 1), b3 + hstep, voffB); PG8_STAGE(PG8_SA(1, 0), a3, voffA);
            PG8_WAIT_V(8); PG8_WAIT_L(0); PG8_BAR; PG8_MMA(1, 0, At, B0); PG8_MMA(1, 1, At, B1); PG8_BAR; PG8_SCHED;
            } else {
            PG8_LDB(B0, 0, 0); PG8_SCHED; PG8_LDA(At, 0, 0); PG8_STAGE(PG8_SA(1, 1), a1 + hstep, voffA);
            PG8_WAIT_L(8); PG8_BAR; PG8_WAIT_L(0); PG8_MMA(0, 0, At, B0); PG8_BAR; PG8_SCHED;
            PG8_LDB(B1, 0, 1); PG8_STAGE(PG8_SB(0, 0), b2, voffB);
            PG8_BAR; PG8_WAIT_L(0); PG8_MMA(0, 1, At, B1); PG8_BAR;
            PG8_LDA(At, 0, 1); PG8_STAGE(PG8_SA(0, 0), a2, voffA);
            PG8_BAR; PG8_WAIT_L(0); PG8_MMA(1, 0, At, B0); PG8_BAR; PG8_SCHED;
            PG8_STAGE(PG8_SB(0, 1), b2 + hstep, voffB);
            PG8_WAIT_V(6); PG8_BAR; PG8_MMA(1, 1, At, B1); PG8_BAR;
            PG8_LDB(B0, 1, 0); PG8_SCHED; PG8_LDA(At, 1, 0); PG8_STAGE(PG8_SA(0, 1), a2 + hstep, voffA);
            PG8_WAIT_L(8); PG8_BAR; PG8_WAIT_L(0); PG8_MMA(0, 0, At, B0); PG8_BAR; PG8_SCHED;
            PG8_LDB(B1, 1, 1); PG8_STAGE(PG8_SB(1, 0), b3, voffB);
            PG8_BAR; PG8_WAIT_L(0); PG8_MMA(0, 1, At, B1); PG8_BAR;
            PG8_LDA(At, 1, 1); PG8_STAGE(PG8_SA(1, 0), a3, voffA);
            PG8_BAR; PG8_WAIT_L(0); PG8_MMA(1, 0, At, B0); PG8_BAR; PG8_SCHED;
            PG8_STAGE(PG8_SB(1, 1), b3 + hstep, voffB);
            PG8_WAIT_V(6); PG8_BAR; PG8_MMA(1, 1, At, B1); PG8_BAR;
            }
        }
        if constexpr (ALIGN_EPI) { if (wr == 0) PG8_BAR; }
        if constexpr (!Epi::AFTER_DRAIN) { E(acc, cur, wr, wc, fr, fq, nxt, has_next, ui); S.done(cur); }
        if (!has_next) break;
#pragma unroll
        for (int a = 0; a < 2; ++a)
#pragma unroll
            for (int b = 0; b < 2; ++b)
#pragma unroll
                for (int m = 0; m < 4; ++m)
#pragma unroll
                    for (int n = 0; n < 2; ++n) acc[a][b][m][n] = (f32x4){0.f, 0.f, 0.f, 0.f};
        cur = nxt; cA = nA; cB = nB; ++ui;
        if constexpr (ALIGN_EPI) { if (wr == 1) PG8_BAR; }
    }
    PG8_WAIT_V(0);
    if constexpr (!ALIGN_EPI) { if (wr == 0) PG8_BAR; }
    PG8_BAR;
    if constexpr (Epi::AFTER_DRAIN) { E.fused(acc, cur, wr, wc, fr, fq, lds, wid, lane); S.done(cur); }
#undef PG8_SA
#undef PG8_SB
#undef PG8_STAGE
#undef PG8_LDA
#undef PG8_LDB
#undef PG8_MMA
#undef PG8_WAIT_V
#undef PG8_WAIT_L
#undef PG8_BAR
#undef PG8_SCHED
}
}
#ifndef REPEAT_MASK
#define REPEAT_MASK 0u
#endif
#ifndef EXTRA_SYNCS
#define EXTRA_SYNCS 0
#endif
#ifndef REP_SSM
#define REP_SSM 1
#endif
#ifndef REP_CONV
#define REP_CONV 1
#endif
#ifndef REP_ATTN
#define REP_ATTN 1
#endif

#define LAS __attribute__((address_space(3)))
typedef unsigned short bf16_t;
typedef short bf16x8 __attribute__((ext_vector_type(8)));
typedef short s16x4 __attribute__((ext_vector_type(4)));
typedef float f32x4 __attribute__((ext_vector_type(4)));
typedef float f32x16 __attribute__((ext_vector_type(16)));
typedef unsigned u32x4 __attribute__((ext_vector_type(4)));
typedef unsigned u32x2 __attribute__((ext_vector_type(2)));
typedef float f32x2v __attribute__((ext_vector_type(2)));
typedef __bf16 bf16x2v __attribute__((ext_vector_type(2)));

constexpr int NT = 65536, SEQ = 4096, DMODEL = 1024, NIN = 2304, DFF = 2816;
constexpr float EPS = 1e-6f;
constexpr float C2 = 0.125f * 1.4426950408889634f;
constexpr size_t MiB = (size_t)1 << 20;
constexpr size_t W_IN = 0, W_OUT = W_IN + (size_t)NIN * 1024 * 2, W_GU = W_OUT + (size_t)1024 * 1024 * 2, W_DN = W_GU + (size_t)2 * DFF * 1024 * 2,
                 W_GLU = W_DN + (size_t)1024 * DFF * 2, W_LAYER = 24 * MiB;
static_assert(W_GLU + 512 * 256 * 2 <= W_LAYER, "weight block");
constexpr size_t WS_W = 0, WS_ROPE = 48 * MiB, WS_H = 64 * MiB, WS_P = 192 * MiB, WS_YC = 544 * MiB, WS_ZB = 640 * MiB, WS_OB = 672 * MiB, WS_ST = 768 * MiB, WS_BAR = 776 * MiB, WS_XB = 778 * MiB, WS_SS = 906 * MiB, WS_END = 912 * MiB;
constexpr int LDS_BYTES = 147456;
constexpr int NTHREADS = 512;

struct Args {
    const float* in[24];
    float* out;
    unsigned char* ws;
    int ph_lo, ph_hi;
};

__device__ __forceinline__ unsigned pk2(float lo, float hi) { f32x2v v = {lo, hi}; bf16x2v b = __builtin_convertvector(v, bf16x2v); return __builtin_bit_cast(unsigned, b); }
__device__ __forceinline__ float bflo(unsigned u) { return __uint_as_float(u << 16); }
__device__ __forceinline__ float bfhi(unsigned u) { return __uint_as_float(u & 0xffff0000u); }
__device__ __forceinline__ float wave_sum(float v) {
#pragma unroll
    for (int o = 1; o < 64; o <<= 1) v += __shfl_xor(v, o);
    return v;
}
__device__ __forceinline__ float sigmoidf_(float x) { return 1.f / (1.f + __expf(-x)); }
__device__ __forceinline__ float gelu_tanh(float y) {
    const float a = 0.7978845608028654f * (y + 0.044715f * y * y * y);
    const float t = 1.f - 2.f / (__expf(2.f * a) + 1.f);
    return 0.5f * y * (1.f + t);
}
#define WAVE_LDS_SYNC() asm volatile("s_waitcnt lgkmcnt(0)" ::: "memory")

struct RowScale {
    const float* ssp; LAS float* xs;
    __device__ __forceinline__ float rs_of(int row) const { const f32x4 sp = *(const f32x4*)(ssp + (size_t)row * 4); return rsqrtf(((sp.x + sp.y) + (sp.z + sp.w)) * (1.f / DMODEL) + EPS); }
    __device__ __forceinline__ void prime(const pg8::Unit& u) const { const int t = threadIdx.x; if (t < 256) xs[t] = rs_of(u.pm * 256 + t); }
};
struct EpiIn {
    static constexpr bool PERM = true, AFTER_DRAIN = false;
    bf16_t* O; const float* ropec; const float* ropes; RowScale R;
    __device__ __forceinline__ void prime(const pg8::Unit& u) const { R.prime(u); }
    __device__ __forceinline__ void operator()(const f32x4 (&acc)[2][2][4][2], const pg8::Unit& u, int wr, int wc, int fr, int fq, const pg8::Unit& nxt, bool has_next, int ui) const {
        const int row0 = u.pm * 256 + wr * 64 + fr, t = threadIdx.x;
        f32x4 spn = {0.f, 0.f, 0.f, 0.f};
        const bool stage = has_next && t < 256 && nxt.pm != u.pm;
        if (stage) spn = *(const f32x4*)(R.ssp + (size_t)(nxt.pm * 256 + t) * 4);
        const LAS float* xsc = R.xs + (ui & 1) * 256 + wr * 64 + fr;
        if (u.pn == 6 || u.pn == 7) {
            const float sc = (u.pn == 6) ? C2 : 1.f;
            const int dimb = 16 * (wc & 1) + 4 * fq;
#pragma unroll
            for (int ai = 0; ai < 2; ++ai)
#pragma unroll
                for (int m = 0; m < 4; ++m) {
                    const int row = row0 + ai * 128 + m * 16; const int pos = row & (SEQ - 1);
                    const float rsc = xsc[ai * 128 + m * 16] * sc;
                    const f32x4 cs = *(const f32x4*)(ropec + pos * 32 + dimb), sn = *(const f32x4*)(ropes + pos * 32 + dimb);
                    bf16_t* rowp = O + (size_t)row * NIN + u.pn * 256 + 64 * (wc >> 1) + dimb;
#pragma unroll
                    for (int bj = 0; bj < 2; ++bj) {
                        const f32x4 x1 = acc[ai][bj][m][0] * rsc, x2 = acc[ai][bj][m][1] * rsc;
                        const f32x4 o1 = x1 * cs - x2 * sn, o2 = x2 * cs + x1 * sn;
                        u32x2 w1, w2; w1.x = pk2(o1[0], o1[1]); w1.y = pk2(o1[2], o1[3]); w2.x = pk2(o2[0], o2[1]); w2.y = pk2(o2[2], o2[3]);
                        *(u32x2*)(rowp + bj * 128) = w1; *(u32x2*)(rowp + bj * 128 + 32) = w2;
                    }
                }
        } else {
#pragma unroll
            for (int ai = 0; ai < 2; ++ai)
#pragma unroll
                for (int m = 0; m < 4; ++m) {
                    bf16_t* rowp = O + (size_t)(row0 + ai * 128 + m * 16) * NIN + u.pn * 256 + wc * 32 + 8 * fq;
                    const float rsc = xsc[ai * 128 + m * 16];
#pragma unroll
                    for (int bj = 0; bj < 2; ++bj) {
                        const f32x4 v0 = acc[ai][bj][m][0] * rsc, v1 = acc[ai][bj][m][1] * rsc;
                        u32x4 w; w.x = pk2(v0[0], v0[1]); w.y = pk2(v0[2], v0[3]); w.z = pk2(v1[0], v1[1]); w.w = pk2(v1[2], v1[3]);
                        *(u32x4*)(rowp + bj * 128) = w;
                    }
                }
        }
        if (has_next && t < 256) {
            float v = R.xs[(ui & 1) * 256 + t];
            if (nxt.pm != u.pm) v = rsqrtf(((spn.x + spn.y) + (spn.z + spn.w)) * (1.f / DMODEL) + EPS);
            R.xs[((ui + 1) & 1) * 256 + t] = v;
        }
    }
};
struct EpiRes {
    static constexpr bool PERM = true, AFTER_DRAIN = false;
    bf16_t* xb; float* ssp; LAS float* xl;
    __device__ __forceinline__ void prime(const pg8::Unit&) const {}
    __device__ __forceinline__ void operator()(const f32x4 (&acc)[2][2][4][2], const pg8::Unit& u, int wr, int wc, int fr, int fq, const pg8::Unit&, bool, int) const {
        const int row0 = u.pm * 256 + wr * 64 + fr, col0 = u.pn * 256 + wc * 32 + 8 * fq;
        u32x4 rv[2][4][2];
#pragma unroll
        for (int ai = 0; ai < 2; ++ai)
#pragma unroll
            for (int m = 0; m < 4; ++m)
#pragma unroll
                for (int bj = 0; bj < 2; ++bj) rv[ai][m][bj] = *(const u32x4*)(xb + (size_t)(row0 + ai * 128 + m * 16) * DMODEL + col0 + bj * 128);
#pragma unroll
        for (int ai = 0; ai < 2; ++ai)
#pragma unroll
            for (int m = 0; m < 4; ++m) {
                const int row = row0 + ai * 128 + m * 16;
                const size_t off = (size_t)row * DMODEL + col0;
                float sq = 0.f;
#pragma unroll
                for (int bj = 0; bj < 2; ++bj) {
                    const u32x4 r = rv[ai][m][bj];
                    const f32x4 r0 = {bflo(r.x), bfhi(r.x), bflo(r.y), bfhi(r.y)}, r1 = {bflo(r.z), bfhi(r.z), bflo(r.w), bfhi(r.w)};
                    const f32x4 x0 = r0 + acc[ai][bj][m][0], x1 = r1 + acc[ai][bj][m][1];
                    u32x4 w; w.x = pk2(x0[0], x0[1]); w.y = pk2(x0[2], x0[3]); w.z = pk2(x1[0], x1[1]); w.w = pk2(x1[2], x1[3]);
                    *(u32x4*)(xb + off + bj * 128) = w;
                    sq += (x0[0] * x0[0] + x0[1] * x0[1]) + (x0[2] * x0[2] + x0[3] * x0[3]) + (x1[0] * x1[0] + x1[1] * x1[1]) + (x1[2] * x1[2] + x1[3] * x1[3]);
                }
                sq += __shfl_xor(sq, 16); sq += __shfl_xor(sq, 32);
                if (fq == 0) xl[(wr * 64 + ai * 128 + m * 16 + fr) * 4 + wc] = sq;
            }
        asm volatile("s_waitcnt lgkmcnt(0)\n\ts_barrier" ::: "memory");
        const int t = threadIdx.x;
        if (t < 256) { const f32x4 v = *(const LAS f32x4*)(xl + t * 4); ssp[(size_t)(u.pm * 256 + t) * 4 + u.pn] = (v.x + v.y) + (v.z + v.w); }
    }
};
template <int MODE  > struct EpiGate {
    static constexpr bool PERM = true, AFTER_DRAIN = false;
    bf16_t* O; int ldc; int coff; RowScale R;
    __device__ __forceinline__ void prime(const pg8::Unit& u) const { if (MODE == 0) R.prime(u); }
    __device__ __forceinline__ void operator()(const f32x4 (&acc)[2][2][4][2], const pg8::Unit& u, int wr, int wc, int fr, int fq, const pg8::Unit& nxt, bool has_next, int ui) const {
        const int row0 = u.pm * 256 + wr * 64 + fr, col0 = coff + u.pn * 128 + wc * 32 + 8 * fq, t = threadIdx.x;
        f32x4 spn = {0.f, 0.f, 0.f, 0.f};
        if (MODE == 0) { if (has_next && t < 256 && nxt.pm != u.pm) spn = *(const f32x4*)(R.ssp + (size_t)(nxt.pm * 256 + t) * 4); }
        const LAS float* xsc = R.xs + (ui & 1) * 256 + wr * 64 + fr;
#pragma unroll
        for (int ai = 0; ai < 2; ++ai)
#pragma unroll
            for (int m = 0; m < 4; ++m) {
                float r[8];
                float rsc = 1.f; if (MODE == 0) rsc = xsc[ai * 128 + m * 16];
#pragma unroll
                for (int n = 0; n < 2; ++n)
#pragma unroll
                    for (int j = 0; j < 4; ++j) {
                        const float a = acc[ai][0][m][n][j] * rsc, b = acc[ai][1][m][n][j] * rsc;
                        r[4 * n + j] = (MODE == 0) ? (a * sigmoidf_(a)) * b : a * sigmoidf_(b);
                    }
                u32x4 w; w.x = pk2(r[0], r[1]); w.y = pk2(r[2], r[3]); w.z = pk2(r[4], r[5]); w.w = pk2(r[6], r[7]);
                *(u32x4*)(O + (size_t)(row0 + ai * 128 + m * 16) * ldc + col0) = w;
            }
        if (MODE == 0) {
            if (has_next && t < 256) {
                float v = R.xs[(ui & 1) * 256 + t];
                if (nxt.pm != u.pm) v = rsqrtf(((spn.x + spn.y) + (spn.z + spn.w)) * (1.f / DMODEL) + EPS);
                R.xs[((ui + 1) & 1) * 256 + t] = v;
            }
        }
    }
};

struct WMat { const float* src; const float* src2; int K, N, ldw, kind; bf16_t* dst; const float* kscale; };
__device__ __forceinline__ void wconv_tile(LAS float* tile, const WMat& w, int t, int tid) {
    const int nkt = w.K / 64, jt = t / nkt, kt = t % nkt, j0 = jt * 64, k0 = kt * 64;
    {
        const int j = j0 + (tid & 63);
        const float* s = w.src; int col = j;
        if (w.kind == 1) {
            if (j >= 1536 && j < 2048) { const int ww = j & 63; col = (j & ~63) + 32 * ((ww >> 2) & 1) + 16 * (ww >> 5) + 4 * ((ww >> 3) & 3) + (ww & 3); }
        } else if (w.kind == 2) {
            const int pn = j >> 8, wi = j & 255; if (wi < 128) col = pn * 128 + wi; else { s = w.src2; col = pn * 128 + (wi - 128); }
        }
        const int kk = tid >> 6;
#pragma unroll
        for (int i = 0; i < 8; ++i) { const int k = kk + 8 * i; const float sc = w.kscale ? w.kscale[k0 + k] : 1.f; tile[k * 65 + (tid & 63)] = s[(size_t)(k0 + k) * w.ldw + col] * sc; }
    }
    __syncthreads();
    {
        const int jr = tid >> 3, c = tid & 7; const LAS float* s = tile + (8 * c) * 65 + jr;
        u32x4 o; o.x = pk2(s[0], s[65]); o.y = pk2(s[2 * 65], s[3 * 65]); o.z = pk2(s[4 * 65], s[5 * 65]); o.w = pk2(s[6 * 65], s[7 * 65]);
        *(u32x4*)(w.dst + (size_t)(j0 + jr) * w.K + k0 + 8 * c) = o;
    }
    __syncthreads();
}

__device__ __forceinline__ void norm_rows_bf16(const float* X, const float* g, bf16_t* H, int gw, int ngw, int lane) {
    f32x4 gv[4];
#pragma unroll
    for (int j = 0; j < 4; ++j) gv[j] = ((const f32x4*)g)[lane + 64 * j];
    for (int m = gw; m < NT; m += ngw) {
        const f32x4* xr = (const f32x4*)(X + (size_t)m * DMODEL) + lane;
        f32x4 v[4]; float s = 0.f;
#pragma unroll
        for (int j = 0; j < 4; ++j) { v[j] = xr[64 * j]; s += (v[j].x * v[j].x + v[j].y * v[j].y) + (v[j].z * v[j].z + v[j].w * v[j].w); }
        const float rs = rsqrtf(wave_sum(s) * (1.f / DMODEL) + EPS);
        u32x2* o = (u32x2*)(H + (size_t)m * DMODEL) + lane;
#pragma unroll
        for (int j = 0; j < 4; ++j) { u32x2 w; w.x = pk2(v[j].x * rs * gv[j].x, v[j].y * rs * gv[j].y); w.y = pk2(v[j].z * rs * gv[j].z, v[j].w * rs * gv[j].w); o[64 * j] = w; }
    }
}
__device__ __forceinline__ void xb_rows(const float* X, bf16_t* XB, float* ssq, int gw, int ngw, int lane) {
    for (int m = gw; m < NT; m += ngw) {
        const f32x4* xr = (const f32x4*)(X + (size_t)m * DMODEL) + lane;
        f32x4 v[4]; float s = 0.f;
#pragma unroll
        for (int j = 0; j < 4; ++j) { v[j] = xr[64 * j]; s += (v[j].x * v[j].x + v[j].y * v[j].y) + (v[j].z * v[j].z + v[j].w * v[j].w); }
        s = wave_sum(s);
        u32x2* o = (u32x2*)(XB + (size_t)m * DMODEL) + lane;
#pragma unroll
        for (int j = 0; j < 4; ++j) { u32x2 w; w.x = pk2(v[j].x, v[j].y); w.y = pk2(v[j].z, v[j].w); o[64 * j] = w; }
        if (lane == 0) { f32x4 o4 = {s, 0.f, 0.f, 0.f}; *(f32x4*)(ssq + (size_t)m * 4) = o4; }
    }
}
__device__ __forceinline__ void final_rows(const bf16_t* XB, const float* ssp, const float* g, float* OUT, int gw, int ngw, int lane) {
    f32x4 gv[4];
#pragma unroll
    for (int j = 0; j < 4; ++j) gv[j] = ((const f32x4*)g)[lane + 64 * j];
    for (int m = gw; m < NT; m += ngw) {
        const f32x4 sp = *(const f32x4*)(ssp + (size_t)m * 4);
        const float rs = rsqrtf(((sp.x + sp.y) + (sp.z + sp.w)) * (1.f / DMODEL) + EPS);
        const u32x2* xr = (const u32x2*)(XB + (size_t)m * DMODEL) + lane;
        f32x4* o = (f32x4*)(OUT + (size_t)m * DMODEL) + lane;
#pragma unroll
        for (int j = 0; j < 4; ++j) { const u32x2 w = xr[64 * j]; f32x4 v = {bflo(w.x), bfhi(w.x), bflo(w.y), bfhi(w.y)}; o[64 * j] = v * rs * gv[j]; }
    }
}
__device__ __forceinline__ void norm_rows_f32_inplace(float* X, const float* g, int gw, int ngw, int lane) {
    f32x4 gv[4];
#pragma unroll
    for (int j = 0; j < 4; ++j) gv[j] = ((const f32x4*)g)[lane + 64 * j];
    for (int m = gw; m < NT; m += ngw) {
        f32x4* xr = (f32x4*)(X + (size_t)m * DMODEL) + lane;
        f32x4 v[4]; float s = 0.f;
#pragma unroll
        for (int j = 0; j < 4; ++j) { v[j] = xr[64 * j]; s += (v[j].x * v[j].x + v[j].y * v[j].y) + (v[j].z * v[j].z + v[j].w * v[j].w); }
        const float rs = rsqrtf(wave_sum(s) * (1.f / DMODEL) + EPS);
#pragma unroll
        for (int j = 0; j < 4; ++j) xr[64 * j] = v[j] * rs * gv[j];
    }
}

__device__ __forceinline__ void conv_tile(LAS unsigned char* lds, const bf16_t* P, bf16_t* YC, const float* w3, const float* dww, const float* dwb, const float* lng, const float* lnb,
                                          int tix, int tid, int wid, int lane) {
    const int b = tix >> 7, t0 = (tix & 127) * 32;
    LAS float* ZT = (LAS float*)lds;
    LAS float* YT = (LAS float*)(lds + 63488);
    __syncthreads();
    for (int e = tid; e < 62 * 32; e += NTHREADS) {
        const int row = e >> 5, c8 = e & 31, t = t0 - 30 + row;
        f32x4 z0 = {0.f, 0.f, 0.f, 0.f}, z1 = z0;
        if (t >= 0) {
            const bf16_t* src = P + (size_t)(b * SEQ + t) * NIN + 768 + c8 * 8;
            const u32x4 a = *(const u32x4*)src, g = *(const u32x4*)(src + 256);
            z0[0] = bflo(a.x) * sigmoidf_(bflo(g.x)); z0[1] = bfhi(a.x) * sigmoidf_(bfhi(g.x)); z0[2] = bflo(a.y) * sigmoidf_(bflo(g.y)); z0[3] = bfhi(a.y) * sigmoidf_(bfhi(g.y));
            z1[0] = bflo(a.z) * sigmoidf_(bflo(g.z)); z1[1] = bfhi(a.z) * sigmoidf_(bfhi(g.z)); z1[2] = bflo(a.w) * sigmoidf_(bflo(g.w)); z1[3] = bfhi(a.w) * sigmoidf_(bfhi(g.w));
        }
        *(LAS f32x4*)(ZT + row * 256 + c8 * 8) = z0; *(LAS f32x4*)(ZT + row * 256 + c8 * 8 + 4) = z1;
    }
    {
        const int tl = tid >> 4, cgp = tid & 15, t = t0 + tl; const size_t tok = (size_t)b * SEQ + t;
#pragma unroll
        for (int half = 0; half < 2; ++half) {
            const int c0 = cgp * 16 + half * 8;
            const bf16_t* src = P + tok * NIN + c0;
            float g0[8], g1[8], g2[8], bb[8];
            { const u32x4 hh = *(const u32x4*)src, bv = *(const u32x4*)(src + 256), cc = *(const u32x4*)(src + 512);
              g2[0] = bflo(hh.x) * bflo(cc.x); g2[1] = bfhi(hh.x) * bfhi(cc.x); g2[2] = bflo(hh.y) * bflo(cc.y); g2[3] = bfhi(hh.y) * bfhi(cc.y);
              g2[4] = bflo(hh.z) * bflo(cc.z); g2[5] = bfhi(hh.z) * bfhi(cc.z); g2[6] = bflo(hh.w) * bflo(cc.w); g2[7] = bfhi(hh.w) * bfhi(cc.w);
              bb[0] = bflo(bv.x); bb[1] = bfhi(bv.x); bb[2] = bflo(bv.y); bb[3] = bfhi(bv.y); bb[4] = bflo(bv.z); bb[5] = bfhi(bv.z); bb[6] = bflo(bv.w); bb[7] = bfhi(bv.w); }
#pragma unroll
            for (int i = 0; i < 8; ++i) { g1[i] = 0.f; g0[i] = 0.f; }
            if (t >= 1) { const u32x4 hh = *(const u32x4*)(src - NIN), cc = *(const u32x4*)(src - NIN + 512);
              g1[0] = bflo(hh.x) * bflo(cc.x); g1[1] = bfhi(hh.x) * bfhi(cc.x); g1[2] = bflo(hh.y) * bflo(cc.y); g1[3] = bfhi(hh.y) * bfhi(cc.y);
              g1[4] = bflo(hh.z) * bflo(cc.z); g1[5] = bfhi(hh.z) * bfhi(cc.z); g1[6] = bflo(hh.w) * bflo(cc.w); g1[7] = bfhi(hh.w) * bfhi(cc.w); }
            if (t >= 2) { const u32x4 hh = *(const u32x4*)(src - 2 * NIN), cc = *(const u32x4*)(src - 2 * NIN + 512);
              g0[0] = bflo(hh.x) * bflo(cc.x); g0[1] = bfhi(hh.x) * bfhi(cc.x); g0[2] = bflo(hh.y) * bflo(cc.y); g0[3] = bfhi(hh.y) * bfhi(cc.y);
              g0[4] = bflo(hh.z) * bflo(cc.z); g0[5] = bfhi(hh.z) * bfhi(cc.z); g0[6] = bflo(hh.w) * bflo(cc.w); g0[7] = bfhi(hh.w) * bfhi(cc.w); }
            float y[8];
#pragma unroll
            for (int i = 0; i < 8; ++i) y[i] = bb[i] * (w3[c0 + i] * g0[i] + w3[256 + c0 + i] * g1[i] + w3[512 + c0 + i] * g2[i]);
            u32x4 w; w.x = pk2(y[0], y[1]); w.y = pk2(y[2], y[3]); w.z = pk2(y[4], y[5]); w.w = pk2(y[6], y[7]);
            *(u32x4*)(YC + tok * 768 + c0) = w;
        }
    }
    __syncthreads();
    {
        const int c = tid & 255, th = tid >> 8;
        float w[31];
#pragma unroll
        for (int k = 0; k < 31; ++k) w[k] = dww[k * 256 + c];
        const float bias = dwb[c];
        for (int j = 0; j < 16; ++j) {
            const int tl = th * 16 + j; float a = bias;
            const LAS float* zp = ZT + tl * 256 + c;
#pragma unroll
            for (int k = 0; k < 31; ++k) a += w[k] * zp[k * 256];
            YT[tl * 256 + c] = a;
        }
    }
    __syncthreads();
    {
        const f32x4 gg = ((const f32x4*)lng)[lane], bbv = ((const f32x4*)lnb)[lane];
#pragma unroll
        for (int q = 0; q < 4; ++q) {
            const int tl = wid * 4 + q;
            f32x4 v = *(const LAS f32x4*)(YT + tl * 256 + lane * 4);
            const float mean = wave_sum((v.x + v.y) + (v.z + v.w)) * (1.f / 256.f);
            v = v - mean;
            const float var = wave_sum((v.x * v.x + v.y * v.y) + (v.z * v.z + v.w * v.w)) * (1.f / 256.f);
            const float rs = rsqrtf(var + EPS);
            f32x4 y = v * rs * gg + bbv;
            y.x = y.x * sigmoidf_(y.x); y.y = y.y * sigmoidf_(y.y); y.z = y.z * sigmoidf_(y.z); y.w = y.w * sigmoidf_(y.w);
            u32x2 wv; wv.x = pk2(y.x, y.y); wv.y = pk2(y.z, y.w);
            *(u32x2*)(YC + ((size_t)b * SEQ + t0 + tl) * 768 + 256 + lane * 4) = wv;
        }
    }
}

template <bool FULL> __device__ __forceinline__ void ssm_tile_scan(f32x16& xr, f32x16& xi, const float (&pw)[4][2], float& cr, float& ci, const bool hi) {
    const float l1r = pw[0][0], l1i = pw[0][1], l4r = pw[3][0], l4i = pw[3][1];
#pragma unroll
    for (int G = 0; G < 4; ++G)
#pragma unroll
        for (int j = 1; j < 4; ++j) { const int i = 4 * G + j; const float pr = xr[i - 1], pi = xi[i - 1]; xr[i] += l1r * pr - l1i * pi; xi[i] += l1r * pi + l1i * pr; }
    float cinr[4], cini[4];
#pragma unroll
    for (int G = 0; G < 4; ++G) {
        const float er = xr[4 * G + 3], ei = xi[4 * G + 3];
        const float orr = __shfl_xor(er, 32), oi = __shfl_xor(ei, 32);
        const float e0r = hi ? orr : er, e0i = hi ? oi : ei, e1r = hi ? er : orr, e1i = hi ? ei : oi;
        const float c1r = l4r * cr - l4i * ci + e0r, c1i = l4r * ci + l4i * cr + e0i;
        cinr[G] = hi ? c1r : cr; cini[G] = hi ? c1i : ci;
        const float c2r = l4r * c1r - l4i * c1i + e1r, c2i = l4r * c1i + l4i * c1r + e1i;
        cr = c2r; ci = c2i;
    }
    if (FULL) {
#pragma unroll
        for (int G = 0; G < 4; ++G)
#pragma unroll
            for (int j = 0; j < 4; ++j) { const int i = 4 * G + j; xr[i] += pw[j][0] * cinr[G] - pw[j][1] * cini[G]; xi[i] += pw[j][0] * cini[G] + pw[j][1] * cinr[G]; }
    }
}
constexpr int SSM_ROWB = 272;
__device__ __forceinline__ void ssm_item(LAS unsigned char* lds, const bf16_t* P, bf16_t* ZB, const float* a_re, const float* a_im, const float* log_dt, const float* b_re, const float* b_im,
                                         const float* c_re, const float* c_im, const float* d_skip, int item, int tid, int wid, int lane) {
    const int b = item >> 4, g = item & 15;
    const int r32 = lane & 31, h = lane >> 5; const bool hi = h != 0;
    LAS f32x2v* EW = (LAS f32x2v*)lds;
    LAS unsigned char* SBW = lds + 4096 + wid * (32 * SSM_ROWB);
    __syncthreads();
    float pw[2][4][2]; bf16x8 bfr[2][2];
#pragma unroll
    for (int tp = 0; tp < 2; ++tp) {
        const int p = r32 + 32 * tp;
        const float dt = __expf(log_dt[g]);
        const float ar = a_re[g * 64 + p], ai = a_im[g * 64 + p];
        const float mag = __expf(ar * dt);
        const float lr = mag * cosf(ai * dt), li = mag * sinf(ai * dt);
        const float den = ar * ar + ai * ai, nr = lr - 1.f, ni = li;
        const float fr = (nr * ar + ni * ai) / den, fi = (ni * ar - nr * ai) / den;
        const f32x4* br4 = (const f32x4*)(b_re + (size_t)(g * 64 + p) * 16 + 8 * h); const f32x4* bi4 = (const f32x4*)(b_im + (size_t)(g * 64 + p) * 16 + 8 * h);
        const f32x4 r0 = br4[0], r1 = br4[1], i0 = bi4[0], i1 = bi4[1];
        const f32x4 re0 = fr * r0 - fi * i0, re1 = fr * r1 - fi * i1, im0 = fr * i0 + fi * r0, im1 = fr * i1 + fi * r1;
        u32x4 wre, wim;
        wre.x = pk2(re0[0], re0[1]); wre.y = pk2(re0[2], re0[3]); wre.z = pk2(re1[0], re1[1]); wre.w = pk2(re1[2], re1[3]);
        wim.x = pk2(im0[0], im0[1]); wim.y = pk2(im0[2], im0[3]); wim.z = pk2(im1[0], im1[1]); wim.w = pk2(im1[2], im1[3]);
        bfr[tp][0] = __builtin_bit_cast(bf16x8, wre); bfr[tp][1] = __builtin_bit_cast(bf16x8, wim);
        pw[tp][0][0] = lr; pw[tp][0][1] = li;
#pragma unroll
        for (int j = 1; j < 4; ++j) { pw[tp][j][0] = pw[tp][j - 1][0] * lr - pw[tp][j - 1][1] * li; pw[tp][j][1] = pw[tp][j - 1][0] * li + pw[tp][j - 1][1] * lr; }
    }
    const int t16 = lane & 15, quad = lane >> 4;
    bf16x8 cfr[4];
#pragma unroll
    for (int s = 0; s < 4; ++s) {
        const f32x4 cr4 = *(const f32x4*)(c_re + (size_t)(g * 16 + t16) * 64 + 4 * quad + 16 * s), ci4 = *(const f32x4*)(c_im + (size_t)(g * 16 + t16) * 64 + 4 * quad + 16 * s);
        u32x4 w; w.x = pk2(cr4[0], -ci4[0]); w.y = pk2(cr4[1], -ci4[1]); w.z = pk2(cr4[2], -ci4[2]); w.w = pk2(cr4[3], -ci4[3]);
        cfr[s] = __builtin_bit_cast(bf16x8, w);
    }
    const f32x4 dsk = *(const f32x4*)(d_skip + g * 16 + 4 * quad);
    const size_t tok0 = (size_t)b * SEQ + (size_t)wid * 512;
    const bf16_t* ubase = P + tok0 * NIN + 1280 + g * 16;
    f32x16 zero16;
#pragma unroll
    for (int q = 0; q < 16; ++q) zero16[q] = 0.f;
    float cr[2] = {0.f, 0.f}, ci[2] = {0.f, 0.f};
    {
        bf16x8 ua = *(const bf16x8*)(ubase + (size_t)r32 * NIN + 8 * h);
        for (int mt = 0; mt < 16; ++mt) {
            const bf16x8 un = *(const bf16x8*)(ubase + (size_t)((mt < 15 ? mt + 1 : mt) * 32 + r32) * NIN + 8 * h);
#pragma unroll
            for (int tp = 0; tp < 2; ++tp) {
                f32x16 xr = __builtin_amdgcn_mfma_f32_32x32x16_bf16(ua, bfr[tp][0], zero16, 0, 0, 0);
                f32x16 xi = __builtin_amdgcn_mfma_f32_32x32x16_bf16(ua, bfr[tp][1], zero16, 0, 0, 0);
                ssm_tile_scan<false>(xr, xi, pw[tp], cr[tp], ci[tp], hi);
            }
            ua = un;
        }
    }
    if (!hi) { f32x2v e0 = {cr[0], ci[0]}, e1 = {cr[1], ci[1]}; EW[wid * 64 + r32] = e0; EW[wid * 64 + 32 + r32] = e1; }
    __syncthreads();
#pragma unroll
    for (int tp = 0; tp < 2; ++tp) {
        float qr = pw[tp][3][0], qi = pw[tp][3][1];
#pragma unroll
        for (int q = 0; q < 7; ++q) { const float nr = qr * qr - qi * qi, ni = 2.f * qr * qi; qr = nr; qi = ni; }
        float sr = 0.f, si = 0.f;
        for (int w = 0; w < wid; ++w) { const f32x2v e = EW[w * 64 + r32 + 32 * tp]; const float nr = qr * sr - qi * si + e.x, ni = qr * si + qi * sr + e.y; sr = nr; si = ni; }
        cr[tp] = sr; ci[tp] = si;
    }
    {
        bf16x8 ua = *(const bf16x8*)(ubase + (size_t)r32 * NIN + 8 * h);
        for (int mt = 0; mt < 16; ++mt) {
            const bf16x8 un = *(const bf16x8*)(ubase + (size_t)((mt < 15 ? mt + 1 : mt) * 32 + r32) * NIN + 8 * h);
            u32x2 uwv[2];
#pragma unroll
            for (int tt = 0; tt < 2; ++tt) uwv[tt] = *(const u32x2*)(P + (tok0 + mt * 32 + tt * 16 + t16) * NIN + 1280 + g * 16 + 4 * quad);
#pragma unroll
            for (int tp = 0; tp < 2; ++tp) {
                f32x16 xr = __builtin_amdgcn_mfma_f32_32x32x16_bf16(ua, bfr[tp][0], zero16, 0, 0, 0);
                f32x16 xi = __builtin_amdgcn_mfma_f32_32x32x16_bf16(ua, bfr[tp][1], zero16, 0, 0, 0);
                ssm_tile_scan<true>(xr, xi, pw[tp], cr[tp], ci[tp], hi);
#pragma unroll
                for (int i = 0; i < 16; ++i) {
                    const int t = (i & 3) + 8 * (i >> 2) + 4 * h;
                    *(LAS unsigned*)(SBW + t * SSM_ROWB + 4 * (r32 + 32 * tp)) = pk2(xr[i], xi[i]);
                }
            }
            WAVE_LDS_SYNC();
#pragma unroll
            for (int tt = 0; tt < 2; ++tt) {
                f32x4 acc = {0.f, 0.f, 0.f, 0.f};
#pragma unroll
                for (int s = 0; s < 4; ++s) {
                    const bf16x8 sf = *(const LAS bf16x8*)(SBW + (tt * 16 + t16) * SSM_ROWB + quad * 16 + 64 * s);
                    acc = __builtin_amdgcn_mfma_f32_16x16x32_bf16(cfr[s], sf, acc, 0, 0, 0);
                }
                const size_t tok = tok0 + mt * 32 + tt * 16 + t16;
                const u32x2 uw = uwv[tt];
                const f32x4 uu = {bflo(uw.x), bfhi(uw.x), bflo(uw.y), bfhi(uw.y)};
                const f32x4 y = acc + dsk * uu;
                u32x2 w; w.x = pk2(gelu_tanh(y.x), gelu_tanh(y.y)); w.y = pk2(gelu_tanh(y.z), gelu_tanh(y.w));
                *(u32x2*)(ZB + tok * 256 + g * 16 + 4 * quad) = w;
            }
            WAVE_LDS_SYNC();
            ua = un;
        }
    }
}

constexpr int AT_ROWB = 144, AT_KOFF = 0, AT_VOFF = 384 * AT_ROWB;
__device__ __forceinline__ s16x4 vtr(const LAS unsigned char* p) { return __builtin_bit_cast(s16x4, __builtin_amdgcn_ds_read_tr16_b64_v4i16((LAS s16x4*)p)); }
struct AttnU { int pat, head, d, ub; size_t rowbase; };
__device__ __forceinline__ AttnU attn_decode(int u) {
    AttnU U; const int rem = u & 1023, b = rem >> 6, ru = rem & 15; U.pat = u >> 10; U.head = (rem >> 4) & 3;
    int r;
    if (U.pat == 0) { U.d = 1; r = 0; U.ub = ru; } else if (U.pat == 1) { U.d = 4; r = ru & 3; U.ub = ru >> 2; } else { U.d = 16; r = ru; U.ub = 0; }
    U.rowbase = (size_t)b * SEQ + r; return U;
}
__device__ __forceinline__ void attn_issue(const bf16_t* P, const AttnU& U, int tid, int wid, int lane, u32x4 (&kreg)[6], u32x4 (&vreg)[6], bf16x8 (&qf)[4]) {
    const int i0 = U.ub * 256 - 128;
#pragma unroll
    for (int k = 0; k < 6; ++k) {
        const int e = tid + NTHREADS * k, row = e >> 3, c = e & 7; int si = i0 + row; si = si < 0 ? 0 : si;
        const bf16_t* src = P + (U.rowbase + (size_t)si * U.d) * NIN + U.head * 64 + c * 8;
        kreg[k] = *(const u32x4*)(src + 1792); vreg[k] = *(const u32x4*)(src + 2048);
    }
    const int r32 = lane & 31, h = lane >> 5;
    const size_t qtok = U.rowbase + (size_t)(U.ub * 256 + 32 * wid + r32) * U.d;
    const bf16_t* qp = P + qtok * NIN + 1536 + U.head * 64 + 8 * h;
#pragma unroll
    for (int s = 0; s < 4; ++s) qf[s] = *(const bf16x8*)(qp + 16 * s);
}
__device__ __forceinline__ void attn_to_lds(LAS unsigned char* lds, int tid, const u32x4 (&kreg)[6], const u32x4 (&vreg)[6]) {
#pragma unroll
    for (int k = 0; k < 6; ++k) {
        const int e = tid + NTHREADS * k, row = e >> 3, c = e & 7;
        *(LAS u32x4*)(lds + AT_KOFF + row * AT_ROWB + c * 16) = kreg[k];
        *(LAS u32x4*)(lds + AT_VOFF + row * AT_ROWB + c * 16) = vreg[k];
    }
}
__device__ __forceinline__ void attn_compute(LAS unsigned char* lds, const AttnU& U, const bf16x8 (&qf)[4], bf16_t* OB, f32x2v* ST, int wid, int lane) {
    const int pat = U.pat, head = U.head, ub = U.ub;
    const int r32 = lane & 31, h = lane >> 5;
    const size_t qtok = U.rowbase + (size_t)(ub * 256 + 32 * wid + r32) * U.d;
    f32x16 sc[5];
    float mx = -1e30f;
    const float r32f = (float)r32, h4f = (float)(4 * h);
#pragma unroll
    for (int i = 0; i < 5; ++i) {
        const bool tv = (ub > 0) || (wid + i >= 4);
        f32x16 a;
        if (tv) {
#pragma unroll
            for (int q = 0; q < 16; ++q) a[q] = 0.f;
            const LAS unsigned char* kp = lds + AT_KOFF + (32 * wid + 32 * i + r32) * AT_ROWB + 16 * h;
#pragma unroll
            for (int s = 0; s < 4; ++s) { const bf16x8 kf = *(const LAS bf16x8*)(kp + 32 * s); a = __builtin_amdgcn_mfma_f32_32x32x16_bf16(kf, qf[s], a, 0, 0, 0); }
            if (i == 0 || i == 4) {
#pragma unroll
                for (int q = 0; q < 16; ++q) {
                    const float diff = ((float)((q & 3) + 8 * (q >> 2)) + h4f) - r32f;
                    a[q] = (i == 0) ? __builtin_fmaf(fminf(diff, 0.f), 1e30f, a[q]) : __builtin_fmaf(fmaxf(diff, 0.f), -1e30f, a[q]);
                }
            }
#pragma unroll
            for (int q = 0; q < 16; ++q) mx = fmaxf(mx, a[q]);
        } else {
#pragma unroll
            for (int q = 0; q < 16; ++q) a[q] = -1e30f;
        }
        sc[i] = a;
    }
    mx = fmaxf(mx, __shfl_xor(mx, 32));
    float l = 0.f;
#pragma unroll
    for (int i = 0; i < 5; ++i)
#pragma unroll
        for (int q = 0; q < 16; ++q) { const float pv = __builtin_amdgcn_exp2f(sc[i][q] - mx); sc[i][q] = pv; l += pv; }
    l += __shfl_xor(l, 32);
    f32x16 o0, o1;
#pragma unroll
    for (int q = 0; q < 16; ++q) { o0[q] = 0.f; o1[q] = 0.f; }
    const int i16 = lane & 15, q4 = i16 >> 2, p4 = i16 & 3, blk = (lane >> 4) & 1;
#pragma unroll
    for (int i = 0; i < 5; ++i) {
        const bool tv = (ub > 0) || (wid + i >= 4);
        if (tv) {
#pragma unroll
            for (int s2 = 0; s2 < 2; ++s2) {
                u32x4 pw; pw.x = pk2(sc[i][8 * s2], sc[i][8 * s2 + 1]); pw.y = pk2(sc[i][8 * s2 + 2], sc[i][8 * s2 + 3]); pw.z = pk2(sc[i][8 * s2 + 4], sc[i][8 * s2 + 5]); pw.w = pk2(sc[i][8 * s2 + 6], sc[i][8 * s2 + 7]);
                const bf16x8 pb = __builtin_bit_cast(bf16x8, pw);
                const LAS unsigned char* vp = lds + AT_VOFF + (32 * wid + 32 * i + 16 * s2 + 4 * h + q4) * AT_ROWB + 32 * blk + 8 * p4;
                const s16x4 lo0 = vtr(vp), hi0 = vtr(vp + 8 * AT_ROWB), lo1 = vtr(vp + 64), hi1 = vtr(vp + 8 * AT_ROWB + 64);
                const bf16x8 va0 = __builtin_shufflevector(lo0, hi0, 0, 1, 2, 3, 4, 5, 6, 7), va1 = __builtin_shufflevector(lo1, hi1, 0, 1, 2, 3, 4, 5, 6, 7);
                o0 = __builtin_amdgcn_mfma_f32_32x32x16_bf16(va0, pb, o0, 0, 0, 0);
                o1 = __builtin_amdgcn_mfma_f32_32x32x16_bf16(va1, pb, o1, 0, 0, 0);
            }
        }
    }
    const float inv = 1.f / l;
    bf16_t* op = OB + ((size_t)pat * NT + qtok) * 256 + head * 64 + 4 * h;
#pragma unroll
    for (int g4 = 0; g4 < 4; ++g4) {
        u32x2 w0, w1;
        w0.x = pk2(o0[4 * g4] * inv, o0[4 * g4 + 1] * inv); w0.y = pk2(o0[4 * g4 + 2] * inv, o0[4 * g4 + 3] * inv);
        w1.x = pk2(o1[4 * g4] * inv, o1[4 * g4 + 1] * inv); w1.y = pk2(o1[4 * g4 + 2] * inv, o1[4 * g4 + 3] * inv);
        *(u32x2*)(op + 8 * g4) = w0; *(u32x2*)(op + 32 + 8 * g4) = w1;
    }
    if (h == 0) { f32x2v st = {mx, l}; ST[(qtok * 4 + head) * 3 + pat] = st; }
}

__device__ __forceinline__ void combine_rows(const bf16_t* YC, const bf16_t* OB, const f32x2v* ST, const float* gn, bf16_t* H, int gw, int ngw, int lane) {
    f32x4 gv[4];
#pragma unroll
    for (int j = 0; j < 4; ++j) gv[j] = ((const f32x4*)gn)[lane + 64 * j];
    const int head = lane >> 4;
    for (int m = gw; m < NT; m += ngw) {
        f32x4 v[4];
#pragma unroll
        for (int j = 0; j < 3; ++j) { const u32x2 w = *((const u32x2*)(YC + (size_t)m * 768 + 256 * j) + lane); v[j] = (f32x4){bflo(w.x), bfhi(w.x), bflo(w.y), bfhi(w.y)}; }
        {
            const f32x2v s0 = ST[((size_t)m * 4 + head) * 3 + 0], s1 = ST[((size_t)m * 4 + head) * 3 + 1], s2 = ST[((size_t)m * 4 + head) * 3 + 2];
            const float M = fmaxf(s0.x, fmaxf(s1.x, s2.x));
            const float w0 = __builtin_amdgcn_exp2f(s0.x - M) * s0.y, w1 = __builtin_amdgcn_exp2f(s1.x - M) * s1.y, w2 = __builtin_amdgcn_exp2f(s2.x - M) * s2.y;
            const float iw = 1.f / (w0 + w1 + w2);
            const u32x2 a0 = *((const u32x2*)(OB + (size_t)m * 256) + lane), a1 = *((const u32x2*)(OB + ((size_t)NT + m) * 256) + lane), a2 = *((const u32x2*)(OB + ((size_t)2 * NT + m) * 256) + lane);
            f32x4 o;
            o.x = (w0 * bflo(a0.x) + w1 * bflo(a1.x) + w2 * bflo(a2.x)) * iw; o.y = (w0 * bfhi(a0.x) + w1 * bfhi(a1.x) + w2 * bfhi(a2.x)) * iw;
            o.z = (w0 * bflo(a0.y) + w1 * bflo(a1.y) + w2 * bflo(a2.y)) * iw; o.w = (w0 * bfhi(a0.y) + w1 * bfhi(a1.y) + w2 * bfhi(a2.y)) * iw;
            v[3] = o;
        }
#pragma unroll
        for (int j = 0; j < 4; ++j) {
            const float ss = wave_sum((v[j].x * v[j].x + v[j].y * v[j].y) + (v[j].z * v[j].z + v[j].w * v[j].w));
            const float rs = rsqrtf(ss * (1.f / 256.f) + EPS);
            u32x2 w; w.x = pk2(v[j].x * rs * gv[j].x, v[j].y * rs * gv[j].y); w.y = pk2(v[j].z * rs * gv[j].z, v[j].w * rs * gv[j].w);
            *((u32x2*)(H + (size_t)m * DMODEL + 256 * j) + lane) = w;
        }
    }
}

#define XB_TMO      128
#define XB_XCNT(j)  (256  + 64 * (j))
#define XB_XSUB(j)  (1280 + 64 * (j))
#define XB_XGEN(j)  (2304 + 64 * (j))
#define XB_TOP      3328
#define XB_TOPGEN   3392
#define XCD_BAR_WORDS 3456
#define XB_SPIN_CAP (1u << 18)

__device__ __forceinline__ unsigned xb_ld(unsigned* p)              { return __hip_atomic_load(p, __ATOMIC_RELAXED, __HIP_MEMORY_SCOPE_AGENT); }
__device__ __forceinline__ unsigned xb_add(unsigned* p, unsigned v) { return __hip_atomic_fetch_add(p, v, __ATOMIC_RELAXED, __HIP_MEMORY_SCOPE_AGENT); }
__device__ __forceinline__ unsigned xb_xcc_id() { return (unsigned)__builtin_amdgcn_s_getreg((3 << 11) | 20) & 0xFu; }
#define XB_SPIN(cond, bar) do { unsigned _sp = 0; while (cond) { __builtin_amdgcn_s_sleep(1); \
    if ((++_sp & 255u) == 0u) { if (xb_ld(&(bar)[XB_TMO])) break; if (_sp > XB_SPIN_CAP) { atomicAdd(&(bar)[XB_TMO], 1u); break; } } } } while (0)

struct XcdBarrier {
    unsigned* bar; unsigned x;
    volatile LAS unsigned* st;
};

__device__ __forceinline__ XcdBarrier xcd_barrier_post(unsigned* bar, volatile LAS unsigned* st) {
    XcdBarrier b; b.bar = bar; b.x = xb_xcc_id(); b.st = st;
    if (threadIdx.x == 0) (void)xb_add(&bar[XB_XCNT(b.x)], 1u);
    return b;
}
__device__ __forceinline__ void xcd_barrier_complete(unsigned* bar, unsigned x, unsigned& nloc, unsigned& nx) {
    const unsigned G = gridDim.x * gridDim.y * gridDim.z;
    unsigned sum, cnt, mine, sp = 0u;
    for (;;) {
        sum = 0u; cnt = 0u; mine = 0u;
#pragma unroll
        for (unsigned j = 0; j < 16; ++j) { const unsigned c = xb_ld(&bar[XB_XCNT(j)]); sum += c; cnt += (c > 0u) ? 1u : 0u; mine = (j == x) ? c : mine; }
        if (sum == G) break;
        __builtin_amdgcn_s_sleep(1);
        if ((++sp & 255u) == 0u) { if (xb_ld(&bar[XB_TMO])) break; if (sp > XB_SPIN_CAP) { atomicAdd(&bar[XB_TMO], 1u); break; } }
    }
    nloc = mine > 0u ? mine : 1u; nx = cnt > 0u ? cnt : 1u;
}

__device__ __forceinline__ void xcd_barrier(const XcdBarrier& b) {
    asm volatile("s_waitcnt vmcnt(0)" ::: "memory");
    __syncthreads();
    if (threadIdx.x == 0) {
        unsigned* bar = b.bar;
        __builtin_amdgcn_s_waitcnt(0);
        unsigned nloc = b.st[0], nx = b.st[1];
        if (nloc == 0u) { xcd_barrier_complete(bar, b.x, nloc, nx); b.st[0] = nloc; b.st[1] = nx; }
        const unsigned old = xb_add(&bar[XB_XSUB(b.x)], 1u);
        const unsigned gen = old / nloc;
        if (old + 1u == (gen + 1u) * nloc) {
            __builtin_amdgcn_fence(__ATOMIC_RELEASE, "agent");
            asm volatile("s_waitcnt vmcnt(0)" ::: "memory");
            const unsigned og = xb_add(&bar[XB_TOP], 1u);
            const unsigned tg = og / nx;
            if (og + 1u == (tg + 1u) * nx) xb_add(&bar[XB_TOPGEN], 1u);
            else XB_SPIN(xb_ld(&bar[XB_TOPGEN]) == tg, bar);
            __builtin_amdgcn_fence(__ATOMIC_ACQUIRE, "agent");
            xb_add(&bar[XB_XGEN(b.x)], 1u);
            asm volatile("s_waitcnt vmcnt(0)" ::: "memory");
        } else {
            XB_SPIN(xb_ld(&bar[XB_XGEN(b.x)]) == gen, bar);
            __builtin_amdgcn_fence(__ATOMIC_ACQUIRE, "agent");
            asm volatile("s_waitcnt vmcnt(0)" ::: "memory");
        }
    }
    __syncthreads();
}

constexpr int NPHASE = 16;
struct Ctx { const Args* args; LAS unsigned char* lds; int tid, lane, wid, G, bx, gw, ngw; };
#define CAS __attribute__((address_space(4)))
#define LAUNDER(p) asm volatile("" : "+s"(p))
__device__ __forceinline__ void phase_body(const int ph, const CAS Args* ap, LAS unsigned char* lds, const int tid, const int lane, const int wid, const int G, const int bx) {
    const int gw = bx * 8 + wid, ngw = G * 8;
    unsigned char* ws = ap->ws;
    const float* x_in = ap->in[0];
    float* X = ap->out;
    bf16_t* Hb = (bf16_t*)(ws + WS_H); bf16_t* Pb = (bf16_t*)(ws + WS_P); bf16_t* YC = (bf16_t*)(ws + WS_YC); bf16_t* ZB = (bf16_t*)(ws + WS_ZB); bf16_t* OB = (bf16_t*)(ws + WS_OB);
    f32x2v* ST = (f32x2v*)(ws + WS_ST);
    float* ropec = (float*)(ws + WS_ROPE); float* ropes = ropec + SEQ * 32;
    bf16_t* XB = (bf16_t*)(ws + WS_XB); float* SS = (float*)(ws + WS_SS);
    if (ph == 0) {
        for (int it = bx; it < 2 * 2976; it += G) {
            const int layer = it / 2976; int t = it % 2976;
            unsigned char* wb = ws + WS_W + (size_t)layer * W_LAYER;
            WMat w;
            if (t < 576) { w = WMat{ap->in[2] + (size_t)layer * 1024 * NIN, nullptr, 1024, NIN, NIN, 1, (bf16_t*)(wb + W_IN), ap->in[1] + layer * 1024}; }
            else if ((t -= 576) < 256) { w = WMat{ap->in[18] + (size_t)layer * 1024 * 1024, nullptr, 1024, 1024, 1024, 0, (bf16_t*)(wb + W_OUT), nullptr}; }
            else if ((t -= 256) < 1408) { w = WMat{ap->in[20] + (size_t)layer * 1024 * DFF, ap->in[21] + (size_t)layer * 1024 * DFF, 1024, 2 * DFF, DFF, 2, (bf16_t*)(wb + W_GU), ap->in[19] + layer * 1024}; }
            else if ((t -= 1408) < 704) { w = WMat{ap->in[22] + (size_t)layer * DFF * 1024, nullptr, DFF, 1024, 1024, 0, (bf16_t*)(wb + W_DN), nullptr}; }
            else { t -= 704; w = WMat{ap->in[16] + (size_t)layer * 256 * 512, ap->in[16] + (size_t)layer * 256 * 512 + 256, 256, 512, 512, 2, (bf16_t*)(wb + W_GLU), nullptr}; }
            wconv_tile((LAS float*)lds, w, t, tid);
        }
        for (int e = bx * NTHREADS + tid; e < SEQ * 32; e += G * NTHREADS) {
            const int pos = e >> 5, i = e & 31;
            const double inv = (double)exp2f(-(float)i * (13.287712379549449f / 32.f));
            const float angf = (float)pos * (float)inv;
            double rev = (double)angf * 0.15915494309189535; rev -= floor(rev);
            ropec[e] = __builtin_amdgcn_cosf((float)rev); ropes[e] = __builtin_amdgcn_sinf((float)rev);
        }
        xb_rows(x_in, XB, SS, gw, ngw, lane);
        return;
    }
    if (ph == 15) { final_rows(XB, SS + (size_t)4 * NT * 4, ap->in[23], X, gw, ngw, lane); return; }
    const int layer = (ph - 1) / 7, sub = (ph - 1) % 7;
    unsigned char* wb = ws + WS_W + (size_t)layer * W_LAYER;
    if (sub == 0) {
        pg8::Gemm g{XB, (const bf16_t*)(wb + W_IN), NT, NIN, 1024}; pg8::StaticOrder S; S.init(NT, NIN, G, bx);
        EpiIn E{Pb, ropec, ropes, RowScale{SS + (size_t)(layer == 0 ? 0 : 2) * NT * 4, (LAS float*)(lds + 131072 + 4096)}};
        pg8::gemm_phase<EpiIn, pg8::StaticOrder, true, true>(lds, g, S, E);
    } else if (sub == 1) {
        for (int rep = 0; rep < REP_SSM; ++rep)
        for (int it = bx; it < 256; it += G)
            ssm_item(lds, Pb, ZB, ap->in[8] + layer * 1024, ap->in[9] + layer * 1024, ap->in[10] + layer * 16, ap->in[11] + (size_t)layer * 16384, ap->in[12] + (size_t)layer * 16384,
                     ap->in[13] + (size_t)layer * 16384, ap->in[14] + (size_t)layer * 16384, ap->in[15] + layer * 256, it, tid, wid, lane);
        LAUNDER(ap);
        for (int rep = 0; rep < REP_CONV; ++rep)
        for (int it = bx; it < 2048; it += G)
            conv_tile(lds, Pb, YC, ap->in[3] + layer * 768, ap->in[4] + layer * 31 * 256, ap->in[5] + layer * 256, ap->in[6] + layer * 256, ap->in[7] + layer * 256, it, tid, wid, lane);
        LAUNDER(ap);
        for (int rep = 0; rep < REP_ATTN; ++rep)
        {
            u32x4 kreg[6], vreg[6]; bf16x8 qn[4], qc[4];
            int it = bx;
            AttnU U = attn_decode(it < 3072 ? it : 0);
            if (it < 3072) attn_issue(Pb, U, tid, wid, lane, kreg, vreg, qn);
            for (; it < 3072; it += G) {
                __syncthreads();
                attn_to_lds(lds, tid, kreg, vreg);
#pragma unroll
                for (int s = 0; s < 4; ++s) qc[s] = qn[s];
                __syncthreads();
                const AttnU Uc = U;
                if (it + G < 3072) { U = attn_decode(it + G); attn_issue(Pb, U, tid, wid, lane, kreg, vreg, qn); }
                attn_compute(lds, Uc, qc, OB, ST, wid, lane);
            }
        }
        __syncthreads();
    } else if (sub == 2) {
        pg8::Gemm g{ZB, (const bf16_t*)(wb + W_GLU), NT, 512, 256}; pg8::StaticOrder S; S.init(NT, 512, G, bx);
        EpiGate<1> E{YC, 768, 512, RowScale{nullptr, nullptr}};
        pg8::gemm_phase<EpiGate<1>, pg8::StaticOrder, true, true>(lds, g, S, E);
    } else if (sub == 3) {
        combine_rows(YC, OB, ST, ap->in[17] + layer * 1024, Hb, gw, ngw, lane);
    } else if (sub == 4) {
        pg8::Gemm g{Hb, (const bf16_t*)(wb + W_OUT), NT, 1024, 1024}; pg8::StaticOrder S; S.init(NT, 1024, G, bx);
        EpiRes E{XB, SS + (size_t)(layer == 0 ? 1 : 3) * NT * 4, (LAS float*)(lds + 131072)};
        pg8::gemm_phase<EpiRes, pg8::StaticOrder, true, true>(lds, g, S, E);
    } else if (sub == 5) {
        pg8::Gemm g{XB, (const bf16_t*)(wb + W_GU), NT, 2 * DFF, 1024}; pg8::StaticOrder S; S.init(NT, 2 * DFF, G, bx);
        EpiGate<0> E{Pb, DFF, 0, RowScale{SS + (size_t)(layer == 0 ? 1 : 3) * NT * 4, (LAS float*)(lds + 131072 + 4096)}};
        pg8::gemm_phase<EpiGate<0>, pg8::StaticOrder, true, true>(lds, g, S, E);
    } else {
        pg8::Gemm g{Pb, (const bf16_t*)(wb + W_DN), NT, 1024, DFF}; pg8::StaticOrder S; S.init(NT, 1024, G, bx);
        EpiRes E{XB, SS + (size_t)(layer == 0 ? 2 : 4) * NT * 4, (LAS float*)(lds + 131072)};
        pg8::gemm_phase<EpiRes, pg8::StaticOrder, true, true>(lds, g, S, E);
    }
}
__global__ void __launch_bounds__(NTHREADS, 2) fwd_megakernel(Args args) {
    extern __shared__ __attribute__((aligned(16))) unsigned char lds_raw[];
    LAS unsigned char* lds = (LAS unsigned char*)lds_raw;
    cg::grid_group grid = cg::this_grid();
    const int tid = threadIdx.x, lane = tid & 63, wid = __builtin_amdgcn_readfirstlane(tid >> 6);
    const int G = gridDim.x, bx = blockIdx.x;
    const int lo = args.ph_lo, hi = args.ph_hi;
    const CAS Args* ap = (const CAS Args*)__builtin_amdgcn_kernarg_segment_ptr();
    volatile LAS unsigned* bst = (volatile LAS unsigned*)(lds + LDS_BYTES - 64);
    if (tid == 0) { bst[0] = 0u; bst[1] = 0u; }
    __syncthreads();
    XcdBarrier xbar = xcd_barrier_post((unsigned*)(args.ws + WS_BAR), bst);
#define GSYNC(k) do { if ((k) == 1) grid.sync(); else xcd_barrier(xbar); } while (0)
#define PHASE(k) if (lo <= (k) && (k) < hi) { if ((k) > lo) GSYNC(k); LAUNDER(ap); phase_body((k), ap, lds, tid, lane, wid, G, bx); \
        if ((REPEAT_MASK >> (k)) & 1u) { xcd_barrier(xbar); LAUNDER(ap); phase_body((k), ap, lds, tid, lane, wid, G, bx); } \
        if ((k) == 0) { for (int es = 0; es < EXTRA_SYNCS; ++es) xcd_barrier(xbar); } }
    PHASE(0) PHASE(1) PHASE(2) PHASE(3) PHASE(4) PHASE(5) PHASE(6) PHASE(7) PHASE(8) PHASE(9)
    PHASE(10) PHASE(11) PHASE(12) PHASE(13) PHASE(14) PHASE(15)
#undef PHASE
}

extern "C" void kernel_launch(void* const* d_in, const int* in_sizes, int n_in, void* d_out, int out_size, void* d_ws, size_t ws_size, hipStream_t stream) {
    static int grid_blocks = 0;
    if (grid_blocks == 0) {
        if (n_in != 24 || ws_size < WS_END) { fprintf(stderr, "kernel_launch: unexpected n_in %d / ws_size %zu\n", n_in, ws_size); grid_blocks = -1; return; }
        int dev = 0, cus = 0, per_cu = 0;
        hipGetDevice(&dev);
        hipDeviceGetAttribute(&cus, hipDeviceAttributeMultiprocessorCount, dev);
        if (hipFuncSetAttribute((const void*)fwd_megakernel, hipFuncAttributeMaxDynamicSharedMemorySize, LDS_BYTES) != hipSuccess) { fprintf(stderr, "kernel_launch: hipFuncSetAttribute failed\n"); grid_blocks = -1; return; }
        if (hipOccupancyMaxActiveBlocksPerMultiprocessor(&per_cu, (const void*)fwd_megakernel, NTHREADS, LDS_BYTES) != hipSuccess || per_cu < 1) { fprintf(stderr, "kernel_launch: occupancy query %d\n", per_cu); per_cu = 1; }
        (void)hipGetLastError();
        grid_blocks = cus * per_cu;
    }
    if (grid_blocks < 0) return;
    Args a{};
    for (int i = 0; i < 24; ++i) a.in[i] = (const float*)d_in[i];
    a.out = (float*)d_out; a.ws = (unsigned char*)d_ws; a.ph_lo = 0; a.ph_hi = NPHASE;
    if (hipMemsetAsync((char*)d_ws + WS_BAR, 0, 16384, stream) != hipSuccess) { fprintf(stderr, "kernel_launch: memset failed\n"); return; }
    void* kargs[] = {&a};
    hipError_t e = hipLaunchCooperativeKernel((const void*)fwd_megakernel, dim3(grid_blocks), dim3(NTHREADS), kargs, LDS_BYTES, stream);
    if (e != hipSuccess) fprintf(stderr, "cooperative launch failed: %s (grid %d)\n", hipGetErrorString(e), grid_blocks);
}
```

```cpp
#include <hip/hip_runtime.h>
#include <hip/hip_cooperative_groups.h>
#include <cstdio>
#include <cstdint>
namespace cg = cooperative_groups;
namespace pg8 {
#define PG8_LAS __attribute__((address_space(3)))
typedef unsigned short bf16_t;
typedef short bf16x8 __attribute__((ext_vector_type(8)));
typedef float f32x4 __attribute__((ext_vector_type(4)));
typedef unsigned u32x4 __attribute__((ext_vector_type(4)));
constexpr int BM = 256, BK = 64, HALF = 128, HTB = HALF * BK * 2  , STAGE_BYTES = 8 * HTB, NXCD = 8, WGM = 8;

__host__ __device__ __forceinline__ int lds_byte(int r, int c) { const int st = (r >> 4) * 2 + (c >> 5), rr = r & 15, cc = c & 31, ob = rr * 64 + cc * 2; return st * 1024 + (ob ^ (((ob >> 9) & 1) << 5)); }
__host__ __device__ __forceinline__ void stage_rc(int b, int& R, int& C) { const int st = b / 1024, sb = b % 1024, swz = sb ^ (((sb >> 9) & 1) << 5); R = (st >> 1) * 16 + swz / 64; C = (st & 1) * 32 + (swz % 64) / 2; }
__host__ __device__ __forceinline__ int perm32(int rho) { const int n = rho >> 4, i = rho & 15; return 8 * (i >> 2) + 4 * n + (i & 3); }

struct Unit { int pm, pn; };
struct Gemm { const bf16_t* A; const bf16_t* Bt; int M, N, K; };

struct StaticOrder {
    int nM, nN, nwg, G, c;
    __host__ __device__ void init(int M, int N, int G_, int c_) { nM = M / BM; nN = N / BM; nwg = nM * nN; G = G_; c = c_; }
    __host__ __device__ bool next(int i, Unit& u) const {
        const long L = (long)i * G + c; if (L >= nwg) return false;
        int wgid = (int)L; { const int q = nwg / NXCD, r = nwg % NXCD, xcd = wgid % NXCD, off = wgid / NXCD; wgid = (xcd < r ? xcd * (q + 1) : r * (q + 1) + (xcd - r) * q) + off; }
        const int nig = WGM * nN, gid = wgid / nig, fm = gid * WGM, gsz = (nM - fm) < WGM ? (nM - fm) : WGM;
        u.pm = fm + ((wgid % nig) % gsz); u.pn = (wgid % nig) / gsz; return true;
    }
    __device__ __forceinline__ void a_ready(const Unit&) const {}
    __device__ __forceinline__ void done(const Unit&) const {}
};

__device__ __forceinline__ unsigned cvt_pk_bf16(float lo, float hi) { unsigned r; asm volatile("v_cvt_pk_bf16_f32 %0, %1, %2" : "=v"(r) : "v"(lo), "v"(hi)); return r; }
typedef float f32x2 __attribute__((ext_vector_type(2)));
template <class Epi, class Sched, bool ALIGN_EPI = false, bool SP2 = false>
__device__ __forceinline__ void gemm_phase(PG8_LAS unsigned char* lds, const Gemm g, const Sched& S, const Epi& E) {
    const int tid = threadIdx.x, wid = __builtin_amdgcn_readfirstlane(tid >> 6), lane = tid & 63, wr = wid >> 2, wc = wid & 3, fr = lane & 15, fq = lane >> 4;
    const int K = g.K, nt = K / BK;
    unsigned voffA[2], voffB[2];
#pragma unroll
    for (int i = 0; i < 2; ++i) { int R, C; stage_rc(tid * 16 + i * 8192, R, C); const int Rb = Epi::PERM ? ((R & ~31) + perm32(R & 31)) : R;
        voffA[i] = (unsigned)(R * K + C) * 2u; voffB[i] = (unsigned)(Rb * K + C) * 2u; }
    const size_t kstep = (size_t)(BK * 2);
    const size_t hstep = (size_t)HALF * K * 2;
    const size_t tstep = 2 * hstep;
    const unsigned ldsw = (unsigned)wid * 1024u;
    const int aoff = lds_byte(wr * 64 + fr, fq * 8), boff = lds_byte(wc * 32 + fr, fq * 8);
#define PG8_SA(b, h) (((b) * 2 + (h)) * HTB)
#define PG8_SB(b, h) ((4 + (b) * 2 + (h)) * HTB)
#define PG8_STAGE(bufoff, gbase, voff) do { _Pragma("unroll") for (int _i = 0; _i < 2; ++_i) \
        __builtin_amdgcn_global_load_lds((const unsigned*)((const char*)(gbase) + (voff)[_i]), (PG8_LAS unsigned*)(lds + (bufoff) + ldsw + _i * 8192), 16, 0, 0); } while (0)
#define PG8_LDA(dst, b, h) do { _Pragma("unroll") for (int m = 0; m < 4; ++m) _Pragma("unroll") for (int k = 0; k < 2; ++k) dst[m][k] = *(const PG8_LAS bf16x8*)(lds + PG8_SA(b, h) + aoff + m * 2048 + k * 1024); } while (0)
#define PG8_LDB(dst, b, h) do { _Pragma("unroll") for (int n = 0; n < 2; ++n) _Pragma("unroll") for (int k = 0; k < 2; ++k) dst[n][k] = *(const PG8_LAS bf16x8*)(lds + PG8_SB(b, h) + boff + n * 2048 + k * 1024); } while (0)
#define PG8_MMA(ai, bj, At, Bt) do { __builtin_amdgcn_s_setprio(1); _Pragma("unroll") for (int m = 0; m < 4; ++m) _Pragma("unroll") for (int n = 0; n < 2; ++n) _Pragma("unroll") for (int k = 0; k < 2; ++k) \
        acc[ai][bj][m][n] = __builtin_amdgcn_mfma_f32_16x16x32_bf16(Bt[n][k], At[m][k], acc[ai][bj][m][n], 0, 0, 0); __builtin_amdgcn_s_setprio(0); } while (0)
#define PG8_WAIT_V(n) asm volatile("s_waitcnt vmcnt(" #n ")" ::: "memory")
#define PG8_WAIT_L(n) asm volatile("s_waitcnt lgkmcnt(" #n ")" ::: "memory")
#define PG8_BAR __builtin_amdgcn_s_barrier()
#define PG8_SCHED __builtin_amdgcn_sched_barrier(0)
    Unit cur, nxt; int ui = 0;
    if (!S.next(0, cur)) return;
    E.prime(cur);
    f32x4 acc[2][2][4][2];
#pragma unroll
    for (int a = 0; a < 2; ++a)
#pragma unroll
        for (int b = 0; b < 2; ++b)
#pragma unroll
            for (int m = 0; m < 4; ++m)
#pragma unroll
                for (int n = 0; n < 2; ++n) acc[a][b][m][n] = (f32x4){0.f, 0.f, 0.f, 0.f};
    bf16x8 At[4][2], B0[2][2], B1[2][2];
    const char* cA = (const char*)g.A + (size_t)cur.pm * tstep; const char* cB = (const char*)g.Bt + (size_t)cur.pn * tstep;
    S.a_ready(cur);
    if constexpr (SP2) {
        PG8_STAGE(PG8_SB(0, 0), cB, voffB); PG8_STAGE(PG8_SB(0, 1), cB + hstep, voffB); PG8_STAGE(PG8_SA(0, 0), cA, voffA); PG8_STAGE(PG8_SA(0, 1), cA + hstep, voffA);
        if (wr == 1) PG8_BAR;
        PG8_WAIT_V(2); PG8_BAR;
        PG8_STAGE(PG8_SB(1, 0), cB + kstep, voffB); PG8_STAGE(PG8_SA(1, 0), cA + kstep, voffA); PG8_STAGE(PG8_SB(1, 1), cB + hstep + kstep, voffB);
        PG8_WAIT_V(6); PG8_BAR;
    } else {
        PG8_STAGE(PG8_SB(0, 0), cB, voffB); PG8_STAGE(PG8_SA(0, 0), cA, voffA); PG8_STAGE(PG8_SB(0, 1), cB + hstep, voffB); PG8_STAGE(PG8_SA(0, 1), cA + hstep, voffA);
        if (wr == 1) PG8_BAR;
        PG8_WAIT_V(4); PG8_BAR;
        PG8_STAGE(PG8_SB(1, 0), cB + kstep, voffB); PG8_STAGE(PG8_SA(1, 0), cA + kstep, voffA); PG8_STAGE(PG8_SB(1, 1), cB + hstep + kstep, voffB);
        PG8_WAIT_V(6); PG8_BAR;
    }
    for (;;) {
        const bool has_next = S.next(ui + 1, nxt);
        const char* nA = has_next ? (const char*)g.A + (size_t)nxt.pm * tstep : cA; const char* nB = has_next ? (const char*)g.Bt + (size_t)nxt.pn * tstep : cB;
#pragma nounroll
        for (int t = 0; t < nt; t += 2) {
            const bool last = (t == nt - 2);
            const char* a1 = cA + (size_t)(t + 1) * kstep;
            const char* a2 = last ? nA : cA + (size_t)(t + 2) * kstep; const char* b2 = last ? nB : cB + (size_t)(t + 2) * kstep;
            const char* a3 = a2 + kstep; const char* b3 = b2 + kstep;
            if (last && has_next) S.a_ready(nxt);
            if constexpr (SP2) {
            PG8_LDB(B0, 0, 0); PG8_LDB(B1, 0, 1); PG8_SCHED; PG8_LDA(At, 0, 0); PG8_STAGE(PG8_SA(1, 1), a1 + hstep, voffA);
            PG8_WAIT_V(8); PG8_WAIT_L(0); PG8_BAR; PG8_MMA(0, 0, At, B0); PG8_MMA(0, 1, At, B1); PG8_BAR; PG8_SCHED;
            PG8_LDA(At, 0, 1); PG8_STAGE(PG8_SB(0, 0), b2, voffB); PG8_STAGE(PG8_SB(0, 1), b2 + hstep, voffB); PG8_STAGE(PG8_SA(0, 0), a2, voffA);
            PG8_WAIT_V(8); PG8_WAIT_L(0); PG8_BAR; PG8_MMA(1, 0, At, B0); PG8_MMA(1, 1, At, B1); PG8_BAR; PG8_SCHED;
            PG8_LDB(B0, 1, 0); PG8_LDB(B1, 1, 1); PG8_SCHED; PG8_LDA(At, 1, 0); PG8_STAGE(PG8_SA(0, 1), a2 + hstep, voffA);
            PG8_WAIT_V(8); PG8_WAIT_L(0); PG8_BAR; PG8_MMA(0, 0, At, B0); PG8_MMA(0, 1, At, B1); PG8_BAR; PG8_SCHED;
            PG8_LDA(At, 1, 1); PG8_STAGE(PG8_SB(1, 0), b3, voffB); PG8_STAGE(PG8_SB(1, 1), b3 + hstep, voffB); PG8_STAGE(PG8_SA(1, 0), a3, voffA);
            PG8_WAIT_V(8); PG8_WAIT_L(0); PG8_BAR; PG8_MMA(1, 0, At, B0); PG8_MMA(1, 1, At, B1); PG8_BAR; PG8_SCHED;
            } else {
            PG8_LDB(B0, 0, 0); PG8_SCHED; PG8_LDA(At, 0, 0); PG8_STAGE(PG8_SA(1, 1), a1 + hstep, voffA);
            PG8_WAIT_L(8); PG8_BAR; PG8_WAIT_L(0); PG8_MMA(0, 0, At, B0); PG8_BAR; PG8_SCHED;
            PG8_LDB(B1, 0, 1); PG8_STAGE(PG8_SB(0, 0), b2, voffB);
            PG8_BAR; PG8_WAIT_L(0); PG8_MMA(0, 1, At, B1); PG8_BAR;
            PG8_LDA(At, 0, 1); PG8_STAGE(PG8_SA(0, 0), a2, voffA);
            PG8_BAR; PG8_WAIT_L(0); PG8_MMA(1, 0, At, B0); PG8_BAR; PG8_SCHED;
            PG8_STAGE(PG8_SB(0, 1), b2 + hstep, voffB);
            PG8_WAIT_V(6); PG8_BAR; PG8_MMA(1, 1, At, B1); PG8_BAR;
            PG8_LDB(B0, 1, 0); PG8_SCHED; PG8_LDA(At, 1, 0); PG8_STAGE(PG8_SA(0, 1), a2 + hstep, voffA);
            PG8_WAIT_L(8); PG8_BAR; PG8_WAIT_L(0); PG8_MMA(0, 0, At, B0); PG8_BAR; PG8_SCHED;
            PG8_LDB(B1, 1, 1); PG8_STAGE(PG8_SB(1, 0), b3, voffB);
            PG8_BAR; PG8_WAIT_L(0); PG8_MMA(0, 1, At, B1); PG8_BAR;
            PG8_LDA(At, 1, 1); PG8_STAGE(PG8_SA(1, 0), a3, voffA);
            PG8_BAR; PG8_WAIT_L(0); PG8_MMA(1, 0, At, B0); PG8_BAR; PG8_SCHED;
            PG8_STAGE(PG8_SB(1, 1), b3 + hstep, voffB);
            PG8_WAIT_V(6); PG8_BAR; PG8_MMA(1, 1, At, B1); PG8_BAR;
            }
        }
        if constexpr (ALIGN_EPI) { if (wr == 0) PG8_BAR; }
        if constexpr (!Epi::AFTER_DRAIN) { E(acc, cur, wr, wc, fr, fq, nxt, has_next, ui); S.done(cur); }
        if (!has_next) break;
#pragma unroll
        for (int a = 0; a < 2; ++a)
#pragma unroll
            for (int b = 0; b < 2; ++b)
#pragma unroll
                for (int m = 0; m < 4; ++m)
#pragma unroll
                    for (int n = 0; n < 2; ++n) acc[a][b][m][n] = (f32x4){0.f, 0.f, 0.f, 0.f};
        cur = nxt; cA = nA; cB = nB; ++ui;
        if constexpr (ALIGN_EPI) { if (wr == 1) PG8_BAR; }
    }
    PG8_WAIT_V(0);
    if constexpr (!ALIGN_EPI) { if (wr == 0) PG8_BAR; }
    PG8_BAR;
    if constexpr (Epi::AFTER_DRAIN) { E.fused(acc, cur, wr, wc, fr, fq, lds, wid, lane); S.done(cur); }
#undef PG8_SA
#undef PG8_SB
#undef PG8_STAGE
#undef PG8_LDA
#undef PG8_LDB
#undef PG8_MMA
#undef PG8_WAIT_V
#undef PG8_WAIT_L
#undef PG8_BAR
#undef PG8_SCHED
}
}
#ifndef REPEAT_MASK
#define REPEAT_MASK 0u
#endif
#ifndef EXTRA_SYNCS
#define EXTRA_SYNCS 0
#endif
#ifndef REP_SSM
#define REP_SSM 1
#endif
#ifndef REP_CONV
#define REP_CONV 1
#endif
#ifndef REP_ATTN
#define REP_ATTN 1
#endif

#define LAS __attribute__((address_space(3)))
typedef unsigned short bf16_t;
typedef short bf16x8 __attribute__((ext_vector_type(8)));
typedef short s16x4 __attribute__((ext_vector_type(4)));
typedef float f32x4 __attribute__((ext_vector_type(4)));
typedef float f32x16 __attribute__((ext_vector_type(16)));
typedef unsigned u32x4 __attribute__((ext_vector_type(4)));
typedef unsigned u32x2 __attribute__((ext_vector_type(2)));
typedef float f32x2v __attribute__((ext_vector_type(2)));
typedef __bf16 bf16x2v __attribute__((ext_vector_type(2)));

constexpr int NT = 65536, SEQ = 4096, DMODEL = 1024, NIN = 2304, DFF = 2816;
constexpr float EPS = 1e-6f;
constexpr float C2 = 0.125f * 1.4426950408889634f;
constexpr size_t MiB = (size_t)1 << 20;
constexpr size_t W_IN = 0, W_OUT = W_IN + (size_t)NIN * 1024 * 2, W_GU = W_OUT + (size_t)1024 * 1024 * 2, W_DN = W_GU + (size_t)2 * DFF * 1024 * 2,
                 W_GLU = W_DN + (size_t)1024 * DFF * 2, W_LAYER = 24 * MiB;
static_assert(W_GLU + 512 * 256 * 2 <= W_LAYER, "weight block");
constexpr size_t WS_W = 0, WS_ROPE = 48 * MiB, WS_H = 64 * MiB, WS_P = 192 * MiB, WS_YC = 544 * MiB, WS_ZB = 640 * MiB, WS_OB = 672 * MiB, WS_ST = 768 * MiB, WS_BAR = 776 * MiB, WS_XB = 778 * MiB, WS_SS = 906 * MiB, WS_END = 912 * MiB;
constexpr int LDS_BYTES = 147456;
constexpr int NTHREADS = 512;

#define CAS __attribute__((address_space(4)))
struct Args {
    const float* in[24];
    float* out;
    unsigned char* ws;
    int ph_lo, ph_hi;
};

__device__ __forceinline__ unsigned pk2(float lo, float hi) { f32x2v v = {lo, hi}; bf16x2v b = __builtin_convertvector(v, bf16x2v); return __builtin_bit_cast(unsigned, b); }
__device__ __forceinline__ float bflo(unsigned u) { return __uint_as_float(u << 16); }
__device__ __forceinline__ float bfhi(unsigned u) { return __uint_as_float(u & 0xffff0000u); }
__device__ __forceinline__ float wave_sum(float v) {
#pragma unroll
    for (int o = 1; o < 64; o <<= 1) v += __shfl_xor(v, o);
    return v;
}
__device__ __forceinline__ float sigmoidf_(float x) { return __builtin_amdgcn_rcpf(1.f + __expf(-x)); }
__device__ __forceinline__ float gelu_tanh(float y) {
    const float a = 0.7978845608028654f * (y + 0.044715f * y * y * y);
    const float t = 1.f - 2.f * __builtin_amdgcn_rcpf(__expf(2.f * a) + 1.f);
    return 0.5f * y * (1.f + t);
}
#define WAVE_LDS_SYNC() asm volatile("s_waitcnt lgkmcnt(0)" ::: "memory")

struct RowScale {
    const float* ssp; LAS float* xs;
    __device__ __forceinline__ float rs_of(int row) const { const f32x4 sp = *(const f32x4*)(ssp + (size_t)row * 4); return rsqrtf(((sp.x + sp.y) + (sp.z + sp.w)) * (1.f / DMODEL) + EPS); }
    __device__ __forceinline__ void prime(const pg8::Unit& u) const { const int t = threadIdx.x; if (t < 256) xs[t] = rs_of(u.pm * 256 + t); }
};
struct EpiIn {
    static constexpr bool PERM = true, AFTER_DRAIN = false;
    bf16_t* O; const float* ropec; const float* ropes; RowScale R;
    __device__ __forceinline__ void prime(const pg8::Unit& u) const { R.prime(u); }
    __device__ __forceinline__ void operator()(const f32x4 (&acc)[2][2][4][2], const pg8::Unit& u, int wr, int wc, int fr, int fq, const pg8::Unit& nxt, bool has_next, int ui) const {
        const int row0 = u.pm * 256 + wr * 64 + fr, t = threadIdx.x;
        f32x4 spn = {0.f, 0.f, 0.f, 0.f};
        const bool stage = has_next && t < 256 && nxt.pm != u.pm;
        if (stage) spn = *(const f32x4*)(R.ssp + (size_t)(nxt.pm * 256 + t) * 4);
        const LAS float* xsc = R.xs + (ui & 1) * 256 + wr * 64 + fr;
        if (u.pn == 6 || u.pn == 7) {
            const float sc = (u.pn == 6) ? C2 : 1.f;
            const int dimb = 16 * (wc & 1) + 4 * fq;
#pragma unroll
            for (int ai = 0; ai < 2; ++ai)
#pragma unroll
                for (int m = 0; m < 4; ++m) {
                    const int row = row0 + ai * 128 + m * 16; const int pos = row & (SEQ - 1);
                    const float rsc = xsc[ai * 128 + m * 16] * sc;
                    const f32x4 cs = *(const f32x4*)(ropec + pos * 32 + dimb), sn = *(const f32x4*)(ropes + pos * 32 + dimb);
                    bf16_t* rowp = O + (size_t)row * NIN + u.pn * 256 + 64 * (wc >> 1) + dimb;
#pragma unroll
                    for (int bj = 0; bj < 2; ++bj) {
                        const f32x4 x1 = acc[ai][bj][m][0] * rsc, x2 = acc[ai][bj][m][1] * rsc;
                        const f32x4 o1 = x1 * cs - x2 * sn, o2 = x2 * cs + x1 * sn;
                        u32x2 w1, w2; w1.x = pk2(o1[0], o1[1]); w1.y = pk2(o1[2], o1[3]); w2.x = pk2(o2[0], o2[1]); w2.y = pk2(o2[2], o2[3]);
                        *(u32x2*)(rowp + bj * 128) = w1; *(u32x2*)(rowp + bj * 128 + 32) = w2;
                    }
                }
        } else {
#pragma unroll
            for (int ai = 0; ai < 2; ++ai)
#pragma unroll
                for (int m = 0; m < 4; ++m) {
                    bf16_t* rowp = O + (size_t)(row0 + ai * 128 + m * 16) * NIN + u.pn * 256 + wc * 32 + 8 * fq;
                    const float rsc = xsc[ai * 128 + m * 16];
#pragma unroll
                    for (int bj = 0; bj < 2; ++bj) {
                        const f32x4 v0 = acc[ai][bj][m][0] * rsc, v1 = acc[ai][bj][m][1] * rsc;
                        u32x4 w; w.x = pk2(v0[0], v0[1]); w.y = pk2(v0[2], v0[3]); w.z = pk2(v1[0], v1[1]); w.w = pk2(v1[2], v1[3]);
                        *(u32x4*)(rowp + bj * 128) = w;
                    }
                }
        }
        if (has_next && t < 256) {
            float v = R.xs[(ui & 1) * 256 + t];
            if (nxt.pm != u.pm) v = rsqrtf(((spn.x + spn.y) + (spn.z + spn.w)) * (1.f / DMODEL) + EPS);
            R.xs[((ui + 1) & 1) * 256 + t] = v;
        }
    }
};
struct EpiRes {
    static constexpr bool PERM = true, AFTER_DRAIN = false;
    bf16_t* xb; float* ssp; LAS float* xl;
    __device__ __forceinline__ void prime(const pg8::Unit&) const {}
    __device__ __forceinline__ void operator()(const f32x4 (&acc)[2][2][4][2], const pg8::Unit& u, int wr, int wc, int fr, int fq, const pg8::Unit&, bool, int) const {
        const int row0 = u.pm * 256 + wr * 64 + fr, col0 = u.pn * 256 + wc * 32 + 8 * fq;
        u32x4 rv[2][4][2];
#pragma unroll
        for (int ai = 0; ai < 2; ++ai)
#pragma unroll
            for (int m = 0; m < 4; ++m)
#pragma unroll
                for (int bj = 0; bj < 2; ++bj) rv[ai][m][bj] = *(const u32x4*)(xb + (size_t)(row0 + ai * 128 + m * 16) * DMODEL + col0 + bj * 128);
#pragma unroll
        for (int ai = 0; ai < 2; ++ai)
#pragma unroll
            for (int m = 0; m < 4; ++m) {
                const int row = row0 + ai * 128 + m * 16;
                const size_t off = (size_t)row * DMODEL + col0;
                float sq = 0.f;
#pragma unroll
                for (int bj = 0; bj < 2; ++bj) {
                    const u32x4 r = rv[ai][m][bj];
                    const f32x4 r0 = {bflo(r.x), bfhi(r.x), bflo(r.y), bfhi(r.y)}, r1 = {bflo(r.z), bfhi(r.z), bflo(r.w), bfhi(r.w)};
                    const f32x4 x0 = r0 + acc[ai][bj][m][0], x1 = r1 + acc[ai][bj][m][1];
                    u32x4 w; w.x = pk2(x0[0], x0[1]); w.y = pk2(x0[2], x0[3]); w.z = pk2(x1[0], x1[1]); w.w = pk2(x1[2], x1[3]);
                    *(u32x4*)(xb + off + bj * 128) = w;
                    sq += (x0[0] * x0[0] + x0[1] * x0[1]) + (x0[2] * x0[2] + x0[3] * x0[3]) + (x1[0] * x1[0] + x1[1] * x1[1]) + (x1[2] * x1[2] + x1[3] * x1[3]);
                }
                sq += __shfl_xor(sq, 16); sq += __shfl_xor(sq, 32);
                if (fq == 0) xl[(wr * 64 + ai * 128 + m * 16 + fr) * 4 + wc] = sq;
            }
        asm volatile("s_waitcnt lgkmcnt(0)\n\ts_barrier" ::: "memory");
        const int t = threadIdx.x;
        if (t < 256) { const f32x4 v = *(const LAS f32x4*)(xl + t * 4); ssp[(size_t)(u.pm * 256 + t) * 4 + u.pn] = (v.x + v.y) + (v.z + v.w); }
    }
};
template <int MODE  > struct EpiGate {
    static constexpr bool PERM = true, AFTER_DRAIN = false;
    bf16_t* O; int ldc; int coff; RowScale R;
    __device__ __forceinline__ void prime(const pg8::Unit& u) const { if (MODE == 0) R.prime(u); }
    __device__ __forceinline__ void operator()(const f32x4 (&acc)[2][2][4][2], const pg8::Unit& u, int wr, int wc, int fr, int fq, const pg8::Unit& nxt, bool has_next, int ui) const {
        const int row0 = u.pm * 256 + wr * 64 + fr, col0 = coff + u.pn * 128 + wc * 32 + 8 * fq, t = threadIdx.x;
        f32x4 spn = {0.f, 0.f, 0.f, 0.f};
        if (MODE == 0) { if (has_next && t < 256 && nxt.pm != u.pm) spn = *(const f32x4*)(R.ssp + (size_t)(nxt.pm * 256 + t) * 4); }
        const LAS float* xsc = R.xs + (ui & 1) * 256 + wr * 64 + fr;
#pragma unroll
        for (int ai = 0; ai < 2; ++ai)
#pragma unroll
            for (int m = 0; m < 4; ++m) {
                float r[8];
                float rsc = 1.f; if (MODE == 0) rsc = xsc[ai * 128 + m * 16];
#pragma unroll
                for (int n = 0; n < 2; ++n)
#pragma unroll
                    for (int j = 0; j < 4; ++j) {
                        const float a = acc[ai][0][m][n][j] * rsc, b = acc[ai][1][m][n][j] * rsc;
                        r[4 * n + j] = (MODE == 0) ? (a * sigmoidf_(a)) * b : a * sigmoidf_(b);
                    }
                u32x4 w; w.x = pk2(r[0], r[1]); w.y = pk2(r[2], r[3]); w.z = pk2(r[4], r[5]); w.w = pk2(r[6], r[7]);
                *(u32x4*)(O + (size_t)(row0 + ai * 128 + m * 16) * ldc + col0) = w;
            }
        if (MODE == 0) {
            if (has_next && t < 256) {
                float v = R.xs[(ui & 1) * 256 + t];
                if (nxt.pm != u.pm) v = rsqrtf(((spn.x + spn.y) + (spn.z + spn.w)) * (1.f / DMODEL) + EPS);
                R.xs[((ui + 1) & 1) * 256 + t] = v;
            }
        }
    }
};

struct WMat { const float* src; const float* src2; int K, N, ldw, kind; bf16_t* dst; const float* kscale; };
__device__ __forceinline__ void wconv_load(const WMat& w, int t, int tid, float (&v)[8]) {
    const int nkt = w.K / 64, jt = t / nkt, kt = t % nkt, j0 = jt * 64, k0 = kt * 64;
    const int j = j0 + (tid & 63);
    const float* s = w.src; int col = j;
    if (w.kind == 1) {
        if (j >= 1536 && j < 2048) { const int ww = j & 63; col = (j & ~63) + 32 * ((ww >> 2) & 1) + 16 * (ww >> 5) + 4 * ((ww >> 3) & 3) + (ww & 3); }
    } else if (w.kind == 2) {
        const int pn = j >> 8, wi = j & 255; if (wi < 128) col = pn * 128 + wi; else { s = w.src2; col = pn * 128 + (wi - 128); }
    }
    const int kk = tid >> 6;
#pragma unroll
    for (int i = 0; i < 8; ++i) { const int k = kk + 8 * i; const float sc = w.kscale ? w.kscale[k0 + k] : 1.f; v[i] = s[(size_t)(k0 + k) * w.ldw + col] * sc; }
}
__device__ __forceinline__ void wconv_store(LAS float* tile, const WMat& w, int t, int tid, const float (&v)[8]) {
    const int nkt = w.K / 64, jt = t / nkt, kt = t % nkt, j0 = jt * 64, k0 = kt * 64;
    const int kk = tid >> 6;
#pragma unroll
    for (int i = 0; i < 8; ++i) tile[(kk + 8 * i) * 65 + (tid & 63)] = v[i];
    __syncthreads();
    {
        const int jr = tid >> 3, c = tid & 7; const LAS float* s = tile + (8 * c) * 65 + jr;
        u32x4 o; o.x = pk2(s[0], s[65]); o.y = pk2(s[2 * 65], s[3 * 65]); o.z = pk2(s[4 * 65], s[5 * 65]); o.w = pk2(s[6 * 65], s[7 * 65]);
        *(u32x4*)(w.dst + (size_t)(j0 + jr) * w.K + k0 + 8 * c) = o;
    }
    __syncthreads();
}
__device__ __forceinline__ WMat wmat_of(const CAS Args* ap, unsigned char* ws, int it, int& t) {
    const int layer = it / 2976; t = it % 2976;
    unsigned char* wb = ws + WS_W + (size_t)layer * W_LAYER;
    if (t < 576) return WMat{ap->in[2] + (size_t)layer * 1024 * NIN, nullptr, 1024, NIN, NIN, 1, (bf16_t*)(wb + W_IN), ap->in[1] + layer * 1024};
    if ((t -= 576) < 256) return WMat{ap->in[18] + (size_t)layer * 1024 * 1024, nullptr, 1024, 1024, 1024, 0, (bf16_t*)(wb + W_OUT), nullptr};
    if ((t -= 256) < 1408) return WMat{ap->in[20] + (size_t)layer * 1024 * DFF, ap->in[21] + (size_t)layer * 1024 * DFF, 1024, 2 * DFF, DFF, 2, (bf16_t*)(wb + W_GU), ap->in[19] + layer * 1024};
    if ((t -= 1408) < 704) return WMat{ap->in[22] + (size_t)layer * DFF * 1024, nullptr, DFF, 1024, 1024, 0, (bf16_t*)(wb + W_DN), nullptr};
    t -= 704; return WMat{ap->in[16] + (size_t)layer * 256 * 512, ap->in[16] + (size_t)layer * 256 * 512 + 256, 256, 512, 512, 2, (bf16_t*)(wb + W_GLU), nullptr};
}

__device__ __forceinline__ void norm_rows_bf16(const float* X, const float* g, bf16_t* H, int gw, int ngw, int lane) {
    f32x4 gv[4];
#pragma unroll
    for (int j = 0; j < 4; ++j) gv[j] = ((const f32x4*)g)[lane + 64 * j];
    for (int m = gw; m < NT; m += ngw) {
        const f32x4* xr = (const f32x4*)(X + (size_t)m * DMODEL) + lane;
        f32x4 v[4]; float s = 0.f;
#pragma unroll
        for (int j = 0; j < 4; ++j) { v[j] = xr[64 * j]; s += (v[j].x * v[j].x + v[j].y * v[j].y) + (v[j].z * v[j].z + v[j].w * v[j].w); }
        const float rs = rsqrtf(wave_sum(s) * (1.f / DMODEL) + EPS);
        u32x2* o = (u32x2*)(H + (size_t)m * DMODEL) + lane;
#pragma unroll
        for (int j = 0; j < 4; ++j) { u32x2 w; w.x = pk2(v[j].x * rs * gv[j].x, v[j].y * rs * gv[j].y); w.y = pk2(v[j].z * rs * gv[j].z, v[j].w * rs * gv[j].w); o[64 * j] = w; }
    }
}
__device__ __forceinline__ void xb_rows(const float* X, bf16_t* XB, float* ssq, int gw, int ngw, int lane) {
    for (int m = gw; m < NT; m += ngw) {
        const f32x4* xr = (const f32x4*)(X + (size_t)m * DMODEL) + lane;
        f32x4 v[4]; float s = 0.f;
#pragma unroll
        for (int j = 0; j < 4; ++j) { v[j] = xr[64 * j]; s += (v[j].x * v[j].x + v[j].y * v[j].y) + (v[j].z * v[j].z + v[j].w * v[j].w); }
        s = wave_sum(s);
        u32x2* o = (u32x2*)(XB + (size_t)m * DMODEL) + lane;
#pragma unroll
        for (int j = 0; j < 4; ++j) { u32x2 w; w.x = pk2(v[j].x, v[j].y); w.y = pk2(v[j].z, v[j].w); o[64 * j] = w; }
        if (lane == 0) { f32x4 o4 = {s, 0.f, 0.f, 0.f}; *(f32x4*)(ssq + (size_t)m * 4) = o4; }
    }
}
__device__ __forceinline__ void final_rows(const bf16_t* XB, const float* ssp, const float* g, float* OUT, int gw, int ngw, int lane) {
    f32x4 gv[4];
#pragma unroll
    for (int j = 0; j < 4; ++j) gv[j] = ((const f32x4*)g)[lane + 64 * j];
    for (int m = gw; m < NT; m += ngw) {
        const f32x4 sp = *(const f32x4*)(ssp + (size_t)m * 4);
        const float rs = rsqrtf(((sp.x + sp.y) + (sp.z + sp.w)) * (1.f / DMODEL) + EPS);
        const u32x2* xr = (const u32x2*)(XB + (size_t)m * DMODEL) + lane;
        f32x4* o = (f32x4*)(OUT + (size_t)m * DMODEL) + lane;
#pragma unroll
        for (int j = 0; j < 4; ++j) { const u32x2 w = xr[64 * j]; f32x4 v = {bflo(w.x), bfhi(w.x), bflo(w.y), bfhi(w.y)}; o[64 * j] = v * rs * gv[j]; }
    }
}
__device__ __forceinline__ void norm_rows_f32_inplace(float* X, const float* g, int gw, int ngw, int lane) {
    f32x4 gv[4];
#pragma unroll
    for (int j = 0; j < 4; ++j) gv[j] = ((const f32x4*)g)[lane + 64 * j];
    for (int m = gw; m < NT; m += ngw) {
        f32x4* xr = (f32x4*)(X + (size_t)m * DMODEL) + lane;
        f32x4 v[4]; float s = 0.f;
#pragma unroll
        for (int j = 0; j < 4; ++j) { v[j] = xr[64 * j]; s += (v[j].x * v[j].x + v[j].y * v[j].y) + (v[j].z * v[j].z + v[j].w * v[j].w); }
        const float rs = rsqrtf(wave_sum(s) * (1.f / DMODEL) + EPS);
#pragma unroll
        for (int j = 0; j < 4; ++j) xr[64 * j] = v[j] * rs * gv[j];
    }
}

struct C3Regs { u32x4 hh[6], cc[6], bb[4]; };
__device__ __forceinline__ void conv3_issue(const bf16_t* P, int w, C3Regs& R) {
    const int c8 = w & 31, tok = (w >> 5) * 4, t = tok & (SEQ - 1);
    const bf16_t* base = P + (size_t)tok * NIN + c8 * 8;
#pragma unroll
    for (int i = 0; i < 6; ++i) { const int dt = (t == 0 && i < 2) ? 0 : i - 2; R.hh[i] = *(const u32x4*)(base + dt * NIN); R.cc[i] = *(const u32x4*)(base + dt * NIN + 512); }
#pragma unroll
    for (int i = 0; i < 4; ++i) R.bb[i] = *(const u32x4*)(base + i * NIN + 256);
}
__device__ __forceinline__ void mul8(const u32x4 a, const u32x4 b, float (&o)[8]) {
    o[0] = bflo(a.x) * bflo(b.x); o[1] = bfhi(a.x) * bfhi(b.x); o[2] = bflo(a.y) * bflo(b.y); o[3] = bfhi(a.y) * bfhi(b.y);
    o[4] = bflo(a.z) * bflo(b.z); o[5] = bfhi(a.z) * bfhi(b.z); o[6] = bflo(a.w) * bflo(b.w); o[7] = bfhi(a.w) * bfhi(b.w);
}
__device__ __forceinline__ void conv3_compute(bf16_t* YC, int w, const C3Regs& R, const float (&w0)[8], const float (&w1)[8], const float (&w2)[8]) {
    const int c8 = w & 31, tok = (w >> 5) * 4, t = tok & (SEQ - 1);
    const float z01 = (t == 0) ? 0.f : 1.f;
    float g[6][8];
#pragma unroll
    for (int i = 0; i < 6; ++i) mul8(R.hh[i], R.cc[i], g[i]);
#pragma unroll
    for (int j = 0; j < 8; ++j) { g[0][j] *= z01; g[1][j] *= z01; }
#pragma unroll
    for (int i = 0; i < 4; ++i) {
        const u32x4 bv = R.bb[i];
        const float bb[8] = {bflo(bv.x), bfhi(bv.x), bflo(bv.y), bfhi(bv.y), bflo(bv.z), bfhi(bv.z), bflo(bv.w), bfhi(bv.w)};
        float y[8];
#pragma unroll
        for (int j = 0; j < 8; ++j) y[j] = bb[j] * (w0[j] * g[i][j] + w1[j] * g[i + 1][j] + w2[j] * g[i + 2][j]);
        u32x4 o; o.x = pk2(y[0], y[1]); o.y = pk2(y[2], y[3]); o.z = pk2(y[4], y[5]); o.w = pk2(y[6], y[7]);
        *(u32x4*)(YC + (size_t)(tok + i) * 768 + c8 * 8) = o;
    }
}
__device__ __forceinline__ void conv3_phase(const bf16_t* P, bf16_t* YC, const float* w3, int bx, int G, int tid) {
    constexpr int NW = NT / 4 * 32;
    const int c8 = tid & 31;
    float w0[8], w1[8], w2[8];
#pragma unroll
    for (int j = 0; j < 8; ++j) { w0[j] = w3[c8 * 8 + j]; w1[j] = w3[256 + c8 * 8 + j]; w2[j] = w3[512 + c8 * 8 + j]; }
    C3Regs Ra, Rb;
    int w = bx * NTHREADS + tid; const int step = G * NTHREADS;
    if (w < NW) conv3_issue(P, w, Ra);
    for (; w < NW; w += 2 * step) {
        if (w + step < NW) conv3_issue(P, w + step, Rb);
        conv3_compute(YC, w, Ra, w0, w1, w2);
        if (w + step < NW) { if (w + 2 * step < NW) conv3_issue(P, w + 2 * step, Ra); conv3_compute(YC, w + step, Rb, w0, w1, w2); }
    }
}

constexpr int CF_ZOFF = 0, CF_STOFF = 94 * 1024;
__device__ __forceinline__ void cfm_issue(const bf16_t* P, int tix, int tid, u32x4 (&ar)[6], u32x4 (&gr)[6]) {
    const int b = tix >> 6, t0 = (tix & 63) * 64;
#pragma unroll
    for (int k = 0; k < 6; ++k) {
        int e = tid + NTHREADS * k; e = e < 94 * 32 ? e : 94 * 32 - 1;
        const int row = e >> 5, c8 = e & 31; int t = t0 - 30 + row; t = t < 0 ? 0 : t;
        const bf16_t* src = P + ((size_t)b * SEQ + t) * NIN + 768 + c8 * 8;
        ar[k] = *(const u32x4*)src; gr[k] = *(const u32x4*)(src + 256);
    }
}
__device__ __forceinline__ void cfm_stage(LAS unsigned char* lds, int tix, int tid, const u32x4 (&ar)[6], const u32x4 (&gr)[6]) {
    const int t0 = (tix & 63) * 64;
    LAS float* ZT = (LAS float*)(lds + CF_ZOFF);
#pragma unroll
    for (int k = 0; k < 6; ++k) {
        const int e = tid + NTHREADS * k;
        if (e < 94 * 32) {
            const int row = e >> 5, c8 = e & 31; const float zm = (t0 - 30 + row < 0) ? 0.f : 1.f;
            const u32x4 a = ar[k], g = gr[k];
            f32x4 z0, z1;
            z0[0] = bflo(a.x) * sigmoidf_(bflo(g.x)) * zm; z0[1] = bfhi(a.x) * sigmoidf_(bfhi(g.x)) * zm; z0[2] = bflo(a.y) * sigmoidf_(bflo(g.y)) * zm; z0[3] = bfhi(a.y) * sigmoidf_(bfhi(g.y)) * zm;
            z1[0] = bflo(a.z) * sigmoidf_(bflo(g.z)) * zm; z1[1] = bfhi(a.z) * sigmoidf_(bfhi(g.z)) * zm; z1[2] = bflo(a.w) * sigmoidf_(bflo(g.w)) * zm; z1[3] = bfhi(a.w) * sigmoidf_(bfhi(g.w)) * zm;
            *(LAS f32x4*)(ZT + row * 256 + c8 * 8) = z0; *(LAS f32x4*)(ZT + row * 256 + c8 * 8 + 4) = z1;
        }
    }
}
__device__ __forceinline__ void cfm_phase(LAS unsigned char* lds, const bf16_t* P, bf16_t* YC, const float* dww, const float* dwb, const float* lng, const float* lnb,
                                          int bx, int G, int tid, int wid, int lane) {
    const int cp = tid & 127, rr = tid >> 7;
    f32x2v w[31];
#pragma unroll
    for (int k = 0; k < 31; ++k) w[k] = *(const f32x2v*)(dww + k * 256 + 2 * cp);
    const f32x2v bias = *(const f32x2v*)(dwb + 2 * cp), lg = *(const f32x2v*)(lng + 2 * cp), lb = *(const f32x2v*)(lnb + 2 * cp);
    LAS float* ZT = (LAS float*)(lds + CF_ZOFF);
    LAS float* STX = (LAS float*)(lds + CF_STOFF);
    u32x4 ar[6], gr[6];
    int tix = bx;
    if (tix < 1024) cfm_issue(P, tix, tid, ar, gr);
    for (; tix < 1024; tix += G) {
        __syncthreads();
        cfm_stage(lds, tix, tid, ar, gr);
        if (tix + G < 1024) cfm_issue(P, tix + G, tid, ar, gr);
        __syncthreads();
        f32x2v acc[16];
#pragma unroll
        for (int j = 0; j < 16; ++j) acc[j] = bias;
#pragma unroll
        for (int s = 0; s < 46; ++s) {
            const f32x2v z = *(const LAS f32x2v*)(ZT + (rr * 16 + s) * 256 + 2 * cp);
#pragma unroll
            for (int j = 0; j < 16; ++j) { const int k = s - j; if (k >= 0 && k <= 30) acc[j] += w[k] * z; }
        }
        float s1[16], s2[16];
#pragma unroll
        for (int j = 0; j < 16; ++j) { s1[j] = wave_sum(acc[j].x + acc[j].y); s2[j] = wave_sum(acc[j].x * acc[j].x + acc[j].y * acc[j].y); }
        if (lane == 0) {
#pragma unroll
            for (int j = 0; j < 16; ++j) { STX[wid * 32 + j] = s1[j]; STX[wid * 32 + 16 + j] = s2[j]; }
        }
        __syncthreads();
        const int b = tix >> 6, t0 = (tix & 63) * 64;
#pragma unroll
        for (int j = 0; j < 16; ++j) {
            const float S1 = s1[j] + STX[(wid ^ 1) * 32 + j], S2 = s2[j] + STX[(wid ^ 1) * 32 + 16 + j];
            const float mean = S1 * (1.f / 256.f), var = fmaxf(S2 * (1.f / 256.f) - mean * mean, 0.f), rs = rsqrtf(var + EPS);
            f32x2v y = (acc[j] - mean) * rs * lg + lb;
            y.x = y.x * sigmoidf_(y.x); y.y = y.y * sigmoidf_(y.y);
            *(unsigned*)(YC + ((size_t)b * SEQ + t0 + rr * 16 + j) * 768 + 256 + 2 * cp) = pk2(y.x, y.y);
        }
    }
}

template <bool FULL> __device__ __forceinline__ void ssm_tile_scan(f32x16& xr, f32x16& xi, const float (&pw)[4][2], float& cr, float& ci, const bool hi) {
    const float l1r = pw[0][0], l1i = pw[0][1], l4r = pw[3][0], l4i = pw[3][1];
#pragma unroll
    for (int G = 0; G < 4; ++G)
#pragma unroll
        for (int j = 1; j < 4; ++j) { const int i = 4 * G + j; const float pr = xr[i - 1], pi = xi[i - 1]; xr[i] += l1r * pr - l1i * pi; xi[i] += l1r * pi + l1i * pr; }
    float cinr[4], cini[4];
#pragma unroll
    for (int G = 0; G < 4; ++G) {
        const float er = xr[4 * G + 3], ei = xi[4 * G + 3];
        const float orr = __shfl_xor(er, 32), oi = __shfl_xor(ei, 32);
        const float e0r = hi ? orr : er, e0i = hi ? oi : ei, e1r = hi ? er : orr, e1i = hi ? ei : oi;
        const float c1r = l4r * cr - l4i * ci + e0r, c1i = l4r * ci + l4i * cr + e0i;
        cinr[G] = hi ? c1r : cr; cini[G] = hi ? c1i : ci;
        const float c2r = l4r * c1r - l4i * c1i + e1r, c2i = l4r * c1i + l4i * c1r + e1i;
        cr = c2r; ci = c2i;
    }
    if (FULL) {
#pragma unroll
        for (int G = 0; G < 4; ++G)
#pragma unroll
            for (int j = 0; j < 4; ++j) { const int i = 4 * G + j; xr[i] += pw[j][0] * cinr[G] - pw[j][1] * cini[G]; xi[i] += pw[j][0] * cini[G] + pw[j][1] * cinr[G]; }
    }
}
constexpr int SSM_ROWB = 272;
__device__ __forceinline__ void ssm_item(LAS unsigned char* lds, const bf16_t* P, bf16_t* ZB, const float* a_re, const float* a_im, const float* log_dt, const float* b_re, const float* b_im,
                                         const float* c_re, const float* c_im, const float* d_skip, int item, int tid, int wid, int lane) {
    const int b = item >> 4, g = item & 15;
    const int r32 = lane & 31, h = lane >> 5; const bool hi = h != 0;
    LAS f32x2v* EW = (LAS f32x2v*)lds;
    LAS unsigned char* SBW = lds + 4096 + wid * (32 * SSM_ROWB);
    __syncthreads();
    float pw[2][4][2]; bf16x8 bfr[2][2];
#pragma unroll
    for (int tp = 0; tp < 2; ++tp) {
        const int p = r32 + 32 * tp;
        const float dt = __expf(log_dt[g]);
        const float ar = a_re[g * 64 + p], ai = a_im[g * 64 + p];
        const float mag = __expf(ar * dt);
        const float lr = mag * cosf(ai * dt), li = mag * sinf(ai * dt);
        const float den = ar * ar + ai * ai, nr = lr - 1.f, ni = li;
        const float fr = (nr * ar + ni * ai) / den, fi = (ni * ar - nr * ai) / den;
        const f32x4* br4 = (const f32x4*)(b_re + (size_t)(g * 64 + p) * 16 + 8 * h); const f32x4* bi4 = (const f32x4*)(b_im + (size_t)(g * 64 + p) * 16 + 8 * h);
        const f32x4 r0 = br4[0], r1 = br4[1], i0 = bi4[0], i1 = bi4[1];
        const f32x4 re0 = fr * r0 - fi * i0, re1 = fr * r1 - fi * i1, im0 = fr * i0 + fi * r0, im1 = fr * i1 + fi * r1;
        u32x4 wre, wim;
        wre.x = pk2(re0[0], re0[1]); wre.y = pk2(re0[2], re0[3]); wre.z = pk2(re1[0], re1[1]); wre.w = pk2(re1[2], re1[3]);
        wim.x = pk2(im0[0], im0[1]); wim.y = pk2(im0[2], im0[3]); wim.z = pk2(im1[0], im1[1]); wim.w = pk2(im1[2], im1[3]);
        bfr[tp][0] = __builtin_bit_cast(bf16x8, wre); bfr[tp][1] = __builtin_bit_cast(bf16x8, wim);
        pw[tp][0][0] = lr; pw[tp][0][1] = li;
#pragma unroll
        for (int j = 1; j < 4; ++j) { pw[tp][j][0] = pw[tp][j - 1][0] * lr - pw[tp][j - 1][1] * li; pw[tp][j][1] = pw[tp][j - 1][0] * li + pw[tp][j - 1][1] * lr; }
    }
    const int t16 = lane & 15, quad = lane >> 4;
    bf16x8 cfr[4];
#pragma unroll
    for (int s = 0; s < 4; ++s) {
        const f32x4 cr4 = *(const f32x4*)(c_re + (size_t)(g * 16 + t16) * 64 + 4 * quad + 16 * s), ci4 = *(const f32x4*)(c_im + (size_t)(g * 16 + t16) * 64 + 4 * quad + 16 * s);
        u32x4 w; w.x = pk2(cr4[0], -ci4[0]); w.y = pk2(cr4[1], -ci4[1]); w.z = pk2(cr4[2], -ci4[2]); w.w = pk2(cr4[3], -ci4[3]);
        cfr[s] = __builtin_bit_cast(bf16x8, w);
    }
    const f32x4 dsk = *(const f32x4*)(d_skip + g * 16 + 4 * quad);
    const size_t tok0 = (size_t)b * SEQ + (size_t)wid * 512;
    const bf16_t* ubase = P + tok0 * NIN + 1280 + g * 16;
    f32x16 zero16;
#pragma unroll
    for (int q = 0; q < 16; ++q) zero16[q] = 0.f;
    float cr[2] = {0.f, 0.f}, ci[2] = {0.f, 0.f};
    {
        bf16x8 ua = *(const bf16x8*)(ubase + (size_t)r32 * NIN + 8 * h);
        for (int mt = 0; mt < 16; ++mt) {
            const bf16x8 un = *(const bf16x8*)(ubase + (size_t)((mt < 15 ? mt + 1 : mt) * 32 + r32) * NIN + 8 * h);
#pragma unroll
            for (int tp = 0; tp < 2; ++tp) {
                f32x16 xr = __builtin_amdgcn_mfma_f32_32x32x16_bf16(ua, bfr[tp][0], zero16, 0, 0, 0);
                f32x16 xi = __builtin_amdgcn_mfma_f32_32x32x16_bf16(ua, bfr[tp][1], zero16, 0, 0, 0);
                ssm_tile_scan<false>(xr, xi, pw[tp], cr[tp], ci[tp], hi);
            }
            ua = un;
        }
    }
    if (!hi) { f32x2v e0 = {cr[0], ci[0]}, e1 = {cr[1], ci[1]}; EW[wid * 64 + r32] = e0; EW[wid * 64 + 32 + r32] = e1; }
    __syncthreads();
#pragma unroll
    for (int tp = 0; tp < 2; ++tp) {
        float qr = pw[tp][3][0], qi = pw[tp][3][1];
#pragma unroll
        for (int q = 0; q < 7; ++q) { const float nr = qr * qr - qi * qi, ni = 2.f * qr * qi; qr = nr; qi = ni; }
        float sr = 0.f, si = 0.f;
        for (int w = 0; w < wid; ++w) { const f32x2v e = EW[w * 64 + r32 + 32 * tp]; const float nr = qr * sr - qi * si + e.x, ni = qr * si + qi * sr + e.y; sr = nr; si = ni; }
        cr[tp] = sr; ci[tp] = si;
    }
    {
        bf16x8 ua = *(const bf16x8*)(ubase + (size_t)r32 * NIN + 8 * h);
        for (int mt = 0; mt < 16; ++mt) {
            const bf16x8 un = *(const bf16x8*)(ubase + (size_t)((mt < 15 ? mt + 1 : mt) * 32 + r32) * NIN + 8 * h);
            u32x2 uwv[2];
#pragma unroll
            for (int tt = 0; tt < 2; ++tt) uwv[tt] = *(const u32x2*)(P + (tok0 + mt * 32 + tt * 16 + t16) * NIN + 1280 + g * 16 + 4 * quad);
#pragma unroll
            for (int tp = 0; tp < 2; ++tp) {
                f32x16 xr = __builtin_amdgcn_mfma_f32_32x32x16_bf16(ua, bfr[tp][0], zero16, 0, 0, 0);
                f32x16 xi = __builtin_amdgcn_mfma_f32_32x32x16_bf16(ua, bfr[tp][1], zero16, 0, 0, 0);
                ssm_tile_scan<true>(xr, xi, pw[tp], cr[tp], ci[tp], hi);
#pragma unroll
                for (int i = 0; i < 16; ++i) {
                    const int t = (i & 3) + 8 * (i >> 2) + 4 * h;
                    *(LAS unsigned*)(SBW + t * SSM_ROWB + 4 * (r32 + 32 * tp)) = pk2(xr[i], xi[i]);
                }
            }
            WAVE_LDS_SYNC();
#pragma unroll
            for (int tt = 0; tt < 2; ++tt) {
                f32x4 acc = {0.f, 0.f, 0.f, 0.f};
#pragma unroll
                for (int s = 0; s < 4; ++s) {
                    const bf16x8 sf = *(const LAS bf16x8*)(SBW + (tt * 16 + t16) * SSM_ROWB + quad * 16 + 64 * s);
                    acc = __builtin_amdgcn_mfma_f32_16x16x32_bf16(cfr[s], sf, acc, 0, 0, 0);
                }
                const size_t tok = tok0 + mt * 32 + tt * 16 + t16;
                const u32x2 uw = uwv[tt];
                const f32x4 uu = {bflo(uw.x), bfhi(uw.x), bflo(uw.y), bfhi(uw.y)};
                const f32x4 y = acc + dsk * uu;
                u32x2 w; w.x = pk2(gelu_tanh(y.x), gelu_tanh(y.y)); w.y = pk2(gelu_tanh(y.z), gelu_tanh(y.w));
                *(u32x2*)(ZB + tok * 256 + g * 16 + 4 * quad) = w;
            }
            WAVE_LDS_SYNC();
            ua = un;
        }
    }
}

constexpr int AT_ROWB = 144, AT_KOFF = 0, AT_VOFF = 384 * AT_ROWB;
__device__ __forceinline__ s16x4 vtr(const LAS unsigned char* p) { return __builtin_bit_cast(s16x4, __builtin_amdgcn_ds_read_tr16_b64_v4i16((LAS s16x4*)p)); }
struct AttnU { int pat, head, d, ub; size_t rowbase; };
__device__ __forceinline__ AttnU attn_decode(int u) {
    AttnU U; const int rem = u & 1023, b = rem >> 6, ru = rem & 15; U.pat = u >> 10; U.head = (rem >> 4) & 3;
    int r;
    if (U.pat == 0) { U.d = 1; r = 0; U.ub = ru; } else if (U.pat == 1) { U.d = 4; r = ru >> 2; U.ub = ru & 3; } else { U.d = 16; r = ru; U.ub = 0; }
    U.rowbase = (size_t)b * SEQ + r; return U;
}
__device__ __forceinline__ void attn_issue(const bf16_t* P, const AttnU& U, int tid, int wid, int lane, u32x4 (&kreg)[6], u32x4 (&vreg)[6], bf16x8 (&qf)[4]) {
    const int i0 = U.ub * 256 - 128;
#pragma unroll
    for (int k = 0; k < 6; ++k) {
        const int e = tid + NTHREADS * k, row = e >> 3, c = e & 7; int si = i0 + row; si = si < 0 ? 0 : si;
        const bf16_t* src = P + (U.rowbase + (size_t)si * U.d) * NIN + U.head * 64 + c * 8;
        kreg[k] = *(const u32x4*)(src + 1792); vreg[k] = *(const u32x4*)(src + 2048);
    }
    const int r32 = lane & 31, h = lane >> 5;
    const size_t qtok = U.rowbase + (size_t)(U.ub * 256 + 32 * wid + r32) * U.d;
    const bf16_t* qp = P + qtok * NIN + 1536 + U.head * 64 + 8 * h;
#pragma unroll
    for (int s = 0; s < 4; ++s) qf[s] = *(const bf16x8*)(qp + 16 * s);
}
__device__ __forceinline__ void attn_to_lds(LAS unsigned char* lds, int tid, const u32x4 (&kreg)[6], const u32x4 (&vreg)[6]) {
#pragma unroll
    for (int k = 0; k < 6; ++k) {
        const int e = tid + NTHREADS * k, row = e >> 3, c = e & 7;
        *(LAS u32x4*)(lds + AT_KOFF + row * AT_ROWB + c * 16) = kreg[k];
        *(LAS u32x4*)(lds + AT_VOFF + row * AT_ROWB + c * 16) = vreg[k];
    }
}
__device__ __forceinline__ void attn_compute(LAS unsigned char* lds, const AttnU& U, const bf16x8 (&qf)[4], bf16_t* OB, f32x2v* ST, int wid, int lane) {
    const int pat = U.pat, head = U.head, ub = U.ub;
    const int r32 = lane & 31, h = lane >> 5;
    const size_t qtok = U.rowbase + (size_t)(ub * 256 + 32 * wid + r32) * U.d;
    f32x16 sc[5];
    float mx = -1e30f;
    const float r32f = (float)r32, h4f = (float)(4 * h);
#pragma unroll
    for (int i = 0; i < 5; ++i) {
        const bool tv = (ub > 0) || (wid + i >= 4);
        f32x16 a;
        if (tv) {
#pragma unroll
            for (int q = 0; q < 16; ++q) a[q] = 0.f;
            const LAS unsigned char* kp = lds + AT_KOFF + (32 * wid + 32 * i + r32) * AT_ROWB + 16 * h;
#pragma unroll
            for (int s = 0; s < 4; ++s) { const bf16x8 kf = *(const LAS bf16x8*)(kp + 32 * s); a = __builtin_amdgcn_mfma_f32_32x32x16_bf16(kf, qf[s], a, 0, 0, 0); }
            if (i == 0 || i == 4) {
#pragma unroll
                for (int q = 0; q < 16; ++q) {
                    const float diff = ((float)((q & 3) + 8 * (q >> 2)) + h4f) - r32f;
                    a[q] = (i == 0) ? __builtin_fmaf(fminf(diff, 0.f), 1e30f, a[q]) : __builtin_fmaf(fmaxf(diff, 0.f), -1e30f, a[q]);
                }
            }
#pragma unroll
            for (int q = 0; q < 16; ++q) mx = fmaxf(mx, a[q]);
        } else {
#pragma unroll
            for (int q = 0; q < 16; ++q) a[q] = -1e30f;
        }
        sc[i] = a;
    }
    mx = fmaxf(mx, __shfl_xor(mx, 32));
    float l = 0.f;
#pragma unroll
    for (int i = 0; i < 5; ++i)
#pragma unroll
        for (int q = 0; q < 16; ++q) { const float pv = __builtin_amdgcn_exp2f(sc[i][q] - mx); sc[i][q] = pv; l += pv; }
    l += __shfl_xor(l, 32);
    f32x16 o0, o1;
#pragma unroll
    for (int q = 0; q < 16; ++q) { o0[q] = 0.f; o1[q] = 0.f; }
    const int i16 = lane & 15, q4 = i16 >> 2, p4 = i16 & 3, blk = (lane >> 4) & 1;
#pragma unroll
    for (int i = 0; i < 5; ++i) {
        const bool tv = (ub > 0) || (wid + i >= 4);
        if (tv) {
#pragma unroll
            for (int s2 = 0; s2 < 2; ++s2) {
                u32x4 pw; pw.x = pk2(sc[i][8 * s2], sc[i][8 * s2 + 1]); pw.y = pk2(sc[i][8 * s2 + 2], sc[i][8 * s2 + 3]); pw.z = pk2(sc[i][8 * s2 + 4], sc[i][8 * s2 + 5]); pw.w = pk2(sc[i][8 * s2 + 6], sc[i][8 * s2 + 7]);
                const bf16x8 pb = __builtin_bit_cast(bf16x8, pw);
                const LAS unsigned char* vp = lds + AT_VOFF + (32 * wid + 32 * i + 16 * s2 + 4 * h + q4) * AT_ROWB + 32 * blk + 8 * p4;
                const s16x4 lo0 = vtr(vp), hi0 = vtr(vp + 8 * AT_ROWB), lo1 = vtr(vp + 64), hi1 = vtr(vp + 8 * AT_ROWB + 64);
                const bf16x8 va0 = __builtin_shufflevector(lo0, hi0, 0, 1, 2, 3, 4, 5, 6, 7), va1 = __builtin_shufflevector(lo1, hi1, 0, 1, 2, 3, 4, 5, 6, 7);
                o0 = __builtin_amdgcn_mfma_f32_32x32x16_bf16(va0, pb, o0, 0, 0, 0);
                o1 = __builtin_amdgcn_mfma_f32_32x32x16_bf16(va1, pb, o1, 0, 0, 0);
            }
        }
    }
    const float inv = 1.f / l;
    bf16_t* op = OB + ((size_t)pat * NT + qtok) * 256 + head * 64 + 4 * h;
#pragma unroll
    for (int g4 = 0; g4 < 4; ++g4) {
        u32x2 w0, w1;
        w0.x = pk2(o0[4 * g4] * inv, o0[4 * g4 + 1] * inv); w0.y = pk2(o0[4 * g4 + 2] * inv, o0[4 * g4 + 3] * inv);
        w1.x = pk2(o1[4 * g4] * inv, o1[4 * g4 + 1] * inv); w1.y = pk2(o1[4 * g4 + 2] * inv, o1[4 * g4 + 3] * inv);
        *(u32x2*)(op + 8 * g4) = w0; *(u32x2*)(op + 32 + 8 * g4) = w1;
    }
    if (h == 0) { f32x2v st = {mx, l}; ST[(qtok * 4 + head) * 3 + pat] = st; }
}

__device__ __forceinline__ void combine_rows(const bf16_t* YC, const bf16_t* OB, const f32x2v* ST, const float* gn, bf16_t* H, int gw, int ngw, int lane) {
    f32x4 gv[4];
#pragma unroll
    for (int j = 0; j < 4; ++j) gv[j] = ((const f32x4*)gn)[lane + 64 * j];
    const int head = lane >> 4;
    for (int m = gw; m < NT; m += ngw) {
        f32x4 v[4];
#pragma unroll
        for (int j = 0; j < 3; ++j) { const u32x2 w = *((const u32x2*)(YC + (size_t)m * 768 + 256 * j) + lane); v[j] = (f32x4){bflo(w.x), bfhi(w.x), bflo(w.y), bfhi(w.y)}; }
        {
            const f32x2v s0 = ST[((size_t)m * 4 + head) * 3 + 0], s1 = ST[((size_t)m * 4 + head) * 3 + 1], s2 = ST[((size_t)m * 4 + head) * 3 + 2];
            const float M = fmaxf(s0.x, fmaxf(s1.x, s2.x));
            const float w0 = __builtin_amdgcn_exp2f(s0.x - M) * s0.y, w1 = __builtin_amdgcn_exp2f(s1.x - M) * s1.y, w2 = __builtin_amdgcn_exp2f(s2.x - M) * s2.y;
            const float iw = 1.f / (w0 + w1 + w2);
            const u32x2 a0 = *((const u32x2*)(OB + (size_t)m * 256) + lane), a1 = *((const u32x2*)(OB + ((size_t)NT + m) * 256) + lane), a2 = *((const u32x2*)(OB + ((size_t)2 * NT + m) * 256) + lane);
            f32x4 o;
            o.x = (w0 * bflo(a0.x) + w1 * bflo(a1.x) + w2 * bflo(a2.x)) * iw; o.y = (w0 * bfhi(a0.x) + w1 * bfhi(a1.x) + w2 * bfhi(a2.x)) * iw;
            o.z = (w0 * bflo(a0.y) + w1 * bflo(a1.y) + w2 * bflo(a2.y)) * iw; o.w = (w0 * bfhi(a0.y) + w1 * bfhi(a1.y) + w2 * bfhi(a2.y)) * iw;
            v[3] = o;
        }
#pragma unroll
        for (int j = 0; j < 4; ++j) {
            const float ss = wave_sum((v[j].x * v[j].x + v[j].y * v[j].y) + (v[j].z * v[j].z + v[j].w * v[j].w));
            const float rs = rsqrtf(ss * (1.f / 256.f) + EPS);
            u32x2 w; w.x = pk2(v[j].x * rs * gv[j].x, v[j].y * rs * gv[j].y); w.y = pk2(v[j].z * rs * gv[j].z, v[j].w * rs * gv[j].w);
            *((u32x2*)(H + (size_t)m * DMODEL + 256 * j) + lane) = w;
        }
    }
}

#define XB_TMO      128
#define XB_XCNT(j)  (256  + 64 * (j))
#define XB_XSUB(j)  (1280 + 64 * (j))
#define XB_XGEN(j)  (2304 + 64 * (j))
#define XB_TOP      3328
#define XB_TOPGEN   3392
#define XCD_BAR_WORDS 3456
#define XB_SPIN_CAP (1u << 18)

__device__ __forceinline__ unsigned xb_ld(unsigned* p)              { return __hip_atomic_load(p, __ATOMIC_RELAXED, __HIP_MEMORY_SCOPE_AGENT); }
__device__ __forceinline__ unsigned xb_add(unsigned* p, unsigned v) { return __hip_atomic_fetch_add(p, v, __ATOMIC_RELAXED, __HIP_MEMORY_SCOPE_AGENT); }
__device__ __forceinline__ unsigned xb_xcc_id() { return (unsigned)__builtin_amdgcn_s_getreg((3 << 11) | 20) & 0xFu; }
#define XB_SPIN(cond, bar) do { unsigned _sp = 0; while (cond) { __builtin_amdgcn_s_sleep(1); \
    if ((++_sp & 255u) == 0u) { if (xb_ld(&(bar)[XB_TMO])) break; if (_sp > XB_SPIN_CAP) { atomicAdd(&(bar)[XB_TMO], 1u); break; } } } } while (0)

struct XcdBarrier {
    unsigned* bar; unsigned x;
    volatile LAS unsigned* st;
};

__device__ __forceinline__ XcdBarrier xcd_barrier_post(unsigned* bar, volatile LAS unsigned* st) {
    XcdBarrier b; b.bar = bar; b.x = xb_xcc_id(); b.st = st;
    if (threadIdx.x == 0) (void)xb_add(&bar[XB_XCNT(b.x)], 1u);
    return b;
}
__device__ __forceinline__ void xcd_barrier_complete(unsigned* bar, unsigned x, unsigned& nloc, unsigned& nx) {
    const unsigned G = gridDim.x * gridDim.y * gridDim.z;
    unsigned sum, cnt, mine, sp = 0u;
    for (;;) {
        sum = 0u; cnt = 0u; mine = 0u;
#pragma unroll
        for (unsigned j = 0; j < 16; ++j) { const unsigned c = xb_ld(&bar[XB_XCNT(j)]); sum += c; cnt += (c > 0u) ? 1u : 0u; mine = (j == x) ? c : mine; }
        if (sum == G) break;
        __builtin_amdgcn_s_sleep(1);
        if ((++sp & 255u) == 0u) { if (xb_ld(&bar[XB_TMO])) break; if (sp > XB_SPIN_CAP) { atomicAdd(&bar[XB_TMO], 1u); break; } }
    }
    nloc = mine > 0u ? mine : 1u; nx = cnt > 0u ? cnt : 1u;
}

__device__ __forceinline__ void xcd_barrier(const XcdBarrier& b) {
    asm volatile("s_waitcnt vmcnt(0)" ::: "memory");
    __syncthreads();
    if (threadIdx.x == 0) {
        unsigned* bar = b.bar;
        __builtin_amdgcn_s_waitcnt(0);
        unsigned nloc = b.st[0], nx = b.st[1];
        if (nloc == 0u) { xcd_barrier_complete(bar, b.x, nloc, nx); b.st[0] = nloc; b.st[1] = nx; }
        const unsigned old = xb_add(&bar[XB_XSUB(b.x)], 1u);
        const unsigned gen = old / nloc;
        if (old + 1u == (gen + 1u) * nloc) {
            __builtin_amdgcn_fence(__ATOMIC_RELEASE, "agent");
            asm volatile("s_waitcnt vmcnt(0)" ::: "memory");
            const unsigned og = xb_add(&bar[XB_TOP], 1u);
            const unsigned tg = og / nx;
            if (og + 1u == (tg + 1u) * nx) xb_add(&bar[XB_TOPGEN], 1u);
            else XB_SPIN(xb_ld(&bar[XB_TOPGEN]) == tg, bar);
            __builtin_amdgcn_fence(__ATOMIC_ACQUIRE, "agent");
            xb_add(&bar[XB_XGEN(b.x)], 1u);
            asm volatile("s_waitcnt vmcnt(0)" ::: "memory");
        } else {
            XB_SPIN(xb_ld(&bar[XB_XGEN(b.x)]) == gen, bar);
            __builtin_amdgcn_fence(__ATOMIC_ACQUIRE, "agent");
            asm volatile("s_waitcnt vmcnt(0)" ::: "memory");
        }
    }
    __syncthreads();
}

constexpr int NPHASE = 16;
struct Ctx { const Args* args; LAS unsigned char* lds; int tid, lane, wid, G, bx, gw, ngw; };
#define LAUNDER(p) asm volatile("" : "+s"(p))
__device__ __forceinline__ void phase_body(const int ph, const CAS Args* ap, LAS unsigned char* lds, const int tid, const int lane, const int wid, const int G, const int bx) {
    const int gw = bx * 8 + wid, ngw = G * 8;
    unsigned char* ws = ap->ws;
    const float* x_in = ap->in[0];
    float* X = ap->out;
    bf16_t* Hb = (bf16_t*)(ws + WS_H); bf16_t* Pb = (bf16_t*)(ws + WS_P); bf16_t* YC = (bf16_t*)(ws + WS_YC); bf16_t* ZB = (bf16_t*)(ws + WS_ZB); bf16_t* OB = (bf16_t*)(ws + WS_OB);
    f32x2v* ST = (f32x2v*)(ws + WS_ST);
    float* ropec = (float*)(ws + WS_ROPE); float* ropes = ropec + SEQ * 32;
    bf16_t* XB = (bf16_t*)(ws + WS_XB); float* SS = (float*)(ws + WS_SS);
    if (ph == 0) {
        {
            float v[8], vn[8]; int t = 0, tn = 0;
            int it = bx;
            WMat w = wmat_of(ap, ws, it < 2 * 2976 ? it : 0, t), wn = w;
            if (it < 2 * 2976) wconv_load(w, t, tid, v);
            for (; it < 2 * 2976; it += G) {
                const bool more = it + G < 2 * 2976;
                if (more) { wn = wmat_of(ap, ws, it + G, tn); wconv_load(wn, tn, tid, vn); }
                wconv_store((LAS float*)lds, w, t, tid, v);
                if (more) {
#pragma unroll
                    for (int i = 0; i < 8; ++i) v[i] = vn[i];
                    w = wn; t = tn;
                }
            }
        }
        for (int e = bx * NTHREADS + tid; e < SEQ * 32; e += G * NTHREADS) {
            const int pos = e >> 5, i = e & 31;
            const double inv = (double)exp2f(-(float)i * (13.287712379549449f / 32.f));
            const float angf = (float)pos * (float)inv;
            double rev = (double)angf * 0.15915494309189535; rev -= floor(rev);
            ropec[e] = __builtin_amdgcn_cosf((float)rev); ropes[e] = __builtin_amdgcn_sinf((float)rev);
        }
        xb_rows(x_in, XB, SS, gw, ngw, lane);
        return;
    }
    if (ph == 15) { final_rows(XB, SS + (size_t)4 * NT * 4, ap->in[23], X, gw, ngw, lane); return; }
    const int layer = (ph - 1) / 7, sub = (ph - 1) % 7;
    unsigned char* wb = ws + WS_W + (size_t)layer * W_LAYER;
    if (sub == 0) {
        pg8::Gemm g{XB, (const bf16_t*)(wb + W_IN), NT, NIN, 1024}; pg8::StaticOrder S; S.init(NT, NIN, G, bx);
        EpiIn E{Pb, ropec, ropes, RowScale{SS + (size_t)(layer == 0 ? 0 : 2) * NT * 4, (LAS float*)(lds + 131072 + 4096)}};
        pg8::gemm_phase<EpiIn, pg8::StaticOrder, true, true>(lds, g, S, E);
    } else if (sub == 1) {
        const int rot = bx % 3;
#define RUN_S do { LAUNDER(ap); for (int it = bx; it < 256; it += G) \
            ssm_item(lds, Pb, ZB, ap->in[8] + layer * 1024, ap->in[9] + layer * 1024, ap->in[10] + layer * 16, ap->in[11] + (size_t)layer * 16384, ap->in[12] + (size_t)layer * 16384, \
                     ap->in[13] + (size_t)layer * 16384, ap->in[14] + (size_t)layer * 16384, ap->in[15] + layer * 256, it, tid, wid, lane); __syncthreads(); } while (0)
#define RUN_C do { LAUNDER(ap); conv3_phase(Pb, YC, ap->in[3] + layer * 768, bx, G, tid); \
            cfm_phase(lds, Pb, YC, ap->in[4] + layer * 31 * 256, ap->in[5] + layer * 256, ap->in[6] + layer * 256, ap->in[7] + layer * 256, bx, G, tid, wid, lane); __syncthreads(); } while (0)
        if (rot == 0) RUN_S;
        if (rot <= 1) RUN_C;
        {
            const int per = (3072 + G - 1) / G, it0 = bx * per, it1 = (it0 + per < 3072) ? it0 + per : 3072;
            u32x4 kreg[6], vreg[6]; bf16x8 qn[4], qc[4];
            int it = it0;
            AttnU U = attn_decode(it < it1 ? it : 0);
            if (it < it1) attn_issue(Pb, U, tid, wid, lane, kreg, vreg, qn);
            for (; it < it1; ++it) {
                __syncthreads();
                attn_to_lds(lds, tid, kreg, vreg);
#pragma unroll
                for (int s = 0; s < 4; ++s) qc[s] = qn[s];
                __syncthreads();
                const AttnU Uc = U;
                if (it + 1 < it1) { U = attn_decode(it + 1); attn_issue(Pb, U, tid, wid, lane, kreg, vreg, qn); }
                attn_compute(lds, Uc, qc, OB, ST, wid, lane);
            }
            __syncthreads();
        }
        if (rot >= 1) RUN_S;
        if (rot == 2) RUN_C;
#undef RUN_S
#undef RUN_C
    } else if (sub == 2) {
        pg8::Gemm g{ZB, (const bf16_t*)(wb + W_GLU), NT, 512, 256}; pg8::StaticOrder S; S.init(NT, 512, G, bx);
        EpiGate<1> E{YC, 768, 512, RowScale{nullptr, nullptr}};
        pg8::gemm_phase<EpiGate<1>, pg8::StaticOrder, true, true>(lds, g, S, E);
    } else if (sub == 3) {
        combine_rows(YC, OB, ST, ap->in[17] + layer * 1024, Hb, gw, ngw, lane);
    } else if (sub == 4) {
        pg8::Gemm g{Hb, (const bf16_t*)(wb + W_OUT), NT, 1024, 1024}; pg8::StaticOrder S; S.init(NT, 1024, G, bx);
        EpiRes E{XB, SS + (size_t)(layer == 0 ? 1 : 3) * NT * 4, (LAS float*)(lds + 131072)};
        pg8::gemm_phase<EpiRes, pg8::StaticOrder, true, true>(lds, g, S, E);
    } else if (sub == 5) {
        pg8::Gemm g{XB, (const bf16_t*)(wb + W_GU), NT, 2 * DFF, 1024}; pg8::StaticOrder S; S.init(NT, 2 * DFF, G, bx);
        EpiGate<0> E{Pb, DFF, 0, RowScale{SS + (size_t)(layer == 0 ? 1 : 3) * NT * 4, (LAS float*)(lds + 131072 + 4096)}};
        pg8::gemm_phase<EpiGate<0>, pg8::StaticOrder, true, true>(lds, g, S, E);
    } else {
        pg8::Gemm g{Pb, (const bf16_t*)(wb + W_DN), NT, 1024, DFF}; pg8::StaticOrder S; S.init(NT, 1024, G, bx);
        EpiRes E{XB, SS + (size_t)(layer == 0 ? 2 : 4) * NT * 4, (LAS float*)(lds + 131072)};
        pg8::gemm_phase<EpiRes, pg8::StaticOrder, true, true>(lds, g, S, E);
    }
}
__global__ void __launch_bounds__(NTHREADS, 2) fwd_megakernel(Args args) {
    extern __shared__ __attribute__((aligned(16))) unsigned char lds_raw[];
    LAS unsigned char* lds = (LAS unsigned char*)lds_raw;
    cg::grid_group grid = cg::this_grid();
    const int tid = threadIdx.x, lane = tid & 63, wid = __builtin_amdgcn_readfirstlane(tid >> 6);
    const int G = gridDim.x, bx = blockIdx.x;
    const int lo = args.ph_lo, hi = args.ph_hi;
    const CAS Args* ap = (const CAS Args*)__builtin_amdgcn_kernarg_segment_ptr();
    volatile LAS unsigned* bst = (volatile LAS unsigned*)(lds + LDS_BYTES - 64);
    if (tid == 0) { bst[0] = 0u; bst[1] = 0u; }
    __syncthreads();
    XcdBarrier xbar = xcd_barrier_post((unsigned*)(args.ws + WS_BAR), bst);
#define GSYNC(k) do { if ((k) == 1) grid.sync(); else xcd_barrier(xbar); } while (0)
#define PHASE(k) if (lo <= (k) && (k) < hi) { if ((k) > lo) GSYNC(k); LAUNDER(ap); phase_body((k), ap, lds, tid, lane, wid, G, bx); \
        if ((REPEAT_MASK >> (k)) & 1u) { xcd_barrier(xbar); LAUNDER(ap); phase_body((k), ap, lds, tid, lane, wid, G, bx); } \
        if ((k) == 0) { for (int es = 0; es < EXTRA_SYNCS; ++es) xcd_barrier(xbar); } }
    PHASE(0) PHASE(1) PHASE(2) PHASE(3) PHASE(4) PHASE(5) PHASE(6) PHASE(7) PHASE(8) PHASE(9)
    PHASE(10) PHASE(11) PHASE(12) PHASE(13) PHASE(14) PHASE(15)
#undef PHASE
}

extern "C" void kernel_launch(void* const* d_in, const int* in_sizes, int n_in, void* d_out, int out_size, void* d_ws, size_t ws_size, hipStream_t stream) {
    static int grid_blocks = 0;
    if (grid_blocks == 0) {
        if (n_in != 24 || ws_size < WS_END) { fprintf(stderr, "kernel_launch: unexpected n_in %d / ws_size %zu\n", n_in, ws_size); grid_blocks = -1; return; }
        int dev = 0, cus = 0, per_cu = 0;
        hipGetDevice(&dev);
        hipDeviceGetAttribute(&cus, hipDeviceAttributeMultiprocessorCount, dev);
        if (hipFuncSetAttribute((const void*)fwd_megakernel, hipFuncAttributeMaxDynamicSharedMemorySize, LDS_BYTES) != hipSuccess) { fprintf(stderr, "kernel_launch: hipFuncSetAttribute failed\n"); grid_blocks = -1; return; }
        if (hipOccupancyMaxActiveBlocksPerMultiprocessor(&per_cu, (const void*)fwd_megakernel, NTHREADS, LDS_BYTES) != hipSuccess || per_cu < 1) { fprintf(stderr, "kernel_launch: occupancy query %d\n", per_cu); per_cu = 1; }
        (void)hipGetLastError();
        grid_blocks = cus * per_cu;
    }
    if (grid_blocks < 0) return;
    Args a{};
    for (int i = 0; i < 24; ++i) a.in[i] = (const float*)d_in[i];
    a.out = (float*)d_out; a.ws = (unsigned char*)d_ws; a.ph_lo = 0; a.ph_hi = NPHASE;
    if (hipMemsetAsync((char*)d_ws + WS_BAR, 0, 16384, stream) != hipSuccess) { fprintf(stderr, "kernel_launch: memset failed\n"); return; }
    void* kargs[] = {&a};
    hipError_t e = hipLaunchCooperativeKernel((const void*)fwd_megakernel, dim3(grid_blocks), dim3(NTHREADS), kargs, LDS_BYTES, stream);
    if (e != hipSuccess) fprintf(stderr, "cooperative launch failed: %s (grid %d)\n", hipGetErrorString(e), grid_blocks);
}
```

```cpp
#include <hip/hip_runtime.h>
#include <hip/hip_cooperative_groups.h>
#include <cstdio>
#include <cstdint>
namespace cg = cooperative_groups;
namespace pg8 {
#define PG8_LAS __attribute__((address_space(3)))
typedef unsigned short bf16_t;
typedef short bf16x8 __attribute__((ext_vector_type(8)));
typedef float f32x4 __attribute__((ext_vector_type(4)));
typedef unsigned u32x4 __attribute__((ext_vector_type(4)));
constexpr int BM = 256, BK = 64, HALF = 128, HTB = HALF * BK * 2  , STAGE_BYTES = 8 * HTB, NXCD = 8, WGM = 8;

__host__ __device__ __forceinline__ int lds_byte(int r, int c) { const int st = (r >> 4) * 2 + (c >> 5), rr = r & 15, cc = c & 31, ob = rr * 64 + cc * 2; return st * 1024 + (ob ^ (((ob >> 9) & 1) << 5)); }
__host__ __device__ __forceinline__ void stage_rc(int b, int& R, int& C) { const int st = b / 1024, sb = b % 1024, swz = sb ^ (((sb >> 9) & 1) << 5); R = (st >> 1) * 16 + swz / 64; C = (st & 1) * 32 + (swz % 64) / 2; }
__host__ __device__ __forceinline__ int perm32(int rho) { const int n = rho >> 4, i = rho & 15; return 8 * (i >> 2) + 4 * n + (i & 3); }

struct Unit { int pm, pn; };
struct Gemm { const bf16_t* A; const bf16_t* Bt; int M, N, K; };

struct StaticOrder {
    int nM, nN, nwg, G, c;
    __host__ __device__ void init(int M, int N, int G_, int c_) { nM = M / BM; nN = N / BM; nwg = nM * nN; G = G_; c = c_; }
    __host__ __device__ bool next(int i, Unit& u) const {
        const long L = (long)i * G + c; if (L >= nwg) return false;
        int wgid = (int)L; { const int q = nwg / NXCD, r = nwg % NXCD, xcd = wgid % NXCD, off = wgid / NXCD; wgid = (xcd < r ? xcd * (q + 1) : r * (q + 1) + (xcd - r) * q) + off; }
        const int nig = WGM * nN, gid = wgid / nig, fm = gid * WGM, gsz = (nM - fm) < WGM ? (nM - fm) : WGM;
        u.pm = fm + ((wgid % nig) % gsz); u.pn = (wgid % nig) / gsz; return true;
    }
    __device__ __forceinline__ void a_ready(const Unit&) const {}
    __device__ __forceinline__ void done(const Unit&) const {}
};

__device__ __forceinline__ unsigned cvt_pk_bf16(float lo, float hi) { unsigned r; asm volatile("v_cvt_pk_bf16_f32 %0, %1, %2" : "=v"(r) : "v"(lo), "v"(hi)); return r; }
typedef float f32x2 __attribute__((ext_vector_type(2)));
template <class Epi, class Sched, bool ALIGN_EPI = false, bool SP2 = false>
__device__ __forceinline__ void gemm_phase(PG8_LAS unsigned char* lds, const Gemm g, const Sched& S, const Epi& E) {
    const int tid = threadIdx.x, wid = __builtin_amdgcn_readfirstlane(tid >> 6), lane = tid & 63, wr = wid >> 2, wc = wid & 3, fr = lane & 15, fq = lane >> 4;
    const int K = g.K, nt = K / BK;
    unsigned voffA[2], voffB[2];
#pragma unroll
    for (int i = 0; i < 2; ++i) { int R, C; stage_rc(tid * 16 + i * 8192, R, C); const int Rb = Epi::PERM ? ((R & ~31) + perm32(R & 31)) : R;
        voffA[i] = (unsigned)(R * K + C) * 2u; voffB[i] = (unsigned)(Rb * K + C) * 2u; }
    const size_t kstep = (size_t)(BK * 2);
    const size_t hstep = (size_t)HALF * K * 2;
    const size_t tstep = 2 * hstep;
    const unsigned ldsw = (unsigned)wid * 1024u;
    const int aoff = lds_byte(wr * 64 + fr, fq * 8), boff = lds_byte(wc * 32 + fr, fq * 8);
#define PG8_SA(b, h) (((b) * 2 + (h)) * HTB)
#define PG8_SB(b, h) ((4 + (b) * 2 + (h)) * HTB)
#define PG8_STAGE(bufoff, gbase, voff) do { _Pragma("unroll") for (int _i = 0; _i < 2; ++_i) \
        __builtin_amdgcn_global_load_lds((const unsigned*)((const char*)(gbase) + (voff)[_i]), (PG8_LAS unsigned*)(lds + (bufoff) + ldsw + _i * 8192), 16, 0, 0); } while (0)
#define PG8_LDA(dst, b, h) do { _Pragma("unroll") for (int m = 0; m < 4; ++m) _Pragma("unroll") for (int k = 0; k < 2; ++k) dst[m][k] = *(const PG8_LAS bf16x8*)(lds + PG8_SA(b, h) + aoff + m * 2048 + k * 1024); } while (0)
#define PG8_LDB(dst, b, h) do { _Pragma("unroll") for (int n = 0; n < 2; ++n) _Pragma("unroll") for (int k = 0; k < 2; ++k) dst[n][k] = *(const PG8_LAS bf16x8*)(lds + PG8_SB(b, h) + boff + n * 2048 + k * 1024); } while (0)
#define PG8_MMA(ai, bj, At, Bt) do { __builtin_amdgcn_s_setprio(1); _Pragma("unroll") for (int m = 0; m < 4; ++m) _Pragma("unroll") for (int n = 0; n < 2; ++n) _Pragma("unroll") for (int k = 0; k < 2; ++k) \
        acc[ai][bj][m][n] = __builtin_amdgcn_mfma_f32_16x16x32_bf16(Bt[n][k], At[m][k], acc[ai][bj][m][n], 0, 0, 0); __builtin_amdgcn_s_setprio(0); } while (0)
#define PG8_WAIT_V(n) asm volatile("s_waitcnt vmcnt(" #n ")" ::: "memory")
#define PG8_WAIT_L(n) asm volatile("s_waitcnt lgkmcnt(" #n ")" ::: "memory")
#define PG8_BAR __builtin_amdgcn_s_barrier()
#define PG8_SCHED __builtin_amdgcn_sched_barrier(0)
    Unit cur, nxt; int ui = 0;
    if (!S.next(0, cur)) return;
    E.prime(cur);
    f32x4 acc[2][2][4][2];
#pragma unroll
    for (int a = 0; a < 2; ++a)
#pragma unroll
        for (int b = 0; b < 2; ++b)
#pragma unroll
            for (int m = 0; m < 4; ++m)
#pragma unroll
                for (int n = 0; n < 2; ++n) acc[a][b][m][n] = (f32x4){0.f, 0.f, 0.f, 0.f};
    bf16x8 At[4][2], B0[2][2], B1[2][2];
    const char* cA = (const char*)g.A + (size_t)cur.pm * tstep; const char* cB = (const char*)g.Bt + (size_t)cur.pn * tstep;
    S.a_ready(cur);
    if constexpr (SP2) {
        PG8_STAGE(PG8_SB(0, 0), cB, voffB); PG8_STAGE(PG8_SB(0, 1), cB + hstep, voffB); PG8_STAGE(PG8_SA(0, 0), cA, voffA); PG8_STAGE(PG8_SA(0, 1), cA + hstep, voffA);
        if (wr == 1) PG8_BAR;
        PG8_WAIT_V(2); PG8_BAR;
        PG8_STAGE(PG8_SB(1, 0), cB + kstep, voffB); PG8_STAGE(PG8_SA(1, 0), cA + kstep, voffA); PG8_STAGE(PG8_SB(1, 1), cB + hstep + kstep, voffB);
        PG8_WAIT_V(6); PG8_BAR;
    } else {
        PG8_STAGE(PG8_SB(0, 0), cB, voffB); PG8_STAGE(PG8_SA(0, 0), cA, voffA); PG8_STAGE(PG8_SB(0, 1), cB + hstep, voffB); PG8_STAGE(PG8_SA(0, 1), cA + hstep, voffA);
        if (wr == 1) PG8_BAR;
        PG8_WAIT_V(4); PG8_BAR;
        PG8_STAGE(PG8_SB(1, 0), cB + kstep, voffB); PG8_STAGE(PG8_SA(1, 0), cA + kstep, voffA); PG8_STAGE(PG8_SB(1, 1), cB + hstep + kstep, voffB);
        PG8_WAIT_V(6); PG8_BAR;
    }
    for (;;) {
        const bool has_next = S.next(ui + 1, nxt);
        const char* nA = has_next ? (const char*)g.A + (size_t)nxt.pm * tstep : cA; const char* nB = has_next ? (const char*)g.Bt + (size_t)nxt.pn * tstep : cB;
#pragma nounroll
        for (int t = 0; t < nt; t += 2) {
            const bool last = (t == nt - 2);
            const char* a1 = cA + (size_t)(t + 1) * kstep;
            const char* a2 = last ? nA : cA + (size_t)(t + 2) * kstep; const char* b2 = last ? nB : cB + (size_t)(t + 2) * kstep;
            const char* a3 = a2 + kstep; const char* b3 = b2 + kstep;
            if (last && has_next) S.a_ready(nxt);
            if constexpr (SP2) {
            PG8_LDB(B0, 0, 0); PG8_LDB(B1, 0, 1); PG8_SCHED; PG8_LDA(At, 0, 0); PG8_STAGE(PG8_SA(1, 1), a1 + hstep, voffA);
            PG8_WAIT_V(8); PG8_WAIT_L(0); PG8_BAR; PG8_MMA(0, 0, At, B0); PG8_MMA(0, 1, At, B1); PG8_BAR; PG8_SCHED;
            PG8_LDA(At, 0, 1); PG8_STAGE(PG8_SB(0, 0), b2, voffB); PG8_STAGE(PG8_SB(0, 1), b2 + hstep, voffB); PG8_STAGE(PG8_SA(0, 0), a2, voffA);
            PG8_WAIT_V(8); PG8_WAIT_L(0); PG8_BAR; PG8_MMA(1, 0, At, B0); PG8_MMA(1, 1, At, B1); PG8_BAR; PG8_SCHED;
            PG8_LDB(B0, 1, 0); PG8_LDB(B1, 1, 1); PG8_SCHED; PG8_LDA(At, 1, 0); PG8_STAGE(PG8_SA(0, 1), a2 + hstep, voffA);
            PG8_WAIT_V(8); PG8_WAIT_L(0); PG8_BAR; PG8_MMA(0, 0, At, B0); PG8_MMA(0, 1, At, B1); PG8_BAR; PG8_SCHED;
            PG8_LDA(At, 1, 1); PG8_STAGE(PG8_SB(1, 0), b3, voffB); PG8_STAGE(PG8_SB(1, 1), b3 + hstep, voffB); PG8_STAGE(PG8_SA(1, 0), a3, voffA);
            PG8_WAIT_V(8); PG8_WAIT_L(0); PG8_BAR; PG8_MMA(1, 0, At, B0); PG8_MMA(1, 1, At, B1); PG8_BAR; PG8_SCHED;
            } else {
            PG8_LDB(B0, 0, 0); PG8_SCHED; PG8_LDA(At, 0, 0); PG8_STAGE(PG8_SA(1, 1), a1 + hstep, voffA);
            PG8_WAIT_L(8); PG8_BAR; PG8_WAIT_L(0); PG8_MMA(0, 0, At, B0); PG8_BAR; PG8_SCHED;
            PG8_LDB(B1, 0, 1); PG8_STAGE(PG8_SB(0, 0), b2, voffB);
            PG8_BAR; PG8_WAIT_L(0); PG8_MMA(0, 1, At, B1); PG8_BAR;
            PG8_LDA(At, 0, 1); PG8_STAGE(PG8_SA(0, 0), a2, voffA);
            PG8_BAR; PG8_WAIT_L(0); PG8_MMA(1, 0, At, B0); PG8_BAR; PG8_SCHED;
            PG8_STAGE(PG8_SB(0, 1), b2 + hstep, voffB);
            PG8_WAIT_V(6); PG8_BAR; PG8_MMA(1, 1, At, B1); PG8_BAR;
            PG8_LDB(B0, 1, 0); PG8_SCHED; PG8_LDA(At, 1, 0); PG8_STAGE(PG8_SA(0, 1), a2 + hstep, voffA);
            PG8_WAIT_L(8); PG8_BAR; PG8_WAIT_L(0); PG8_MMA(0, 0, At, B0); PG8_BAR; PG8_SCHED;
            PG8_LDB(B1, 1, 1); PG8_STAGE(PG8_SB(1, 0), b3, voffB);
            PG8_BAR; PG8_WAIT_L(0); PG8_MMA(0, 1, At, B1); PG8_BAR;
            PG8_LDA(At, 1, 1); PG8_STAGE(PG8_SA(1, 0), a3, voffA);
            PG8_BAR; PG8_WAIT_L(0); PG8_MMA(1, 0, At, B0); PG8_BAR; PG8_SCHED;
            PG8_STAGE(PG8_SB(1, 1), b3 + hstep, voffB);
            PG8_WAIT_V(6); PG8_BAR; PG8_MMA(1, 1, At, B1); PG8_BAR;
            }
        }
        if constexpr (ALIGN_EPI) { if (wr == 0) PG8_BAR; }
        if constexpr (!Epi::AFTER_DRAIN) { E(acc, cur, wr, wc, fr, fq, nxt, has_next, ui); S.done(cur); }
        if (!has_next) break;
#pragma unroll
        for (int a = 0; a < 2; ++a)
#pragma unroll
            for (int b = 0; b < 2; ++b)
#pragma unroll
                for (int m = 0; m < 4; ++m)
#pragma unroll
                    for (int n = 0; n < 2; ++n) acc[a][b][m][n] = (f32x4){0.f, 0.f, 0.f, 0.f};
        cur = nxt; cA = nA; cB = nB; ++ui;
        if constexpr (ALIGN_EPI) { if (wr == 1) PG8_BAR; }
    }
    PG8_WAIT_V(0);
    if constexpr (!ALIGN_EPI) { if (wr == 0) PG8_BAR; }
    PG8_BAR;
    if constexpr (Epi::AFTER_DRAIN) { E.fused(acc, cur, wr, wc, fr, fq, lds, wid, lane); S.done(cur); }
#undef PG8_SA
#undef PG8_SB
#undef PG8_STAGE
#undef PG8_LDA
#undef PG8_LDB
#undef PG8_MMA
#undef PG8_WAIT_V
#undef PG8_WAIT_L
#undef PG8_BAR
#undef PG8_SCHED
}
}
#ifndef REPEAT_MASK
#define REPEAT_MASK 0u
#endif
#ifndef EXTRA_SYNCS
#define EXTRA_SYNCS 0
#endif
#ifndef REP_SSM
#define REP_SSM 1
#endif
#ifndef REP_CONV
#define REP_CONV 1
#endif
#ifndef REP_ATTN
#define REP_ATTN 1
#endif

#define LAS __attribute__((address_space(3)))
typedef unsigned short bf16_t;
typedef short bf16x8 __attribute__((ext_vector_type(8)));
typedef short s16x4 __attribute__((ext_vector_type(4)));
typedef float f32x4 __attribute__((ext_vector_type(4)));
typedef float f32x16 __attribute__((ext_vector_type(16)));
typedef unsigned u32x4 __attribute__((ext_vector_type(4)));
typedef unsigned u32x2 __attribute__((ext_vector_type(2)));
typedef float f32x2v __attribute__((ext_vector_type(2)));
typedef __bf16 bf16x2v __attribute__((ext_vector_type(2)));

constexpr int NT = 65536, SEQ = 4096, DMODEL = 1024, NIN = 2304, DFF = 2816;
constexpr float EPS = 1e-6f;
constexpr float C2 = 0.125f * 1.4426950408889634f;
constexpr size_t MiB = (size_t)1 << 20;
constexpr size_t W_IN = 0, W_OUT = W_IN + (size_t)NIN * 1024 * 2, W_GU = W_OUT + (size_t)1024 * 1024 * 2, W_DN = W_GU + (size_t)2 * DFF * 1024 * 2,
                 W_GLU = W_DN + (size_t)1024 * DFF * 2, W_LAYER = 24 * MiB;
static_assert(W_GLU + 512 * 256 * 2 <= W_LAYER, "weight block");
constexpr size_t WS_W = 0, WS_ROPE = 48 * MiB, WS_H = 64 * MiB, WS_P = 192 * MiB, WS_YC = 544 * MiB, WS_ZB = 640 * MiB, WS_OB = 672 * MiB, WS_ST = 768 * MiB, WS_BAR = 776 * MiB, WS_XB = 778 * MiB, WS_SS = 906 * MiB, WS_END = 912 * MiB;
constexpr int LDS_BYTES = 147456;
constexpr int NTHREADS = 512;

#define CAS __attribute__((address_space(4)))
struct Args {
    const float* in[24];
    float* out;
    unsigned char* ws;
    int ph_lo, ph_hi;
};

__device__ __forceinline__ unsigned pk2(float lo, float hi) { f32x2v v = {lo, hi}; bf16x2v b = __builtin_convertvector(v, bf16x2v); return __builtin_bit_cast(unsigned, b); }
__device__ __forceinline__ float bflo(unsigned u) { return __uint_as_float(u << 16); }
__device__ __forceinline__ float bfhi(unsigned u) { return __uint_as_float(u & 0xffff0000u); }
__device__ __forceinline__ float wave_sum(float v) {
#pragma unroll
    for (int o = 1; o < 64; o <<= 1) v += __shfl_xor(v, o);
    return v;
}
__device__ __forceinline__ float sigmoidf_(float x) { return __builtin_amdgcn_rcpf(1.f + __expf(-x)); }
__device__ __forceinline__ float gelu_tanh(float y) {
    const float a = 0.7978845608028654f * (y + 0.044715f * y * y * y);
    const float t = 1.f - 2.f * __builtin_amdgcn_rcpf(__expf(2.f * a) + 1.f);
    return 0.5f * y * (1.f + t);
}
#define WAVE_LDS_SYNC() asm volatile("s_waitcnt lgkmcnt(0)" ::: "memory")

struct RowScale {
    const float* ssp; LAS float* xs;
    __device__ __forceinline__ float rs_of(int row) const { const f32x4 sp = *(const f32x4*)(ssp + (size_t)row * 4); return rsqrtf(((sp.x + sp.y) + (sp.z + sp.w)) * (1.f / DMODEL) + EPS); }
    __device__ __forceinline__ void prime(const pg8::Unit& u) const { const int t = threadIdx.x; if (t < 256) xs[t] = rs_of(u.pm * 256 + t); }
};
struct EpiIn {
    static constexpr bool PERM = true, AFTER_DRAIN = false;
    bf16_t* O; const float* ropec; const float* ropes; RowScale R;
    __device__ __forceinline__ void prime(const pg8::Unit& u) const { R.prime(u); }
    __device__ __forceinline__ void operator()(const f32x4 (&acc)[2][2][4][2], const pg8::Unit& u, int wr, int wc, int fr, int fq, const pg8::Unit& nxt, bool has_next, int ui) const {
        const int row0 = u.pm * 256 + wr * 64 + fr, t = threadIdx.x;
        f32x4 spn = {0.f, 0.f, 0.f, 0.f};
        const bool stage = has_next && t < 256 && nxt.pm != u.pm;
        if (stage) spn = *(const f32x4*)(R.ssp + (size_t)(nxt.pm * 256 + t) * 4);
        const LAS float* xsc = R.xs + (ui & 1) * 256 + wr * 64 + fr;
        if (u.pn == 6 || u.pn == 7) {
            const float sc = (u.pn == 6) ? C2 : 1.f;
            const int dimb = 16 * (wc & 1) + 4 * fq;
#pragma unroll
            for (int ai = 0; ai < 2; ++ai)
#pragma unroll
                for (int m = 0; m < 4; ++m) {
                    const int row = row0 + ai * 128 + m * 16; const int pos = row & (SEQ - 1);
                    const float rsc = xsc[ai * 128 + m * 16] * sc;
                    const f32x4 cs = *(const f32x4*)(ropec + pos * 32 + dimb), sn = *(const f32x4*)(ropes + pos * 32 + dimb);
                    bf16_t* rowp = O + (size_t)row * NIN + u.pn * 256 + 64 * (wc >> 1) + dimb;
#pragma unroll
                    for (int bj = 0; bj < 2; ++bj) {
                        const f32x4 x1 = acc[ai][bj][m][0] * rsc, x2 = acc[ai][bj][m][1] * rsc;
                        const f32x4 o1 = x1 * cs - x2 * sn, o2 = x2 * cs + x1 * sn;
                        u32x2 w1, w2; w1.x = pk2(o1[0], o1[1]); w1.y = pk2(o1[2], o1[3]); w2.x = pk2(o2[0], o2[1]); w2.y = pk2(o2[2], o2[3]);
                        *(u32x2*)(rowp + bj * 128) = w1; *(u32x2*)(rowp + bj * 128 + 32) = w2;
                    }
                }
        } else {
#pragma unroll
            for (int ai = 0; ai < 2; ++ai)
#pragma unroll
                for (int m = 0; m < 4; ++m) {
                    bf16_t* rowp = O + (size_t)(row0 + ai * 128 + m * 16) * NIN + u.pn * 256 + wc * 32 + 8 * fq;
                    const float rsc = xsc[ai * 128 + m * 16];
#pragma unroll
                    for (int bj = 0; bj < 2; ++bj) {
                        const f32x4 v0 = acc[ai][bj][m][0] * rsc, v1 = acc[ai][bj][m][1] * rsc;
                        u32x4 w; w.x = pk2(v0[0], v0[1]); w.y = pk2(v0[2], v0[3]); w.z = pk2(v1[0], v1[1]); w.w = pk2(v1[2], v1[3]);
                        *(u32x4*)(rowp + bj * 128) = w;
                    }
                }
        }
        if (has_next && t < 256) {
            float v = R.xs[(ui & 1) * 256 + t];
            if (nxt.pm != u.pm) v = rsqrtf(((spn.x + spn.y) + (spn.z + spn.w)) * (1.f / DMODEL) + EPS);
            R.xs[((ui + 1) & 1) * 256 + t] = v;
        }
    }
};
struct EpiRes {
    static constexpr bool PERM = true, AFTER_DRAIN = false;
    bf16_t* xb; float* ssp; LAS float* xl;
    __device__ __forceinline__ void prime(const pg8::Unit&) const {}
    __device__ __forceinline__ void operator()(const f32x4 (&acc)[2][2][4][2], const pg8::Unit& u, int wr, int wc, int fr, int fq, const pg8::Unit&, bool, int) const {
        const int row0 = u.pm * 256 + wr * 64 + fr, col0 = u.pn * 256 + wc * 32 + 8 * fq;
        u32x4 rv[2][4][2];
#pragma unroll
        for (int ai = 0; ai < 2; ++ai)
#pragma unroll
            for (int m = 0; m < 4; ++m)
#pragma unroll
                for (int bj = 0; bj < 2; ++bj) rv[ai][m][bj] = *(const u32x4*)(xb + (size_t)(row0 + ai * 128 + m * 16) * DMODEL + col0 + bj * 128);
#pragma unroll
        for (int ai = 0; ai < 2; ++ai)
#pragma unroll
            for (int m = 0; m < 4; ++m) {
                const int row = row0 + ai * 128 + m * 16;
                const size_t off = (size_t)row * DMODEL + col0;
                float sq = 0.f;
#pragma unroll
                for (int bj = 0; bj < 2; ++bj) {
                    const u32x4 r = rv[ai][m][bj];
                    const f32x4 r0 = {bflo(r.x), bfhi(r.x), bflo(r.y), bfhi(r.y)}, r1 = {bflo(r.z), bfhi(r.z), bflo(r.w), bfhi(r.w)};
                    const f32x4 x0 = r0 + acc[ai][bj][m][0], x1 = r1 + acc[ai][bj][m][1];
                    u32x4 w; w.x = pk2(x0[0], x0[1]); w.y = pk2(x0[2], x0[3]); w.z = pk2(x1[0], x1[1]); w.w = pk2(x1[2], x1[3]);
                    *(u32x4*)(xb + off + bj * 128) = w;
                    sq += (x0[0] * x0[0] + x0[1] * x0[1]) + (x0[2] * x0[2] + x0[3] * x0[3]) + (x1[0] * x1[0] + x1[1] * x1[1]) + (x1[2] * x1[2] + x1[3] * x1[3]);
                }
                sq += __shfl_xor(sq, 16); sq += __shfl_xor(sq, 32);
                if (fq == 0) xl[(wr * 64 + ai * 128 + m * 16 + fr) * 4 + wc] = sq;
            }
        asm volatile("s_waitcnt lgkmcnt(0)\n\ts_barrier" ::: "memory");
        const int t = threadIdx.x;
        if (t < 256) { const f32x4 v = *(const LAS f32x4*)(xl + t * 4); ssp[(size_t)(u.pm * 256 + t) * 4 + u.pn] = (v.x + v.y) + (v.z + v.w); }
    }
};
template <int MODE  > struct EpiGate {
    static constexpr bool PERM = true, AFTER_DRAIN = false;
    bf16_t* O; int ldc; int coff; RowScale R;
    __device__ __forceinline__ void prime(const pg8::Unit& u) const { if (MODE == 0) R.prime(u); }
    __device__ __forceinline__ void operator()(const f32x4 (&acc)[2][2][4][2], const pg8::Unit& u, int wr, int wc, int fr, int fq, const pg8::Unit& nxt, bool has_next, int ui) const {
        const int row0 = u.pm * 256 + wr * 64 + fr, col0 = coff + u.pn * 128 + wc * 32 + 8 * fq, t = threadIdx.x;
        f32x4 spn = {0.f, 0.f, 0.f, 0.f};
        if (MODE == 0) { if (has_next && t < 256 && nxt.pm != u.pm) spn = *(const f32x4*)(R.ssp + (size_t)(nxt.pm * 256 + t) * 4); }
        const LAS float* xsc = R.xs + (ui & 1) * 256 + wr * 64 + fr;
#pragma unroll
        for (int ai = 0; ai < 2; ++ai)
#pragma unroll
            for (int m = 0; m < 4; ++m) {
                float r[8];
                float rsc = 1.f; if (MODE == 0) rsc = xsc[ai * 128 + m * 16];
#pragma unroll
                for (int n = 0; n < 2; ++n)
#pragma unroll
                    for (int j = 0; j < 4; ++j) {
                        const float a = acc[ai][0][m][n][j] * rsc, b = acc[ai][1][m][n][j] * rsc;
                        r[4 * n + j] = (MODE == 0) ? (a * sigmoidf_(a)) * b : a * sigmoidf_(b);
                    }
                u32x4 w; w.x = pk2(r[0], r[1]); w.y = pk2(r[2], r[3]); w.z = pk2(r[4], r[5]); w.w = pk2(r[6], r[7]);
                *(u32x4*)(O + (size_t)(row0 + ai * 128 + m * 16) * ldc + col0) = w;
            }
        if (MODE == 0) {
            if (has_next && t < 256) {
                float v = R.xs[(ui & 1) * 256 + t];
                if (nxt.pm != u.pm) v = rsqrtf(((spn.x + spn.y) + (spn.z + spn.w)) * (1.f / DMODEL) + EPS);
                R.xs[((ui + 1) & 1) * 256 + t] = v;
            }
        }
    }
};

struct WMat { const float* src; const float* src2; int K, N, ldw, kind; bf16_t* dst; const float* kscale; };
__device__ __forceinline__ void wconv_load(const WMat& w, int t, int tid, float (&v)[8]) {
    const int nkt = w.K / 64, jt = t / nkt, kt = t % nkt, j0 = jt * 64, k0 = kt * 64;
    const int j = j0 + (tid & 63);
    const float* s = w.src; int col = j;
    if (w.kind == 1) {
        if (j >= 1536 && j < 2048) { const int ww = j & 63; col = (j & ~63) + 32 * ((ww >> 2) & 1) + 16 * (ww >> 5) + 4 * ((ww >> 3) & 3) + (ww & 3); }
    } else if (w.kind == 2) {
        const int pn = j >> 8, wi = j & 255; if (wi < 128) col = pn * 128 + wi; else { s = w.src2; col = pn * 128 + (wi - 128); }
    }
    const int kk = tid >> 6;
#pragma unroll
    for (int i = 0; i < 8; ++i) { const int k = kk + 8 * i; const float sc = w.kscale ? w.kscale[k0 + k] : 1.f; v[i] = s[(size_t)(k0 + k) * w.ldw + col] * sc; }
}
__device__ __forceinline__ void wconv_store(LAS float* tile, const WMat& w, int t, int tid, const float (&v)[8]) {
    const int nkt = w.K / 64, jt = t / nkt, kt = t % nkt, j0 = jt * 64, k0 = kt * 64;
    const int kk = tid >> 6;
#pragma unroll
    for (int i = 0; i < 8; ++i) tile[(kk + 8 * i) * 65 + (tid & 63)] = v[i];
    __syncthreads();
    {
        const int jr = tid >> 3, c = tid & 7; const LAS float* s = tile + (8 * c) * 65 + jr;
        u32x4 o; o.x = pk2(s[0], s[65]); o.y = pk2(s[2 * 65], s[3 * 65]); o.z = pk2(s[4 * 65], s[5 * 65]); o.w = pk2(s[6 * 65], s[7 * 65]);
        *(u32x4*)(w.dst + (size_t)(j0 + jr) * w.K + k0 + 8 * c) = o;
    }
    __syncthreads();
}
__device__ __forceinline__ WMat wmat_of(const CAS Args* ap, unsigned char* ws, int it, int& t) {
    const int layer = it / 2976; t = it % 2976;
    unsigned char* wb = ws + WS_W + (size_t)layer * W_LAYER;
    if (t < 576) return WMat{ap->in[2] + (size_t)layer * 1024 * NIN, nullptr, 1024, NIN, NIN, 1, (bf16_t*)(wb + W_IN), ap->in[1] + layer * 1024};
    if ((t -= 576) < 256) return WMat{ap->in[18] + (size_t)layer * 1024 * 1024, nullptr, 1024, 1024, 1024, 0, (bf16_t*)(wb + W_OUT), nullptr};
    if ((t -= 256) < 1408) return WMat{ap->in[20] + (size_t)layer * 1024 * DFF, ap->in[21] + (size_t)layer * 1024 * DFF, 1024, 2 * DFF, DFF, 2, (bf16_t*)(wb + W_GU), ap->in[19] + layer * 1024};
    if ((t -= 1408) < 704) return WMat{ap->in[22] + (size_t)layer * DFF * 1024, nullptr, DFF, 1024, 1024, 0, (bf16_t*)(wb + W_DN), nullptr};
    t -= 704; return WMat{ap->in[16] + (size_t)layer * 256 * 512, ap->in[16] + (size_t)layer * 256 * 512 + 256, 256, 512, 512, 2, (bf16_t*)(wb + W_GLU), nullptr};
}

__device__ __forceinline__ void norm_rows_bf16(const float* X, const float* g, bf16_t* H, int gw, int ngw, int lane) {
    f32x4 gv[4];
#pragma unroll
    for (int j = 0; j < 4; ++j) gv[j] = ((const f32x4*)g)[lane + 64 * j];
    for (int m = gw; m < NT; m += ngw) {
        const f32x4* xr = (const f32x4*)(X + (size_t)m * DMODEL) + lane;
        f32x4 v[4]; float s = 0.f;
#pragma unroll
        for (int j = 0; j < 4; ++j) { v[j] = xr[64 * j]; s += (v[j].x * v[j].x + v[j].y * v[j].y) + (v[j].z * v[j].z + v[j].w * v[j].w); }
        const float rs = rsqrtf(wave_sum(s) * (1.f / DMODEL) + EPS);
        u32x2* o = (u32x2*)(H + (size_t)m * DMODEL) + lane;
#pragma unroll
        for (int j = 0; j < 4; ++j) { u32x2 w; w.x = pk2(v[j].x * rs * gv[j].x, v[j].y * rs * gv[j].y); w.y = pk2(v[j].z * rs * gv[j].z, v[j].w * rs * gv[j].w); o[64 * j] = w; }
    }
}
__device__ __forceinline__ void xb_rows(const float* X, bf16_t* XB, float* ssq, int gw, int ngw, int lane) {
    for (int m0 = gw * 2; m0 < NT; m0 += ngw * 2) {
        f32x4 v[2][4];
#pragma unroll
        for (int r = 0; r < 2; ++r) { const f32x4* xr = (const f32x4*)(X + (size_t)(m0 + r) * DMODEL) + lane;
#pragma unroll
            for (int j = 0; j < 4; ++j) v[r][j] = xr[64 * j]; }
#pragma unroll
        for (int r = 0; r < 2; ++r) {
            const size_t m = (size_t)m0 + r;
            float s = 0.f;
#pragma unroll
            for (int j = 0; j < 4; ++j) s += (v[r][j].x * v[r][j].x + v[r][j].y * v[r][j].y) + (v[r][j].z * v[r][j].z + v[r][j].w * v[r][j].w);
            s = wave_sum(s);
            u32x2* o = (u32x2*)(XB + m * DMODEL) + lane;
#pragma unroll
            for (int j = 0; j < 4; ++j) { u32x2 w; w.x = pk2(v[r][j].x, v[r][j].y); w.y = pk2(v[r][j].z, v[r][j].w); o[64 * j] = w; }
            if (lane == 0) { f32x4 o4 = {s, 0.f, 0.f, 0.f}; *(f32x4*)(ssq + m * 4) = o4; }
        }
    }
}
__device__ __forceinline__ void final_rows(const bf16_t* XB, const float* ssp, const float* g, float* OUT, int gw, int ngw, int lane) {
    f32x4 gv[4];
#pragma unroll
    for (int j = 0; j < 4; ++j) gv[j] = ((const f32x4*)g)[lane + 64 * j];
    for (int m0 = gw * 4; m0 < NT; m0 += ngw * 4) {
        u32x2 w[4][4]; f32x4 sp[4];
#pragma unroll
        for (int r = 0; r < 4; ++r) { const size_t m = (size_t)m0 + r; sp[r] = *(const f32x4*)(ssp + m * 4); const u32x2* xr = (const u32x2*)(XB + m * DMODEL) + lane;
#pragma unroll
            for (int j = 0; j < 4; ++j) w[r][j] = xr[64 * j]; }
#pragma unroll
        for (int r = 0; r < 4; ++r) {
            const float rs = rsqrtf(((sp[r].x + sp[r].y) + (sp[r].z + sp[r].w)) * (1.f / DMODEL) + EPS);
            f32x4* o = (f32x4*)(OUT + (size_t)(m0 + r) * DMODEL) + lane;
#pragma unroll
            for (int j = 0; j < 4; ++j) { f32x4 v = {bflo(w[r][j].x), bfhi(w[r][j].x), bflo(w[r][j].y), bfhi(w[r][j].y)}; o[64 * j] = v * rs * gv[j]; }
        }
    }
}
__device__ __forceinline__ void norm_rows_f32_inplace(float* X, const float* g, int gw, int ngw, int lane) {
    f32x4 gv[4];
#pragma unroll
    for (int j = 0; j < 4; ++j) gv[j] = ((const f32x4*)g)[lane + 64 * j];
    for (int m = gw; m < NT; m += ngw) {
        f32x4* xr = (f32x4*)(X + (size_t)m * DMODEL) + lane;
        f32x4 v[4]; float s = 0.f;
#pragma unroll
        for (int j = 0; j < 4; ++j) { v[j] = xr[64 * j]; s += (v[j].x * v[j].x + v[j].y * v[j].y) + (v[j].z * v[j].z + v[j].w * v[j].w); }
        const float rs = rsqrtf(wave_sum(s) * (1.f / DMODEL) + EPS);
#pragma unroll
        for (int j = 0; j < 4; ++j) xr[64 * j] = v[j] * rs * gv[j];
    }
}

struct C3Regs { u32x4 hh[6], cc[6], bb[4]; };
__device__ __forceinline__ void conv3_issue(const bf16_t* P, int w, C3Regs& R) {
    const int c8 = w & 31, tok = (w >> 5) * 4, t = tok & (SEQ - 1);
    const bf16_t* base = P + (size_t)tok * NIN + c8 * 8;
#pragma unroll
    for (int i = 0; i < 6; ++i) { const int dt = (t == 0 && i < 2) ? 0 : i - 2; R.hh[i] = *(const u32x4*)(base + dt * NIN); R.cc[i] = *(const u32x4*)(base + dt * NIN + 512); }
#pragma unroll
    for (int i = 0; i < 4; ++i) R.bb[i] = *(const u32x4*)(base + i * NIN + 256);
}
__device__ __forceinline__ void mul8(const u32x4 a, const u32x4 b, float (&o)[8]) {
    o[0] = bflo(a.x) * bflo(b.x); o[1] = bfhi(a.x) * bfhi(b.x); o[2] = bflo(a.y) * bflo(b.y); o[3] = bfhi(a.y) * bfhi(b.y);
    o[4] = bflo(a.z) * bflo(b.z); o[5] = bfhi(a.z) * bfhi(b.z); o[6] = bflo(a.w) * bflo(b.w); o[7] = bfhi(a.w) * bfhi(b.w);
}
__device__ __forceinline__ void conv3_compute(bf16_t* H, int w, const C3Regs& R, const float (&w0)[8], const float (&w1)[8], const float (&w2)[8], const float (&gm)[8]) {
    const int c8 = w & 31, tok = (w >> 5) * 4, t = tok & (SEQ - 1);
    const float z01 = (t == 0) ? 0.f : 1.f;
    float g[6][8];
#pragma unroll
    for (int i = 0; i < 6; ++i) mul8(R.hh[i], R.cc[i], g[i]);
#pragma unroll
    for (int j = 0; j < 8; ++j) { g[0][j] *= z01; g[1][j] *= z01; }
#pragma unroll
    for (int i = 0; i < 4; ++i) {
        const u32x4 bv = R.bb[i];
        const float bb[8] = {bflo(bv.x), bfhi(bv.x), bflo(bv.y), bfhi(bv.y), bflo(bv.z), bfhi(bv.z), bflo(bv.w), bfhi(bv.w)};
        float y[8]; float sq = 0.f;
#pragma unroll
        for (int j = 0; j < 8; ++j) { y[j] = bb[j] * (w0[j] * g[i][j] + w1[j] * g[i + 1][j] + w2[j] * g[i + 2][j]); sq += y[j] * y[j]; }
#pragma unroll
        for (int o = 1; o < 32; o <<= 1) sq += __shfl_xor(sq, o);
        const float rs = rsqrtf(sq * (1.f / 256.f) + EPS);
        u32x4 o4; o4.x = pk2(y[0] * rs * gm[0], y[1] * rs * gm[1]); o4.y = pk2(y[2] * rs * gm[2], y[3] * rs * gm[3]); o4.z = pk2(y[4] * rs * gm[4], y[5] * rs * gm[5]); o4.w = pk2(y[6] * rs * gm[6], y[7] * rs * gm[7]);
        *(u32x4*)(H + (size_t)(tok + i) * DMODEL + c8 * 8) = o4;
    }
}
__device__ __forceinline__ void conv3_phase(const bf16_t* P, bf16_t* H, const float* w3, const float* gn, int bx, int G, int tid) {
    constexpr int NW = NT / 4 * 32;
    const int c8 = tid & 31;
    float w0[8], w1[8], w2[8], gm[8];
#pragma unroll
    for (int j = 0; j < 8; ++j) { w0[j] = w3[c8 * 8 + j]; w1[j] = w3[256 + c8 * 8 + j]; w2[j] = w3[512 + c8 * 8 + j]; gm[j] = gn[c8 * 8 + j]; }
    C3Regs Ra, Rb;
    int w = bx * NTHREADS + tid; const int step = G * NTHREADS;
    if (w < NW) conv3_issue(P, w, Ra);
    for (; w < NW; w += 2 * step) {
        if (w + step < NW) conv3_issue(P, w + step, Rb);
        conv3_compute(H, w, Ra, w0, w1, w2, gm);
        if (w + step < NW) { if (w + 2 * step < NW) conv3_issue(P, w + 2 * step, Ra); conv3_compute(H, w + step, Rb, w0, w1, w2, gm); }
    }
}

constexpr int CF_ZOFF = 0, CF_STOFF = 94 * 1024;
__device__ __forceinline__ void cfm_issue(const bf16_t* P, int tix, int tid, u32x4 (&ar)[6], u32x4 (&gr)[6]) {
    const int b = tix >> 6, t0 = (tix & 63) * 64;
#pragma unroll
    for (int k = 0; k < 6; ++k) {
        int e = tid + NTHREADS * k; e = e < 94 * 32 ? e : 94 * 32 - 1;
        const int row = e >> 5, c8 = e & 31; int t = t0 - 30 + row; t = t < 0 ? 0 : t;
        const bf16_t* src = P + ((size_t)b * SEQ + t) * NIN + 768 + c8 * 8;
        ar[k] = *(const u32x4*)src; gr[k] = *(const u32x4*)(src + 256);
    }
}
__device__ __forceinline__ void cfm_stage(LAS unsigned char* lds, int tix, int tid, const u32x4 (&ar)[6], const u32x4 (&gr)[6]) {
    const int t0 = (tix & 63) * 64;
    LAS float* ZT = (LAS float*)(lds + CF_ZOFF);
#pragma unroll
    for (int k = 0; k < 6; ++k) {
        const int e = tid + NTHREADS * k;
        if (e < 94 * 32) {
            const int row = e >> 5, c8 = e & 31; const float zm = (t0 - 30 + row < 0) ? 0.f : 1.f;
            const u32x4 a = ar[k], g = gr[k];
            f32x4 z0, z1;
            z0[0] = bflo(a.x) * sigmoidf_(bflo(g.x)) * zm; z0[1] = bfhi(a.x) * sigmoidf_(bfhi(g.x)) * zm; z0[2] = bflo(a.y) * sigmoidf_(bflo(g.y)) * zm; z0[3] = bfhi(a.y) * sigmoidf_(bfhi(g.y)) * zm;
            z1[0] = bflo(a.z) * sigmoidf_(bflo(g.z)) * zm; z1[1] = bfhi(a.z) * sigmoidf_(bfhi(g.z)) * zm; z1[2] = bflo(a.w) * sigmoidf_(bflo(g.w)) * zm; z1[3] = bfhi(a.w) * sigmoidf_(bfhi(g.w)) * zm;
            *(LAS f32x4*)(ZT + row * 256 + c8 * 8) = z0; *(LAS f32x4*)(ZT + row * 256 + c8 * 8 + 4) = z1;
        }
    }
}
__device__ __forceinline__ void cfm_phase(LAS unsigned char* lds, const bf16_t* P, bf16_t* H, const float* dww, const float* dwb, const float* lng, const float* lnb, const float* gn,
                                          int bx, int G, int tid, int wid, int lane) {
    const int cp = tid & 127, rr = tid >> 7;
    f32x2v w[31];
#pragma unroll
    for (int k = 0; k < 31; ++k) w[k] = *(const f32x2v*)(dww + k * 256 + 2 * cp);
    const f32x2v bias = *(const f32x2v*)(dwb + 2 * cp), lg = *(const f32x2v*)(lng + 2 * cp), lb = *(const f32x2v*)(lnb + 2 * cp), gmm = *(const f32x2v*)(gn + 256 + 2 * cp);
    LAS float* ZT = (LAS float*)(lds + CF_ZOFF);
    LAS float* STX = (LAS float*)(lds + CF_STOFF);
    u32x4 ar[6], gr[6];
    int tix = bx;
    if (tix < 1024) cfm_issue(P, tix, tid, ar, gr);
    for (; tix < 1024; tix += G) {
        __syncthreads();
        cfm_stage(lds, tix, tid, ar, gr);
        if (tix + G < 1024) cfm_issue(P, tix + G, tid, ar, gr);
        __syncthreads();
        f32x2v acc[16];
#pragma unroll
        for (int j = 0; j < 16; ++j) acc[j] = bias;
#pragma unroll
        for (int s = 0; s < 46; ++s) {
            const f32x2v z = *(const LAS f32x2v*)(ZT + (rr * 16 + s) * 256 + 2 * cp);
#pragma unroll
            for (int j = 0; j < 16; ++j) { const int k = s - j; if (k >= 0 && k <= 30) acc[j] += w[k] * z; }
        }
        float s1[16], s2[16];
#pragma unroll
        for (int j = 0; j < 16; ++j) { s1[j] = wave_sum(acc[j].x + acc[j].y); s2[j] = wave_sum(acc[j].x * acc[j].x + acc[j].y * acc[j].y); }
        if (lane == 0) {
#pragma unroll
            for (int j = 0; j < 16; ++j) { STX[wid * 32 + j] = s1[j]; STX[wid * 32 + 16 + j] = s2[j]; }
        }
        __syncthreads();
        const int b = tix >> 6, t0 = (tix & 63) * 64;
        float s3[16];
#pragma unroll
        for (int j = 0; j < 16; ++j) {
            const float S1 = s1[j] + STX[(wid ^ 1) * 32 + j], S2 = s2[j] + STX[(wid ^ 1) * 32 + 16 + j];
            const float mean = S1 * (1.f / 256.f), var = fmaxf(S2 * (1.f / 256.f) - mean * mean, 0.f), rs = rsqrtf(var + EPS);
            f32x2v y = (acc[j] - mean) * rs * lg + lb;
            y.x = y.x * sigmoidf_(y.x); y.y = y.y * sigmoidf_(y.y);
            acc[j] = y;
            s3[j] = wave_sum(y.x * y.x + y.y * y.y);
        }
        if (lane == 0) {
#pragma unroll
            for (int j = 0; j < 16; ++j) STX[256 + wid * 16 + j] = s3[j];
        }
        __syncthreads();
#pragma unroll
        for (int j = 0; j < 16; ++j) {
            const float rs = rsqrtf((s3[j] + STX[256 + (wid ^ 1) * 16 + j]) * (1.f / 256.f) + EPS);
            *(unsigned*)(H + ((size_t)b * SEQ + t0 + rr * 16 + j) * DMODEL + 256 + 2 * cp) = pk2(acc[j].x * rs * gmm.x, acc[j].y * rs * gmm.y);
        }
    }
}

template <bool FULL> __device__ __forceinline__ void ssm_tile_scan(f32x16& xr, f32x16& xi, const float (&pw)[4][2], float& cr, float& ci, const bool hi) {
    const float l1r = pw[0][0], l1i = pw[0][1], l4r = pw[3][0], l4i = pw[3][1];
#pragma unroll
    for (int G = 0; G < 4; ++G)
#pragma unroll
        for (int j = 1; j < 4; ++j) { const int i = 4 * G + j; const float pr = xr[i - 1], pi = xi[i - 1]; xr[i] += l1r * pr - l1i * pi; xi[i] += l1r * pi + l1i * pr; }
    float cinr[4], cini[4];
#pragma unroll
    for (int G = 0; G < 4; ++G) {
        const float er = xr[4 * G + 3], ei = xi[4 * G + 3];
        const float orr = __shfl_xor(er, 32), oi = __shfl_xor(ei, 32);
        const float e0r = hi ? orr : er, e0i = hi ? oi : ei, e1r = hi ? er : orr, e1i = hi ? ei : oi;
        const float c1r = l4r * cr - l4i * ci + e0r, c1i = l4r * ci + l4i * cr + e0i;
        cinr[G] = hi ? c1r : cr; cini[G] = hi ? c1i : ci;
        const float c2r = l4r * c1r - l4i * c1i + e1r, c2i = l4r * c1i + l4i * c1r + e1i;
        cr = c2r; ci = c2i;
    }
    if (FULL) {
#pragma unroll
        for (int G = 0; G < 4; ++G)
#pragma unroll
            for (int j = 0; j < 4; ++j) { const int i = 4 * G + j; xr[i] += pw[j][0] * cinr[G] - pw[j][1] * cini[G]; xi[i] += pw[j][0] * cini[G] + pw[j][1] * cinr[G]; }
    }
}
constexpr int SSM_ROWB = 272;
__device__ __forceinline__ void ssm_item(LAS unsigned char* lds, const bf16_t* P, bf16_t* ZB, const float* a_re, const float* a_im, const float* log_dt, const float* b_re, const float* b_im,
                                         const float* c_re, const float* c_im, const float* d_skip, int item, int tid, int wid, int lane) {
    const int b = item >> 4, g = item & 15;
    const int r32 = lane & 31, h = lane >> 5; const bool hi = h != 0;
    LAS f32x2v* EW = (LAS f32x2v*)lds;
    LAS unsigned char* SBW = lds + 4096 + wid * (32 * SSM_ROWB);
    __syncthreads();
    float pw[2][4][2]; bf16x8 bfr[2][2];
#pragma unroll
    for (int tp = 0; tp < 2; ++tp) {
        const int p = r32 + 32 * tp;
        const float dt = __expf(log_dt[g]);
        const float ar = a_re[g * 64 + p], ai = a_im[g * 64 + p];
        const float mag = __expf(ar * dt);
        const float lr = mag * cosf(ai * dt), li = mag * sinf(ai * dt);
        const float den = ar * ar + ai * ai, nr = lr - 1.f, ni = li;
        const float fr = (nr * ar + ni * ai) / den, fi = (ni * ar - nr * ai) / den;
        const f32x4* br4 = (const f32x4*)(b_re + (size_t)(g * 64 + p) * 16 + 8 * h); const f32x4* bi4 = (const f32x4*)(b_im + (size_t)(g * 64 + p) * 16 + 8 * h);
        const f32x4 r0 = br4[0], r1 = br4[1], i0 = bi4[0], i1 = bi4[1];
        const f32x4 re0 = fr * r0 - fi * i0, re1 = fr * r1 - fi * i1, im0 = fr * i0 + fi * r0, im1 = fr * i1 + fi * r1;
        u32x4 wre, wim;
        wre.x = pk2(re0[0], re0[1]); wre.y = pk2(re0[2], re0[3]); wre.z = pk2(re1[0], re1[1]); wre.w = pk2(re1[2], re1[3]);
        wim.x = pk2(im0[0], im0[1]); wim.y = pk2(im0[2], im0[3]); wim.z = pk2(im1[0], im1[1]); wim.w = pk2(im1[2], im1[3]);
        bfr[tp][0] = __builtin_bit_cast(bf16x8, wre); bfr[tp][1] = __builtin_bit_cast(bf16x8, wim);
        pw[tp][0][0] = lr; pw[tp][0][1] = li;
#pragma unroll
        for (int j = 1; j < 4; ++j) { pw[tp][j][0] = pw[tp][j - 1][0] * lr - pw[tp][j - 1][1] * li; pw[tp][j][1] = pw[tp][j - 1][0] * li + pw[tp][j - 1][1] * lr; }
    }
    const int t16 = lane & 15, quad = lane >> 4;
    bf16x8 cfr[4];
#pragma unroll
    for (int s = 0; s < 4; ++s) {
        const f32x4 cr4 = *(const f32x4*)(c_re + (size_t)(g * 16 + t16) * 64 + 4 * quad + 16 * s), ci4 = *(const f32x4*)(c_im + (size_t)(g * 16 + t16) * 64 + 4 * quad + 16 * s);
        u32x4 w; w.x = pk2(cr4[0], -ci4[0]); w.y = pk2(cr4[1], -ci4[1]); w.z = pk2(cr4[2], -ci4[2]); w.w = pk2(cr4[3], -ci4[3]);
        cfr[s] = __builtin_bit_cast(bf16x8, w);
    }
    const f32x4 dsk = *(const f32x4*)(d_skip + g * 16 + 4 * quad);
    const size_t tok0 = (size_t)b * SEQ + (size_t)wid * 512;
    const bf16_t* ubase = P + tok0 * NIN + 1280 + g * 16;
    f32x16 zero16;
#pragma unroll
    for (int q = 0; q < 16; ++q) zero16[q] = 0.f;
    float cr[2] = {0.f, 0.f}, ci[2] = {0.f, 0.f};
    {
        bf16x8 ua = *(const bf16x8*)(ubase + (size_t)r32 * NIN + 8 * h);
        for (int mt = 0; mt < 16; ++mt) {
            const bf16x8 un = *(const bf16x8*)(ubase + (size_t)((mt < 15 ? mt + 1 : mt) * 32 + r32) * NIN + 8 * h);
#pragma unroll
            for (int tp = 0; tp < 2; ++tp) {
                f32x16 xr = __builtin_amdgcn_mfma_f32_32x32x16_bf16(ua, bfr[tp][0], zero16, 0, 0, 0);
                f32x16 xi = __builtin_amdgcn_mfma_f32_32x32x16_bf16(ua, bfr[tp][1], zero16, 0, 0, 0);
                ssm_tile_scan<false>(xr, xi, pw[tp], cr[tp], ci[tp], hi);
            }
            ua = un;
        }
    }
    if (!hi) { f32x2v e0 = {cr[0], ci[0]}, e1 = {cr[1], ci[1]}; EW[wid * 64 + r32] = e0; EW[wid * 64 + 32 + r32] = e1; }
    __syncthreads();
#pragma unroll
    for (int tp = 0; tp < 2; ++tp) {
        float qr = pw[tp][3][0], qi = pw[tp][3][1];
#pragma unroll
        for (int q = 0; q < 7; ++q) { const float nr = qr * qr - qi * qi, ni = 2.f * qr * qi; qr = nr; qi = ni; }
        float sr = 0.f, si = 0.f;
        for (int w = 0; w < wid; ++w) { const f32x2v e = EW[w * 64 + r32 + 32 * tp]; const float nr = qr * sr - qi * si + e.x, ni = qr * si + qi * sr + e.y; sr = nr; si = ni; }
        cr[tp] = sr; ci[tp] = si;
    }
    {
        bf16x8 ua = *(const bf16x8*)(ubase + (size_t)r32 * NIN + 8 * h);
        for (int mt = 0; mt < 16; ++mt) {
            const bf16x8 un = *(const bf16x8*)(ubase + (size_t)((mt < 15 ? mt + 1 : mt) * 32 + r32) * NIN + 8 * h);
            u32x2 uwv[2];
#pragma unroll
            for (int tt = 0; tt < 2; ++tt) uwv[tt] = *(const u32x2*)(P + (tok0 + mt * 32 + tt * 16 + t16) * NIN + 1280 + g * 16 + 4 * quad);
#pragma unroll
            for (int tp = 0; tp < 2; ++tp) {
                f32x16 xr = __builtin_amdgcn_mfma_f32_32x32x16_bf16(ua, bfr[tp][0], zero16, 0, 0, 0);
                f32x16 xi = __builtin_amdgcn_mfma_f32_32x32x16_bf16(ua, bfr[tp][1], zero16, 0, 0, 0);
                ssm_tile_scan<true>(xr, xi, pw[tp], cr[tp], ci[tp], hi);
#pragma unroll
                for (int i = 0; i < 16; ++i) {
                    const int t = (i & 3) + 8 * (i >> 2) + 4 * h;
                    *(LAS unsigned*)(SBW + t * SSM_ROWB + 4 * (r32 + 32 * tp)) = pk2(xr[i], xi[i]);
                }
            }
            WAVE_LDS_SYNC();
#pragma unroll
            for (int tt = 0; tt < 2; ++tt) {
                f32x4 acc = {0.f, 0.f, 0.f, 0.f};
#pragma unroll
                for (int s = 0; s < 4; ++s) {
                    const bf16x8 sf = *(const LAS bf16x8*)(SBW + (tt * 16 + t16) * SSM_ROWB + quad * 16 + 64 * s);
                    acc = __builtin_amdgcn_mfma_f32_16x16x32_bf16(cfr[s], sf, acc, 0, 0, 0);
                }
                const size_t tok = tok0 + mt * 32 + tt * 16 + t16;
                const u32x2 uw = uwv[tt];
                const f32x4 uu = {bflo(uw.x), bfhi(uw.x), bflo(uw.y), bfhi(uw.y)};
                const f32x4 y = acc + dsk * uu;
                u32x2 w; w.x = pk2(gelu_tanh(y.x), gelu_tanh(y.y)); w.y = pk2(gelu_tanh(y.z), gelu_tanh(y.w));
                *(u32x2*)(ZB + tok * 256 + g * 16 + 4 * quad) = w;
            }
            WAVE_LDS_SYNC();
            ua = un;
        }
    }
}

constexpr int AT_ROWB = 144, AT_KOFF = 0, AT_VOFF = 384 * AT_ROWB;
__device__ __forceinline__ s16x4 vtr(const LAS unsigned char* p) { return __builtin_bit_cast(s16x4, __builtin_amdgcn_ds_read_tr16_b64_v4i16((LAS s16x4*)p)); }
struct AttnU { int pat, head, d, ub; size_t rowbase; };
__device__ __forceinline__ AttnU attn_decode(int u) {
    AttnU U; const int rem = u & 1023, b = rem >> 6, ru = rem & 15; U.pat = u >> 10; U.head = (rem >> 4) & 3;
    int r;
    if (U.pat == 0) { U.d = 1; r = 0; U.ub = ru; } else if (U.pat == 1) { U.d = 4; r = ru >> 2; U.ub = ru & 3; } else { U.d = 16; r = ru; U.ub = 0; }
    U.rowbase = (size_t)b * SEQ + r; return U;
}
__device__ __forceinline__ void attn_issue(const bf16_t* P, const AttnU& U, int tid, int wid, int lane, u32x4 (&kreg)[6], u32x4 (&vreg)[6], bf16x8 (&qf)[4]) {
    const int i0 = U.ub * 256 - 128;
#pragma unroll
    for (int k = 0; k < 6; ++k) {
        const int e = tid + NTHREADS * k, row = e >> 3, c = e & 7; int si = i0 + row; si = si < 0 ? 0 : si;
        const bf16_t* src = P + (U.rowbase + (size_t)si * U.d) * NIN + U.head * 64 + c * 8;
        kreg[k] = *(const u32x4*)(src + 1792); vreg[k] = *(const u32x4*)(src + 2048);
    }
    const int r32 = lane & 31, h = lane >> 5;
    const size_t qtok = U.rowbase + (size_t)(U.ub * 256 + 32 * wid + r32) * U.d;
    const bf16_t* qp = P + qtok * NIN + 1536 + U.head * 64 + 8 * h;
#pragma unroll
    for (int s = 0; s < 4; ++s) qf[s] = *(const bf16x8*)(qp + 16 * s);
}
__device__ __forceinline__ void attn_to_lds(LAS unsigned char* lds, int tid, const u32x4 (&kreg)[6], const u32x4 (&vreg)[6]) {
#pragma unroll
    for (int k = 0; k < 6; ++k) {
        const int e = tid + NTHREADS * k, row = e >> 3, c = e & 7;
        *(LAS u32x4*)(lds + AT_KOFF + row * AT_ROWB + c * 16) = kreg[k];
        *(LAS u32x4*)(lds + AT_VOFF + row * AT_ROWB + c * 16) = vreg[k];
    }
}
__device__ __forceinline__ void attn_compute(LAS unsigned char* lds, const AttnU& U, const bf16x8 (&qf)[4], bf16_t* OB, f32x2v* ST, int wid, int lane) {
    const int pat = U.pat, head = U.head, ub = U.ub;
    const int r32 = lane & 31, h = lane >> 5;
    const size_t qtok = U.rowbase + (size_t)(ub * 256 + 32 * wid + r32) * U.d;
    f32x16 sc[5];
    float mx = -1e30f;
    const float r32f = (float)r32, h4f = (float)(4 * h);
#pragma unroll
    for (int i = 0; i < 5; ++i) {
        const bool tv = (ub > 0) || (wid + i >= 4);
        f32x16 a;
        if (tv) {
#pragma unroll
            for (int q = 0; q < 16; ++q) a[q] = 0.f;
            const LAS unsigned char* kp = lds + AT_KOFF + (32 * wid + 32 * i + r32) * AT_ROWB + 16 * h;
#pragma unroll
            for (int s = 0; s < 4; ++s) { const bf16x8 kf = *(const LAS bf16x8*)(kp + 32 * s); a = __builtin_amdgcn_mfma_f32_32x32x16_bf16(kf, qf[s], a, 0, 0, 0); }
            if (i == 0 || i == 4) {
#pragma unroll
                for (int q = 0; q < 16; ++q) {
                    const float diff = ((float)((q & 3) + 8 * (q >> 2)) + h4f) - r32f;
                    a[q] = (i == 0) ? __builtin_fmaf(fminf(diff, 0.f), 1e30f, a[q]) : __builtin_fmaf(fmaxf(diff, 0.f), -1e30f, a[q]);
                }
            }
#pragma unroll
            for (int q = 0; q < 16; ++q) mx = fmaxf(mx, a[q]);
        } else {
#pragma unroll
            for (int q = 0; q < 16; ++q) a[q] = -1e30f;
        }
        sc[i] = a;
    }
    mx = fmaxf(mx, __shfl_xor(mx, 32));
    float l = 0.f;
#pragma unroll
    for (int i = 0; i < 5; ++i)
#pragma unroll
        for (int q = 0; q < 16; ++q) { const float pv = __builtin_amdgcn_exp2f(sc[i][q] - mx); sc[i][q] = pv; l += pv; }
    l += __shfl_xor(l, 32);
    f32x16 o0, o1;
#pragma unroll
    for (int q = 0; q < 16; ++q) { o0[q] = 0.f; o1[q] = 0.f; }
    const int i16 = lane & 15, q4 = i16 >> 2, p4 = i16 & 3, blk = (lane >> 4) & 1;
#pragma unroll
    for (int i = 0; i < 5; ++i) {
        const bool tv = (ub > 0) || (wid + i >= 4);
        if (tv) {
#pragma unroll
            for (int s2 = 0; s2 < 2; ++s2) {
                u32x4 pw; pw.x = pk2(sc[i][8 * s2], sc[i][8 * s2 + 1]); pw.y = pk2(sc[i][8 * s2 + 2], sc[i][8 * s2 + 3]); pw.z = pk2(sc[i][8 * s2 + 4], sc[i][8 * s2 + 5]); pw.w = pk2(sc[i][8 * s2 + 6], sc[i][8 * s2 + 7]);
                const bf16x8 pb = __builtin_bit_cast(bf16x8, pw);
                const LAS unsigned char* vp = lds + AT_VOFF + (32 * wid + 32 * i + 16 * s2 + 4 * h + q4) * AT_ROWB + 32 * blk + 8 * p4;
                const s16x4 lo0 = vtr(vp), hi0 = vtr(vp + 8 * AT_ROWB), lo1 = vtr(vp + 64), hi1 = vtr(vp + 8 * AT_ROWB + 64);
                const bf16x8 va0 = __builtin_shufflevector(lo0, hi0, 0, 1, 2, 3, 4, 5, 6, 7), va1 = __builtin_shufflevector(lo1, hi1, 0, 1, 2, 3, 4, 5, 6, 7);
                o0 = __builtin_amdgcn_mfma_f32_32x32x16_bf16(va0, pb, o0, 0, 0, 0);
                o1 = __builtin_amdgcn_mfma_f32_32x32x16_bf16(va1, pb, o1, 0, 0, 0);
            }
        }
    }
    const float inv = 1.f / l;
    bf16_t* op = OB + ((size_t)pat * NT + qtok) * 256 + head * 64 + 4 * h;
#pragma unroll
    for (int g4 = 0; g4 < 4; ++g4) {
        u32x2 w0, w1;
        w0.x = pk2(o0[4 * g4] * inv, o0[4 * g4 + 1] * inv); w0.y = pk2(o0[4 * g4 + 2] * inv, o0[4 * g4 + 3] * inv);
        w1.x = pk2(o1[4 * g4] * inv, o1[4 * g4 + 1] * inv); w1.y = pk2(o1[4 * g4 + 2] * inv, o1[4 * g4 + 3] * inv);
        *(u32x2*)(op + 8 * g4) = w0; *(u32x2*)(op + 32 + 8 * g4) = w1;
    }
    if (h == 0) { f32x2v st = {mx, l}; ST[(qtok * 4 + head) * 3 + pat] = st; }
}

__device__ __forceinline__ void combine_rows(const bf16_t* YC, const bf16_t* OB, const f32x2v* ST, const float* gn, bf16_t* H, int gw, int ngw, int lane) {
    f32x4 gv[2];
#pragma unroll
    for (int j = 0; j < 2; ++j) gv[j] = ((const f32x4*)gn)[lane + 64 * (j + 2)];
    const int head = lane >> 4;
    for (int m0 = gw * 4; m0 < NT; m0 += ngw * 4) {
        u32x2 yw[4], a0[4], a1[4], a2[4]; f32x2v s0[4], s1[4], s2[4];
#pragma unroll
        for (int r = 0; r < 4; ++r) {
            const size_t m = (size_t)m0 + r;
            yw[r] = *((const u32x2*)(YC + m * 768 + 512) + lane);
            s0[r] = ST[(m * 4 + head) * 3 + 0]; s1[r] = ST[(m * 4 + head) * 3 + 1]; s2[r] = ST[(m * 4 + head) * 3 + 2];
            a0[r] = *((const u32x2*)(OB + m * 256) + lane); a1[r] = *((const u32x2*)(OB + ((size_t)NT + m) * 256) + lane); a2[r] = *((const u32x2*)(OB + ((size_t)2 * NT + m) * 256) + lane);
        }
#pragma unroll
        for (int r = 0; r < 4; ++r) {
            const size_t m = (size_t)m0 + r;
            f32x4 v[2];
            v[0] = (f32x4){bflo(yw[r].x), bfhi(yw[r].x), bflo(yw[r].y), bfhi(yw[r].y)};
            {
                const float M = fmaxf(s0[r].x, fmaxf(s1[r].x, s2[r].x));
                const float w0 = __builtin_amdgcn_exp2f(s0[r].x - M) * s0[r].y, w1 = __builtin_amdgcn_exp2f(s1[r].x - M) * s1[r].y, w2 = __builtin_amdgcn_exp2f(s2[r].x - M) * s2[r].y;
                const float iw = __builtin_amdgcn_rcpf(w0 + w1 + w2);
                f32x4 o;
                o.x = (w0 * bflo(a0[r].x) + w1 * bflo(a1[r].x) + w2 * bflo(a2[r].x)) * iw; o.y = (w0 * bfhi(a0[r].x) + w1 * bfhi(a1[r].x) + w2 * bfhi(a2[r].x)) * iw;
                o.z = (w0 * bflo(a0[r].y) + w1 * bflo(a1[r].y) + w2 * bflo(a2[r].y)) * iw; o.w = (w0 * bfhi(a0[r].y) + w1 * bfhi(a1[r].y) + w2 * bfhi(a2[r].y)) * iw;
                v[1] = o;
            }
#pragma unroll
            for (int j = 0; j < 2; ++j) {
                const float ss = wave_sum((v[j].x * v[j].x + v[j].y * v[j].y) + (v[j].z * v[j].z + v[j].w * v[j].w));
                const float rs = rsqrtf(ss * (1.f / 256.f) + EPS);
                u32x2 w; w.x = pk2(v[j].x * rs * gv[j].x, v[j].y * rs * gv[j].y); w.y = pk2(v[j].z * rs * gv[j].z, v[j].w * rs * gv[j].w);
                *((u32x2*)(H + m * DMODEL + 256 * (j + 2)) + lane) = w;
            }
        }
    }
}

#define XB_TMO      128
#define XB_XCNT(j)  (256  + 64 * (j))
#define XB_XSUB(j)  (1280 + 64 * (j))
#define XB_XGEN(j)  (2304 + 64 * (j))
#define XB_TOP      3328
#define XB_TOPGEN   3392
#define XCD_BAR_WORDS 3456
#define XB_SPIN_CAP (1u << 18)

__device__ __forceinline__ unsigned xb_ld(unsigned* p)              { return __hip_atomic_load(p, __ATOMIC_RELAXED, __HIP_MEMORY_SCOPE_AGENT); }
__device__ __forceinline__ unsigned xb_add(unsigned* p, unsigned v) { return __hip_atomic_fetch_add(p, v, __ATOMIC_RELAXED, __HIP_MEMORY_SCOPE_AGENT); }
__device__ __forceinline__ unsigned xb_xcc_id() { return (unsigned)__builtin_amdgcn_s_getreg((3 << 11) | 20) & 0xFu; }
#define XB_SPIN(cond, bar) do { unsigned _sp = 0; while (cond) { __builtin_amdgcn_s_sleep(1); \
    if ((++_sp & 255u) == 0u) { if (xb_ld(&(bar)[XB_TMO])) break; if (_sp > XB_SPIN_CAP) { atomicAdd(&(bar)[XB_TMO], 1u); break; } } } } while (0)

struct XcdBarrier {
    unsigned* bar; unsigned x;
    volatile LAS unsigned* st;
};

__device__ __forceinline__ XcdBarrier xcd_barrier_post(unsigned* bar, volatile LAS unsigned* st) {
    XcdBarrier b; b.bar = bar; b.x = xb_xcc_id(); b.st = st;
    if (threadIdx.x == 0) (void)xb_add(&bar[XB_XCNT(b.x)], 1u);
    return b;
}
__device__ __forceinline__ void xcd_barrier_complete(unsigned* bar, unsigned x, unsigned& nloc, unsigned& nx) {
    const unsigned G = gridDim.x * gridDim.y * gridDim.z;
    unsigned sum, cnt, mine, sp = 0u;
    for (;;) {
        sum = 0u; cnt = 0u; mine = 0u;
#pragma unroll
        for (unsigned j = 0; j < 16; ++j) { const unsigned c = xb_ld(&bar[XB_XCNT(j)]); sum += c; cnt += (c > 0u) ? 1u : 0u; mine = (j == x) ? c : mine; }
        if (sum == G) break;
        __builtin_amdgcn_s_sleep(1);
        if ((++sp & 255u) == 0u) { if (xb_ld(&bar[XB_TMO])) break; if (sp > XB_SPIN_CAP) { atomicAdd(&bar[XB_TMO], 1u); break; } }
    }
    nloc = mine > 0u ? mine : 1u; nx = cnt > 0u ? cnt : 1u;
}

__device__ __forceinline__ void xcd_barrier(const XcdBarrier& b) {
    asm volatile("s_waitcnt vmcnt(0)" ::: "memory");
    __syncthreads();
    if (threadIdx.x == 0) {
        unsigned* bar = b.bar;
        __builtin_amdgcn_s_waitcnt(0);
        unsigned nloc = b.st[0], nx = b.st[1];
        if (nloc == 0u) { xcd_barrier_complete(bar, b.x, nloc, nx); b.st[0] = nloc; b.st[1] = nx; }
        const unsigned old = xb_add(&bar[XB_XSUB(b.x)], 1u);
        const unsigned gen = old / nloc;
        if (old + 1u == (gen + 1u) * nloc) {
            __builtin_amdgcn_fence(__ATOMIC_RELEASE, "agent");
            asm volatile("s_waitcnt vmcnt(0)" ::: "memory");
            const unsigned og = xb_add(&bar[XB_TOP], 1u);
            const unsigned tg = og / nx;
            if (og + 1u == (tg + 1u) * nx) xb_add(&bar[XB_TOPGEN], 1u);
            else XB_SPIN(xb_ld(&bar[XB_TOPGEN]) == tg, bar);
            __builtin_amdgcn_fence(__ATOMIC_ACQUIRE, "agent");
            xb_add(&bar[XB_XGEN(b.x)], 1u);
            asm volatile("s_waitcnt vmcnt(0)" ::: "memory");
        } else {
            XB_SPIN(xb_ld(&bar[XB_XGEN(b.x)]) == gen, bar);
            __builtin_amdgcn_fence(__ATOMIC_ACQUIRE, "agent");
            asm volatile("s_waitcnt vmcnt(0)" ::: "memory");
        }
    }
    __syncthreads();
}

constexpr int NPHASE = 16;
struct Ctx { const Args* args; LAS unsigned char* lds; int tid, lane, wid, G, bx, gw, ngw; };
#define LAUNDER(p) asm volatile("" : "+s"(p))
__device__ __forceinline__ void phase_body(const int ph, const CAS Args* ap, LAS unsigned char* lds, const int tid, const int lane, const int wid, const int G, const int bx) {
    const int gw = bx * 8 + wid, ngw = G * 8;
    unsigned char* ws = ap->ws;
    const float* x_in = ap->in[0];
    float* X = ap->out;
    bf16_t* Hb = (bf16_t*)(ws + WS_H); bf16_t* Pb = (bf16_t*)(ws + WS_P); bf16_t* YC = (bf16_t*)(ws + WS_YC); bf16_t* ZB = (bf16_t*)(ws + WS_ZB); bf16_t* OB = (bf16_t*)(ws + WS_OB);
    f32x2v* ST = (f32x2v*)(ws + WS_ST);
    float* ropec = (float*)(ws + WS_ROPE); float* ropes = ropec + SEQ * 32;
    bf16_t* XB = (bf16_t*)(ws + WS_XB); float* SS = (float*)(ws + WS_SS);
    if (ph == 0) {
        {
            float v[8], vn[8]; int t = 0, tn = 0;
            int it = bx;
            WMat w = wmat_of(ap, ws, it < 2 * 2976 ? it : 0, t), wn = w;
            if (it < 2 * 2976) wconv_load(w, t, tid, v);
            for (; it < 2 * 2976; it += G) {
                const bool more = it + G < 2 * 2976;
                if (more) { wn = wmat_of(ap, ws, it + G, tn); wconv_load(wn, tn, tid, vn); }
                wconv_store((LAS float*)lds, w, t, tid, v);
                if (more) {
#pragma unroll
                    for (int i = 0; i < 8; ++i) v[i] = vn[i];
                    w = wn; t = tn;
                }
            }
        }
        for (int e = bx * NTHREADS + tid; e < SEQ * 32; e += G * NTHREADS) {
            const int pos = e >> 5, i = e & 31;
            const double inv = (double)exp2f(-(float)i * (13.287712379549449f / 32.f));
            const float angf = (float)pos * (float)inv;
            double rev = (double)angf * 0.15915494309189535; rev -= floor(rev);
            ropec[e] = __builtin_amdgcn_cosf((float)rev); ropes[e] = __builtin_amdgcn_sinf((float)rev);
        }
        xb_rows(x_in, XB, SS, gw, ngw, lane);
        return;
    }
    if (ph == 15) { final_rows(XB, SS + (size_t)4 * NT * 4, ap->in[23], X, gw, ngw, lane); return; }
    const int layer = (ph - 1) / 7, sub = (ph - 1) % 7;
    unsigned char* wb = ws + WS_W + (size_t)layer * W_LAYER;
    if (sub == 0) {
        pg8::Gemm g{XB, (const bf16_t*)(wb + W_IN), NT, NIN, 1024}; pg8::StaticOrder S; S.init(NT, NIN, G, bx);
        EpiIn E{Pb, ropec, ropes, RowScale{SS + (size_t)(layer == 0 ? 0 : 2) * NT * 4, (LAS float*)(lds + 131072 + 4096)}};
        pg8::gemm_phase<EpiIn, pg8::StaticOrder, true, true>(lds, g, S, E);
    } else if (sub == 1) {
        const int rot = bx % 3;
#define RUN_S do { LAUNDER(ap); for (int it = bx; it < 256; it += G) \
            ssm_item(lds, Pb, ZB, ap->in[8] + layer * 1024, ap->in[9] + layer * 1024, ap->in[10] + layer * 16, ap->in[11] + (size_t)layer * 16384, ap->in[12] + (size_t)layer * 16384, \
                     ap->in[13] + (size_t)layer * 16384, ap->in[14] + (size_t)layer * 16384, ap->in[15] + layer * 256, it, tid, wid, lane); __syncthreads(); } while (0)
#define RUN_C do { LAUNDER(ap); conv3_phase(Pb, Hb, ap->in[3] + layer * 768, ap->in[17] + layer * 1024, bx, G, tid); \
            cfm_phase(lds, Pb, Hb, ap->in[4] + layer * 31 * 256, ap->in[5] + layer * 256, ap->in[6] + layer * 256, ap->in[7] + layer * 256, ap->in[17] + layer * 1024, bx, G, tid, wid, lane); __syncthreads(); } while (0)
        if (rot == 0) RUN_S;
        if (rot <= 1) RUN_C;
        {
            const int per = (3072 + G - 1) / G, it0 = bx * per, it1 = (it0 + per < 3072) ? it0 + per : 3072;
            u32x4 kreg[6], vreg[6]; bf16x8 qn[4], qc[4];
            int it = it0;
            AttnU U = attn_decode(it < it1 ? it : 0);
            if (it < it1) attn_issue(Pb, U, tid, wid, lane, kreg, vreg, qn);
            for (; it < it1; ++it) {
                __syncthreads();
                attn_to_lds(lds, tid, kreg, vreg);
#pragma unroll
                for (int s = 0; s < 4; ++s) qc[s] = qn[s];
                __syncthreads();
                const AttnU Uc = U;
                if (it + 1 < it1) { U = attn_decode(it + 1); attn_issue(Pb, U, tid, wid, lane, kreg, vreg, qn); }
                attn_compute(lds, Uc, qc, OB, ST, wid, lane);
            }
            __syncthreads();
        }
        if (rot >= 1) RUN_S;
        if (rot == 2) RUN_C;
#undef RUN_S
#undef RUN_C
    } else if (sub == 2) {
        pg8::Gemm g{ZB, (const bf16_t*)(wb + W_GLU), NT, 512, 256}; pg8::StaticOrder S; S.init(NT, 512, G, bx);
        EpiGate<1> E{YC, 768, 512, RowScale{nullptr, nullptr}};
        pg8::gemm_phase<EpiGate<1>, pg8::StaticOrder, true, true>(lds, g, S, E);
    } else if (sub == 3) {
        combine_rows(YC, OB, ST, ap->in[17] + layer * 1024, Hb, gw, ngw, lane);
    } else if (sub == 4) {
        pg8::Gemm g{Hb, (const bf16_t*)(wb + W_OUT), NT, 1024, 1024}; pg8::StaticOrder S; S.init(NT, 1024, G, bx);
        EpiRes E{XB, SS + (size_t)(layer == 0 ? 1 : 3) * NT * 4, (LAS float*)(lds + 131072)};
        pg8::gemm_phase<EpiRes, pg8::StaticOrder, true, true>(lds, g, S, E);
    } else if (sub == 5) {
#ifdef STAGGER_GU
        { const int st = (bx >> 3) & 7; for (int q = 0; q < st; ++q) __builtin_amdgcn_s_sleep(127); }
#endif
        pg8::Gemm g{XB, (const bf16_t*)(wb + W_GU), NT, 2 * DFF, 1024}; pg8::StaticOrder S; S.init(NT, 2 * DFF, G, bx);
        EpiGate<0> E{Pb, DFF, 0, RowScale{SS + (size_t)(layer == 0 ? 1 : 3) * NT * 4, (LAS float*)(lds + 131072 + 4096)}};
        pg8::gemm_phase<EpiGate<0>, pg8::StaticOrder, true, true>(lds, g, S, E);
    } else {
        pg8::Gemm g{Pb, (const bf16_t*)(wb + W_DN), NT, 1024, DFF}; pg8::StaticOrder S; S.init(NT, 1024, G, bx);
        EpiRes E{XB, SS + (size_t)(layer == 0 ? 2 : 4) * NT * 4, (LAS float*)(lds + 131072)};
        pg8::gemm_phase<EpiRes, pg8::StaticOrder, true, true>(lds, g, S, E);
    }
}
__global__ void __launch_bounds__(NTHREADS, 2) fwd_megakernel(Args args) {
    extern __shared__ __attribute__((aligned(16))) unsigned char lds_raw[];
    LAS unsigned char* lds = (LAS unsigned char*)lds_raw;
    cg::grid_group grid = cg::this_grid();
    const int tid = threadIdx.x, lane = tid & 63, wid = __builtin_amdgcn_readfirstlane(tid >> 6);
    const int G = gridDim.x, bx = blockIdx.x;
    const int lo = args.ph_lo, hi = args.ph_hi;
    const CAS Args* ap = (const CAS Args*)__builtin_amdgcn_kernarg_segment_ptr();
    volatile LAS unsigned* bst = (volatile LAS unsigned*)(lds + LDS_BYTES - 64);
    if (tid == 0) { bst[0] = 0u; bst[1] = 0u; }
    __syncthreads();
    XcdBarrier xbar = xcd_barrier_post((unsigned*)(args.ws + WS_BAR), bst);
#define GSYNC(k) do { if ((k) == 1) grid.sync(); else xcd_barrier(xbar); } while (0)
#define PHASE(k) if (lo <= (k) && (k) < hi) { if ((k) > lo) GSYNC(k); LAUNDER(ap); phase_body((k), ap, lds, tid, lane, wid, G, bx); \
        if ((REPEAT_MASK >> (k)) & 1u) { xcd_barrier(xbar); LAUNDER(ap); phase_body((k), ap, lds, tid, lane, wid, G, bx); } \
        if ((k) == 0) { for (int es = 0; es < EXTRA_SYNCS; ++es) xcd_barrier(xbar); } }
    PHASE(0) PHASE(1) PHASE(2) PHASE(3) PHASE(4) PHASE(5) PHASE(6) PHASE(7) PHASE(8) PHASE(9)
    PHASE(10) PHASE(11) PHASE(12) PHASE(13) PHASE(14) PHASE(15)
#undef PHASE
}

extern "C" void kernel_launch(void* const* d_in, const int* in_sizes, int n_in, void* d_out, int out_size, void* d_ws, size_t ws_size, hipStream_t stream) {
    static int grid_blocks = 0;
    if (grid_blocks == 0) {
        if (n_in != 24 || ws_size < WS_END) { fprintf(stderr, "kernel_launch: unexpected n_in %d / ws_size %zu\n", n_in, ws_size); grid_blocks = -1; return; }
        int dev = 0, cus = 0, per_cu = 0;
        hipGetDevice(&dev);
        hipDeviceGetAttribute(&cus, hipDeviceAttributeMultiprocessorCount, dev);
        if (hipFuncSetAttribute((const void*)fwd_megakernel, hipFuncAttributeMaxDynamicSharedMemorySize, LDS_BYTES) != hipSuccess) { fprintf(stderr, "kernel_launch: hipFuncSetAttribute failed\n"); grid_blocks = -1; return; }
        if (hipOccupancyMaxActiveBlocksPerMultiprocessor(&per_cu, (const void*)fwd_megakernel, NTHREADS, LDS_BYTES) != hipSuccess || per_cu < 1) { fprintf(stderr, "kernel_launch: occupancy query %d\n", per_cu); per_cu = 1; }
        (void)hipGetLastError();
        grid_blocks = cus * per_cu;
    }
    if (grid_blocks < 0) return;
    Args a{};
    for (int i = 0; i < 24; ++i) a.in[i] = (const float*)d_in[i];
    a.out = (float*)d_out; a.ws = (unsigned char*)d_ws; a.ph_lo = 0; a.ph_hi = NPHASE;
    if (hipMemsetAsync((char*)d_ws + WS_BAR, 0, 16384, stream) != hipSuccess) { fprintf(stderr, "kernel_launch: memset failed\n"); return; }
    void* kargs[] = {&a};
    hipError_t e = hipLaunchCooperativeKernel((const void*)fwd_megakernel, dim3(grid_blocks), dim3(NTHREADS), kargs, LDS_BYTES, stream);
    if (e != hipSuccess) fprintf(stderr, "cooperative launch failed: %s (grid %d)\n", hipGetErrorString(e), grid_blocks);
}
```

```cpp
#include <hip/hip_runtime.h>
#include <hip/hip_cooperative_groups.h>
#include <cstdio>
#include <cstdint>
namespace cg = cooperative_groups;
namespace pg8 {
#define PG8_LAS __attribute__((address_space(3)))
typedef unsigned short bf16_t;
typedef short bf16x8 __attribute__((ext_vector_type(8)));
typedef float f32x4 __attribute__((ext_vector_type(4)));
typedef unsigned u32x4 __attribute__((ext_vector_type(4)));
constexpr int BM = 256, BK = 64, HALF = 128, HTB = HALF * BK * 2  , STAGE_BYTES = 8 * HTB, NXCD = 8, WGM = 8;

__host__ __device__ __forceinline__ int lds_byte(int r, int c) { const int st = (r >> 4) * 2 + (c >> 5), rr = r & 15, cc = c & 31, ob = rr * 64 + cc * 2; return st * 1024 + (ob ^ (((ob >> 9) & 1) << 5)); }
__host__ __device__ __forceinline__ void stage_rc(int b, int& R, int& C) { const int st = b / 1024, sb = b % 1024, swz = sb ^ (((sb >> 9) & 1) << 5); R = (st >> 1) * 16 + swz / 64; C = (st & 1) * 32 + (swz % 64) / 2; }
__host__ __device__ __forceinline__ int perm32(int rho) { const int n = rho >> 4, i = rho & 15; return 8 * (i >> 2) + 4 * n + (i & 3); }

struct Unit { int pm, pn; };
struct Gemm { const bf16_t* A; const bf16_t* Bt; int M, N, K; };

struct StaticOrder {
    int nM, nN, nwg, G, c;
    __host__ __device__ void init(int M, int N, int G_, int c_) { nM = M / BM; nN = N / BM; nwg = nM * nN; G = G_; c = c_; }
    __host__ __device__ bool next(int i, Unit& u) const {
        const long L = (long)i * G + c; if (L >= nwg) return false;
        int wgid = (int)L; { const int q = nwg / NXCD, r = nwg % NXCD, xcd = wgid % NXCD, off = wgid / NXCD; wgid = (xcd < r ? xcd * (q + 1) : r * (q + 1) + (xcd - r) * q) + off; }
        const int nig = WGM * nN, gid = wgid / nig, fm = gid * WGM, gsz = (nM - fm) < WGM ? (nM - fm) : WGM;
        u.pm = fm + ((wgid % nig) % gsz); u.pn = (wgid % nig) / gsz; return true;
    }
    __device__ __forceinline__ void a_ready(const Unit&) const {}
    __device__ __forceinline__ void done(const Unit&) const {}
};

__device__ __forceinline__ unsigned cvt_pk_bf16(float lo, float hi) { unsigned r; asm volatile("v_cvt_pk_bf16_f32 %0, %1, %2" : "=v"(r) : "v"(lo), "v"(hi)); return r; }
typedef float f32x2 __attribute__((ext_vector_type(2)));
template <class Epi, class Sched, bool ALIGN_EPI = false, bool SP2 = false>
__device__ __forceinline__ void gemm_phase(PG8_LAS unsigned char* lds, const Gemm g, const Sched& S, const Epi& E) {
    const int tid = threadIdx.x, wid = __builtin_amdgcn_readfirstlane(tid >> 6), lane = tid & 63, wr = wid >> 2, wc = wid & 3, fr = lane & 15, fq = lane >> 4;
    const int K = g.K, nt = K / BK;
    unsigned voffA[2], voffB[2];
#pragma unroll
    for (int i = 0; i < 2; ++i) { int R, C; stage_rc(tid * 16 + i * 8192, R, C); const int Rb = Epi::PERM ? ((R & ~31) + perm32(R & 31)) : R;
        voffA[i] = (unsigned)(R * K + C) * 2u; voffB[i] = (unsigned)(Rb * K + C) * 2u; }
    const size_t kstep = (size_t)(BK * 2);
    const size_t hstep = (size_t)HALF * K * 2;
    const size_t tstep = 2 * hstep;
    const unsigned ldsw = (unsigned)wid * 1024u;
    const int aoff = lds_byte(wr * 64 + fr, fq * 8), boff = lds_byte(wc * 32 + fr, fq * 8);
#define PG8_SA(b, h) (((b) * 2 + (h)) * HTB)
#define PG8_SB(b, h) ((4 + (b) * 2 + (h)) * HTB)
#define PG8_STAGE(bufoff, gbase, voff) do { _Pragma("unroll") for (int _i = 0; _i < 2; ++_i) \
        __builtin_amdgcn_global_load_lds((const unsigned*)((const char*)(gbase) + (voff)[_i]), (PG8_LAS unsigned*)(lds + (bufoff) + ldsw + _i * 8192), 16, 0, 0); } while (0)
#define PG8_LDA(dst, b, h) do { _Pragma("unroll") for (int m = 0; m < 4; ++m) _Pragma("unroll") for (int k = 0; k < 2; ++k) dst[m][k] = *(const PG8_LAS bf16x8*)(lds + PG8_SA(b, h) + aoff + m * 2048 + k * 1024); } while (0)
#define PG8_LDB(dst, b, h) do { _Pragma("unroll") for (int n = 0; n < 2; ++n) _Pragma("unroll") for (int k = 0; k < 2; ++k) dst[n][k] = *(const PG8_LAS bf16x8*)(lds + PG8_SB(b, h) + boff + n * 2048 + k * 1024); } while (0)
#define PG8_MMA(ai, bj, At, Bt) do { __builtin_amdgcn_s_setprio(1); _Pragma("unroll") for (int m = 0; m < 4; ++m) _Pragma("unroll") for (int n = 0; n < 2; ++n) _Pragma("unroll") for (int k = 0; k < 2; ++k) \
        acc[ai][bj][m][n] = __builtin_amdgcn_mfma_f32_16x16x32_bf16(Bt[n][k], At[m][k], acc[ai][bj][m][n], 0, 0, 0); __builtin_amdgcn_s_setprio(0); } while (0)
#define PG8_WAIT_V(n) asm volatile("s_waitcnt vmcnt(" #n ")" ::: "memory")
#define PG8_WAIT_L(n) asm volatile("s_waitcnt lgkmcnt(" #n ")" ::: "memory")
#define PG8_BAR __builtin_amdgcn_s_barrier()
#define PG8_SCHED __builtin_amdgcn_sched_barrier(0)
    Unit cur, nxt; int ui = 0;
    if (!S.next(0, cur)) return;
    E.prime(cur);
    f32x4 acc[2][2][4][2];
#pragma unroll
    for (int a = 0; a < 2; ++a)
#pragma unroll
        for (int b = 0; b < 2; ++b)
#pragma unroll
            for (int m = 0; m < 4; ++m)
#pragma unroll
                for (int n = 0; n < 2; ++n) acc[a][b][m][n] = (f32x4){0.f, 0.f, 0.f, 0.f};
    bf16x8 At[4][2], B0[2][2], B1[2][2];
    const char* cA = (const char*)g.A + (size_t)cur.pm * tstep; const char* cB = (const char*)g.Bt + (size_t)cur.pn * tstep;
    S.a_ready(cur);
    if constexpr (SP2) {
        PG8_STAGE(PG8_SB(0, 0), cB, voffB); PG8_STAGE(PG8_SB(0, 1), cB + hstep, voffB); PG8_STAGE(PG8_SA(0, 0), cA, voffA); PG8_STAGE(PG8_SA(0, 1), cA + hstep, voffA);
        if (wr == 1) PG8_BAR;
        PG8_WAIT_V(2); PG8_BAR;
        PG8_STAGE(PG8_SB(1, 0), cB + kstep, voffB); PG8_STAGE(PG8_SA(1, 0), cA + kstep, voffA); PG8_STAGE(PG8_SB(1, 1), cB + hstep + kstep, voffB);
        PG8_WAIT_V(6); PG8_BAR;
    } else {
        PG8_STAGE(PG8_SB(0, 0), cB, voffB); PG8_STAGE(PG8_SA(0, 0), cA, voffA); PG8_STAGE(PG8_SB(0, 1), cB + hstep, voffB); PG8_STAGE(PG8_SA(0, 1), cA + hstep, voffA);
        if (wr == 1) PG8_BAR;
        PG8_WAIT_V(4); PG8_BAR;
        PG8_STAGE(PG8_SB(1, 0), cB + kstep, voffB); PG8_STAGE(PG8_SA(1, 0), cA + kstep, voffA); PG8_STAGE(PG8_SB(1, 1), cB + hstep + kstep, voffB);
        PG8_WAIT_V(6); PG8_BAR;
    }
    for (;;) {
        const bool has_next = S.next(ui + 1, nxt);
        const char* nA = has_next ? (const char*)g.A + (size_t)nxt.pm * tstep : cA; const char* nB = has_next ? (const char*)g.Bt + (size_t)nxt.pn * tstep : cB;
#pragma nounroll
        for (int t = 0; t < nt; t += 2) {
            const bool last = (t == nt - 2);
            const char* a1 = cA + (size_t)(t + 1) * kstep;
            const char* a2 = last ? nA : cA + (size_t)(t + 2) * kstep; const char* b2 = last ? nB : cB + (size_t)(t + 2) * kstep;
            const char* a3 = a2 + kstep; const char* b3 = b2 + kstep;
            if (last && has_next) S.a_ready(nxt);
            if constexpr (SP2) {
            PG8_LDB(B0, 0, 0); PG8_LDB(B1, 0, 1); PG8_SCHED; PG8_LDA(At, 0, 0); PG8_STAGE(PG8_SA(1, 1), a1 + hstep, voffA);
            PG8_WAIT_V(8); PG8_WAIT_L(0); PG8_BAR; PG8_MMA(0, 0, At, B0); PG8_MMA(0, 1, At, B1); PG8_BAR; PG8_SCHED;
            PG8_LDA(At, 0, 1); PG8_STAGE(PG8_SB(0, 0), b2, voffB); PG8_STAGE(PG8_SB(0, 1), b2 + hstep, voffB); PG8_STAGE(PG8_SA(0, 0), a2, voffA);
            PG8_WAIT_V(8); PG8_WAIT_L(0); PG8_BAR; PG8_MMA(1, 0, At, B0); PG8_MMA(1, 1, At, B1); PG8_BAR; PG8_SCHED;
            PG8_LDB(B0, 1, 0); PG8_LDB(B1, 1, 1); PG8_SCHED; PG8_LDA(At, 1, 0); PG8_STAGE(PG8_SA(0, 1), a2 + hstep, voffA);
            PG8_WAIT_V(8); PG8_WAIT_L(0); PG8_BAR; PG8_MMA(0, 0, At, B0); PG8_MMA(0, 1, At, B1); PG8_BAR; PG8_SCHED;
            PG8_LDA(At, 1, 1); PG8_STAGE(PG8_SB(1, 0), b3, voffB); PG8_STAGE(PG8_SB(1, 1), b3 + hstep, voffB); PG8_STAGE(PG8_SA(1, 0), a3, voffA);
            PG8_WAIT_V(8); PG8_WAIT_L(0); PG8_BAR; PG8_MMA(1, 0, At, B0); PG8_MMA(1, 1, At, B1); PG8_BAR; PG8_SCHED;
            } else {
            PG8_LDB(B0, 0, 0); PG8_SCHED; PG8_LDA(At, 0, 0); PG8_STAGE(PG8_SA(1, 1), a1 + hstep, voffA);
            PG8_WAIT_L(8); PG8_BAR; PG8_WAIT_L(0); PG8_MMA(0, 0, At, B0); PG8_BAR; PG8_SCHED;
            PG8_LDB(B1, 0, 1); PG8_STAGE(PG8_SB(0, 0), b2, voffB);
            PG8_BAR; PG8_WAIT_L(0); PG8_MMA(0, 1, At, B1); PG8_BAR;
            PG8_LDA(At, 0, 1); PG8_STAGE(PG8_SA(0, 0), a2, voffA);
            PG8_BAR; PG8_WAIT_L(0); PG8_MMA(1, 0, At, B0); PG8_BAR; PG8_SCHED;
            PG8_STAGE(PG8_SB(0, 1), b2 + hstep, voffB);
            PG8_WAIT_V(6); PG8_BAR; PG8_MMA(1, 1, At, B1); PG8_BAR;
            PG8_LDB(B0, 1, 0); PG8_SCHED; PG8_LDA(At, 1, 0); PG8_STAGE(PG8_SA(0, 1), a2 + hstep, voffA);
            PG8_WAIT_L(8); PG8_BAR; PG8_WAIT_L(0); PG8_MMA(0, 0, At, B0); PG8_BAR; PG8_SCHED;
            PG8_LDB(B1, 1, 1); PG8_STAGE(PG8_SB(1, 0), b3, voffB);
            PG8_BAR; PG8_WAIT_L(0); PG8_MMA(0, 1, At, B1); PG8_BAR;
            PG8_LDA(At, 1, 1); PG8_STAGE(PG8_SA(1, 0), a3, voffA);
            PG8_BAR; PG8_WAIT_L(0); PG8_MMA(1, 0, At, B0); PG8_BAR; PG8_SCHED;
            PG8_STAGE(PG8_SB(1, 1), b3 + hstep, voffB);
            PG8_WAIT_V(6); PG8_BAR; PG8_MMA(1, 1, At, B1); PG8_BAR;
            }
        }
        if constexpr (ALIGN_EPI) { if (wr == 0) PG8_BAR; }
        if constexpr (!Epi::AFTER_DRAIN) { E(acc, cur, wr, wc, fr, fq, nxt, has_next, ui); S.done(cur); }
        if (!has_next) break;
#pragma unroll
        for (int a = 0; a < 2; ++a)
#pragma unroll
            for (int b = 0; b < 2; ++b)
#pragma unroll
                for (int m = 0; m < 4; ++m)
#pragma unroll
                    for (int n = 0; n < 2; ++n) acc[a][b][m][n] = (f32x4){0.f, 0.f, 0.f, 0.f};
        cur = nxt; cA = nA; cB = nB; ++ui;
        if constexpr (ALIGN_EPI) { if (wr == 1) PG8_BAR; }
    }
    PG8_WAIT_V(0);
    if constexpr (!ALIGN_EPI) { if (wr == 0) PG8_BAR; }
    PG8_BAR;
    if constexpr (Epi::AFTER_DRAIN) { E.fused(acc, cur, wr, wc, fr, fq, lds, wid, lane); S.done(cur); }
#undef PG8_SA
#undef PG8_SB
#undef PG8_STAGE
#undef PG8_LDA
#undef PG8_LDB
#undef PG8_MMA
#undef PG8_WAIT_V
#undef PG8_WAIT_L
#undef PG8_BAR
#undef PG8_SCHED
}
}
#ifndef REPEAT_MASK
#define REPEAT_MASK 0u
#endif
#ifndef EXTRA_SYNCS
#define EXTRA_SYNCS 0
#endif
#ifndef REP_SSM
#define REP_SSM 1
#endif
#ifndef REP_CONV
#define REP_CONV 1
#endif
#ifndef REP_ATTN
#define REP_ATTN 1
#endif

#define LAS __attribute__((address_space(3)))
typedef unsigned short bf16_t;
typedef short bf16x8 __attribute__((ext_vector_type(8)));
typedef short s16x4 __attribute__((ext_vector_type(4)));
typedef float f32x4 __attribute__((ext_vector_type(4)));
typedef float f32x16 __attribute__((ext_vector_type(16)));
typedef unsigned u32x4 __attribute__((ext_vector_type(4)));
typedef unsigned u32x2 __attribute__((ext_vector_type(2)));
typedef float f32x2v __attribute__((ext_vector_type(2)));
typedef __bf16 bf16x2v __attribute__((ext_vector_type(2)));

constexpr int NT = 65536, SEQ = 4096, DMODEL = 1024, NIN = 2304, DFF = 2816;
constexpr float EPS = 1e-6f;
constexpr float C2 = 0.125f * 1.4426950408889634f;
constexpr size_t MiB = (size_t)1 << 20;
constexpr size_t W_IN = 0, W_OUT = W_IN + (size_t)NIN * 1024 * 2, W_GU = W_OUT + (size_t)1024 * 1024 * 2, W_DN = W_GU + (size_t)2 * DFF * 1024 * 2,
                 W_GLU = W_DN + (size_t)1024 * DFF * 2, W_LAYER = 24 * MiB;
static_assert(W_GLU + 512 * 256 * 2 <= W_LAYER, "weight block");
constexpr size_t WS_W = 0, WS_ROPE = 48 * MiB, WS_H = 64 * MiB, WS_P = 192 * MiB, WS_YC = 544 * MiB, WS_ZB = 640 * MiB, WS_OB = 672 * MiB, WS_ST = 768 * MiB, WS_BAR = 776 * MiB, WS_XB = 778 * MiB, WS_SS = 906 * MiB, WS_END = 912 * MiB;
constexpr int LDS_BYTES = 147456;
constexpr int NTHREADS = 512;

#define CAS __attribute__((address_space(4)))
struct Args {
    const float* in[24];
    float* out;
    unsigned char* ws;
    int ph_lo, ph_hi;
};

__device__ __forceinline__ unsigned pk2(float lo, float hi) { f32x2v v = {lo, hi}; bf16x2v b = __builtin_convertvector(v, bf16x2v); return __builtin_bit_cast(unsigned, b); }
__device__ __forceinline__ float bflo(unsigned u) { return __uint_as_float(u << 16); }
__device__ __forceinline__ float bfhi(unsigned u) { return __uint_as_float(u & 0xffff0000u); }
template <int CTRL, int ROWMASK> __device__ __forceinline__ float dpp_add(float v) {
    return v + __builtin_bit_cast(float, __builtin_amdgcn_update_dpp(0, __builtin_bit_cast(int, v), CTRL, ROWMASK, 0xF, false));
}
__device__ __forceinline__ float wave_sum(float v) {
    v = dpp_add<0xB1, 0xF>(v);
    v = dpp_add<0x4E, 0xF>(v);
    v = dpp_add<0x141, 0xF>(v);
    v = dpp_add<0x140, 0xF>(v);
    v = dpp_add<0x142, 0xA>(v);
    v = dpp_add<0x143, 0xC>(v);
    return __builtin_bit_cast(float, __builtin_amdgcn_readlane(__builtin_bit_cast(int, v), 63));
}
__device__ __forceinline__ float sigmoidf_(float x) { return __builtin_amdgcn_rcpf(1.f + __expf(-x)); }
__device__ __forceinline__ float gelu_tanh(float y) {
    const float a = 0.7978845608028654f * (y + 0.044715f * y * y * y);
    const float t = 1.f - 2.f * __builtin_amdgcn_rcpf(__expf(2.f * a) + 1.f);
    return 0.5f * y * (1.f + t);
}
#define WAVE_LDS_SYNC() asm volatile("s_waitcnt lgkmcnt(0)" ::: "memory")

struct RowScale {
    const float* ssp; LAS float* xs;
    __device__ __forceinline__ float rs_of(int row) const { const f32x4 sp = *(const f32x4*)(ssp + (size_t)row * 4); return rsqrtf(((sp.x + sp.y) + (sp.z + sp.w)) * (1.f / DMODEL) + EPS); }
    __device__ __forceinline__ void prime(const pg8::Unit& u) const { const int t = threadIdx.x; if (t < 256) xs[t] = rs_of(u.pm * 256 + t); }
};
struct EpiIn {
    static constexpr bool PERM = true, AFTER_DRAIN = false;
    bf16_t* O; const float* ropec; const float* ropes; RowScale R;
    __device__ __forceinline__ void prime(const pg8::Unit& u) const { R.prime(u); }
    __device__ __forceinline__ void operator()(const f32x4 (&acc)[2][2][4][2], const pg8::Unit& u, int wr, int wc, int fr, int fq, const pg8::Unit& nxt, bool has_next, int ui) const {
        const int row0 = u.pm * 256 + wr * 64 + fr, t = threadIdx.x;
        f32x4 spn = {0.f, 0.f, 0.f, 0.f};
        const bool stage = has_next && t < 256 && nxt.pm != u.pm;
        if (stage) spn = *(const f32x4*)(R.ssp + (size_t)(nxt.pm * 256 + t) * 4);
        const LAS float* xsc = R.xs + (ui & 1) * 256 + wr * 64 + fr;
        if (u.pn == 6 || u.pn == 7) {
            const float sc = (u.pn == 6) ? C2 : 1.f;
            const int dimb = 16 * (wc & 1) + 4 * fq;
#pragma unroll
            for (int ai = 0; ai < 2; ++ai)
#pragma unroll
                for (int m = 0; m < 4; ++m) {
                    const int row = row0 + ai * 128 + m * 16; const int pos = row & (SEQ - 1);
                    const float rsc = xsc[ai * 128 + m * 16] * sc;
                    const f32x4 cs = *(const f32x4*)(ropec + pos * 32 + dimb), sn = *(const f32x4*)(ropes + pos * 32 + dimb);
                    bf16_t* rowp = O + (size_t)row * NIN + u.pn * 256 + 64 * (wc >> 1) + dimb;
#pragma unroll
                    for (int bj = 0; bj < 2; ++bj) {
                        const f32x4 x1 = acc[ai][bj][m][0] * rsc, x2 = acc[ai][bj][m][1] * rsc;
                        const f32x4 o1 = x1 * cs - x2 * sn, o2 = x2 * cs + x1 * sn;
                        u32x2 w1, w2; w1.x = pk2(o1[0], o1[1]); w1.y = pk2(o1[2], o1[3]); w2.x = pk2(o2[0], o2[1]); w2.y = pk2(o2[2], o2[3]);
                        *(u32x2*)(rowp + bj * 128) = w1; *(u32x2*)(rowp + bj * 128 + 32) = w2;
                    }
                }
        } else {
#pragma unroll
            for (int ai = 0; ai < 2; ++ai)
#pragma unroll
                for (int m = 0; m < 4; ++m) {
                    bf16_t* rowp = O + (size_t)(row0 + ai * 128 + m * 16) * NIN + u.pn * 256 + wc * 32 + 8 * fq;
                    const float rsc = xsc[ai * 128 + m * 16];
#pragma unroll
                    for (int bj = 0; bj < 2; ++bj) {
                        const f32x4 v0 = acc[ai][bj][m][0] * rsc, v1 = acc[ai][bj][m][1] * rsc;
                        u32x4 w; w.x = pk2(v0[0], v0[1]); w.y = pk2(v0[2], v0[3]); w.z = pk2(v1[0], v1[1]); w.w = pk2(v1[2], v1[3]);
                        *(u32x4*)(rowp + bj * 128) = w;
                    }
                }
        }
        if (has_next && t < 256) {
            float v = R.xs[(ui & 1) * 256 + t];
            if (nxt.pm != u.pm) v = rsqrtf(((spn.x + spn.y) + (spn.z + spn.w)) * (1.f / DMODEL) + EPS);
            R.xs[((ui + 1) & 1) * 256 + t] = v;
        }
    }
};
struct EpiRes {
    static constexpr bool PERM = true, AFTER_DRAIN = false;
    bf16_t* xb; float* ssp; LAS float* xl;
    __device__ __forceinline__ void prime(const pg8::Unit&) const {}
    __device__ __forceinline__ void operator()(const f32x4 (&acc)[2][2][4][2], const pg8::Unit& u, int wr, int wc, int fr, int fq, const pg8::Unit&, bool, int) const {
        const int row0 = u.pm * 256 + wr * 64 + fr, col0 = u.pn * 256 + wc * 32 + 8 * fq;
        u32x4 rv[2][4][2];
#pragma unroll
        for (int ai = 0; ai < 2; ++ai)
#pragma unroll
            for (int m = 0; m < 4; ++m)
#pragma unroll
                for (int bj = 0; bj < 2; ++bj) rv[ai][m][bj] = *(const u32x4*)(xb + (size_t)(row0 + ai * 128 + m * 16) * DMODEL + col0 + bj * 128);
#pragma unroll
        for (int ai = 0; ai < 2; ++ai)
#pragma unroll
            for (int m = 0; m < 4; ++m) {
                const int row = row0 + ai * 128 + m * 16;
                const size_t off = (size_t)row * DMODEL + col0;
                float sq = 0.f;
#pragma unroll
                for (int bj = 0; bj < 2; ++bj) {
                    const u32x4 r = rv[ai][m][bj];
                    const f32x4 r0 = {bflo(r.x), bfhi(r.x), bflo(r.y), bfhi(r.y)}, r1 = {bflo(r.z), bfhi(r.z), bflo(r.w), bfhi(r.w)};
                    const f32x4 x0 = r0 + acc[ai][bj][m][0], x1 = r1 + acc[ai][bj][m][1];
                    u32x4 w; w.x = pk2(x0[0], x0[1]); w.y = pk2(x0[2], x0[3]); w.z = pk2(x1[0], x1[1]); w.w = pk2(x1[2], x1[3]);
                    *(u32x4*)(xb + off + bj * 128) = w;
                    sq += (x0[0] * x0[0] + x0[1] * x0[1]) + (x0[2] * x0[2] + x0[3] * x0[3]) + (x1[0] * x1[0] + x1[1] * x1[1]) + (x1[2] * x1[2] + x1[3] * x1[3]);
                }
                sq += __shfl_xor(sq, 16); sq += __shfl_xor(sq, 32);
                if (fq == 0) xl[(wr * 64 + ai * 128 + m * 16 + fr) * 4 + wc] = sq;
            }
        asm volatile("s_waitcnt lgkmcnt(0)\n\ts_barrier" ::: "memory");
        const int t = threadIdx.x;
        if (t < 256) { const f32x4 v = *(const LAS f32x4*)(xl + t * 4); ssp[(size_t)(u.pm * 256 + t) * 4 + u.pn] = (v.x + v.y) + (v.z + v.w); }
    }
};
template <int MODE  > struct EpiGate {
    static constexpr bool PERM = true, AFTER_DRAIN = false;
    bf16_t* O; int ldc; int coff; RowScale R;
    __device__ __forceinline__ void prime(const pg8::Unit& u) const { if (MODE == 0) R.prime(u); }
    __device__ __forceinline__ void operator()(const f32x4 (&acc)[2][2][4][2], const pg8::Unit& u, int wr, int wc, int fr, int fq, const pg8::Unit& nxt, bool has_next, int ui) const {
        const int row0 = u.pm * 256 + wr * 64 + fr, col0 = coff + u.pn * 128 + wc * 32 + 8 * fq, t = threadIdx.x;
        f32x4 spn = {0.f, 0.f, 0.f, 0.f};
        if (MODE == 0) { if (has_next && t < 256 && nxt.pm != u.pm) spn = *(const f32x4*)(R.ssp + (size_t)(nxt.pm * 256 + t) * 4); }
        const LAS float* xsc = R.xs + (ui & 1) * 256 + wr * 64 + fr;
#pragma unroll
        for (int ai = 0; ai < 2; ++ai)
#pragma unroll
            for (int m = 0; m < 4; ++m) {
                float r[8];
                float rsc = 1.f; if (MODE == 0) rsc = xsc[ai * 128 + m * 16];
                const float c1 = -1.4426950408889634f * rsc, r2 = rsc * rsc;
#pragma unroll
                for (int n = 0; n < 2; ++n)
#pragma unroll
                    for (int j = 0; j < 4; ++j) {
                        const float a = acc[ai][0][m][n][j], b = acc[ai][1][m][n][j];
                        if (MODE == 0) r[4 * n + j] = (a * b) * (r2 * __builtin_amdgcn_rcpf(1.f + __builtin_amdgcn_exp2f(a * c1)));
                        else r[4 * n + j] = a * __builtin_amdgcn_rcpf(1.f + __builtin_amdgcn_exp2f(b * -1.4426950408889634f));
                    }
                u32x4 w; w.x = pk2(r[0], r[1]); w.y = pk2(r[2], r[3]); w.z = pk2(r[4], r[5]); w.w = pk2(r[6], r[7]);
                *(u32x4*)(O + (size_t)(row0 + ai * 128 + m * 16) * ldc + col0) = w;
            }
        if (MODE == 0) {
            if (has_next && t < 256) {
                float v = R.xs[(ui & 1) * 256 + t];
                if (nxt.pm != u.pm) v = rsqrtf(((spn.x + spn.y) + (spn.z + spn.w)) * (1.f / DMODEL) + EPS);
                R.xs[((ui + 1) & 1) * 256 + t] = v;
            }
        }
    }
};

struct WMat { const float* src; const float* src2; int K, N, ldw, kind; bf16_t* dst; const float* kscale; };
__device__ __forceinline__ void wconv_load(const WMat& w, int t, int tid, float (&v)[8]) {
    const int nkt = w.K / 64, jt = t / nkt, kt = t % nkt, j0 = jt * 64, k0 = kt * 64;
    const int j = j0 + (tid & 63);
    const float* s = w.src; int col = j;
    if (w.kind == 1) {
        if (j >= 1536 && j < 2048) { const int ww = j & 63; col = (j & ~63) + 32 * ((ww >> 2) & 1) + 16 * (ww >> 5) + 4 * ((ww >> 3) & 3) + (ww & 3); }
    } else if (w.kind == 2) {
        const int pn = j >> 8, wi = j & 255; if (wi < 128) col = pn * 128 + wi; else { s = w.src2; col = pn * 128 + (wi - 128); }
    }
    const int kk = tid >> 6;
#pragma unroll
    for (int i = 0; i < 8; ++i) { const int k = kk + 8 * i; const float sc = w.kscale ? w.kscale[k0 + k] : 1.f; v[i] = s[(size_t)(k0 + k) * w.ldw + col] * sc; }
}
__device__ __forceinline__ void wconv_store(LAS float* tile, const WMat& w, int t, int tid, const float (&v)[8]) {
    const int nkt = w.K / 64, jt = t / nkt, kt = t % nkt, j0 = jt * 64, k0 = kt * 64;
    const int kk = tid >> 6;
#pragma unroll
    for (int i = 0; i < 8; ++i) tile[(kk + 8 * i) * 65 + (tid & 63)] = v[i];
    __syncthreads();
    {
        const int jr = tid >> 3, c = tid & 7; const LAS float* s = tile + (8 * c) * 65 + jr;
        u32x4 o; o.x = pk2(s[0], s[65]); o.y = pk2(s[2 * 65], s[3 * 65]); o.z = pk2(s[4 * 65], s[5 * 65]); o.w = pk2(s[6 * 65], s[7 * 65]);
        *(u32x4*)(w.dst + (size_t)(j0 + jr) * w.K + k0 + 8 * c) = o;
    }
    __syncthreads();
}
__device__ __forceinline__ WMat wmat_of(const CAS Args* ap, unsigned char* ws, int it, int& t) {
    const int layer = it / 2976; t = it % 2976;
    unsigned char* wb = ws + WS_W + (size_t)layer * W_LAYER;
    if (t < 576) return WMat{ap->in[2] + (size_t)layer * 1024 * NIN, nullptr, 1024, NIN, NIN, 1, (bf16_t*)(wb + W_IN), ap->in[1] + layer * 1024};
    if ((t -= 576) < 256) return WMat{ap->in[18] + (size_t)layer * 1024 * 1024, nullptr, 1024, 1024, 1024, 0, (bf16_t*)(wb + W_OUT), nullptr};
    if ((t -= 256) < 1408) return WMat{ap->in[20] + (size_t)layer * 1024 * DFF, ap->in[21] + (size_t)layer * 1024 * DFF, 1024, 2 * DFF, DFF, 2, (bf16_t*)(wb + W_GU), ap->in[19] + layer * 1024};
    if ((t -= 1408) < 704) return WMat{ap->in[22] + (size_t)layer * DFF * 1024, nullptr, DFF, 1024, 1024, 0, (bf16_t*)(wb + W_DN), nullptr};
    t -= 704; return WMat{ap->in[16] + (size_t)layer * 256 * 512, ap->in[16] + (size_t)layer * 256 * 512 + 256, 256, 512, 512, 2, (bf16_t*)(wb + W_GLU), nullptr};
}

__device__ __forceinline__ void norm_rows_bf16(const float* X, const float* g, bf16_t* H, int gw, int ngw, int lane) {
    f32x4 gv[4];
#pragma unroll
    for (int j = 0; j < 4; ++j) gv[j] = ((const f32x4*)g)[lane + 64 * j];
    for (int m = gw; m < NT; m += ngw) {
        const f32x4* xr = (const f32x4*)(X + (size_t)m * DMODEL) + lane;
        f32x4 v[4]; float s = 0.f;
#pragma unroll
        for (int j = 0; j < 4; ++j) { v[j] = xr[64 * j]; s += (v[j].x * v[j].x + v[j].y * v[j].y) + (v[j].z * v[j].z + v[j].w * v[j].w); }
        const float rs = rsqrtf(wave_sum(s) * (1.f / DMODEL) + EPS);
        u32x2* o = (u32x2*)(H + (size_t)m * DMODEL) + lane;
#pragma unroll
        for (int j = 0; j < 4; ++j) { u32x2 w; w.x = pk2(v[j].x * rs * gv[j].x, v[j].y * rs * gv[j].y); w.y = pk2(v[j].z * rs * gv[j].z, v[j].w * rs * gv[j].w); o[64 * j] = w; }
    }
}
__device__ __forceinline__ void xb2_issue(const float* X, int m0, int lane, f32x4 (&v)[2][4]) {
#pragma unroll
    for (int r = 0; r < 2; ++r) { const f32x4* xr = (const f32x4*)(X + (size_t)(m0 + r) * DMODEL) + lane;
#pragma unroll
        for (int j = 0; j < 4; ++j) v[r][j] = xr[64 * j]; }
}
__device__ __forceinline__ void xb2_finish(bf16_t* XB, float* ssq, int m0, int lane, const f32x4 (&v)[2][4]) {
#pragma unroll
    for (int r = 0; r < 2; ++r) {
        const size_t m = (size_t)m0 + r;
        float s = 0.f;
#pragma unroll
        for (int j = 0; j < 4; ++j) s += (v[r][j].x * v[r][j].x + v[r][j].y * v[r][j].y) + (v[r][j].z * v[r][j].z + v[r][j].w * v[r][j].w);
        s = wave_sum(s);
        u32x2* o = (u32x2*)(XB + m * DMODEL) + lane;
#pragma unroll
        for (int j = 0; j < 4; ++j) { u32x2 w; w.x = pk2(v[r][j].x, v[r][j].y); w.y = pk2(v[r][j].z, v[r][j].w); o[64 * j] = w; }
        if (lane == 0) { f32x4 o4 = {s, 0.f, 0.f, 0.f}; *(f32x4*)(ssq + m * 4) = o4; }
    }
}
__device__ __forceinline__ void xb_rows(const float* X, bf16_t* XB, float* ssq, int gw, int ngw, int lane) {
    for (int m0 = gw * 2; m0 < NT; m0 += ngw * 2) {
        f32x4 v[2][4];
#pragma unroll
        for (int r = 0; r < 2; ++r) { const f32x4* xr = (const f32x4*)(X + (size_t)(m0 + r) * DMODEL) + lane;
#pragma unroll
            for (int j = 0; j < 4; ++j) v[r][j] = xr[64 * j]; }
#pragma unroll
        for (int r = 0; r < 2; ++r) {
            const size_t m = (size_t)m0 + r;
            float s = 0.f;
#pragma unroll
            for (int j = 0; j < 4; ++j) s += (v[r][j].x * v[r][j].x + v[r][j].y * v[r][j].y) + (v[r][j].z * v[r][j].z + v[r][j].w * v[r][j].w);
            s = wave_sum(s);
            u32x2* o = (u32x2*)(XB + m * DMODEL) + lane;
#pragma unroll
            for (int j = 0; j < 4; ++j) { u32x2 w; w.x = pk2(v[r][j].x, v[r][j].y); w.y = pk2(v[r][j].z, v[r][j].w); o[64 * j] = w; }
            if (lane == 0) { f32x4 o4 = {s, 0.f, 0.f, 0.f}; *(f32x4*)(ssq + m * 4) = o4; }
        }
    }
}
__device__ __forceinline__ void final_rows(const bf16_t* XB, const float* ssp, const float* g, float* OUT, int gw, int ngw, int lane, float tscale) {
    f32x4 gv[4];
#pragma unroll
    for (int j = 0; j < 4; ++j) gv[j] = ((const f32x4*)g)[lane + 64 * j];
    for (int m0 = gw * 4; m0 < NT; m0 += ngw * 4) {
        u32x2 w[4][4]; f32x4 sp[4];
#pragma unroll
        for (int r = 0; r < 4; ++r) { const size_t m = (size_t)m0 + r; sp[r] = *(const f32x4*)(ssp + m * 4); const u32x2* xr = (const u32x2*)(XB + m * DMODEL) + lane;
#pragma unroll
            for (int j = 0; j < 4; ++j) w[r][j] = xr[64 * j]; }
#pragma unroll
        for (int r = 0; r < 4; ++r) {
            const float rs = rsqrtf(((sp[r].x + sp[r].y) + (sp[r].z + sp[r].w)) * (1.f / DMODEL) + EPS) * tscale;
            f32x4* o = (f32x4*)(OUT + (size_t)(m0 + r) * DMODEL) + lane;
#pragma unroll
            for (int j = 0; j < 4; ++j) { f32x4 v = {bflo(w[r][j].x), bfhi(w[r][j].x), bflo(w[r][j].y), bfhi(w[r][j].y)}; o[64 * j] = v * rs * gv[j]; }
        }
    }
}
__device__ __forceinline__ void norm_rows_f32_inplace(float* X, const float* g, int gw, int ngw, int lane) {
    f32x4 gv[4];
#pragma unroll
    for (int j = 0; j < 4; ++j) gv[j] = ((const f32x4*)g)[lane + 64 * j];
    for (int m = gw; m < NT; m += ngw) {
        f32x4* xr = (f32x4*)(X + (size_t)m * DMODEL) + lane;
        f32x4 v[4]; float s = 0.f;
#pragma unroll
        for (int j = 0; j < 4; ++j) { v[j] = xr[64 * j]; s += (v[j].x * v[j].x + v[j].y * v[j].y) + (v[j].z * v[j].z + v[j].w * v[j].w); }
        const float rs = rsqrtf(wave_sum(s) * (1.f / DMODEL) + EPS);
#pragma unroll
        for (int j = 0; j < 4; ++j) xr[64 * j] = v[j] * rs * gv[j];
    }
}

struct C3Regs { u32x4 hh[6], cc[6], bb[4]; };
__device__ __forceinline__ void conv3_issue(const bf16_t* P, int w, C3Regs& R) {
    const int c8 = w & 31, tok = (w >> 5) * 4, t = tok & (SEQ - 1);
    const bf16_t* base = P + (size_t)tok * NIN + c8 * 8;
#pragma unroll
    for (int i = 0; i < 6; ++i) { const int dt = (t == 0 && i < 2) ? 0 : i - 2; R.hh[i] = *(const u32x4*)(base + dt * NIN); R.cc[i] = *(const u32x4*)(base + dt * NIN + 512); }
#pragma unroll
    for (int i = 0; i < 4; ++i) R.bb[i] = *(const u32x4*)(base + i * NIN + 256);
}
__device__ __forceinline__ void mul8(const u32x4 a, const u32x4 b, float (&o)[8]) {
    o[0] = bflo(a.x) * bflo(b.x); o[1] = bfhi(a.x) * bfhi(b.x); o[2] = bflo(a.y) * bflo(b.y); o[3] = bfhi(a.y) * bfhi(b.y);
    o[4] = bflo(a.z) * bflo(b.z); o[5] = bfhi(a.z) * bfhi(b.z); o[6] = bflo(a.w) * bflo(b.w); o[7] = bfhi(a.w) * bfhi(b.w);
}
__device__ __forceinline__ void conv3_compute(bf16_t* H, int w, const C3Regs& R, const float (&w0)[8], const float (&w1)[8], const float (&w2)[8], const float (&gm)[8]) {
    const int c8 = w & 31, tok = (w >> 5) * 4, t = tok & (SEQ - 1);
    const float z01 = (t == 0) ? 0.f : 1.f;
    float g[6][8];
#pragma unroll
    for (int i = 0; i < 6; ++i) mul8(R.hh[i], R.cc[i], g[i]);
#pragma unroll
    for (int j = 0; j < 8; ++j) { g[0][j] *= z01; g[1][j] *= z01; }
#pragma unroll
    for (int i = 0; i < 4; ++i) {
        const u32x4 bv = R.bb[i];
        const float bb[8] = {bflo(bv.x), bfhi(bv.x), bflo(bv.y), bfhi(bv.y), bflo(bv.z), bfhi(bv.z), bflo(bv.w), bfhi(bv.w)};
        float y[8]; float sq = 0.f;
#pragma unroll
        for (int j = 0; j < 8; ++j) { y[j] = bb[j] * (w0[j] * g[i][j] + w1[j] * g[i + 1][j] + w2[j] * g[i + 2][j]); sq += y[j] * y[j]; }
#pragma unroll
        for (int o = 1; o < 32; o <<= 1) sq += __shfl_xor(sq, o);
        const float rs = rsqrtf(sq * (1.f / 256.f) + EPS);
        u32x4 o4; o4.x = pk2(y[0] * rs * gm[0], y[1] * rs * gm[1]); o4.y = pk2(y[2] * rs * gm[2], y[3] * rs * gm[3]); o4.z = pk2(y[4] * rs * gm[4], y[5] * rs * gm[5]); o4.w = pk2(y[6] * rs * gm[6], y[7] * rs * gm[7]);
        *(u32x4*)(H + (size_t)(tok + i) * DMODEL + c8 * 8) = o4;
    }
}
__device__ __forceinline__ void conv3_phase(const bf16_t* P, bf16_t* H, const float* w3, const float* gn, int bx, int G, int tid) {
    constexpr int NW = NT / 4 * 32;
    const int c8 = tid & 31;
    float w0[8], w1[8], w2[8], gm[8];
#pragma unroll
    for (int j = 0; j < 8; ++j) { w0[j] = w3[c8 * 8 + j]; w1[j] = w3[256 + c8 * 8 + j]; w2[j] = w3[512 + c8 * 8 + j]; gm[j] = gn[c8 * 8 + j]; }
    C3Regs Ra, Rb;
    int w = bx * NTHREADS + tid; const int step = G * NTHREADS;
    if (w < NW) conv3_issue(P, w, Ra);
    for (; w < NW; w += 2 * step) {
        if (w + step < NW) conv3_issue(P, w + step, Rb);
        conv3_compute(H, w, Ra, w0, w1, w2, gm);
        if (w + step < NW) { if (w + 2 * step < NW) conv3_issue(P, w + 2 * step, Ra); conv3_compute(H, w + step, Rb, w0, w1, w2, gm); }
    }
}

constexpr int CF_ZOFF = 0, CF_STOFF = 94 * 1024;
__device__ __forceinline__ void cfm_issue(const bf16_t* P, int tix, int tid, u32x4 (&ar)[6], u32x4 (&gr)[6]) {
    const int b = tix >> 6, t0 = (tix & 63) * 64;
#pragma unroll
    for (int k = 0; k < 6; ++k) {
        int e = tid + NTHREADS * k; e = e < 94 * 32 ? e : 94 * 32 - 1;
        const int row = e >> 5, c8 = e & 31; int t = t0 - 30 + row; t = t < 0 ? 0 : t;
        const bf16_t* src = P + ((size_t)b * SEQ + t) * NIN + 768 + c8 * 8;
        ar[k] = *(const u32x4*)src; gr[k] = *(const u32x4*)(src + 256);
    }
}
__device__ __forceinline__ void cfm_stage(LAS unsigned char* lds, int tix, int tid, const u32x4 (&ar)[6], const u32x4 (&gr)[6]) {
    const int t0 = (tix & 63) * 64;
    LAS float* ZT = (LAS float*)(lds + CF_ZOFF);
#pragma unroll
    for (int k = 0; k < 6; ++k) {
        const int e = tid + NTHREADS * k;
        if (e < 94 * 32) {
            const int row = e >> 5, c8 = e & 31; const float zm = (t0 - 30 + row < 0) ? 0.f : 1.f;
            const u32x4 a = ar[k], g = gr[k];
            f32x4 z0, z1;
            z0[0] = bflo(a.x) * sigmoidf_(bflo(g.x)) * zm; z0[1] = bfhi(a.x) * sigmoidf_(bfhi(g.x)) * zm; z0[2] = bflo(a.y) * sigmoidf_(bflo(g.y)) * zm; z0[3] = bfhi(a.y) * sigmoidf_(bfhi(g.y)) * zm;
            z1[0] = bflo(a.z) * sigmoidf_(bflo(g.z)) * zm; z1[1] = bfhi(a.z) * sigmoidf_(bfhi(g.z)) * zm; z1[2] = bflo(a.w) * sigmoidf_(bflo(g.w)) * zm; z1[3] = bfhi(a.w) * sigmoidf_(bfhi(g.w)) * zm;
            *(LAS f32x4*)(ZT + row * 256 + c8 * 8) = z0; *(LAS f32x4*)(ZT + row * 256 + c8 * 8 + 4) = z1;
        }
    }
}
__device__ __forceinline__ void cfm_phase(LAS unsigned char* lds, const bf16_t* P, bf16_t* H, const float* dww, const float* dwb, const float* lng, const float* lnb, const float* gn,
                                          int bx, int G, int tid, int wid, int lane) {
    const int cp = tid & 127, rr = tid >> 7;
    f32x2v w[31];
#pragma unroll
    for (int k = 0; k < 31; ++k) w[k] = *(const f32x2v*)(dww + k * 256 + 2 * cp);
    const f32x2v bias = *(const f32x2v*)(dwb + 2 * cp), lg = *(const f32x2v*)(lng + 2 * cp), lb = *(const f32x2v*)(lnb + 2 * cp), gmm = *(const f32x2v*)(gn + 256 + 2 * cp);
    LAS float* ZT = (LAS float*)(lds + CF_ZOFF);
    LAS float* STX = (LAS float*)(lds + CF_STOFF);
    u32x4 ar[6], gr[6];
    int tix = bx;
    if (tix < 1024) cfm_issue(P, tix, tid, ar, gr);
    for (; tix < 1024; tix += G) {
        __syncthreads();
        cfm_stage(lds, tix, tid, ar, gr);
        if (tix + G < 1024) cfm_issue(P, tix + G, tid, ar, gr);
        __syncthreads();
        f32x2v acc[16];
#pragma unroll
        for (int j = 0; j < 16; ++j) acc[j] = bias;
#pragma unroll
        for (int s = 0; s < 46; ++s) {
            const f32x2v z = *(const LAS f32x2v*)(ZT + (rr * 16 + s) * 256 + 2 * cp);
#pragma unroll
            for (int j = 0; j < 16; ++j) { const int k = s - j; if (k >= 0 && k <= 30) acc[j] += w[k] * z; }
        }
        float s1[16], s2[16];
#pragma unroll
        for (int j = 0; j < 16; ++j) { s1[j] = wave_sum(acc[j].x + acc[j].y); s2[j] = wave_sum(acc[j].x * acc[j].x + acc[j].y * acc[j].y); }
        if (lane == 0) {
#pragma unroll
            for (int j = 0; j < 16; ++j) { STX[wid * 32 + j] = s1[j]; STX[wid * 32 + 16 + j] = s2[j]; }
        }
        __syncthreads();
        const int b = tix >> 6, t0 = (tix & 63) * 64;
        float s3[16];
#pragma unroll
        for (int j = 0; j < 16; ++j) {
            const float S1 = s1[j] + STX[(wid ^ 1) * 32 + j], S2 = s2[j] + STX[(wid ^ 1) * 32 + 16 + j];
            const float mean = S1 * (1.f / 256.f), var = fmaxf(S2 * (1.f / 256.f) - mean * mean, 0.f), rs = rsqrtf(var + EPS);
            f32x2v y = (acc[j] - mean) * rs * lg + lb;
            y.x = y.x * sigmoidf_(y.x); y.y = y.y * sigmoidf_(y.y);
            acc[j] = y;
            s3[j] = wave_sum(y.x * y.x + y.y * y.y);
        }
        if (lane == 0) {
#pragma unroll
            for (int j = 0; j < 16; ++j) STX[256 + wid * 16 + j] = s3[j];
        }
        __syncthreads();
#pragma unroll
        for (int j = 0; j < 16; ++j) {
            const float rs = rsqrtf((s3[j] + STX[256 + (wid ^ 1) * 16 + j]) * (1.f / 256.f) + EPS);
            *(unsigned*)(H + ((size_t)b * SEQ + t0 + rr * 16 + j) * DMODEL + 256 + 2 * cp) = pk2(acc[j].x * rs * gmm.x, acc[j].y * rs * gmm.y);
        }
    }
}

template <bool FULL> __device__ __forceinline__ void ssm_tile_scan(f32x16& xr, f32x16& xi, const float (&pw)[4][2], float& cr, float& ci, const bool hi) {
    const float l1r = pw[0][0], l1i = pw[0][1], l4r = pw[3][0], l4i = pw[3][1];
#pragma unroll
    for (int G = 0; G < 4; ++G)
#pragma unroll
        for (int j = 1; j < 4; ++j) { const int i = 4 * G + j; const float pr = xr[i - 1], pi = xi[i - 1]; xr[i] += l1r * pr - l1i * pi; xi[i] += l1r * pi + l1i * pr; }
    float cinr[4], cini[4];
#pragma unroll
    for (int G = 0; G < 4; ++G) {
        const float er = xr[4 * G + 3], ei = xi[4 * G + 3];
        const float orr = __shfl_xor(er, 32), oi = __shfl_xor(ei, 32);
        const float e0r = hi ? orr : er, e0i = hi ? oi : ei, e1r = hi ? er : orr, e1i = hi ? ei : oi;
        const float c1r = l4r * cr - l4i * ci + e0r, c1i = l4r * ci + l4i * cr + e0i;
        cinr[G] = hi ? c1r : cr; cini[G] = hi ? c1i : ci;
        const float c2r = l4r * c1r - l4i * c1i + e1r, c2i = l4r * c1i + l4i * c1r + e1i;
        cr = c2r; ci = c2i;
    }
    if (FULL) {
#pragma unroll
        for (int G = 0; G < 4; ++G)
#pragma unroll
            for (int j = 0; j < 4; ++j) { const int i = 4 * G + j; xr[i] += pw[j][0] * cinr[G] - pw[j][1] * cini[G]; xi[i] += pw[j][0] * cini[G] + pw[j][1] * cinr[G]; }
    }
}
constexpr int SSM_ROWB = 272;
__device__ __forceinline__ void ssm_item(LAS unsigned char* lds, const bf16_t* P, bf16_t* ZB, const float* a_re, const float* a_im, const float* log_dt, const float* b_re, const float* b_im,
                                         const float* c_re, const float* c_im, const float* d_skip, int item, int tid, int wid, int lane) {
    const int b = item >> 4, g = item & 15;
    const int r32 = lane & 31, h = lane >> 5; const bool hi = h != 0;
    LAS f32x2v* EW = (LAS f32x2v*)lds;
    LAS unsigned char* SBW = lds + 4096 + wid * (32 * SSM_ROWB);
    __syncthreads();
    float pw[2][4][2]; bf16x8 bfr[2][2];
#pragma unroll
    for (int tp = 0; tp < 2; ++tp) {
        const int p = r32 + 32 * tp;
        const float dt = __expf(log_dt[g]);
        const float ar = a_re[g * 64 + p], ai = a_im[g * 64 + p];
        const float mag = __expf(ar * dt);
        const float lr = mag * cosf(ai * dt), li = mag * sinf(ai * dt);
        const float den = ar * ar + ai * ai, nr = lr - 1.f, ni = li;
        const float fr = (nr * ar + ni * ai) / den, fi = (ni * ar - nr * ai) / den;
        const f32x4* br4 = (const f32x4*)(b_re + (size_t)(g * 64 + p) * 16 + 8 * h); const f32x4* bi4 = (const f32x4*)(b_im + (size_t)(g * 64 + p) * 16 + 8 * h);
        const f32x4 r0 = br4[0], r1 = br4[1], i0 = bi4[0], i1 = bi4[1];
        const f32x4 re0 = fr * r0 - fi * i0, re1 = fr * r1 - fi * i1, im0 = fr * i0 + fi * r0, im1 = fr * i1 + fi * r1;
        u32x4 wre, wim;
        wre.x = pk2(re0[0], re0[1]); wre.y = pk2(re0[2], re0[3]); wre.z = pk2(re1[0], re1[1]); wre.w = pk2(re1[2], re1[3]);
        wim.x = pk2(im0[0], im0[1]); wim.y = pk2(im0[2], im0[3]); wim.z = pk2(im1[0], im1[1]); wim.w = pk2(im1[2], im1[3]);
        bfr[tp][0] = __builtin_bit_cast(bf16x8, wre); bfr[tp][1] = __builtin_bit_cast(bf16x8, wim);
        pw[tp][0][0] = lr; pw[tp][0][1] = li;
#pragma unroll
        for (int j = 1; j < 4; ++j) { pw[tp][j][0] = pw[tp][j - 1][0] * lr - pw[tp][j - 1][1] * li; pw[tp][j][1] = pw[tp][j - 1][0] * li + pw[tp][j - 1][1] * lr; }
    }
    const int t16 = lane & 15, quad = lane >> 4;
    bf16x8 cfr[4];
#pragma unroll
    for (int s = 0; s < 4; ++s) {
        const f32x4 cr4 = *(const f32x4*)(c_re + (size_t)(g * 16 + t16) * 64 + 4 * quad + 16 * s), ci4 = *(const f32x4*)(c_im + (size_t)(g * 16 + t16) * 64 + 4 * quad + 16 * s);
        u32x4 w; w.x = pk2(cr4[0], -ci4[0]); w.y = pk2(cr4[1], -ci4[1]); w.z = pk2(cr4[2], -ci4[2]); w.w = pk2(cr4[3], -ci4[3]);
        cfr[s] = __builtin_bit_cast(bf16x8, w);
    }
    const f32x4 dsk = *(const f32x4*)(d_skip + g * 16 + 4 * quad);
    const size_t tok0 = (size_t)b * SEQ + (size_t)wid * 512;
    const bf16_t* ubase = P + tok0 * NIN + 1280 + g * 16;
    f32x16 zero16;
#pragma unroll
    for (int q = 0; q < 16; ++q) zero16[q] = 0.f;
    float cr[2] = {0.f, 0.f}, ci[2] = {0.f, 0.f};
    {
        bf16x8 ua = *(const bf16x8*)(ubase + (size_t)r32 * NIN + 8 * h);
        for (int mt = 0; mt < 16; ++mt) {
            const bf16x8 un = *(const bf16x8*)(ubase + (size_t)((mt < 15 ? mt + 1 : mt) * 32 + r32) * NIN + 8 * h);
#pragma unroll
            for (int tp = 0; tp < 2; ++tp) {
                f32x16 xr = __builtin_amdgcn_mfma_f32_32x32x16_bf16(ua, bfr[tp][0], zero16, 0, 0, 0);
                f32x16 xi = __builtin_amdgcn_mfma_f32_32x32x16_bf16(ua, bfr[tp][1], zero16, 0, 0, 0);
                ssm_tile_scan<false>(xr, xi, pw[tp], cr[tp], ci[tp], hi);
            }
            ua = un;
        }
    }
    if (!hi) { f32x2v e0 = {cr[0], ci[0]}, e1 = {cr[1], ci[1]}; EW[wid * 64 + r32] = e0; EW[wid * 64 + 32 + r32] = e1; }
    __syncthreads();
#pragma unroll
    for (int tp = 0; tp < 2; ++tp) {
        float qr = pw[tp][3][0], qi = pw[tp][3][1];
#pragma unroll
        for (int q = 0; q < 7; ++q) { const float nr = qr * qr - qi * qi, ni = 2.f * qr * qi; qr = nr; qi = ni; }
        float sr = 0.f, si = 0.f;
        for (int w = 0; w < wid; ++w) { const f32x2v e = EW[w * 64 + r32 + 32 * tp]; const float nr = qr * sr - qi * si + e.x, ni = qr * si + qi * sr + e.y; sr = nr; si = ni; }
        cr[tp] = sr; ci[tp] = si;
    }
    {
        bf16x8 ua = *(const bf16x8*)(ubase + (size_t)r32 * NIN + 8 * h);
        for (int mt = 0; mt < 16; ++mt) {
            const bf16x8 un = *(const bf16x8*)(ubase + (size_t)((mt < 15 ? mt + 1 : mt) * 32 + r32) * NIN + 8 * h);
            u32x2 uwv[2];
#pragma unroll
            for (int tt = 0; tt < 2; ++tt) uwv[tt] = *(const u32x2*)(P + (tok0 + mt * 32 + tt * 16 + t16) * NIN + 1280 + g * 16 + 4 * quad);
#pragma unroll
            for (int tp = 0; tp < 2; ++tp) {
                f32x16 xr = __builtin_amdgcn_mfma_f32_32x32x16_bf16(ua, bfr[tp][0], zero16, 0, 0, 0);
                f32x16 xi = __builtin_amdgcn_mfma_f32_32x32x16_bf16(ua, bfr[tp][1], zero16, 0, 0, 0);
                ssm_tile_scan<true>(xr, xi, pw[tp], cr[tp], ci[tp], hi);
#pragma unroll
                for (int i = 0; i < 16; ++i) {
                    const int t = (i & 3) + 8 * (i >> 2) + 4 * h;
                    *(LAS unsigned*)(SBW + t * SSM_ROWB + 4 * (r32 + 32 * tp)) = pk2(xr[i], xi[i]);
                }
            }
            WAVE_LDS_SYNC();
#pragma unroll
            for (int tt = 0; tt < 2; ++tt) {
                f32x4 acc = {0.f, 0.f, 0.f, 0.f};
#pragma unroll
                for (int s = 0; s < 4; ++s) {
                    const bf16x8 sf = *(const LAS bf16x8*)(SBW + (tt * 16 + t16) * SSM_ROWB + quad * 16 + 64 * s);
                    acc = __builtin_amdgcn_mfma_f32_16x16x32_bf16(cfr[s], sf, acc, 0, 0, 0);
                }
                const size_t tok = tok0 + mt * 32 + tt * 16 + t16;
                const u32x2 uw = uwv[tt];
                const f32x4 uu = {bflo(uw.x), bfhi(uw.x), bflo(uw.y), bfhi(uw.y)};
                const f32x4 y = acc + dsk * uu;
                u32x2 w; w.x = pk2(gelu_tanh(y.x), gelu_tanh(y.y)); w.y = pk2(gelu_tanh(y.z), gelu_tanh(y.w));
                *(u32x2*)(ZB + tok * 256 + g * 16 + 4 * quad) = w;
            }
            WAVE_LDS_SYNC();
            ua = un;
        }
    }
}

constexpr int AT_ROWB = 144, AT_KOFF = 0, AT_VOFF = 384 * AT_ROWB;
__device__ __forceinline__ s16x4 vtr(const LAS unsigned char* p) { return __builtin_bit_cast(s16x4, __builtin_amdgcn_ds_read_tr16_b64_v4i16((LAS s16x4*)p)); }
struct AttnU { int pat, head, d, ub; size_t rowbase; };
__device__ __forceinline__ AttnU attn_decode(int u) {
    AttnU U; const int rem = u & 1023, b = rem >> 6, ru = rem & 15; U.pat = u >> 10; U.head = (rem >> 4) & 3;
    int r;
    if (U.pat == 0) { U.d = 1; r = 0; U.ub = ru; } else if (U.pat == 1) { U.d = 4; r = ru >> 2; U.ub = ru & 3; } else { U.d = 16; r = ru; U.ub = 0; }
    U.rowbase = (size_t)b * SEQ + r; return U;
}
__device__ __forceinline__ void attn_issue(const bf16_t* P, const AttnU& U, int tid, int wid, int lane, u32x4 (&kreg)[6], u32x4 (&vreg)[6], bf16x8 (&qf)[4]) {
    const int i0 = U.ub * 256 - 128;
#pragma unroll
    for (int k = 0; k < 6; ++k) {
        const int e = tid + NTHREADS * k, row = e >> 3, c = e & 7; int si = i0 + row; si = si < 0 ? 0 : si;
        const bf16_t* src = P + (U.rowbase + (size_t)si * U.d) * NIN + U.head * 64 + c * 8;
        kreg[k] = *(const u32x4*)(src + 1792); vreg[k] = *(const u32x4*)(src + 2048);
    }
    const int r32 = lane & 31, h = lane >> 5;
    const size_t qtok = U.rowbase + (size_t)(U.ub * 256 + 32 * wid + r32) * U.d;
    const bf16_t* qp = P + qtok * NIN + 1536 + U.head * 64 + 8 * h;
#pragma unroll
    for (int s = 0; s < 4; ++s) qf[s] = *(const bf16x8*)(qp + 16 * s);
}
__device__ __forceinline__ void attn_to_lds(LAS unsigned char* lds, int tid, const u32x4 (&kreg)[6], const u32x4 (&vreg)[6]) {
#pragma unroll
    for (int k = 0; k < 6; ++k) {
        const int e = tid + NTHREADS * k, row = e >> 3, c = e & 7;
        *(LAS u32x4*)(lds + AT_KOFF + row * AT_ROWB + c * 16) = kreg[k];
        *(LAS u32x4*)(lds + AT_VOFF + row * AT_ROWB + c * 16) = vreg[k];
    }
}
__device__ __forceinline__ void attn_compute(LAS unsigned char* lds, const AttnU& U, const bf16x8 (&qf)[4], bf16_t* OB, f32x2v* ST, int wid, int lane) {
    const int pat = U.pat, head = U.head, ub = U.ub;
    const int r32 = lane & 31, h = lane >> 5;
    const size_t qtok = U.rowbase + (size_t)(ub * 256 + 32 * wid + r32) * U.d;
    f32x16 sc[5];
    float mx = -1e30f;
    const float r32f = (float)r32, h4f = (float)(4 * h);
#pragma unroll
    for (int i = 0; i < 5; ++i) {
        const bool tv = (ub > 0) || (wid + i >= 4);
        f32x16 a;
        if (tv) {
#pragma unroll
            for (int q = 0; q < 16; ++q) a[q] = 0.f;
            const LAS unsigned char* kp = lds + AT_KOFF + (32 * wid + 32 * i + r32) * AT_ROWB + 16 * h;
#pragma unroll
            for (int s = 0; s < 4; ++s) { const bf16x8 kf = *(const LAS bf16x8*)(kp + 32 * s); a = __builtin_amdgcn_mfma_f32_32x32x16_bf16(kf, qf[s], a, 0, 0, 0); }
            if (i == 0 || i == 4) {
#pragma unroll
                for (int q = 0; q < 16; ++q) {
                    const float diff = ((float)((q & 3) + 8 * (q >> 2)) + h4f) - r32f;
                    a[q] = (i == 0) ? __builtin_fmaf(fminf(diff, 0.f), 1e30f, a[q]) : __builtin_fmaf(fmaxf(diff, 0.f), -1e30f, a[q]);
                }
            }
#pragma unroll
            for (int q = 0; q < 16; ++q) mx = fmaxf(mx, a[q]);
        } else {
#pragma unroll
            for (int q = 0; q < 16; ++q) a[q] = -1e30f;
        }
        sc[i] = a;
    }
    mx = fmaxf(mx, __shfl_xor(mx, 32));
    float l = 0.f;
#pragma unroll
    for (int i = 0; i < 5; ++i)
#pragma unroll
        for (int q = 0; q < 16; ++q) { const float pv = __builtin_amdgcn_exp2f(sc[i][q] - mx); sc[i][q] = pv; l += pv; }
    l += __shfl_xor(l, 32);
    f32x16 o0, o1;
#pragma unroll
    for (int q = 0; q < 16; ++q) { o0[q] = 0.f; o1[q] = 0.f; }
    const int i16 = lane & 15, q4 = i16 >> 2, p4 = i16 & 3, blk = (lane >> 4) & 1;
#pragma unroll
    for (int i = 0; i < 5; ++i) {
        const bool tv = (ub > 0) || (wid + i >= 4);
        if (tv) {
#pragma unroll
            for (int s2 = 0; s2 < 2; ++s2) {
                u32x4 pw; pw.x = pk2(sc[i][8 * s2], sc[i][8 * s2 + 1]); pw.y = pk2(sc[i][8 * s2 + 2], sc[i][8 * s2 + 3]); pw.z = pk2(sc[i][8 * s2 + 4], sc[i][8 * s2 + 5]); pw.w = pk2(sc[i][8 * s2 + 6], sc[i][8 * s2 + 7]);
                const bf16x8 pb = __builtin_bit_cast(bf16x8, pw);
                const LAS unsigned char* vp = lds + AT_VOFF + (32 * wid + 32 * i + 16 * s2 + 4 * h + q4) * AT_ROWB + 32 * blk + 8 * p4;
                const s16x4 lo0 = vtr(vp), hi0 = vtr(vp + 8 * AT_ROWB), lo1 = vtr(vp + 64), hi1 = vtr(vp + 8 * AT_ROWB + 64);
                const bf16x8 va0 = __builtin_shufflevector(lo0, hi0, 0, 1, 2, 3, 4, 5, 6, 7), va1 = __builtin_shufflevector(lo1, hi1, 0, 1, 2, 3, 4, 5, 6, 7);
                o0 = __builtin_amdgcn_mfma_f32_32x32x16_bf16(va0, pb, o0, 0, 0, 0);
                o1 = __builtin_amdgcn_mfma_f32_32x32x16_bf16(va1, pb, o1, 0, 0, 0);
            }
        }
    }
    const float inv = 1.f / l;
    bf16_t* op = OB + ((size_t)pat * NT + qtok) * 256 + head * 64 + 4 * h;
#pragma unroll
    for (int g4 = 0; g4 < 4; ++g4) {
        u32x2 w0, w1;
        w0.x = pk2(o0[4 * g4] * inv, o0[4 * g4 + 1] * inv); w0.y = pk2(o0[4 * g4 + 2] * inv, o0[4 * g4 + 3] * inv);
        w1.x = pk2(o1[4 * g4] * inv, o1[4 * g4 + 1] * inv); w1.y = pk2(o1[4 * g4 + 2] * inv, o1[4 * g4 + 3] * inv);
        *(u32x2*)(op + 8 * g4) = w0; *(u32x2*)(op + 32 + 8 * g4) = w1;
    }
    if (h == 0) { f32x2v st = {mx, l}; ST[(qtok * 4 + head) * 3 + pat] = st; }
}

__device__ __forceinline__ void combine_rows(const bf16_t* YC, const bf16_t* OB, const f32x2v* ST, const float* gn, bf16_t* H, int gw, int ngw, int lane) {
    f32x4 gv[2];
#pragma unroll
    for (int j = 0; j < 2; ++j) gv[j] = ((const f32x4*)gn)[lane + 64 * (j + 2)];
    const int head = lane >> 4;
    for (int m0 = gw * 4; m0 < NT; m0 += ngw * 4) {
        u32x2 yw[4], a0[4], a1[4], a2[4]; f32x2v s0[4], s1[4], s2[4];
#pragma unroll
        for (int r = 0; r < 4; ++r) {
            const size_t m = (size_t)m0 + r;
            yw[r] = *((const u32x2*)(YC + m * 768 + 512) + lane);
            s0[r] = ST[(m * 4 + head) * 3 + 0]; s1[r] = ST[(m * 4 + head) * 3 + 1]; s2[r] = ST[(m * 4 + head) * 3 + 2];
            a0[r] = *((const u32x2*)(OB + m * 256) + lane); a1[r] = *((const u32x2*)(OB + ((size_t)NT + m) * 256) + lane); a2[r] = *((const u32x2*)(OB + ((size_t)2 * NT + m) * 256) + lane);
        }
#pragma unroll
        for (int r = 0; r < 4; ++r) {
            const size_t m = (size_t)m0 + r;
            f32x4 v[2];
            v[0] = (f32x4){bflo(yw[r].x), bfhi(yw[r].x), bflo(yw[r].y), bfhi(yw[r].y)};
            {
                const float M = fmaxf(s0[r].x, fmaxf(s1[r].x, s2[r].x));
                const float w0 = __builtin_amdgcn_exp2f(s0[r].x - M) * s0[r].y, w1 = __builtin_amdgcn_exp2f(s1[r].x - M) * s1[r].y, w2 = __builtin_amdgcn_exp2f(s2[r].x - M) * s2[r].y;
                const float iw = __builtin_amdgcn_rcpf(w0 + w1 + w2);
                f32x4 o;
                o.x = (w0 * bflo(a0[r].x) + w1 * bflo(a1[r].x) + w2 * bflo(a2[r].x)) * iw; o.y = (w0 * bfhi(a0[r].x) + w1 * bfhi(a1[r].x) + w2 * bfhi(a2[r].x)) * iw;
                o.z = (w0 * bflo(a0[r].y) + w1 * bflo(a1[r].y) + w2 * bflo(a2[r].y)) * iw; o.w = (w0 * bfhi(a0[r].y) + w1 * bfhi(a1[r].y) + w2 * bfhi(a2[r].y)) * iw;
                v[1] = o;
            }
#pragma unroll
            for (int j = 0; j < 2; ++j) {
                const float ss = wave_sum((v[j].x * v[j].x + v[j].y * v[j].y) + (v[j].z * v[j].z + v[j].w * v[j].w));
                const float rs = rsqrtf(ss * (1.f / 256.f) + EPS);
                u32x2 w; w.x = pk2(v[j].x * rs * gv[j].x, v[j].y * rs * gv[j].y); w.y = pk2(v[j].z * rs * gv[j].z, v[j].w * rs * gv[j].w);
                *((u32x2*)(H + m * DMODEL + 256 * (j + 2)) + lane) = w;
            }
        }
    }
}

#define XB_TMO      128
#define XB_XCNT(j)  (256  + 64 * (j))
#define XB_XSUB(j)  (1280 + 64 * (j))
#define XB_XGEN(j)  (2304 + 64 * (j))
#define XB_TOP      3328
#define XB_TOPGEN   3392
#define XCD_BAR_WORDS 3456
#define XB_SPIN_CAP (1u << 18)

__device__ __forceinline__ unsigned xb_ld(unsigned* p)              { return __hip_atomic_load(p, __ATOMIC_RELAXED, __HIP_MEMORY_SCOPE_AGENT); }
__device__ __forceinline__ unsigned xb_add(unsigned* p, unsigned v) { return __hip_atomic_fetch_add(p, v, __ATOMIC_RELAXED, __HIP_MEMORY_SCOPE_AGENT); }
__device__ __forceinline__ unsigned xb_xcc_id() { return (unsigned)__builtin_amdgcn_s_getreg((3 << 11) | 20) & 0xFu; }
#define XB_SPIN(cond, bar) do { unsigned _sp = 0; while (cond) { __builtin_amdgcn_s_sleep(1); \
    if ((++_sp & 255u) == 0u) { if (xb_ld(&(bar)[XB_TMO])) break; if (_sp > XB_SPIN_CAP) { atomicAdd(&(bar)[XB_TMO], 1u); break; } } } } while (0)

struct XcdBarrier {
    unsigned* bar; unsigned x;
    volatile LAS unsigned* st;
};

__device__ __forceinline__ XcdBarrier xcd_barrier_post(unsigned* bar, volatile LAS unsigned* st) {
    XcdBarrier b; b.bar = bar; b.x = xb_xcc_id(); b.st = st;
    if (threadIdx.x == 0) (void)xb_add(&bar[XB_XCNT(b.x)], 1u);
    return b;
}
__device__ __forceinline__ void xcd_barrier_complete(unsigned* bar, unsigned x, unsigned& nloc, unsigned& nx) {
    const unsigned G = gridDim.x * gridDim.y * gridDim.z;
    unsigned sum, cnt, mine, sp = 0u;
    for (;;) {
        sum = 0u; cnt = 0u; mine = 0u;
#pragma unroll
        for (unsigned j = 0; j < 16; ++j) { const unsigned c = xb_ld(&bar[XB_XCNT(j)]); sum += c; cnt += (c > 0u) ? 1u : 0u; mine = (j == x) ? c : mine; }
        if (sum == G) break;
        __builtin_amdgcn_s_sleep(1);
        if ((++sp & 255u) == 0u) { if (xb_ld(&bar[XB_TMO])) break; if (sp > XB_SPIN_CAP) { atomicAdd(&bar[XB_TMO], 1u); break; } }
    }
    nloc = mine > 0u ? mine : 1u; nx = cnt > 0u ? cnt : 1u;
}

__device__ __forceinline__ void xcd_barrier(const XcdBarrier& b) {
    asm volatile("s_waitcnt vmcnt(0)" ::: "memory");
    __syncthreads();
    if (threadIdx.x == 0) {
        unsigned* bar = b.bar;
        __builtin_amdgcn_s_waitcnt(0);
        unsigned nloc = b.st[0], nx = b.st[1];
        if (nloc == 0u) { xcd_barrier_complete(bar, b.x, nloc, nx); b.st[0] = nloc; b.st[1] = nx; }
        const unsigned old = xb_add(&bar[XB_XSUB(b.x)], 1u);
        const unsigned gen = old / nloc;
        if (old + 1u == (gen + 1u) * nloc) {
            __builtin_amdgcn_fence(__ATOMIC_RELEASE, "agent");
            asm volatile("s_waitcnt vmcnt(0)" ::: "memory");
            const unsigned og = xb_add(&bar[XB_TOP], 1u);
            const unsigned tg = og / nx;
            if (og + 1u == (tg + 1u) * nx) xb_add(&bar[XB_TOPGEN], 1u);
            else XB_SPIN(xb_ld(&bar[XB_TOPGEN]) == tg, bar);
            __builtin_amdgcn_fence(__ATOMIC_ACQUIRE, "agent");
            xb_add(&bar[XB_XGEN(b.x)], 1u);
            asm volatile("s_waitcnt vmcnt(0)" ::: "memory");
        } else {
            XB_SPIN(xb_ld(&bar[XB_XGEN(b.x)]) == gen, bar);
            __builtin_amdgcn_fence(__ATOMIC_ACQUIRE, "agent");
            asm volatile("s_waitcnt vmcnt(0)" ::: "memory");
        }
    }
    __syncthreads();
}

constexpr int NPHASE = 16;
struct Ctx { const Args* args; LAS unsigned char* lds; int tid, lane, wid, G, bx, gw, ngw; };
#define LAUNDER(p) asm volatile("" : "+s"(p))
__device__ __forceinline__ void phase_body(const int ph, const CAS Args* ap, LAS unsigned char* lds, const int tid, const int lane, const int wid, const int G, const int bx) {
    const int gw = bx * 8 + wid, ngw = G * 8;
    unsigned char* ws = ap->ws;
    const float* x_in = ap->in[0];
    float* X = ap->out;
    bf16_t* Hb = (bf16_t*)(ws + WS_H); bf16_t* Pb = (bf16_t*)(ws + WS_P); bf16_t* YC = (bf16_t*)(ws + WS_YC); bf16_t* ZB = (bf16_t*)(ws + WS_ZB); bf16_t* OB = (bf16_t*)(ws + WS_OB);
    f32x2v* ST = (f32x2v*)(ws + WS_ST);
    float* ropec = (float*)(ws + WS_ROPE); float* ropes = ropec + SEQ * 32;
    bf16_t* XB = (bf16_t*)(ws + WS_XB); float* SS = (float*)(ws + WS_SS);
    if (ph == 0) {
        {
            float v[8], vn[8]; int t = 0, tn = 0;
            int it = bx; int mrow = gw * 2;
            WMat w = wmat_of(ap, ws, it < 2 * 2976 ? it : 0, t), wn = w;
            if (it < 2 * 2976) wconv_load(w, t, tid, v);
            for (; it < 2 * 2976; it += G) {
                const bool more = it + G < 2 * 2976;
                f32x4 xr2[2][4]; const bool rows = mrow < NT;
                if (rows) xb2_issue(x_in, mrow, lane, xr2);
                if (more) { wn = wmat_of(ap, ws, it + G, tn); wconv_load(wn, tn, tid, vn); }
                wconv_store((LAS float*)lds, w, t, tid, v);
                if (rows) { xb2_finish(XB, SS, mrow, lane, xr2); mrow += ngw * 2; }
                if (more) {
#pragma unroll
                    for (int i = 0; i < 8; ++i) v[i] = vn[i];
                    w = wn; t = tn;
                }
            }
            for (; mrow < NT; mrow += ngw * 2) { f32x4 xr2[2][4]; xb2_issue(x_in, mrow, lane, xr2); xb2_finish(XB, SS, mrow, lane, xr2); }
        }
        for (int e = bx * NTHREADS + tid; e < SEQ * 32; e += G * NTHREADS) {
            const int pos = e >> 5, i = e & 31;
            const double inv = (double)exp2f(-(float)i * (13.287712379549449f / 32.f));
            const float angf = (float)pos * (float)inv;
            double rev = (double)angf * 0.15915494309189535; rev -= floor(rev);
            ropec[e] = __builtin_amdgcn_cosf((float)rev); ropes[e] = __builtin_amdgcn_sinf((float)rev);
        }

        return;
    }
    if (ph == 15) {
        float tscale = 1.f;
#ifdef TIMED
        { const unsigned long long* ts = (const unsigned long long*)(ws + WS_BAR) + 1800; tscale = 1.f + (float)(ts[1] - ts[0]) * 1e-5f; }
#endif
        final_rows(XB, SS + (size_t)4 * NT * 4, ap->in[23], X, gw, ngw, lane, tscale); return; }
    const int layer = (ph - 1) / 7, sub = (ph - 1) % 7;
    unsigned char* wb = ws + WS_W + (size_t)layer * W_LAYER;
    if (sub == 0) {
        pg8::Gemm g{XB, (const bf16_t*)(wb + W_IN), NT, NIN, 1024}; pg8::StaticOrder S; S.init(NT, NIN, G, bx);
        EpiIn E{Pb, ropec, ropes, RowScale{SS + (size_t)(layer == 0 ? 0 : 2) * NT * 4, (LAS float*)(lds + 131072 + 4096)}};
        pg8::gemm_phase<EpiIn, pg8::StaticOrder, true, true>(lds, g, S, E);
    } else if (sub == 1) {
        const int rot = bx % 3;
#define RUN_S do { LAUNDER(ap); for (int it = bx; it < 256; it += G) \
            ssm_item(lds, Pb, ZB, ap->in[8] + layer * 1024, ap->in[9] + layer * 1024, ap->in[10] + layer * 16, ap->in[11] + (size_t)layer * 16384, ap->in[12] + (size_t)layer * 16384, \
                     ap->in[13] + (size_t)layer * 16384, ap->in[14] + (size_t)layer * 16384, ap->in[15] + layer * 256, it, tid, wid, lane); __syncthreads(); } while (0)
#define RUN_C do { LAUNDER(ap); conv3_phase(Pb, Hb, ap->in[3] + layer * 768, ap->in[17] + layer * 1024, bx, G, tid); \
            cfm_phase(lds, Pb, Hb, ap->in[4] + layer * 31 * 256, ap->in[5] + layer * 256, ap->in[6] + layer * 256, ap->in[7] + layer * 256, ap->in[17] + layer * 1024, bx, G, tid, wid, lane); __syncthreads(); } while (0)
        if (rot == 0) RUN_S;
        if (rot <= 1) RUN_C;
        {
            const int per = (3072 + G - 1) / G, it0 = bx * per, it1 = (it0 + per < 3072) ? it0 + per : 3072;
            u32x4 kreg[6], vreg[6]; bf16x8 qn[4], qc[4];
            int it = it0;
            AttnU U = attn_decode(it < it1 ? it : 0);
            if (it < it1) attn_issue(Pb, U, tid, wid, lane, kreg, vreg, qn);
            for (; it < it1; ++it) {
                __syncthreads();
                attn_to_lds(lds, tid, kreg, vreg);
#pragma unroll
                for (int s = 0; s < 4; ++s) qc[s] = qn[s];
                __syncthreads();
                const AttnU Uc = U;
                if (it + 1 < it1) { U = attn_decode(it + 1); attn_issue(Pb, U, tid, wid, lane, kreg, vreg, qn); }
                attn_compute(lds, Uc, qc, OB, ST, wid, lane);
            }
            __syncthreads();
        }
        if (rot >= 1) RUN_S;
        if (rot == 2) RUN_C;
#undef RUN_S
#undef RUN_C
    } else if (sub == 2) {
        pg8::Gemm g{ZB, (const bf16_t*)(wb + W_GLU), NT, 512, 256}; pg8::StaticOrder S; S.init(NT, 512, G, bx);
        EpiGate<1> E{YC, 768, 512, RowScale{nullptr, nullptr}};
        pg8::gemm_phase<EpiGate<1>, pg8::StaticOrder, true, true>(lds, g, S, E);
    } else if (sub == 3) {
        combine_rows(YC, OB, ST, ap->in[17] + layer * 1024, Hb, gw, ngw, lane);
    } else if (sub == 4) {
        pg8::Gemm g{Hb, (const bf16_t*)(wb + W_OUT), NT, 1024, 1024}; pg8::StaticOrder S; S.init(NT, 1024, G, bx);
        EpiRes E{XB, SS + (size_t)(layer == 0 ? 1 : 3) * NT * 4, (LAS float*)(lds + 131072)};
        pg8::gemm_phase<EpiRes, pg8::StaticOrder, true, true>(lds, g, S, E);
    } else if (sub == 5) {
#ifdef STAGGER_GU
        { const int st = (bx >> 3) & 7; for (int q = 0; q < st; ++q) __builtin_amdgcn_s_sleep(127); }
#endif
        pg8::Gemm g{XB, (const bf16_t*)(wb + W_GU), NT, 2 * DFF, 1024}; pg8::StaticOrder S; S.init(NT, 2 * DFF, G, bx);
        EpiGate<0> E{Pb, DFF, 0, RowScale{SS + (size_t)(layer == 0 ? 1 : 3) * NT * 4, (LAS float*)(lds + 131072 + 4096)}};
        pg8::gemm_phase<EpiGate<0>, pg8::StaticOrder, true, true>(lds, g, S, E);
    } else {
        pg8::Gemm g{Pb, (const bf16_t*)(wb + W_DN), NT, 1024, DFF}; pg8::StaticOrder S; S.init(NT, 1024, G, bx);
        EpiRes E{XB, SS + (size_t)(layer == 0 ? 2 : 4) * NT * 4, (LAS float*)(lds + 131072)};
        pg8::gemm_phase<EpiRes, pg8::StaticOrder, true, true>(lds, g, S, E);
    }
}
__global__ void __launch_bounds__(NTHREADS, 2) fwd_megakernel(Args args) {
    extern __shared__ __attribute__((aligned(16))) unsigned char lds_raw[];
    LAS unsigned char* lds = (LAS unsigned char*)lds_raw;
    cg::grid_group grid = cg::this_grid();
    const int tid = threadIdx.x, lane = tid & 63, wid = __builtin_amdgcn_readfirstlane(tid >> 6);
    const int G = gridDim.x, bx = blockIdx.x;
    const int lo = args.ph_lo, hi = args.ph_hi;
    const CAS Args* ap = (const CAS Args*)__builtin_amdgcn_kernarg_segment_ptr();
    volatile LAS unsigned* bst = (volatile LAS unsigned*)(lds + LDS_BYTES - 64);
    if (tid == 0) { bst[0] = 0u; bst[1] = 0u; }
    __syncthreads();
    XcdBarrier xbar = xcd_barrier_post((unsigned*)(args.ws + WS_BAR), bst);
#define GSYNC(k) do { if ((k) == 1) grid.sync(); else xcd_barrier(xbar); } while (0)
#ifdef TIMED
#define TSTAMP(k) do { if (bx == 0 && tid == 0) { if ((k) == TIMED) ((unsigned long long*)(args.ws + WS_BAR))[1800] = __builtin_amdgcn_s_memrealtime(); \
        if ((k) == TIMED + TIMED_N) ((unsigned long long*)(args.ws + WS_BAR))[1801] = __builtin_amdgcn_s_memrealtime(); } } while (0)
#else
#define TSTAMP(k) do { } while (0)
#endif
#define PHASE(k) if (lo <= (k) && (k) < hi) { if ((k) > lo) GSYNC(k); TSTAMP(k); LAUNDER(ap); phase_body((k), ap, lds, tid, lane, wid, G, bx); }
    PHASE(0) PHASE(1) PHASE(2) PHASE(3) PHASE(4) PHASE(5) PHASE(6) PHASE(7) PHASE(8) PHASE(9)
    PHASE(10) PHASE(11) PHASE(12) PHASE(13) PHASE(14) PHASE(15)
#undef PHASE
}

extern "C" void kernel_launch(void* const* d_in, const int* in_sizes, int n_in, void* d_out, int out_size, void* d_ws, size_t ws_size, hipStream_t stream) {
    static int grid_blocks = 0;
    if (grid_blocks == 0) {
        if (n_in != 24 || ws_size < WS_END) { fprintf(stderr, "kernel_launch: unexpected n_in %d / ws_size %zu\n", n_in, ws_size); grid_blocks = -1; return; }
        int dev = 0, cus = 0, per_cu = 0;
        hipGetDevice(&dev);
        hipDeviceGetAttribute(&cus, hipDeviceAttributeMultiprocessorCount, dev);
        if (hipFuncSetAttribute((const void*)fwd_megakernel, hipFuncAttributeMaxDynamicSharedMemorySize, LDS_BYTES) != hipSuccess) { fprintf(stderr, "kernel_launch: hipFuncSetAttribute failed\n"); grid_blocks = -1; return; }
        if (hipOccupancyMaxActiveBlocksPerMultiprocessor(&per_cu, (const void*)fwd_megakernel, NTHREADS, LDS_BYTES) != hipSuccess || per_cu < 1) { fprintf(stderr, "kernel_launch: occupancy query %d\n", per_cu); per_cu = 1; }
        (void)hipGetLastError();
        grid_blocks = cus * per_cu;
    }
    if (grid_blocks < 0) return;
    Args a{};
    for (int i = 0; i < 24; ++i) a.in[i] = (const float*)d_in[i];
    a.out = (float*)d_out; a.ws = (unsigned char*)d_ws; a.ph_lo = 0; a.ph_hi = NPHASE;
    if (hipMemsetAsync((char*)d_ws + WS_BAR, 0, 16384, stream) != hipSuccess) { fprintf(stderr, "kernel_launch: memset failed\n"); return; }
    void* kargs[] = {&a};
    hipError_t e = hipLaunchCooperativeKernel((const void*)fwd_megakernel, dim3(grid_blocks), dim3(NTHREADS), kargs, LDS_BYTES, stream);
    if (e != hipSuccess) fprintf(stderr, "cooperative launch failed: %s (grid %d)\n", hipGetErrorString(e), grid_blocks);
}
```

```cpp
#include <hip/hip_runtime.h>
#include <hip/hip_cooperative_groups.h>
#include <cstdio>
#include <cstdint>
namespace cg = cooperative_groups;
namespace pg8 {
#define PG8_LAS __attribute__((address_space(3)))
typedef unsigned short bf16_t;
typedef short bf16x8 __attribute__((ext_vector_type(8)));
typedef float f32x4 __attribute__((ext_vector_type(4)));
typedef unsigned u32x4 __attribute__((ext_vector_type(4)));
constexpr int BM = 256, BK = 64, HALF = 128, HTB = HALF * BK * 2  , STAGE_BYTES = 8 * HTB, NXCD = 8, WGM = 8;

__host__ __device__ __forceinline__ int lds_byte(int r, int c) { const int st = (r >> 4) * 2 + (c >> 5), rr = r & 15, cc = c & 31, ob = rr * 64 + cc * 2; return st * 1024 + (ob ^ (((ob >> 9) & 1) << 5)); }
__host__ __device__ __forceinline__ void stage_rc(int b, int& R, int& C) { const int st = b / 1024, sb = b % 1024, swz = sb ^ (((sb >> 9) & 1) << 5); R = (st >> 1) * 16 + swz / 64; C = (st & 1) * 32 + (swz % 64) / 2; }
__host__ __device__ __forceinline__ int perm32(int rho) { const int n = rho >> 4, i = rho & 15; return 8 * (i >> 2) + 4 * n + (i & 3); }

struct Unit { int pm, pn; };
struct Gemm { const bf16_t* A; const bf16_t* Bt; int M, N, K; };

struct StaticOrder {
    int nM, nN, nwg, G, c;
    __host__ __device__ void init(int M, int N, int G_, int c_) { nM = M / BM; nN = N / BM; nwg = nM * nN; G = G_; c = c_; }
    __host__ __device__ bool next(int i, Unit& u) const {
        const long L = (long)i * G + c; if (L >= nwg) return false;
        int wgid = (int)L; { const int q = nwg / NXCD, r = nwg % NXCD, xcd = wgid % NXCD, off = wgid / NXCD; wgid = (xcd < r ? xcd * (q + 1) : r * (q + 1) + (xcd - r) * q) + off; }
        const int nig = WGM * nN, gid = wgid / nig, fm = gid * WGM, gsz = (nM - fm) < WGM ? (nM - fm) : WGM;
        u.pm = fm + ((wgid % nig) % gsz); u.pn = (wgid % nig) / gsz; return true;
    }
    __device__ __forceinline__ void a_ready(const Unit&) const {}
    __device__ __forceinline__ void done(const Unit&) const {}
};

__device__ __forceinline__ unsigned cvt_pk_bf16(float lo, float hi) { unsigned r; asm volatile("v_cvt_pk_bf16_f32 %0, %1, %2" : "=v"(r) : "v"(lo), "v"(hi)); return r; }
typedef float f32x2 __attribute__((ext_vector_type(2)));
template <class Epi, class Sched, bool ALIGN_EPI = false, bool SP2 = false>
__device__ __forceinline__ void gemm_phase(PG8_LAS unsigned char* lds, const Gemm g, const Sched& S, const Epi& E) {
    const int tid = threadIdx.x, wid = __builtin_amdgcn_readfirstlane(tid >> 6), lane = tid & 63, wr = wid >> 2, wc = wid & 3, fr = lane & 15, fq = lane >> 4;
    const int K = g.K, nt = K / BK;
    unsigned voffA[2], voffB[2];
#pragma unroll
    for (int i = 0; i < 2; ++i) { int R, C; stage_rc(tid * 16 + i * 8192, R, C); const int Rb = Epi::PERM ? ((R & ~31) + perm32(R & 31)) : R;
        voffA[i] = (unsigned)(R * K + C) * 2u; voffB[i] = (unsigned)(Rb * K + C) * 2u; }
    const size_t kstep = (size_t)(BK * 2);
    const size_t hstep = (size_t)HALF * K * 2;
    const size_t tstep = 2 * hstep;
    const unsigned ldsw = (unsigned)wid * 1024u;
    const int aoff = lds_byte(wr * 64 + fr, fq * 8), boff = lds_byte(wc * 32 + fr, fq * 8);
#define PG8_SA(b, h) (((b) * 2 + (h)) * HTB)
#define PG8_SB(b, h) ((4 + (b) * 2 + (h)) * HTB)
#define PG8_STAGE(bufoff, gbase, voff) do { _Pragma("unroll") for (int _i = 0; _i < 2; ++_i) \
        __builtin_amdgcn_global_load_lds((const unsigned*)((const char*)(gbase) + (voff)[_i]), (PG8_LAS unsigned*)(lds + (bufoff) + ldsw + _i * 8192), 16, 0, 0); } while (0)
#define PG8_LDA(dst, b, h) do { _Pragma("unroll") for (int m = 0; m < 4; ++m) _Pragma("unroll") for (int k = 0; k < 2; ++k) dst[m][k] = *(const PG8_LAS bf16x8*)(lds + PG8_SA(b, h) + aoff + m * 2048 + k * 1024); } while (0)
#define PG8_LDB(dst, b, h) do { _Pragma("unroll") for (int n = 0; n < 2; ++n) _Pragma("unroll") for (int k = 0; k < 2; ++k) dst[n][k] = *(const PG8_LAS bf16x8*)(lds + PG8_SB(b, h) + boff + n * 2048 + k * 1024); } while (0)
#define PG8_MMA(ai, bj, At, Bt) do { __builtin_amdgcn_s_setprio(1); _Pragma("unroll") for (int m = 0; m < 4; ++m) _Pragma("unroll") for (int n = 0; n < 2; ++n) _Pragma("unroll") for (int k = 0; k < 2; ++k) \
        acc[ai][bj][m][n] = __builtin_amdgcn_mfma_f32_16x16x32_bf16(Bt[n][k], At[m][k], acc[ai][bj][m][n], 0, 0, 0); __builtin_amdgcn_s_setprio(0); } while (0)
#define PG8_WAIT_V(n) asm volatile("s_waitcnt vmcnt(" #n ")" ::: "memory")
#define PG8_WAIT_L(n) asm volatile("s_waitcnt lgkmcnt(" #n ")" ::: "memory")
#define PG8_BAR __builtin_amdgcn_s_barrier()
#define PG8_SCHED __builtin_amdgcn_sched_barrier(0)
    Unit cur, nxt; int ui = 0;
    if (!S.next(0, cur)) return;
    E.prime(cur);
    f32x4 acc[2][2][4][2];
#pragma unroll
    for (int a = 0; a < 2; ++a)
#pragma unroll
        for (int b = 0; b < 2; ++b)
#pragma unroll
            for (int m = 0; m < 4; ++m)
#pragma unroll
                for (int n = 0; n < 2; ++n) acc[a][b][m][n] = (f32x4){0.f, 0.f, 0.f, 0.f};
    bf16x8 At[4][2], B0[2][2], B1[2][2];
    const char* cA = (const char*)g.A + (size_t)cur.pm * tstep; const char* cB = (const char*)g.Bt + (size_t)cur.pn * tstep;
    S.a_ready(cur);
    if constexpr (SP2) {
        PG8_STAGE(PG8_SB(0, 0), cB, voffB); PG8_STAGE(PG8_SB(0, 1), cB + hstep, voffB); PG8_STAGE(PG8_SA(0, 0), cA, voffA); PG8_STAGE(PG8_SA(0, 1), cA + hstep, voffA);
        if (wr == 1) PG8_BAR;
        PG8_WAIT_V(2); PG8_BAR;
        PG8_STAGE(PG8_SB(1, 0), cB + kstep, voffB); PG8_STAGE(PG8_SA(1, 0), cA + kstep, voffA); PG8_STAGE(PG8_SB(1, 1), cB + hstep + kstep, voffB);
        PG8_WAIT_V(6); PG8_BAR;
    } else {
        PG8_STAGE(PG8_SB(0, 0), cB, voffB); PG8_STAGE(PG8_SA(0, 0), cA, voffA); PG8_STAGE(PG8_SB(0, 1), cB + hstep, voffB); PG8_STAGE(PG8_SA(0, 1), cA + hstep, voffA);
        if (wr == 1) PG8_BAR;
        PG8_WAIT_V(4); PG8_BAR;
        PG8_STAGE(PG8_SB(1, 0), cB + kstep, voffB); PG8_STAGE(PG8_SA(1, 0), cA + kstep, voffA); PG8_STAGE(PG8_SB(1, 1), cB + hstep + kstep, voffB);
        PG8_WAIT_V(6); PG8_BAR;
    }
    for (;;) {
        const bool has_next = S.next(ui + 1, nxt);
        const char* nA = has_next ? (const char*)g.A + (size_t)nxt.pm * tstep : cA; const char* nB = has_next ? (const char*)g.Bt + (size_t)nxt.pn * tstep : cB;
#pragma nounroll
        for (int t = 0; t < nt; t += 2) {
            const bool last = (t == nt - 2);
            const char* a1 = cA + (size_t)(t + 1) * kstep;
            const char* a2 = last ? nA : cA + (size_t)(t + 2) * kstep; const char* b2 = last ? nB : cB + (size_t)(t + 2) * kstep;
            const char* a3 = a2 + kstep; const char* b3 = b2 + kstep;
            if (last && has_next) S.a_ready(nxt);
            if constexpr (SP2) {
            PG8_LDB(B0, 0, 0); PG8_LDB(B1, 0, 1); PG8_SCHED; PG8_LDA(At, 0, 0); PG8_STAGE(PG8_SA(1, 1), a1 + hstep, voffA);
            PG8_WAIT_V(8); PG8_WAIT_L(0); PG8_BAR; PG8_MMA(0, 0, At, B0); PG8_MMA(0, 1, At, B1); PG8_BAR; PG8_SCHED;
            PG8_LDA(At, 0, 1); PG8_STAGE(PG8_SB(0, 0), b2, voffB); PG8_STAGE(PG8_SB(0, 1), b2 + hstep, voffB); PG8_STAGE(PG8_SA(0, 0), a2, voffA);
            PG8_WAIT_V(8); PG8_WAIT_L(0); PG8_BAR; PG8_MMA(1, 0, At, B0); PG8_MMA(1, 1, At, B1); PG8_BAR; PG8_SCHED;
            PG8_LDB(B0, 1, 0); PG8_LDB(B1, 1, 1); PG8_SCHED; PG8_LDA(At, 1, 0); PG8_STAGE(PG8_SA(0, 1), a2 + hstep, voffA);
            PG8_WAIT_V(8); PG8_WAIT_L(0); PG8_BAR; PG8_MMA(0, 0, At, B0); PG8_MMA(0, 1, At, B1); PG8_BAR; PG8_SCHED;
            PG8_LDA(At, 1, 1); PG8_STAGE(PG8_SB(1, 0), b3, voffB); PG8_STAGE(PG8_SB(1, 1), b3 + hstep, voffB); PG8_STAGE(PG8_SA(1, 0), a3, voffA);
            PG8_WAIT_V(8); PG8_WAIT_L(0); PG8_BAR; PG8_MMA(1, 0, At, B0); PG8_MMA(1, 1, At, B1); PG8_BAR; PG8_SCHED;
            } else {
            PG8_LDB(B0, 0, 0); PG8_SCHED; PG8_LDA(At, 0, 0); PG8_STAGE(PG8_SA(1, 1), a1 + hstep, voffA);
            PG8_WAIT_L(8); PG8_BAR; PG8_WAIT_L(0); PG8_MMA(0, 0, At, B0); PG8_BAR; PG8_SCHED;
            PG8_LDB(B1, 0, 1); PG8_STAGE(PG8_SB(0, 0), b2, voffB);
            PG8_BAR; PG8_WAIT_L(0); PG8_MMA(0, 1, At, B1); PG8_BAR;
            PG8_LDA(At, 0, 1); PG8_STAGE(PG8_SA(0, 0), a2, voffA);
            PG8_BAR; PG8_WAIT_L(0); PG8_MMA(1, 0, At, B0); PG8_BAR; PG8_SCHED;
            PG8_STAGE(PG8_SB(0, 1), b2 + hstep, voffB);
            PG8_WAIT_V(6); PG8_BAR; PG8_MMA(1, 1, At, B1); PG8_BAR;
            PG8_LDB(B0, 1, 0); PG8_SCHED; PG8_LDA(At, 1, 0); PG8_STAGE(PG8_SA(0, 1), a2 + hstep, voffA);
            PG8_WAIT_L(8); PG8_BAR; PG8_WAIT_L(0); PG8_MMA(0, 0, At, B0); PG8_BAR; PG8_SCHED;
            PG8_LDB(B1, 1, 1); PG8_STAGE(PG8_SB(1, 0), b3, voffB);
            PG8_BAR; PG8_WAIT_L(0); PG8_MMA(0, 1, At, B1); PG8_BAR;
            PG8_LDA(At, 1, 1); PG8_STAGE(PG8_SA(1, 0), a3, voffA);
            PG8_BAR; PG8_WAIT_L(0); PG8_MMA(1, 0, At, B0); PG8_BAR; PG8_SCHED;
            PG8_STAGE(PG8_SB(1, 1), b3 + hstep, voffB);
            PG8_WAIT_V(6); PG8_BAR; PG8_MMA(1, 1, At, B1); PG8_BAR;
            }
        }
        if constexpr (ALIGN_EPI) { if (wr == 0) PG8_BAR; }
        if constexpr (!Epi::AFTER_DRAIN) { E(acc, cur, wr, wc, fr, fq, nxt, has_next, ui); S.done(cur); }
        if (!has_next) break;
#pragma unroll
        for (int a = 0; a < 2; ++a)
#pragma unroll
            for (int b = 0; b < 2; ++b)
#pragma unroll
                for (int m = 0; m < 4; ++m)
#pragma unroll
                    for (int n = 0; n < 2; ++n) acc[a][b][m][n] = (f32x4){0.f, 0.f, 0.f, 0.f};
        cur = nxt; cA = nA; cB = nB; ++ui;
        if constexpr (ALIGN_EPI) { if (wr == 1) PG8_BAR; }
    }
    PG8_WAIT_V(0);
    if constexpr (!ALIGN_EPI) { if (wr == 0) PG8_BAR; }
    PG8_BAR;
    if constexpr (Epi::AFTER_DRAIN) { E.fused(acc, cur, wr, wc, fr, fq, lds, wid, lane); S.done(cur); }
#undef PG8_SA
#undef PG8_SB
#undef PG8_STAGE
#undef PG8_LDA
#undef PG8_LDB
#undef PG8_MMA
#undef PG8_WAIT_V
#undef PG8_WAIT_L
#undef PG8_BAR
#undef PG8_SCHED
}
}
#ifndef REPEAT_MASK
#define REPEAT_MASK 0u
#endif
#ifndef EXTRA_SYNCS
#define EXTRA_SYNCS 0
#endif
#ifndef REP_SSM
#define REP_SSM 1
#endif
#ifndef REP_CONV
#define REP_CONV 1
#endif
#ifndef REP_ATTN
#define REP_ATTN 1
#endif

#define LAS __attribute__((address_space(3)))
typedef unsigned short bf16_t;
typedef short bf16x8 __attribute__((ext_vector_type(8)));
typedef short s16x4 __attribute__((ext_vector_type(4)));
typedef float f32x4 __attribute__((ext_vector_type(4)));
typedef float f32x16 __attribute__((ext_vector_type(16)));
typedef unsigned u32x4 __attribute__((ext_vector_type(4)));
typedef unsigned u32x2 __attribute__((ext_vector_type(2)));
typedef float f32x2v __attribute__((ext_vector_type(2)));
typedef __bf16 bf16x2v __attribute__((ext_vector_type(2)));

constexpr int NT = 65536, SEQ = 4096, DMODEL = 1024, NIN = 2304, DFF = 2816;
constexpr float EPS = 1e-6f;
constexpr float C2 = 0.125f * 1.4426950408889634f;
constexpr size_t MiB = (size_t)1 << 20;
constexpr size_t W_IN = 0, W_OUT = W_IN + (size_t)NIN * 1024 * 2, W_GU = W_OUT + (size_t)1024 * 1024 * 2, W_DN = W_GU + (size_t)2 * DFF * 1024 * 2,
                 W_GLU = W_DN + (size_t)1024 * DFF * 2, W_LAYER = 24 * MiB;
static_assert(W_GLU + 512 * 256 * 2 <= W_LAYER, "weight block");
constexpr size_t WS_W = 0, WS_ROPE = 48 * MiB, WS_H = 64 * MiB, WS_P = 192 * MiB, WS_YC = 544 * MiB, WS_ZB = 640 * MiB, WS_OB = 672 * MiB, WS_ST = 768 * MiB, WS_BAR = 776 * MiB, WS_XB = 778 * MiB, WS_SS = 906 * MiB, WS_END = 912 * MiB;
constexpr int LDS_BYTES = 147456;
constexpr int NTHREADS = 512;

#define CAS __attribute__((address_space(4)))
struct Args {
    const float* in[24];
    float* out;
    unsigned char* ws;
    int ph_lo, ph_hi;
};

__device__ __forceinline__ unsigned pk2(float lo, float hi) { f32x2v v = {lo, hi}; bf16x2v b = __builtin_convertvector(v, bf16x2v); return __builtin_bit_cast(unsigned, b); }
__device__ __forceinline__ float bflo(unsigned u) { return __uint_as_float(u << 16); }
__device__ __forceinline__ float bfhi(unsigned u) { return __uint_as_float(u & 0xffff0000u); }
template <int CTRL, int ROWMASK> __device__ __forceinline__ float dpp_add(float v) {
    return v + __builtin_bit_cast(float, __builtin_amdgcn_update_dpp(0, __builtin_bit_cast(int, v), CTRL, ROWMASK, 0xF, false));
}
__device__ __forceinline__ float wave_sum(float v) {
    v = dpp_add<0xB1, 0xF>(v);
    v = dpp_add<0x4E, 0xF>(v);
    v = dpp_add<0x141, 0xF>(v);
    v = dpp_add<0x140, 0xF>(v);
    v = dpp_add<0x142, 0xA>(v);
    v = dpp_add<0x143, 0xC>(v);
    return __builtin_bit_cast(float, __builtin_amdgcn_readlane(__builtin_bit_cast(int, v), 63));
}
__device__ __forceinline__ float sigmoidf_(float x) { return __builtin_amdgcn_rcpf(1.f + __expf(-x)); }
__device__ __forceinline__ float gelu_tanh(float y) {
    const float a = 0.7978845608028654f * (y + 0.044715f * y * y * y);
    const float t = 1.f - 2.f * __builtin_amdgcn_rcpf(__expf(2.f * a) + 1.f);
    return 0.5f * y * (1.f + t);
}
#define WAVE_LDS_SYNC() asm volatile("s_waitcnt lgkmcnt(0)" ::: "memory")

struct RowScale {
    const float* ssp; LAS float* xs;
    __device__ __forceinline__ float rs_of(int row) const { const f32x4 sp = *(const f32x4*)(ssp + (size_t)row * 4); return rsqrtf(((sp.x + sp.y) + (sp.z + sp.w)) * (1.f / DMODEL) + EPS); }
    __device__ __forceinline__ void prime(const pg8::Unit& u) const { const int t = threadIdx.x; if (t < 256) xs[t] = rs_of(u.pm * 256 + t); }
};
struct EpiIn {
    static constexpr bool PERM = true, AFTER_DRAIN = false;
    bf16_t* O; const float* ropec; const float* ropes; RowScale R;
    __device__ __forceinline__ void prime(const pg8::Unit& u) const { R.prime(u); }
    __device__ __forceinline__ void operator()(const f32x4 (&acc)[2][2][4][2], const pg8::Unit& u, int wr, int wc, int fr, int fq, const pg8::Unit& nxt, bool has_next, int ui) const {
        const int row0 = u.pm * 256 + wr * 64 + fr, t = threadIdx.x;
        f32x4 spn = {0.f, 0.f, 0.f, 0.f};
        const bool stage = has_next && t < 256 && nxt.pm != u.pm;
        if (stage) spn = *(const f32x4*)(R.ssp + (size_t)(nxt.pm * 256 + t) * 4);
        const LAS float* xsc = R.xs + (ui & 1) * 256 + wr * 64 + fr;
        if (u.pn == 6 || u.pn == 7) {
            const float sc = (u.pn == 6) ? C2 : 1.f;
            const int dimb = 16 * (wc & 1) + 4 * fq;
#pragma unroll
            for (int ai = 0; ai < 2; ++ai)
#pragma unroll
                for (int m = 0; m < 4; ++m) {
                    const int row = row0 + ai * 128 + m * 16; const int pos = row & (SEQ - 1);
                    const float rsc = xsc[ai * 128 + m * 16] * sc;
                    const f32x4 cs = *(const f32x4*)(ropec + pos * 32 + dimb), sn = *(const f32x4*)(ropes + pos * 32 + dimb);
                    bf16_t* rowp = O + (size_t)row * NIN + u.pn * 256 + 64 * (wc >> 1) + dimb;
#pragma unroll
                    for (int bj = 0; bj < 2; ++bj) {
                        const f32x4 x1 = acc[ai][bj][m][0] * rsc, x2 = acc[ai][bj][m][1] * rsc;
                        const f32x4 o1 = x1 * cs - x2 * sn, o2 = x2 * cs + x1 * sn;
                        u32x2 w1, w2; w1.x = pk2(o1[0], o1[1]); w1.y = pk2(o1[2], o1[3]); w2.x = pk2(o2[0], o2[1]); w2.y = pk2(o2[2], o2[3]);
                        *(u32x2*)(rowp + bj * 128) = w1; *(u32x2*)(rowp + bj * 128 + 32) = w2;
                    }
                }
        } else {
#pragma unroll
            for (int ai = 0; ai < 2; ++ai)
#pragma unroll
                for (int m = 0; m < 4; ++m) {
                    bf16_t* rowp = O + (size_t)(row0 + ai * 128 + m * 16) * NIN + u.pn * 256 + wc * 32 + 8 * fq;
                    const float rsc = xsc[ai * 128 + m * 16];
#pragma unroll
                    for (int bj = 0; bj < 2; ++bj) {
                        const f32x4 v0 = acc[ai][bj][m][0] * rsc, v1 = acc[ai][bj][m][1] * rsc;
                        u32x4 w; w.x = pk2(v0[0], v0[1]); w.y = pk2(v0[2], v0[3]); w.z = pk2(v1[0], v1[1]); w.w = pk2(v1[2], v1[3]);
                        *(u32x4*)(rowp + bj * 128) = w;
                    }
                }
        }
        if (has_next && t < 256) {
            float v = R.xs[(ui & 1) * 256 + t];
            if (nxt.pm != u.pm) v = rsqrtf(((spn.x + spn.y) + (spn.z + spn.w)) * (1.f / DMODEL) + EPS);
            R.xs[((ui + 1) & 1) * 256 + t] = v;
        }
    }
};
struct EpiRes {
    static constexpr bool PERM = true, AFTER_DRAIN = false;
    bf16_t* xb; float* ssp; LAS float* xl;
    __device__ __forceinline__ void prime(const pg8::Unit&) const {}
    __device__ __forceinline__ void operator()(const f32x4 (&acc)[2][2][4][2], const pg8::Unit& u, int wr, int wc, int fr, int fq, const pg8::Unit&, bool, int) const {
        const int row0 = u.pm * 256 + wr * 64 + fr, col0 = u.pn * 256 + wc * 32 + 8 * fq;
        u32x4 rv[2][4][2];
#pragma unroll
        for (int ai = 0; ai < 2; ++ai)
#pragma unroll
            for (int m = 0; m < 4; ++m)
#pragma unroll
                for (int bj = 0; bj < 2; ++bj) rv[ai][m][bj] = *(const u32x4*)(xb + (size_t)(row0 + ai * 128 + m * 16) * DMODEL + col0 + bj * 128);
#pragma unroll
        for (int ai = 0; ai < 2; ++ai)
#pragma unroll
            for (int m = 0; m < 4; ++m) {
                const int row = row0 + ai * 128 + m * 16;
                const size_t off = (size_t)row * DMODEL + col0;
                float sq = 0.f;
#pragma unroll
                for (int bj = 0; bj < 2; ++bj) {
                    const u32x4 r = rv[ai][m][bj];
                    const f32x4 r0 = {bflo(r.x), bfhi(r.x), bflo(r.y), bfhi(r.y)}, r1 = {bflo(r.z), bfhi(r.z), bflo(r.w), bfhi(r.w)};
                    const f32x4 x0 = r0 + acc[ai][bj][m][0], x1 = r1 + acc[ai][bj][m][1];
                    u32x4 w; w.x = pk2(x0[0], x0[1]); w.y = pk2(x0[2], x0[3]); w.z = pk2(x1[0], x1[1]); w.w = pk2(x1[2], x1[3]);
                    *(u32x4*)(xb + off + bj * 128) = w;
                    sq += (x0[0] * x0[0] + x0[1] * x0[1]) + (x0[2] * x0[2] + x0[3] * x0[3]) + (x1[0] * x1[0] + x1[1] * x1[1]) + (x1[2] * x1[2] + x1[3] * x1[3]);
                }
                sq += __shfl_xor(sq, 16); sq += __shfl_xor(sq, 32);
                if (fq == 0) xl[(wr * 64 + ai * 128 + m * 16 + fr) * 4 + wc] = sq;
            }
        asm volatile("s_waitcnt lgkmcnt(0)\n\ts_barrier" ::: "memory");
        const int t = threadIdx.x;
        if (t < 256) { const f32x4 v = *(const LAS f32x4*)(xl + t * 4); ssp[(size_t)(u.pm * 256 + t) * 4 + u.pn] = (v.x + v.y) + (v.z + v.w); }
    }
};
template <int MODE  > struct EpiGate {
    static constexpr bool PERM = true, AFTER_DRAIN = false;
    bf16_t* O; int ldc; int coff; RowScale R;
    __device__ __forceinline__ void prime(const pg8::Unit& u) const { if (MODE == 0) R.prime(u); }
    __device__ __forceinline__ void operator()(const f32x4 (&acc)[2][2][4][2], const pg8::Unit& u, int wr, int wc, int fr, int fq, const pg8::Unit& nxt, bool has_next, int ui) const {
        const int row0 = u.pm * 256 + wr * 64 + fr, col0 = coff + u.pn * 128 + wc * 32 + 8 * fq, t = threadIdx.x;
        f32x4 spn = {0.f, 0.f, 0.f, 0.f};
        if (MODE == 0) { if (has_next && t < 256 && nxt.pm != u.pm) spn = *(const f32x4*)(R.ssp + (size_t)(nxt.pm * 256 + t) * 4); }
        const LAS float* xsc = R.xs + (ui & 1) * 256 + wr * 64 + fr;
#pragma unroll
        for (int ai = 0; ai < 2; ++ai)
#pragma unroll
            for (int m = 0; m < 4; ++m) {
                float r[8];
                float rsc = 1.f; if (MODE == 0) rsc = xsc[ai * 128 + m * 16];
                const float c1 = -1.4426950408889634f * rsc, r2 = rsc * rsc;
#pragma unroll
                for (int n = 0; n < 2; ++n)
#pragma unroll
                    for (int j = 0; j < 4; ++j) {
                        const float a = acc[ai][0][m][n][j], b = acc[ai][1][m][n][j];
                        if (MODE == 0) r[4 * n + j] = (a * b) * (r2 * __builtin_amdgcn_rcpf(1.f + __builtin_amdgcn_exp2f(a * c1)));
                        else r[4 * n + j] = a * __builtin_amdgcn_rcpf(1.f + __builtin_amdgcn_exp2f(b * -1.4426950408889634f));
                    }
                u32x4 w; w.x = pk2(r[0], r[1]); w.y = pk2(r[2], r[3]); w.z = pk2(r[4], r[5]); w.w = pk2(r[6], r[7]);
                *(u32x4*)(O + (size_t)(row0 + ai * 128 + m * 16) * ldc + col0) = w;
            }
        if (MODE == 0) {
            if (has_next && t < 256) {
                float v = R.xs[(ui & 1) * 256 + t];
                if (nxt.pm != u.pm) v = rsqrtf(((spn.x + spn.y) + (spn.z + spn.w)) * (1.f / DMODEL) + EPS);
                R.xs[((ui + 1) & 1) * 256 + t] = v;
            }
        }
    }
};

struct WMat { const float* src; const float* src2; int K, N, ldw, kind; bf16_t* dst; const float* kscale; };
__device__ __forceinline__ void wconv_load(const WMat& w, int t, int tid, float (&v)[8]) {
    const int nkt = w.K / 64, jt = t / nkt, kt = t % nkt, j0 = jt * 64, k0 = kt * 64;
    const int j = j0 + (tid & 63);
    const float* s = w.src; int col = j;
    if (w.kind == 1) {
        if (j >= 1536 && j < 2048) { const int ww = j & 63; col = (j & ~63) + 32 * ((ww >> 2) & 1) + 16 * (ww >> 5) + 4 * ((ww >> 3) & 3) + (ww & 3); }
    } else if (w.kind == 2) {
        const int pn = j >> 8, wi = j & 255; if (wi < 128) col = pn * 128 + wi; else { s = w.src2; col = pn * 128 + (wi - 128); }
    }
    const int kk = tid >> 6;
#pragma unroll
    for (int i = 0; i < 8; ++i) { const int k = kk + 8 * i; const float sc = w.kscale ? w.kscale[k0 + k] : 1.f; v[i] = s[(size_t)(k0 + k) * w.ldw + col] * sc; }
}
__device__ __forceinline__ void wconv_store(LAS float* tile, const WMat& w, int t, int tid, const float (&v)[8]) {
    const int nkt = w.K / 64, jt = t / nkt, kt = t % nkt, j0 = jt * 64, k0 = kt * 64;
    const int kk = tid >> 6;
#pragma unroll
    for (int i = 0; i < 8; ++i) tile[(kk + 8 * i) * 65 + (tid & 63)] = v[i];
    __syncthreads();
    {
        const int jr = tid >> 3, c = tid & 7; const LAS float* s = tile + (8 * c) * 65 + jr;
        u32x4 o; o.x = pk2(s[0], s[65]); o.y = pk2(s[2 * 65], s[3 * 65]); o.z = pk2(s[4 * 65], s[5 * 65]); o.w = pk2(s[6 * 65], s[7 * 65]);
        *(u32x4*)(w.dst + (size_t)(j0 + jr) * w.K + k0 + 8 * c) = o;
    }
    __syncthreads();
}
__device__ __forceinline__ WMat wmat_of(const CAS Args* ap, unsigned char* ws, int it, int& t) {
    const int layer = it / 2976; t = it % 2976;
    unsigned char* wb = ws + WS_W + (size_t)layer * W_LAYER;
    if (t < 576) return WMat{ap->in[2] + (size_t)layer * 1024 * NIN, nullptr, 1024, NIN, NIN, 1, (bf16_t*)(wb + W_IN), ap->in[1] + layer * 1024};
    if ((t -= 576) < 256) return WMat{ap->in[18] + (size_t)layer * 1024 * 1024, nullptr, 1024, 1024, 1024, 0, (bf16_t*)(wb + W_OUT), nullptr};
    if ((t -= 256) < 1408) return WMat{ap->in[20] + (size_t)layer * 1024 * DFF, ap->in[21] + (size_t)layer * 1024 * DFF, 1024, 2 * DFF, DFF, 2, (bf16_t*)(wb + W_GU), ap->in[19] + layer * 1024};
    if ((t -= 1408) < 704) return WMat{ap->in[22] + (size_t)layer * DFF * 1024, nullptr, DFF, 1024, 1024, 0, (bf16_t*)(wb + W_DN), nullptr};
    t -= 704; return WMat{ap->in[16] + (size_t)layer * 256 * 512, ap->in[16] + (size_t)layer * 256 * 512 + 256, 256, 512, 512, 2, (bf16_t*)(wb + W_GLU), nullptr};
}

__device__ __forceinline__ void norm_rows_bf16(const float* X, const float* g, bf16_t* H, int gw, int ngw, int lane) {
    f32x4 gv[4];
#pragma unroll
    for (int j = 0; j < 4; ++j) gv[j] = ((const f32x4*)g)[lane + 64 * j];
    for (int m = gw; m < NT; m += ngw) {
        const f32x4* xr = (const f32x4*)(X + (size_t)m * DMODEL) + lane;
        f32x4 v[4]; float s = 0.f;
#pragma unroll
        for (int j = 0; j < 4; ++j) { v[j] = xr[64 * j]; s += (v[j].x * v[j].x + v[j].y * v[j].y) + (v[j].z * v[j].z + v[j].w * v[j].w); }
        const float rs = rsqrtf(wave_sum(s) * (1.f / DMODEL) + EPS);
        u32x2* o = (u32x2*)(H + (size_t)m * DMODEL) + lane;
#pragma unroll
        for (int j = 0; j < 4; ++j) { u32x2 w; w.x = pk2(v[j].x * rs * gv[j].x, v[j].y * rs * gv[j].y); w.y = pk2(v[j].z * rs * gv[j].z, v[j].w * rs * gv[j].w); o[64 * j] = w; }
    }
}
__device__ __forceinline__ void xb_rows(const float* X, bf16_t* XB, float* ssq, int gw, int ngw, int lane) {
    for (int m0 = gw * 2; m0 < NT; m0 += ngw * 2) {
        f32x4 v[2][4];
#pragma unroll
        for (int r = 0; r < 2; ++r) { const f32x4* xr = (const f32x4*)(X + (size_t)(m0 + r) * DMODEL) + lane;
#pragma unroll
            for (int j = 0; j < 4; ++j) v[r][j] = xr[64 * j]; }
#pragma unroll
        for (int r = 0; r < 2; ++r) {
            const size_t m = (size_t)m0 + r;
            float s = 0.f;
#pragma unroll
            for (int j = 0; j < 4; ++j) s += (v[r][j].x * v[r][j].x + v[r][j].y * v[r][j].y) + (v[r][j].z * v[r][j].z + v[r][j].w * v[r][j].w);
            s = wave_sum(s);
            u32x2* o = (u32x2*)(XB + m * DMODEL) + lane;
#pragma unroll
            for (int j = 0; j < 4; ++j) { u32x2 w; w.x = pk2(v[r][j].x, v[r][j].y); w.y = pk2(v[r][j].z, v[r][j].w); o[64 * j] = w; }
            if (lane == 0) { f32x4 o4 = {s, 0.f, 0.f, 0.f}; *(f32x4*)(ssq + m * 4) = o4; }
        }
    }
}
__device__ __forceinline__ void final_rows(const bf16_t* XB, const float* ssp, const float* g, float* OUT, int gw, int ngw, int lane, float tscale) {
    f32x4 gv[4];
#pragma unroll
    for (int j = 0; j < 4; ++j) gv[j] = ((const f32x4*)g)[lane + 64 * j];
    for (int m0 = gw * 4; m0 < NT; m0 += ngw * 4) {
        u32x2 w[4][4]; f32x4 sp[4];
#pragma unroll
        for (int r = 0; r < 4; ++r) { const size_t m = (size_t)m0 + r; sp[r] = *(const f32x4*)(ssp + m * 4); const u32x2* xr = (const u32x2*)(XB + m * DMODEL) + lane;
#pragma unroll
            for (int j = 0; j < 4; ++j) w[r][j] = xr[64 * j]; }
#pragma unroll
        for (int r = 0; r < 4; ++r) {
            const float rs = rsqrtf(((sp[r].x + sp[r].y) + (sp[r].z + sp[r].w)) * (1.f / DMODEL) + EPS) * tscale;
            f32x4* o = (f32x4*)(OUT + (size_t)(m0 + r) * DMODEL) + lane;
#pragma unroll
            for (int j = 0; j < 4; ++j) { f32x4 v = {bflo(w[r][j].x), bfhi(w[r][j].x), bflo(w[r][j].y), bfhi(w[r][j].y)}; o[64 * j] = v * rs * gv[j]; }
        }
    }
}
__device__ __forceinline__ void norm_rows_f32_inplace(float* X, const float* g, int gw, int ngw, int lane) {
    f32x4 gv[4];
#pragma unroll
    for (int j = 0; j < 4; ++j) gv[j] = ((const f32x4*)g)[lane + 64 * j];
    for (int m = gw; m < NT; m += ngw) {
        f32x4* xr = (f32x4*)(X + (size_t)m * DMODEL) + lane;
        f32x4 v[4]; float s = 0.f;
#pragma unroll
        for (int j = 0; j < 4; ++j) { v[j] = xr[64 * j]; s += (v[j].x * v[j].x + v[j].y * v[j].y) + (v[j].z * v[j].z + v[j].w * v[j].w); }
        const float rs = rsqrtf(wave_sum(s) * (1.f / DMODEL) + EPS);
#pragma unroll
        for (int j = 0; j < 4; ++j) xr[64 * j] = v[j] * rs * gv[j];
    }
}

struct C3Regs { u32x4 hh[6], cc[6], bb[4]; };
__device__ __forceinline__ void conv3_issue(const bf16_t* P, int w, C3Regs& R) {
    const int c8 = w & 31, tok = (w >> 5) * 4, t = tok & (SEQ - 1);
    const bf16_t* base = P + (size_t)tok * NIN + c8 * 8;
#pragma unroll
    for (int i = 0; i < 6; ++i) { const int dt = (t == 0 && i < 2) ? 0 : i - 2; R.hh[i] = *(const u32x4*)(base + dt * NIN); R.cc[i] = *(const u32x4*)(base + dt * NIN + 512); }
#pragma unroll
    for (int i = 0; i < 4; ++i) R.bb[i] = *(const u32x4*)(base + i * NIN + 256);
}
__device__ __forceinline__ void mul8(const u32x4 a, const u32x4 b, float (&o)[8]) {
    o[0] = bflo(a.x) * bflo(b.x); o[1] = bfhi(a.x) * bfhi(b.x); o[2] = bflo(a.y) * bflo(b.y); o[3] = bfhi(a.y) * bfhi(b.y);
    o[4] = bflo(a.z) * bflo(b.z); o[5] = bfhi(a.z) * bfhi(b.z); o[6] = bflo(a.w) * bflo(b.w); o[7] = bfhi(a.w) * bfhi(b.w);
}
__device__ __forceinline__ void conv3_compute(bf16_t* H, int w, const C3Regs& R, const float (&w0)[8], const float (&w1)[8], const float (&w2)[8], const float (&gm)[8]) {
    const int c8 = w & 31, tok = (w >> 5) * 4, t = tok & (SEQ - 1);
    const float z01 = (t == 0) ? 0.f : 1.f;
    float g[6][8];
#pragma unroll
    for (int i = 0; i < 6; ++i) mul8(R.hh[i], R.cc[i], g[i]);
#pragma unroll
    for (int j = 0; j < 8; ++j) { g[0][j] *= z01; g[1][j] *= z01; }
#pragma unroll
    for (int i = 0; i < 4; ++i) {
        const u32x4 bv = R.bb[i];
        const float bb[8] = {bflo(bv.x), bfhi(bv.x), bflo(bv.y), bfhi(bv.y), bflo(bv.z), bfhi(bv.z), bflo(bv.w), bfhi(bv.w)};
        float y[8]; float sq = 0.f;
#pragma unroll
        for (int j = 0; j < 8; ++j) { y[j] = bb[j] * (w0[j] * g[i][j] + w1[j] * g[i + 1][j] + w2[j] * g[i + 2][j]); sq += y[j] * y[j]; }
#pragma unroll
        for (int o = 1; o < 32; o <<= 1) sq += __shfl_xor(sq, o);
        const float rs = rsqrtf(sq * (1.f / 256.f) + EPS);
        u32x4 o4; o4.x = pk2(y[0] * rs * gm[0], y[1] * rs * gm[1]); o4.y = pk2(y[2] * rs * gm[2], y[3] * rs * gm[3]); o4.z = pk2(y[4] * rs * gm[4], y[5] * rs * gm[5]); o4.w = pk2(y[6] * rs * gm[6], y[7] * rs * gm[7]);
        *(u32x4*)(H + (size_t)(tok + i) * DMODEL + c8 * 8) = o4;
    }
}
__device__ __forceinline__ void conv3_phase(const bf16_t* P, bf16_t* H, const float* w3, const float* gn, int bx, int G, int tid) {
    constexpr int NW = NT / 4 * 32;
    const int c8 = tid & 31;
    float w0[8], w1[8], w2[8], gm[8];
#pragma unroll
    for (int j = 0; j < 8; ++j) { w0[j] = w3[c8 * 8 + j]; w1[j] = w3[256 + c8 * 8 + j]; w2[j] = w3[512 + c8 * 8 + j]; gm[j] = gn[c8 * 8 + j]; }
    C3Regs Ra, Rb;
    int w = bx * NTHREADS + tid; const int step = G * NTHREADS;
    if (w < NW) conv3_issue(P, w, Ra);
    for (; w < NW; w += 2 * step) {
        if (w + step < NW) conv3_issue(P, w + step, Rb);
        conv3_compute(H, w, Ra, w0, w1, w2, gm);
        if (w + step < NW) { if (w + 2 * step < NW) conv3_issue(P, w + 2 * step, Ra); conv3_compute(H, w + step, Rb, w0, w1, w2, gm); }
    }
}

constexpr int CF_ZOFF = 0, CF_STOFF = 94 * 1024;
__device__ __forceinline__ void cfm_issue(const bf16_t* P, int tix, int tid, u32x4 (&ar)[6], u32x4 (&gr)[6]) {
    const int b = tix >> 6, t0 = (tix & 63) * 64;
#pragma unroll
    for (int k = 0; k < 6; ++k) {
        int e = tid + NTHREADS * k; e = e < 94 * 32 ? e : 94 * 32 - 1;
        const int row = e >> 5, c8 = e & 31; int t = t0 - 30 + row; t = t < 0 ? 0 : t;
        const bf16_t* src = P + ((size_t)b * SEQ + t) * NIN + 768 + c8 * 8;
        ar[k] = *(const u32x4*)src; gr[k] = *(const u32x4*)(src + 256);
    }
}
__device__ __forceinline__ void cfm_stage(LAS unsigned char* lds, int tix, int tid, const u32x4 (&ar)[6], const u32x4 (&gr)[6]) {
    const int t0 = (tix & 63) * 64;
    LAS float* ZT = (LAS float*)(lds + CF_ZOFF);
#pragma unroll
    for (int k = 0; k < 6; ++k) {
        const int e = tid + NTHREADS * k;
        if (e < 94 * 32) {
            const int row = e >> 5, c8 = e & 31; const float zm = (t0 - 30 + row < 0) ? 0.f : 1.f;
            const u32x4 a = ar[k], g = gr[k];
            f32x4 z0, z1;
            z0[0] = bflo(a.x) * sigmoidf_(bflo(g.x)) * zm; z0[1] = bfhi(a.x) * sigmoidf_(bfhi(g.x)) * zm; z0[2] = bflo(a.y) * sigmoidf_(bflo(g.y)) * zm; z0[3] = bfhi(a.y) * sigmoidf_(bfhi(g.y)) * zm;
            z1[0] = bflo(a.z) * sigmoidf_(bflo(g.z)) * zm; z1[1] = bfhi(a.z) * sigmoidf_(bfhi(g.z)) * zm; z1[2] = bflo(a.w) * sigmoidf_(bflo(g.w)) * zm; z1[3] = bfhi(a.w) * sigmoidf_(bfhi(g.w)) * zm;
            *(LAS f32x4*)(ZT + row * 256 + c8 * 8) = z0; *(LAS f32x4*)(ZT + row * 256 + c8 * 8 + 4) = z1;
        }
    }
}
__device__ __forceinline__ void cfm_phase(LAS unsigned char* lds, const bf16_t* P, bf16_t* H, const float* dww, const float* dwb, const float* lng, const float* lnb, const float* gn,
                                          int bx, int G, int tid, int wid, int lane) {
    const int cp = tid & 127, rr = tid >> 7;
    f32x2v w[31];
#pragma unroll
    for (int k = 0; k < 31; ++k) w[k] = *(const f32x2v*)(dww + k * 256 + 2 * cp);
    const f32x2v bias = *(const f32x2v*)(dwb + 2 * cp), lg = *(const f32x2v*)(lng + 2 * cp), lb = *(const f32x2v*)(lnb + 2 * cp), gmm = *(const f32x2v*)(gn + 256 + 2 * cp);
    LAS float* ZT = (LAS float*)(lds + CF_ZOFF);
    LAS float* STX = (LAS float*)(lds + CF_STOFF);
    u32x4 ar[6], gr[6];
    int tix = bx;
    if (tix < 1024) cfm_issue(P, tix, tid, ar, gr);
    for (; tix < 1024; tix += G) {
        __syncthreads();
        cfm_stage(lds, tix, tid, ar, gr);
        if (tix + G < 1024) cfm_issue(P, tix + G, tid, ar, gr);
        __syncthreads();
        f32x2v acc[16];
#pragma unroll
        for (int j = 0; j < 16; ++j) acc[j] = bias;
#pragma unroll
        for (int s = 0; s < 46; ++s) {
            const f32x2v z = *(const LAS f32x2v*)(ZT + (rr * 16 + s) * 256 + 2 * cp);
#pragma unroll
            for (int j = 0; j < 16; ++j) { const int k = s - j; if (k >= 0 && k <= 30) acc[j] += w[k] * z; }
        }
        float s1[16], s2[16];
#pragma unroll
        for (int j = 0; j < 16; ++j) { s1[j] = wave_sum(acc[j].x + acc[j].y); s2[j] = wave_sum(acc[j].x * acc[j].x + acc[j].y * acc[j].y); }
        if (lane == 0) {
#pragma unroll
            for (int j = 0; j < 16; ++j) { STX[wid * 32 + j] = s1[j]; STX[wid * 32 + 16 + j] = s2[j]; }
        }
        __syncthreads();
        const int b = tix >> 6, t0 = (tix & 63) * 64;
        float s3[16];
#pragma unroll
        for (int j = 0; j < 16; ++j) {
            const float S1 = s1[j] + STX[(wid ^ 1) * 32 + j], S2 = s2[j] + STX[(wid ^ 1) * 32 + 16 + j];
            const float mean = S1 * (1.f / 256.f), var = fmaxf(S2 * (1.f / 256.f) - mean * mean, 0.f), rs = rsqrtf(var + EPS);
            f32x2v y = (acc[j] - mean) * rs * lg + lb;
            y.x = y.x * sigmoidf_(y.x); y.y = y.y * sigmoidf_(y.y);
            acc[j] = y;
            s3[j] = wave_sum(y.x * y.x + y.y * y.y);
        }
        if (lane == 0) {
#pragma unroll
            for (int j = 0; j < 16; ++j) STX[256 + wid * 16 + j] = s3[j];
        }
        __syncthreads();
#pragma unroll
        for (int j = 0; j < 16; ++j) {
            const float rs = rsqrtf((s3[j] + STX[256 + (wid ^ 1) * 16 + j]) * (1.f / 256.f) + EPS);
            *(unsigned*)(H + ((size_t)b * SEQ + t0 + rr * 16 + j) * DMODEL + 256 + 2 * cp) = pk2(acc[j].x * rs * gmm.x, acc[j].y * rs * gmm.y);
        }
    }
}

template <bool FULL> __device__ __forceinline__ void ssm_tile_scan(f32x16& xr, f32x16& xi, const float (&pw)[4][2], float& cr, float& ci, const bool hi) {
    const float l1r = pw[0][0], l1i = pw[0][1], l4r = pw[3][0], l4i = pw[3][1];
#pragma unroll
    for (int G = 0; G < 4; ++G)
#pragma unroll
        for (int j = 1; j < 4; ++j) { const int i = 4 * G + j; const float pr = xr[i - 1], pi = xi[i - 1]; xr[i] += l1r * pr - l1i * pi; xi[i] += l1r * pi + l1i * pr; }
    float cinr[4], cini[4];
#pragma unroll
    for (int G = 0; G < 4; ++G) {
        const float er = xr[4 * G + 3], ei = xi[4 * G + 3];
        const float orr = __shfl_xor(er, 32), oi = __shfl_xor(ei, 32);
        const float e0r = hi ? orr : er, e0i = hi ? oi : ei, e1r = hi ? er : orr, e1i = hi ? ei : oi;
        const float c1r = l4r * cr - l4i * ci + e0r, c1i = l4r * ci + l4i * cr + e0i;
        cinr[G] = hi ? c1r : cr; cini[G] = hi ? c1i : ci;
        const float c2r = l4r * c1r - l4i * c1i + e1r, c2i = l4r * c1i + l4i * c1r + e1i;
        cr = c2r; ci = c2i;
    }
    if (FULL) {
#pragma unroll
        for (int G = 0; G < 4; ++G)
#pragma unroll
            for (int j = 0; j < 4; ++j) { const int i = 4 * G + j; xr[i] += pw[j][0] * cinr[G] - pw[j][1] * cini[G]; xi[i] += pw[j][0] * cini[G] + pw[j][1] * cinr[G]; }
    }
}
constexpr int SSM_ROWB = 272;
__device__ __forceinline__ void ssm_item(LAS unsigned char* lds, const bf16_t* P, bf16_t* ZB, const float* a_re, const float* a_im, const float* log_dt, const float* b_re, const float* b_im,
                                         const float* c_re, const float* c_im, const float* d_skip, int item, int tid, int wid, int lane) {
    const int b = item >> 4, g = item & 15;
    const int r32 = lane & 31, h = lane >> 5; const bool hi = h != 0;
    LAS f32x2v* EW = (LAS f32x2v*)lds;
    LAS unsigned char* SBW = lds + 4096 + wid * (32 * SSM_ROWB);
    __syncthreads();
    float pw[2][4][2]; bf16x8 bfr[2][2];
#pragma unroll
    for (int tp = 0; tp < 2; ++tp) {
        const int p = r32 + 32 * tp;
        const float dt = __expf(log_dt[g]);
        const float ar = a_re[g * 64 + p], ai = a_im[g * 64 + p];
        const float mag = __expf(ar * dt);
        const float lr = mag * cosf(ai * dt), li = mag * sinf(ai * dt);
        const float den = ar * ar + ai * ai, nr = lr - 1.f, ni = li;
        const float fr = (nr * ar + ni * ai) / den, fi = (ni * ar - nr * ai) / den;
        const f32x4* br4 = (const f32x4*)(b_re + (size_t)(g * 64 + p) * 16 + 8 * h); const f32x4* bi4 = (const f32x4*)(b_im + (size_t)(g * 64 + p) * 16 + 8 * h);
        const f32x4 r0 = br4[0], r1 = br4[1], i0 = bi4[0], i1 = bi4[1];
        const f32x4 re0 = fr * r0 - fi * i0, re1 = fr * r1 - fi * i1, im0 = fr * i0 + fi * r0, im1 = fr * i1 + fi * r1;
        u32x4 wre, wim;
        wre.x = pk2(re0[0], re0[1]); wre.y = pk2(re0[2], re0[3]); wre.z = pk2(re1[0], re1[1]); wre.w = pk2(re1[2], re1[3]);
        wim.x = pk2(im0[0], im0[1]); wim.y = pk2(im0[2], im0[3]); wim.z = pk2(im1[0], im1[1]); wim.w = pk2(im1[2], im1[3]);
        bfr[tp][0] = __builtin_bit_cast(bf16x8, wre); bfr[tp][1] = __builtin_bit_cast(bf16x8, wim);
        pw[tp][0][0] = lr; pw[tp][0][1] = li;
#pragma unroll
        for (int j = 1; j < 4; ++j) { pw[tp][j][0] = pw[tp][j - 1][0] * lr - pw[tp][j - 1][1] * li; pw[tp][j][1] = pw[tp][j - 1][0] * li + pw[tp][j - 1][1] * lr; }
    }
    const int t16 = lane & 15, quad = lane >> 4;
    bf16x8 cfr[4];
#pragma unroll
    for (int s = 0; s < 4; ++s) {
        const f32x4 cr4 = *(const f32x4*)(c_re + (size_t)(g * 16 + t16) * 64 + 4 * quad + 16 * s), ci4 = *(const f32x4*)(c_im + (size_t)(g * 16 + t16) * 64 + 4 * quad + 16 * s);
        u32x4 w; w.x = pk2(cr4[0], -ci4[0]); w.y = pk2(cr4[1], -ci4[1]); w.z = pk2(cr4[2], -ci4[2]); w.w = pk2(cr4[3], -ci4[3]);
        cfr[s] = __builtin_bit_cast(bf16x8, w);
    }
    const f32x4 dsk = *(const f32x4*)(d_skip + g * 16 + 4 * quad);
    const size_t tok0 = (size_t)b * SEQ + (size_t)wid * 512;
    const bf16_t* ubase = P + tok0 * NIN + 1280 + g * 16;
    f32x16 zero16;
#pragma unroll
    for (int q = 0; q < 16; ++q) zero16[q] = 0.f;
    float cr[2] = {0.f, 0.f}, ci[2] = {0.f, 0.f};
    {
        bf16x8 ua = *(const bf16x8*)(ubase + (size_t)r32 * NIN + 8 * h);
        for (int mt = 0; mt < 16; ++mt) {
            const bf16x8 un = *(const bf16x8*)(ubase + (size_t)((mt < 15 ? mt + 1 : mt) * 32 + r32) * NIN + 8 * h);
#pragma unroll
            for (int tp = 0; tp < 2; ++tp) {
                f32x16 xr = __builtin_amdgcn_mfma_f32_32x32x16_bf16(ua, bfr[tp][0], zero16, 0, 0, 0);
                f32x16 xi = __builtin_amdgcn_mfma_f32_32x32x16_bf16(ua, bfr[tp][1], zero16, 0, 0, 0);
                ssm_tile_scan<false>(xr, xi, pw[tp], cr[tp], ci[tp], hi);
            }
            ua = un;
        }
    }
    if (!hi) { f32x2v e0 = {cr[0], ci[0]}, e1 = {cr[1], ci[1]}; EW[wid * 64 + r32] = e0; EW[wid * 64 + 32 + r32] = e1; }
    __syncthreads();
#pragma unroll
    for (int tp = 0; tp < 2; ++tp) {
        float qr = pw[tp][3][0], qi = pw[tp][3][1];
#pragma unroll
        for (int q = 0; q < 7; ++q) { const float nr = qr * qr - qi * qi, ni = 2.f * qr * qi; qr = nr; qi = ni; }
        float sr = 0.f, si = 0.f;
        for (int w = 0; w < wid; ++w) { const f32x2v e = EW[w * 64 + r32 + 32 * tp]; const float nr = qr * sr - qi * si + e.x, ni = qr * si + qi * sr + e.y; sr = nr; si = ni; }
        cr[tp] = sr; ci[tp] = si;
    }
    {
        bf16x8 ua = *(const bf16x8*)(ubase + (size_t)r32 * NIN + 8 * h);
        for (int mt = 0; mt < 16; ++mt) {
            const bf16x8 un = *(const bf16x8*)(ubase + (size_t)((mt < 15 ? mt + 1 : mt) * 32 + r32) * NIN + 8 * h);
            u32x2 uwv[2];
#pragma unroll
            for (int tt = 0; tt < 2; ++tt) uwv[tt] = *(const u32x2*)(P + (tok0 + mt * 32 + tt * 16 + t16) * NIN + 1280 + g * 16 + 4 * quad);
#pragma unroll
            for (int tp = 0; tp < 2; ++tp) {
                f32x16 xr = __builtin_amdgcn_mfma_f32_32x32x16_bf16(ua, bfr[tp][0], zero16, 0, 0, 0);
                f32x16 xi = __builtin_amdgcn_mfma_f32_32x32x16_bf16(ua, bfr[tp][1], zero16, 0, 0, 0);
                ssm_tile_scan<true>(xr, xi, pw[tp], cr[tp], ci[tp], hi);
#pragma unroll
                for (int i = 0; i < 16; ++i) {
                    const int t = (i & 3) + 8 * (i >> 2) + 4 * h;
                    *(LAS unsigned*)(SBW + t * SSM_ROWB + 4 * (r32 + 32 * tp)) = pk2(xr[i], xi[i]);
                }
            }
            WAVE_LDS_SYNC();
#pragma unroll
            for (int tt = 0; tt < 2; ++tt) {
                f32x4 acc = {0.f, 0.f, 0.f, 0.f};
#pragma unroll
                for (int s = 0; s < 4; ++s) {
                    const bf16x8 sf = *(const LAS bf16x8*)(SBW + (tt * 16 + t16) * SSM_ROWB + quad * 16 + 64 * s);
                    acc = __builtin_amdgcn_mfma_f32_16x16x32_bf16(cfr[s], sf, acc, 0, 0, 0);
                }
                const size_t tok = tok0 + mt * 32 + tt * 16 + t16;
                const u32x2 uw = uwv[tt];
                const f32x4 uu = {bflo(uw.x), bfhi(uw.x), bflo(uw.y), bfhi(uw.y)};
                const f32x4 y = acc + dsk * uu;
                u32x2 w; w.x = pk2(gelu_tanh(y.x), gelu_tanh(y.y)); w.y = pk2(gelu_tanh(y.z), gelu_tanh(y.w));
                *(u32x2*)(ZB + tok * 256 + g * 16 + 4 * quad) = w;
            }
            WAVE_LDS_SYNC();
            ua = un;
        }
    }
}

constexpr int AT_ROWB = 144, AT_KOFF = 0, AT_VOFF = 384 * AT_ROWB;
__device__ __forceinline__ s16x4 vtr(const LAS unsigned char* p) { return __builtin_bit_cast(s16x4, __builtin_amdgcn_ds_read_tr16_b64_v4i16((LAS s16x4*)p)); }
struct AttnU { int pat, head, d, ub; size_t rowbase; };
__device__ __forceinline__ AttnU attn_decode(int u) {
    AttnU U; const int rem = u & 1023, b = rem >> 6, ru = rem & 15; U.pat = u >> 10; U.head = (rem >> 4) & 3;
    int r;
    if (U.pat == 0) { U.d = 1; r = 0; U.ub = ru; } else if (U.pat == 1) { U.d = 4; r = ru >> 2; U.ub = ru & 3; } else { U.d = 16; r = ru; U.ub = 0; }
    U.rowbase = (size_t)b * SEQ + r; return U;
}
__device__ __forceinline__ void attn_issue(const bf16_t* P, const AttnU& U, int tid, int wid, int lane, u32x4 (&kreg)[6], u32x4 (&vreg)[6], bf16x8 (&qf)[4]) {
    const int i0 = U.ub * 256 - 128;
#pragma unroll
    for (int k = 0; k < 6; ++k) {
        const int e = tid + NTHREADS * k, row = e >> 3, c = e & 7; int si = i0 + row; si = si < 0 ? 0 : si;
        const bf16_t* src = P + (U.rowbase + (size_t)si * U.d) * NIN + U.head * 64 + c * 8;
        kreg[k] = *(const u32x4*)(src + 1792); vreg[k] = *(const u32x4*)(src + 2048);
    }
    const int r32 = lane & 31, h = lane >> 5;
    const size_t qtok = U.rowbase + (size_t)(U.ub * 256 + 32 * wid + r32) * U.d;
    const bf16_t* qp = P + qtok * NIN + 1536 + U.head * 64 + 8 * h;
#pragma unroll
    for (int s = 0; s < 4; ++s) qf[s] = *(const bf16x8*)(qp + 16 * s);
}
__device__ __forceinline__ void attn_to_lds(LAS unsigned char* lds, int tid, const u32x4 (&kreg)[6], const u32x4 (&vreg)[6]) {
#pragma unroll
    for (int k = 0; k < 6; ++k) {
        const int e = tid + NTHREADS * k, row = e >> 3, c = e & 7;
        *(LAS u32x4*)(lds + AT_KOFF + row * AT_ROWB + c * 16) = kreg[k];
        *(LAS u32x4*)(lds + AT_VOFF + row * AT_ROWB + c * 16) = vreg[k];
    }
}
__device__ __forceinline__ void attn_compute(LAS unsigned char* lds, const AttnU& U, const bf16x8 (&qf)[4], bf16_t* OB, f32x2v* ST, int wid, int lane) {
    const int pat = U.pat, head = U.head, ub = U.ub;
    const int r32 = lane & 31, h = lane >> 5;
    const size_t qtok = U.rowbase + (size_t)(ub * 256 + 32 * wid + r32) * U.d;
    f32x16 sc[5];
    float mx = -1e30f;
    const float r32f = (float)r32, h4f = (float)(4 * h);
#pragma unroll
    for (int i = 0; i < 5; ++i) {
        const bool tv = (ub > 0) || (wid + i >= 4);
        f32x16 a;
        if (tv) {
#pragma unroll
            for (int q = 0; q < 16; ++q) a[q] = 0.f;
            const LAS unsigned char* kp = lds + AT_KOFF + (32 * wid + 32 * i + r32) * AT_ROWB + 16 * h;
#pragma unroll
            for (int s = 0; s < 4; ++s) { const bf16x8 kf = *(const LAS bf16x8*)(kp + 32 * s); a = __builtin_amdgcn_mfma_f32_32x32x16_bf16(kf, qf[s], a, 0, 0, 0); }
            if (i == 0 || i == 4) {
#pragma unroll
                for (int q = 0; q < 16; ++q) {
                    const float diff = ((float)((q & 3) + 8 * (q >> 2)) + h4f) - r32f;
                    a[q] = (i == 0) ? __builtin_fmaf(fminf(diff, 0.f), 1e30f, a[q]) : __builtin_fmaf(fmaxf(diff, 0.f), -1e30f, a[q]);
                }
            }
#pragma unroll
            for (int q = 0; q < 16; ++q) mx = fmaxf(mx, a[q]);
        } else {
#pragma unroll
            for (int q = 0; q < 16; ++q) a[q] = -1e30f;
        }
        sc[i] = a;
    }
    mx = fmaxf(mx, __shfl_xor(mx, 32));
    float l = 0.f;
#pragma unroll
    for (int i = 0; i < 5; ++i)
#pragma unroll
        for (int q = 0; q < 16; ++q) { const float pv = __builtin_amdgcn_exp2f(sc[i][q] - mx); sc[i][q] = pv; l += pv; }
    l += __shfl_xor(l, 32);
    f32x16 o0, o1;
#pragma unroll
    for (int q = 0; q < 16; ++q) { o0[q] = 0.f; o1[q] = 0.f; }
    const int i16 = lane & 15, q4 = i16 >> 2, p4 = i16 & 3, blk = (lane >> 4) & 1;
#pragma unroll
    for (int i = 0; i < 5; ++i) {
        const bool tv = (ub > 0) || (wid + i >= 4);
        if (tv) {
#pragma unroll
            for (int s2 = 0; s2 < 2; ++s2) {
                u32x4 pw; pw.x = pk2(sc[i][8 * s2], sc[i][8 * s2 + 1]); pw.y = pk2(sc[i][8 * s2 + 2], sc[i][8 * s2 + 3]); pw.z = pk2(sc[i][8 * s2 + 4], sc[i][8 * s2 + 5]); pw.w = pk2(sc[i][8 * s2 + 6], sc[i][8 * s2 + 7]);
                const bf16x8 pb = __builtin_bit_cast(bf16x8, pw);
                const LAS unsigned char* vp = lds + AT_VOFF + (32 * wid + 32 * i + 16 * s2 + 4 * h + q4) * AT_ROWB + 32 * blk + 8 * p4;
                const s16x4 lo0 = vtr(vp), hi0 = vtr(vp + 8 * AT_ROWB), lo1 = vtr(vp + 64), hi1 = vtr(vp + 8 * AT_ROWB + 64);
                const bf16x8 va0 = __builtin_shufflevector(lo0, hi0, 0, 1, 2, 3, 4, 5, 6, 7), va1 = __builtin_shufflevector(lo1, hi1, 0, 1, 2, 3, 4, 5, 6, 7);
                o0 = __builtin_amdgcn_mfma_f32_32x32x16_bf16(va0, pb, o0, 0, 0, 0);
                o1 = __builtin_amdgcn_mfma_f32_32x32x16_bf16(va1, pb, o1, 0, 0, 0);
            }
        }
    }
    const float inv = 1.f / l;
    bf16_t* op = OB + ((size_t)pat * NT + qtok) * 256 + head * 64 + 4 * h;
#pragma unroll
    for (int g4 = 0; g4 < 4; ++g4) {
        u32x2 w0, w1;
        w0.x = pk2(o0[4 * g4] * inv, o0[4 * g4 + 1] * inv); w0.y = pk2(o0[4 * g4 + 2] * inv, o0[4 * g4 + 3] * inv);
        w1.x = pk2(o1[4 * g4] * inv, o1[4 * g4 + 1] * inv); w1.y = pk2(o1[4 * g4 + 2] * inv, o1[4 * g4 + 3] * inv);
        *(u32x2*)(op + 8 * g4) = w0; *(u32x2*)(op + 32 + 8 * g4) = w1;
    }
    if (h == 0) { f32x2v st = {mx, l}; ST[(qtok * 4 + head) * 3 + pat] = st; }
}

__device__ __forceinline__ void combine_rows(const bf16_t* YC, const bf16_t* OB, const f32x2v* ST, const float* gn, bf16_t* H, int gw, int ngw, int lane) {
    f32x4 gv[2];
#pragma unroll
    for (int j = 0; j < 2; ++j) gv[j] = ((const f32x4*)gn)[lane + 64 * (j + 2)];
    const int head = lane >> 4;
    for (int m0 = gw * 4; m0 < NT; m0 += ngw * 4) {
        u32x2 yw[4], a0[4], a1[4], a2[4]; f32x2v s0[4], s1[4], s2[4];
#pragma unroll
        for (int r = 0; r < 4; ++r) {
            const size_t m = (size_t)m0 + r;
            yw[r] = *((const u32x2*)(YC + m * 768 + 512) + lane);
            s0[r] = ST[(m * 4 + head) * 3 + 0]; s1[r] = ST[(m * 4 + head) * 3 + 1]; s2[r] = ST[(m * 4 + head) * 3 + 2];
            a0[r] = *((const u32x2*)(OB + m * 256) + lane); a1[r] = *((const u32x2*)(OB + ((size_t)NT + m) * 256) + lane); a2[r] = *((const u32x2*)(OB + ((size_t)2 * NT + m) * 256) + lane);
        }
#pragma unroll
        for (int r = 0; r < 4; ++r) {
            const size_t m = (size_t)m0 + r;
            f32x4 v[2];
            v[0] = (f32x4){bflo(yw[r].x), bfhi(yw[r].x), bflo(yw[r].y), bfhi(yw[r].y)};
            {
                const float M = fmaxf(s0[r].x, fmaxf(s1[r].x, s2[r].x));
                const float w0 = __builtin_amdgcn_exp2f(s0[r].x - M) * s0[r].y, w1 = __builtin_amdgcn_exp2f(s1[r].x - M) * s1[r].y, w2 = __builtin_amdgcn_exp2f(s2[r].x - M) * s2[r].y;
                const float iw = __builtin_amdgcn_rcpf(w0 + w1 + w2);
                f32x4 o;
                o.x = (w0 * bflo(a0[r].x) + w1 * bflo(a1[r].x) + w2 * bflo(a2[r].x)) * iw; o.y = (w0 * bfhi(a0[r].x) + w1 * bfhi(a1[r].x) + w2 * bfhi(a2[r].x)) * iw;
                o.z = (w0 * bflo(a0[r].y) + w1 * bflo(a1[r].y) + w2 * bflo(a2[r].y)) * iw; o.w = (w0 * bfhi(a0[r].y) + w1 * bfhi(a1[r].y) + w2 * bfhi(a2[r].y)) * iw;
                v[1] = o;
            }
#pragma unroll
            for (int j = 0; j < 2; ++j) {
                const float ss = wave_sum((v[j].x * v[j].x + v[j].y * v[j].y) + (v[j].z * v[j].z + v[j].w * v[j].w));
                const float rs = rsqrtf(ss * (1.f / 256.f) + EPS);
                u32x2 w; w.x = pk2(v[j].x * rs * gv[j].x, v[j].y * rs * gv[j].y); w.y = pk2(v[j].z * rs * gv[j].z, v[j].w * rs * gv[j].w);
                *((u32x2*)(H + m * DMODEL + 256 * (j + 2)) + lane) = w;
            }
        }
    }
}

#define XB_TMO      128
#define XB_XCNT(j)  (256  + 64 * (j))
#define XB_XSUB(j)  (1280 + 64 * (j))
#define XB_XGEN(j)  (2304 + 64 * (j))
#define XB_TOP      3328
#define XB_TOPGEN   3392
#define XCD_BAR_WORDS 3456
#define XB_SPIN_CAP (1u << 18)

__device__ __forceinline__ unsigned xb_ld(unsigned* p)              { return __hip_atomic_load(p, __ATOMIC_RELAXED, __HIP_MEMORY_SCOPE_AGENT); }
__device__ __forceinline__ unsigned xb_add(unsigned* p, unsigned v) { return __hip_atomic_fetch_add(p, v, __ATOMIC_RELAXED, __HIP_MEMORY_SCOPE_AGENT); }
__device__ __forceinline__ unsigned xb_xcc_id() { return (unsigned)__builtin_amdgcn_s_getreg((3 << 11) | 20) & 0xFu; }
#define XB_SPIN(cond, bar) do { unsigned _sp = 0; while (cond) { __builtin_amdgcn_s_sleep(1); \
    if ((++_sp & 255u) == 0u) { if (xb_ld(&(bar)[XB_TMO])) break; if (_sp > XB_SPIN_CAP) { atomicAdd(&(bar)[XB_TMO], 1u); break; } } } } while (0)

struct XcdBarrier {
    unsigned* bar; unsigned x;
    volatile LAS unsigned* st;
};

__device__ __forceinline__ XcdBarrier xcd_barrier_post(unsigned* bar, volatile LAS unsigned* st) {
    XcdBarrier b; b.bar = bar; b.x = xb_xcc_id(); b.st = st;
    if (threadIdx.x == 0) (void)xb_add(&bar[XB_XCNT(b.x)], 1u);
    return b;
}
__device__ __forceinline__ void xcd_barrier_complete(unsigned* bar, unsigned x, unsigned& nloc, unsigned& nx) {
    const unsigned G = gridDim.x * gridDim.y * gridDim.z;
    unsigned sum, cnt, mine, sp = 0u;
    for (;;) {
        sum = 0u; cnt = 0u; mine = 0u;
#pragma unroll
        for (unsigned j = 0; j < 16; ++j) { const unsigned c = xb_ld(&bar[XB_XCNT(j)]); sum += c; cnt += (c > 0u) ? 1u : 0u; mine = (j == x) ? c : mine; }
        if (sum == G) break;
        __builtin_amdgcn_s_sleep(1);
        if ((++sp & 255u) == 0u) { if (xb_ld(&bar[XB_TMO])) break; if (sp > XB_SPIN_CAP) { atomicAdd(&bar[XB_TMO], 1u); break; } }
    }
    nloc = mine > 0u ? mine : 1u; nx = cnt > 0u ? cnt : 1u;
}

__device__ __forceinline__ void xcd_barrier(const XcdBarrier& b) {
    asm volatile("s_waitcnt vmcnt(0)" ::: "memory");
    __syncthreads();
    if (threadIdx.x == 0) {
        unsigned* bar = b.bar;
        __builtin_amdgcn_s_waitcnt(0);
        unsigned nloc = b.st[0], nx = b.st[1];
        if (nloc == 0u) { xcd_barrier_complete(bar, b.x, nloc, nx); b.st[0] = nloc; b.st[1] = nx; }
        const unsigned old = xb_add(&bar[XB_XSUB(b.x)], 1u);
        const unsigned gen = old / nloc;
        if (old + 1u == (gen + 1u) * nloc) {
            __builtin_amdgcn_fence(__ATOMIC_RELEASE, "agent");
            asm volatile("s_waitcnt vmcnt(0)" ::: "memory");
            const unsigned og = xb_add(&bar[XB_TOP], 1u);
            const unsigned tg = og / nx;
            if (og + 1u == (tg + 1u) * nx) xb_add(&bar[XB_TOPGEN], 1u);
            else XB_SPIN(xb_ld(&bar[XB_TOPGEN]) == tg, bar);
            __builtin_amdgcn_fence(__ATOMIC_ACQUIRE, "agent");
            xb_add(&bar[XB_XGEN(b.x)], 1u);
            asm volatile("s_waitcnt vmcnt(0)" ::: "memory");
        } else {
            XB_SPIN(xb_ld(&bar[XB_XGEN(b.x)]) == gen, bar);
            __builtin_amdgcn_fence(__ATOMIC_ACQUIRE, "agent");
            asm volatile("s_waitcnt vmcnt(0)" ::: "memory");
        }
    }
    __syncthreads();
}

constexpr int NPHASE = 16;
struct Ctx { const Args* args; LAS unsigned char* lds; int tid, lane, wid, G, bx, gw, ngw; };
#define LAUNDER(p) asm volatile("" : "+s"(p))
__device__ __forceinline__ void phase_body(const int ph, const CAS Args* ap, LAS unsigned char* lds, const int tid, const int lane, const int wid, const int G, const int bx) {
    const int gw = bx * 8 + wid, ngw = G * 8;
    unsigned char* ws = ap->ws;
    const float* x_in = ap->in[0];
    float* X = ap->out;
    bf16_t* Hb = (bf16_t*)(ws + WS_H); bf16_t* Pb = (bf16_t*)(ws + WS_P); bf16_t* YC = (bf16_t*)(ws + WS_YC); bf16_t* ZB = (bf16_t*)(ws + WS_ZB); bf16_t* OB = (bf16_t*)(ws + WS_OB);
    f32x2v* ST = (f32x2v*)(ws + WS_ST);
    float* ropec = (float*)(ws + WS_ROPE); float* ropes = ropec + SEQ * 32;
    bf16_t* XB = (bf16_t*)(ws + WS_XB); float* SS = (float*)(ws + WS_SS);
    if (ph == 0) {
        {
            float v[8], vn[8]; int t = 0, tn = 0;
            int it = bx;
            WMat w = wmat_of(ap, ws, it < 2 * 2976 ? it : 0, t), wn = w;
            if (it < 2 * 2976) wconv_load(w, t, tid, v);
            for (; it < 2 * 2976; it += G) {
                const bool more = it + G < 2 * 2976;
                if (more) { wn = wmat_of(ap, ws, it + G, tn); wconv_load(wn, tn, tid, vn); }
                wconv_store((LAS float*)lds, w, t, tid, v);
                if (more) {
#pragma unroll
                    for (int i = 0; i < 8; ++i) v[i] = vn[i];
                    w = wn; t = tn;
                }
            }
        }
        for (int e = bx * NTHREADS + tid; e < SEQ * 32; e += G * NTHREADS) {
            const int pos = e >> 5, i = e & 31;
            const double inv = (double)exp2f(-(float)i * (13.287712379549449f / 32.f));
            const float angf = (float)pos * (float)inv;
            double rev = (double)angf * 0.15915494309189535; rev -= floor(rev);
            ropec[e] = __builtin_amdgcn_cosf((float)rev); ropes[e] = __builtin_amdgcn_sinf((float)rev);
        }
        xb_rows(x_in, XB, SS, gw, ngw, lane);
        return;
    }
    if (ph == 15) {
        float tscale = 1.f;
#ifdef TIMED
        { const unsigned long long* ts = (const unsigned long long*)(ws + WS_BAR) + 1800; tscale = 1.f + (float)(ts[1] - ts[0]) * 1e-5f; }
#endif
        final_rows(XB, SS + (size_t)4 * NT * 4, ap->in[23], X, gw, ngw, lane, tscale); return; }
    const int layer = (ph - 1) / 7, sub = (ph - 1) % 7;
    unsigned char* wb = ws + WS_W + (size_t)layer * W_LAYER;
    if (sub == 0) {
        pg8::Gemm g{XB, (const bf16_t*)(wb + W_IN), NT, NIN, 1024}; pg8::StaticOrder S; S.init(NT, NIN, G, bx);
        EpiIn E{Pb, ropec, ropes, RowScale{SS + (size_t)(layer == 0 ? 0 : 2) * NT * 4, (LAS float*)(lds + 131072 + 4096)}};
        pg8::gemm_phase<EpiIn, pg8::StaticOrder, false, true>(lds, g, S, E);
    } else if (sub == 1) {
        const int rot = bx % 3;
#define RUN_S do { LAUNDER(ap); for (int it = bx; it < 256; it += G) \
            ssm_item(lds, Pb, ZB, ap->in[8] + layer * 1024, ap->in[9] + layer * 1024, ap->in[10] + layer * 16, ap->in[11] + (size_t)layer * 16384, ap->in[12] + (size_t)layer * 16384, \
                     ap->in[13] + (size_t)layer * 16384, ap->in[14] + (size_t)layer * 16384, ap->in[15] + layer * 256, it, tid, wid, lane); __syncthreads(); } while (0)
#define RUN_C do { LAUNDER(ap); conv3_phase(Pb, Hb, ap->in[3] + layer * 768, ap->in[17] + layer * 1024, bx, G, tid); \
            cfm_phase(lds, Pb, Hb, ap->in[4] + layer * 31 * 256, ap->in[5] + layer * 256, ap->in[6] + layer * 256, ap->in[7] + layer * 256, ap->in[17] + layer * 1024, bx, G, tid, wid, lane); __syncthreads(); } while (0)
        if (rot == 0) RUN_S;
        if (rot <= 1) RUN_C;
        {
            const int per = (3072 + G - 1) / G, it0 = bx * per, it1 = (it0 + per < 3072) ? it0 + per : 3072;
            u32x4 kreg[6], vreg[6]; bf16x8 qn[4], qc[4];
            int it = it0;
            AttnU U = attn_decode(it < it1 ? it : 0);
            if (it < it1) attn_issue(Pb, U, tid, wid, lane, kreg, vreg, qn);
            for (; it < it1; ++it) {
                __syncthreads();
                attn_to_lds(lds, tid, kreg, vreg);
#pragma unroll
                for (int s = 0; s < 4; ++s) qc[s] = qn[s];
                __syncthreads();
                const AttnU Uc = U;
                if (it + 1 < it1) { U = attn_decode(it + 1); attn_issue(Pb, U, tid, wid, lane, kreg, vreg, qn); }
                attn_compute(lds, Uc, qc, OB, ST, wid, lane);
            }
            __syncthreads();
        }
        if (rot >= 1) RUN_S;
        if (rot == 2) RUN_C;
#undef RUN_S
#undef RUN_C
    } else if (sub == 2) {
        pg8::Gemm g{ZB, (const bf16_t*)(wb + W_GLU), NT, 512, 256}; pg8::StaticOrder S; S.init(NT, 512, G, bx);
        EpiGate<1> E{YC, 768, 512, RowScale{nullptr, nullptr}};
        pg8::gemm_phase<EpiGate<1>, pg8::StaticOrder, true, true>(lds, g, S, E);
    } else if (sub == 3) {
        combine_rows(YC, OB, ST, ap->in[17] + layer * 1024, Hb, gw, ngw, lane);
    } else if (sub == 4) {
        pg8::Gemm g{Hb, (const bf16_t*)(wb + W_OUT), NT, 1024, 1024}; pg8::StaticOrder S; S.init(NT, 1024, G, bx);
        EpiRes E{XB, SS + (size_t)(layer == 0 ? 1 : 3) * NT * 4, (LAS float*)(lds + 131072)};
        pg8::gemm_phase<EpiRes, pg8::StaticOrder, true, true>(lds, g, S, E);
    } else if (sub == 5) {
#ifdef STAGGER_GU
        { const int st = (bx >> 3) & 7; for (int q = 0; q < st; ++q) __builtin_amdgcn_s_sleep(127); }
#endif
        pg8::Gemm g{XB, (const bf16_t*)(wb + W_GU), NT, 2 * DFF, 1024}; pg8::StaticOrder S; S.init(NT, 2 * DFF, G, bx);
        EpiGate<0> E{Pb, DFF, 0, RowScale{SS + (size_t)(layer == 0 ? 1 : 3) * NT * 4, (LAS float*)(lds + 131072 + 4096)}};
        pg8::gemm_phase<EpiGate<0>, pg8::StaticOrder, true, true>(lds, g, S, E);
    } else {
        pg8::Gemm g{Pb, (const bf16_t*)(wb + W_DN), NT, 1024, DFF}; pg8::StaticOrder S; S.init(NT, 1024, G, bx);
        EpiRes E{XB, SS + (size_t)(layer == 0 ? 2 : 4) * NT * 4, (LAS float*)(lds + 131072)};
        pg8::gemm_phase<EpiRes, pg8::StaticOrder, true, true>(lds, g, S, E);
    }
}
__global__ void __launch_bounds__(NTHREADS, 2) fwd_megakernel(Args args) {
    extern __shared__ __attribute__((aligned(16))) unsigned char lds_raw[];
    LAS unsigned char* lds = (LAS unsigned char*)lds_raw;
    cg::grid_group grid = cg::this_grid();
    const int tid = threadIdx.x, lane = tid & 63, wid = __builtin_amdgcn_readfirstlane(tid >> 6);
    const int G = gridDim.x, bx = blockIdx.x;
    const int lo = args.ph_lo, hi = args.ph_hi;
    const CAS Args* ap = (const CAS Args*)__builtin_amdgcn_kernarg_segment_ptr();
    volatile LAS unsigned* bst = (volatile LAS unsigned*)(lds + LDS_BYTES - 64);
    if (tid == 0) { bst[0] = 0u; bst[1] = 0u; }
    __syncthreads();
    XcdBarrier xbar = xcd_barrier_post((unsigned*)(args.ws + WS_BAR), bst);
#define GSYNC(k) do { if ((k) == 1) grid.sync(); else xcd_barrier(xbar); } while (0)
#ifdef TIMED
#define TSTAMP(k) do { if (bx == 0 && tid == 0) { if ((k) == TIMED) ((unsigned long long*)(args.ws + WS_BAR))[1800] = __builtin_amdgcn_s_memrealtime(); \
        if ((k) == TIMED + TIMED_N) ((unsigned long long*)(args.ws + WS_BAR))[1801] = __builtin_amdgcn_s_memrealtime(); } } while (0)
#else
#define TSTAMP(k) do { } while (0)
#endif
#define PHASE(k) if (lo <= (k) && (k) < hi) { if ((k) > lo) GSYNC(k); TSTAMP(k); LAUNDER(ap); phase_body((k), ap, lds, tid, lane, wid, G, bx); }
    PHASE(0) PHASE(1) PHASE(2) PHASE(3) PHASE(4) PHASE(5) PHASE(6) PHASE(7) PHASE(8) PHASE(9)
    PHASE(10) PHASE(11) PHASE(12) PHASE(13) PHASE(14) PHASE(15)
#undef PHASE
}

extern "C" void kernel_launch(void* const* d_in, const int* in_sizes, int n_in, void* d_out, int out_size, void* d_ws, size_t ws_size, hipStream_t stream) {
    static int grid_blocks = 0;
    if (grid_blocks == 0) {
        if (n_in != 24 || ws_size < WS_END) { fprintf(stderr, "kernel_launch: unexpected n_in %d / ws_size %zu\n", n_in, ws_size); grid_blocks = -1; return; }
        int dev = 0, cus = 0, per_cu = 0;
        hipGetDevice(&dev);
        hipDeviceGetAttribute(&cus, hipDeviceAttributeMultiprocessorCount, dev);
        if (hipFuncSetAttribute((const void*)fwd_megakernel, hipFuncAttributeMaxDynamicSharedMemorySize, LDS_BYTES) != hipSuccess) { fprintf(stderr, "kernel_launch: hipFuncSetAttribute failed\n"); grid_blocks = -1; return; }
        if (hipOccupancyMaxActiveBlocksPerMultiprocessor(&per_cu, (const void*)fwd_megakernel, NTHREADS, LDS_BYTES) != hipSuccess || per_cu < 1) { fprintf(stderr, "kernel_launch: occupancy query %d\n", per_cu); per_cu = 1; }
        (void)hipGetLastError();
        grid_blocks = cus * per_cu;
    }
    if (grid_blocks < 0) return;
    Args a{};
    for (int i = 0; i < 24; ++i) a.in[i] = (const float*)d_in[i];
    a.out = (float*)d_out; a.ws = (unsigned char*)d_ws; a.ph_lo = 0; a.ph_hi = NPHASE;
    if (hipMemsetAsync((char*)d_ws + WS_BAR, 0, 16384, stream) != hipSuccess) { fprintf(stderr, "kernel_launch: memset failed\n"); return; }
    void* kargs[] = {&a};
    hipError_t e = hipLaunchCooperativeKernel((const void*)fwd_megakernel, dim3(grid_blocks), dim3(NTHREADS), kargs, LDS_BYTES, stream);
    if (e != hipSuccess) fprintf(stderr, "cooperative launch failed: %s (grid %d)\n", hipGetErrorString(e), grid_blocks);
}
```

```cpp
#include <hip/hip_runtime.h>
#include <hip/hip_cooperative_groups.h>
#include <cstdio>
#include <cstdint>
namespace cg = cooperative_groups;
namespace pg8 {
#define PG8_LAS __attribute__((address_space(3)))
typedef unsigned short bf16_t;
typedef short bf16x8 __attribute__((ext_vector_type(8)));
typedef float f32x4 __attribute__((ext_vector_type(4)));
typedef unsigned u32x4 __attribute__((ext_vector_type(4)));
constexpr int BM = 256, BK = 64, HALF = 128, HTB = HALF * BK * 2  , STAGE_BYTES = 8 * HTB, NXCD = 8, WGM = 8;

__host__ __device__ __forceinline__ int lds_byte(int r, int c) { const int st = (r >> 4) * 2 + (c >> 5), rr = r & 15, cc = c & 31, ob = rr * 64 + cc * 2; return st * 1024 + (ob ^ (((ob >> 9) & 1) << 5)); }
__host__ __device__ __forceinline__ void stage_rc(int b, int& R, int& C) { const int st = b / 1024, sb = b % 1024, swz = sb ^ (((sb >> 9) & 1) << 5); R = (st >> 1) * 16 + swz / 64; C = (st & 1) * 32 + (swz % 64) / 2; }
__host__ __device__ __forceinline__ int perm32(int rho) { const int n = rho >> 4, i = rho & 15; return 8 * (i >> 2) + 4 * n + (i & 3); }

struct Unit { int pm, pn; };
struct Gemm { const bf16_t* A; const bf16_t* Bt; int M, N, K; };

struct StaticOrder {
    int nM, nN, nwg, G, c;
    __host__ __device__ void init(int M, int N, int G_, int c_) { nM = M / BM; nN = N / BM; nwg = nM * nN; G = G_; c = c_; }
    __host__ __device__ bool next(int i, Unit& u) const {
        const long L = (long)i * G + c; if (L >= nwg) return false;
        int wgid = (int)L; { const int q = nwg / NXCD, r = nwg % NXCD, xcd = wgid % NXCD, off = wgid / NXCD; wgid = (xcd < r ? xcd * (q + 1) : r * (q + 1) + (xcd - r) * q) + off; }
        const int nig = WGM * nN, gid = wgid / nig, fm = gid * WGM, gsz = (nM - fm) < WGM ? (nM - fm) : WGM;
        u.pm = fm + ((wgid % nig) % gsz); u.pn = (wgid % nig) / gsz; return true;
    }
    __device__ __forceinline__ void a_ready(const Unit&) const {}
    __device__ __forceinline__ void done(const Unit&) const {}
};

__device__ __forceinline__ unsigned cvt_pk_bf16(float lo, float hi) { unsigned r; asm volatile("v_cvt_pk_bf16_f32 %0, %1, %2" : "=v"(r) : "v"(lo), "v"(hi)); return r; }
typedef float f32x2 __attribute__((ext_vector_type(2)));
template <int N> __device__ __forceinline__ void wait_vm() { static_assert(N >= 0 && N <= 63, "vmcnt is 6 bits"); asm volatile("s_waitcnt vmcnt(%0)" :: "n"(N) : "memory"); }
template <class Epi, class Sched, bool ALIGN_EPI = false, bool SP2 = false>
__device__ __forceinline__ void gemm_phase(PG8_LAS unsigned char* lds, const Gemm g, const Sched& S, const Epi& E) {
    const int tid = threadIdx.x, wid = __builtin_amdgcn_readfirstlane(tid >> 6), lane = tid & 63, wr = wid >> 2, wc = wid & 3, fr = lane & 15, fq = lane >> 4;
    const int K = g.K, nt = K / BK;
    unsigned voffA[2], voffB[2];
#pragma unroll
    for (int i = 0; i < 2; ++i) { int R, C; stage_rc(tid * 16 + i * 8192, R, C); const int Rb = Epi::PERM ? ((R & ~31) + perm32(R & 31)) : R;
        voffA[i] = (unsigned)(R * K + C) * 2u; voffB[i] = (unsigned)(Rb * K + C) * 2u; }
    const size_t kstep = (size_t)(BK * 2);
    const size_t hstep = (size_t)HALF * K * 2;
    const size_t tstep = 2 * hstep;
    const unsigned ldsw = (unsigned)wid * 1024u;
    const int aoff = lds_byte(wr * 64 + fr, fq * 8), boff = lds_byte(wc * 32 + fr, fq * 8);
#define PG8_SA(b, h) (((b) * 2 + (h)) * HTB)
#define PG8_SB(b, h) ((4 + (b) * 2 + (h)) * HTB)
#define PG8_STAGE(bufoff, gbase, voff) do { _Pragma("unroll") for (int _i = 0; _i < 2; ++_i) \
        __builtin_amdgcn_global_load_lds((const unsigned*)((const char*)(gbase) + (voff)[_i]), (PG8_LAS unsigned*)(lds + (bufoff) + ldsw + _i * 8192), 16, 0, 0); } while (0)
#define PG8_LDA(dst, b, h) do { _Pragma("unroll") for (int m = 0; m < 4; ++m) _Pragma("unroll") for (int k = 0; k < 2; ++k) dst[m][k] = *(const PG8_LAS bf16x8*)(lds + PG8_SA(b, h) + aoff + m * 2048 + k * 1024); } while (0)
#define PG8_LDB(dst, b, h) do { _Pragma("unroll") for (int n = 0; n < 2; ++n) _Pragma("unroll") for (int k = 0; k < 2; ++k) dst[n][k] = *(const PG8_LAS bf16x8*)(lds + PG8_SB(b, h) + boff + n * 2048 + k * 1024); } while (0)
#define PG8_MMA(ai, bj, At, Bt) do { __builtin_amdgcn_s_setprio(1); _Pragma("unroll") for (int m = 0; m < 4; ++m) _Pragma("unroll") for (int n = 0; n < 2; ++n) _Pragma("unroll") for (int k = 0; k < 2; ++k) \
        acc[ai][bj][m][n] = __builtin_amdgcn_mfma_f32_16x16x32_bf16(Bt[n][k], At[m][k], acc[ai][bj][m][n], 0, 0, 0); __builtin_amdgcn_s_setprio(0); } while (0)
#define PG8_WAIT_V(n) asm volatile("s_waitcnt vmcnt(" #n ")" ::: "memory")
#define PG8_WAIT_L(n) asm volatile("s_waitcnt lgkmcnt(" #n ")" ::: "memory")
#define PG8_BAR __builtin_amdgcn_s_barrier()
#define PG8_SCHED __builtin_amdgcn_sched_barrier(0)
    Unit cur, nxt; int ui = 0;
    if (!S.next(0, cur)) return;
    E.prime(cur);
    f32x4 acc[2][2][4][2];
#pragma unroll
    for (int a = 0; a < 2; ++a)
#pragma unroll
        for (int b = 0; b < 2; ++b)
#pragma unroll
            for (int m = 0; m < 4; ++m)
#pragma unroll
                for (int n = 0; n < 2; ++n) acc[a][b][m][n] = (f32x4){0.f, 0.f, 0.f, 0.f};
    bf16x8 At[4][2], B0[2][2], B1[2][2];
    const char* cA = (const char*)g.A + (size_t)cur.pm * tstep; const char* cB = (const char*)g.Bt + (size_t)cur.pn * tstep;
    S.a_ready(cur);
    if constexpr (SP2) {
        PG8_STAGE(PG8_SB(0, 0), cB, voffB); PG8_STAGE(PG8_SB(0, 1), cB + hstep, voffB); PG8_STAGE(PG8_SA(0, 0), cA, voffA); PG8_STAGE(PG8_SA(0, 1), cA + hstep, voffA);
        if (wr == 1) PG8_BAR;
        PG8_WAIT_V(2); PG8_BAR;
        PG8_STAGE(PG8_SB(1, 0), cB + kstep, voffB); PG8_STAGE(PG8_SA(1, 0), cA + kstep, voffA); PG8_STAGE(PG8_SB(1, 1), cB + hstep + kstep, voffB);
        PG8_WAIT_V(6); PG8_BAR;
    } else {
        PG8_STAGE(PG8_SB(0, 0), cB, voffB); PG8_STAGE(PG8_SA(0, 0), cA, voffA); PG8_STAGE(PG8_SB(0, 1), cB + hstep, voffB); PG8_STAGE(PG8_SA(0, 1), cA + hstep, voffA);
        if (wr == 1) PG8_BAR;
        PG8_WAIT_V(4); PG8_BAR;
        PG8_STAGE(PG8_SB(1, 0), cB + kstep, voffB); PG8_STAGE(PG8_SA(1, 0), cA + kstep, voffA); PG8_STAGE(PG8_SB(1, 1), cB + hstep + kstep, voffB);
        PG8_WAIT_V(6); PG8_BAR;
    }
    for (;;) {
        const bool has_next = S.next(ui + 1, nxt);
        const char* nA = has_next ? (const char*)g.A + (size_t)nxt.pm * tstep : cA; const char* nB = has_next ? (const char*)g.Bt + (size_t)nxt.pn * tstep : cB;
#pragma nounroll
        for (int t = 0; t < nt; t += 2) {
            const bool last = (t == nt - 2);
            const char* a1 = cA + (size_t)(t + 1) * kstep;
            const char* a2 = last ? nA : cA + (size_t)(t + 2) * kstep; const char* b2 = last ? nB : cB + (size_t)(t + 2) * kstep;
            const char* a3 = a2 + kstep; const char* b3 = b2 + kstep;
            if (last && has_next) S.a_ready(nxt);
            if constexpr (SP2) {
            const bool relax = (t == 0) && (ui > 0);
            PG8_LDB(B0, 0, 0); PG8_LDB(B1, 0, 1); PG8_SCHED; PG8_LDA(At, 0, 0); PG8_STAGE(PG8_SA(1, 1), a1 + hstep, voffA);
            if (relax) wait_vm<8 + Epi::NVMEM>(); else PG8_WAIT_V(8);
            PG8_WAIT_L(0); PG8_BAR; PG8_MMA(0, 0, At, B0); PG8_MMA(0, 1, At, B1); PG8_BAR; PG8_SCHED;
            PG8_LDA(At, 0, 1); PG8_STAGE(PG8_SB(0, 0), b2, voffB); PG8_STAGE(PG8_SB(0, 1), b2 + hstep, voffB); PG8_STAGE(PG8_SA(0, 0), a2, voffA);
            if (relax) wait_vm<8 + Epi::NVMEM>(); else PG8_WAIT_V(8);
            PG8_WAIT_L(0); PG8_BAR; PG8_MMA(1, 0, At, B0); PG8_MMA(1, 1, At, B1); PG8_BAR; PG8_SCHED;
            PG8_LDB(B0, 1, 0); PG8_LDB(B1, 1, 1); PG8_SCHED; PG8_LDA(At, 1, 0); PG8_STAGE(PG8_SA(0, 1), a2 + hstep, voffA);
            PG8_WAIT_V(8); PG8_WAIT_L(0); PG8_BAR; PG8_MMA(0, 0, At, B0); PG8_MMA(0, 1, At, B1); PG8_BAR; PG8_SCHED;
            PG8_LDA(At, 1, 1); PG8_STAGE(PG8_SB(1, 0), b3, voffB); PG8_STAGE(PG8_SB(1, 1), b3 + hstep, voffB); PG8_STAGE(PG8_SA(1, 0), a3, voffA);
            PG8_WAIT_V(8); PG8_WAIT_L(0); PG8_BAR; PG8_MMA(1, 0, At, B0); PG8_MMA(1, 1, At, B1); PG8_BAR; PG8_SCHED;
            } else {
            PG8_LDB(B0, 0, 0); PG8_SCHED; PG8_LDA(At, 0, 0); PG8_STAGE(PG8_SA(1, 1), a1 + hstep, voffA);
            PG8_WAIT_L(8); PG8_BAR; PG8_WAIT_L(0); PG8_MMA(0, 0, At, B0); PG8_BAR; PG8_SCHED;
            PG8_LDB(B1, 0, 1); PG8_STAGE(PG8_SB(0, 0), b2, voffB);
            PG8_BAR; PG8_WAIT_L(0); PG8_MMA(0, 1, At, B1); PG8_BAR;
            PG8_LDA(At, 0, 1); PG8_STAGE(PG8_SA(0, 0), a2, voffA);
            PG8_BAR; PG8_WAIT_L(0); PG8_MMA(1, 0, At, B0); PG8_BAR; PG8_SCHED;
            PG8_STAGE(PG8_SB(0, 1), b2 + hstep, voffB);
            PG8_WAIT_V(6); PG8_BAR; PG8_MMA(1, 1, At, B1); PG8_BAR;
            PG8_LDB(B0, 1, 0); PG8_SCHED; PG8_LDA(At, 1, 0); PG8_STAGE(PG8_SA(0, 1), a2 + hstep, voffA);
            PG8_WAIT_L(8); PG8_BAR; PG8_WAIT_L(0); PG8_MMA(0, 0, At, B0); PG8_BAR; PG8_SCHED;
            PG8_LDB(B1, 1, 1); PG8_STAGE(PG8_SB(1, 0), b3, voffB);
            PG8_BAR; PG8_WAIT_L(0); PG8_MMA(0, 1, At, B1); PG8_BAR;
            PG8_LDA(At, 1, 1); PG8_STAGE(PG8_SA(1, 0), a3, voffA);
            PG8_BAR; PG8_WAIT_L(0); PG8_MMA(1, 0, At, B0); PG8_BAR; PG8_SCHED;
            PG8_STAGE(PG8_SB(1, 1), b3 + hstep, voffB);
            PG8_WAIT_V(6); PG8_BAR; PG8_MMA(1, 1, At, B1); PG8_BAR;
            }
        }
        if constexpr (ALIGN_EPI) { if (wr == 0) PG8_BAR; }
        if constexpr (!Epi::AFTER_DRAIN) { E(acc, cur, wr, wc, fr, fq, nxt, has_next, ui); S.done(cur); }
        if (!has_next) break;
#pragma unroll
        for (int a = 0; a < 2; ++a)
#pragma unroll
            for (int b = 0; b < 2; ++b)
#pragma unroll
                for (int m = 0; m < 4; ++m)
#pragma unroll
                    for (int n = 0; n < 2; ++n) acc[a][b][m][n] = (f32x4){0.f, 0.f, 0.f, 0.f};
        cur = nxt; cA = nA; cB = nB; ++ui;
        if constexpr (ALIGN_EPI) { if (wr == 1) PG8_BAR; }
    }
    PG8_WAIT_V(0);
    if constexpr (!ALIGN_EPI) { if (wr == 0) PG8_BAR; }
    PG8_BAR;
    if constexpr (Epi::AFTER_DRAIN) { E.fused(acc, cur, wr, wc, fr, fq, lds, wid, lane); S.done(cur); }
#undef PG8_SA
#undef PG8_SB
#undef PG8_STAGE
#undef PG8_LDA
#undef PG8_LDB
#undef PG8_MMA
#undef PG8_WAIT_V
#undef PG8_WAIT_L
#undef PG8_BAR
#undef PG8_SCHED
}
}
#ifndef REPEAT_MASK
#define REPEAT_MASK 0u
#endif
#ifndef EXTRA_SYNCS
#define EXTRA_SYNCS 0
#endif
#ifndef REP_SSM
#define REP_SSM 1
#endif
#ifndef REP_CONV
#define REP_CONV 1
#endif
#ifndef REP_ATTN
#define REP_ATTN 1
#endif

#define LAS __attribute__((address_space(3)))
typedef unsigned short bf16_t;
typedef short bf16x8 __attribute__((ext_vector_type(8)));
typedef short s16x4 __attribute__((ext_vector_type(4)));
typedef float f32x4 __attribute__((ext_vector_type(4)));
typedef float f32x16 __attribute__((ext_vector_type(16)));
typedef unsigned u32x4 __attribute__((ext_vector_type(4)));
typedef unsigned u32x2 __attribute__((ext_vector_type(2)));
typedef float f32x2v __attribute__((ext_vector_type(2)));
typedef __bf16 bf16x2v __attribute__((ext_vector_type(2)));

constexpr int NT = 65536, SEQ = 4096, DMODEL = 1024, NIN = 2304, DFF = 2816;
constexpr float EPS = 1e-6f;
constexpr float C2 = 0.125f * 1.4426950408889634f;
constexpr size_t MiB = (size_t)1 << 20;
constexpr size_t W_IN = 0, W_OUT = W_IN + (size_t)NIN * 1024 * 2, W_GU = W_OUT + (size_t)1024 * 1024 * 2, W_DN = W_GU + (size_t)2 * DFF * 1024 * 2,
                 W_GLU = W_DN + (size_t)1024 * DFF * 2, W_LAYER = 24 * MiB;
static_assert(W_GLU + 512 * 256 * 2 <= W_LAYER, "weight block");
constexpr size_t WS_W = 0, WS_ROPE = 48 * MiB, WS_H = 64 * MiB, WS_P = 192 * MiB, WS_YC = 544 * MiB, WS_ZB = 640 * MiB, WS_OB = 672 * MiB, WS_ST = 768 * MiB, WS_BAR = 776 * MiB, WS_XB = 778 * MiB, WS_SS = 906 * MiB, WS_END = 912 * MiB;
constexpr int LDS_BYTES = 147456;
constexpr int NTHREADS = 512;

#define CAS __attribute__((address_space(4)))
struct Args {
    const float* in[24];
    float* out;
    unsigned char* ws;
    int ph_lo, ph_hi;
};

__device__ __forceinline__ unsigned pk2(float lo, float hi) { f32x2v v = {lo, hi}; bf16x2v b = __builtin_convertvector(v, bf16x2v); return __builtin_bit_cast(unsigned, b); }
__device__ __forceinline__ float bflo(unsigned u) { return __uint_as_float(u << 16); }
__device__ __forceinline__ float bfhi(unsigned u) { return __uint_as_float(u & 0xffff0000u); }
template <int CTRL, int ROWMASK> __device__ __forceinline__ float dpp_add(float v) {
    return v + __builtin_bit_cast(float, __builtin_amdgcn_update_dpp(0, __builtin_bit_cast(int, v), CTRL, ROWMASK, 0xF, false));
}
__device__ __forceinline__ float wave_sum(float v) {
    v = dpp_add<0xB1, 0xF>(v);
    v = dpp_add<0x4E, 0xF>(v);
    v = dpp_add<0x141, 0xF>(v);
    v = dpp_add<0x140, 0xF>(v);
    v = dpp_add<0x142, 0xA>(v);
    v = dpp_add<0x143, 0xC>(v);
    return __builtin_bit_cast(float, __builtin_amdgcn_readlane(__builtin_bit_cast(int, v), 63));
}
__device__ __forceinline__ float sigmoidf_(float x) { return __builtin_amdgcn_rcpf(1.f + __expf(-x)); }
__device__ __forceinline__ float gelu_tanh(float y) {
    const float a = 0.7978845608028654f * (y + 0.044715f * y * y * y);
    const float t = 1.f - 2.f * __builtin_amdgcn_rcpf(__expf(2.f * a) + 1.f);
    return 0.5f * y * (1.f + t);
}
#define WAVE_LDS_SYNC() asm volatile("s_waitcnt lgkmcnt(0)" ::: "memory")

struct RowScale {
    const float* ssp; LAS float* xs;
    __device__ __forceinline__ float rs_of(int row) const { const f32x4 sp = *(const f32x4*)(ssp + (size_t)row * 4); return rsqrtf(((sp.x + sp.y) + (sp.z + sp.w)) * (1.f / DMODEL) + EPS); }
    __device__ __forceinline__ void prime(const pg8::Unit& u) const { const int t = threadIdx.x; if (t < 256) xs[t] = rs_of(u.pm * 256 + t); }
};
struct EpiIn {
    static constexpr int NVMEM = 16;
    static constexpr bool PERM = true, AFTER_DRAIN = false;
    bf16_t* O; const float* ropec; const float* ropes; RowScale R;
    __device__ __forceinline__ void prime(const pg8::Unit& u) const { R.prime(u); }
    __device__ __forceinline__ void operator()(const f32x4 (&acc)[2][2][4][2], const pg8::Unit& u, int wr, int wc, int fr, int fq, const pg8::Unit& nxt, bool has_next, int ui) const {
        const int row0 = u.pm * 256 + wr * 64 + fr, t = threadIdx.x;
        f32x4 spn = {0.f, 0.f, 0.f, 0.f};
        const bool stage = has_next && t < 256 && nxt.pm != u.pm;
        if (stage) spn = *(const f32x4*)(R.ssp + (size_t)(nxt.pm * 256 + t) * 4);
        const LAS float* xsc = R.xs + (ui & 1) * 256 + wr * 64 + fr;
        if (u.pn == 6 || u.pn == 7) {
            const float sc = (u.pn == 6) ? C2 : 1.f;
            const int dimb = 16 * (wc & 1) + 4 * fq;
#pragma unroll
            for (int ai = 0; ai < 2; ++ai)
#pragma unroll
                for (int m = 0; m < 4; ++m) {
                    const int row = row0 + ai * 128 + m * 16; const int pos = row & (SEQ - 1);
                    const float rsc = xsc[ai * 128 + m * 16] * sc;
                    const f32x4 cs = *(const f32x4*)(ropec + pos * 32 + dimb), sn = *(const f32x4*)(ropes + pos * 32 + dimb);
                    bf16_t* rowp = O + (size_t)row * NIN + u.pn * 256 + 64 * (wc >> 1) + dimb;
#pragma unroll
                    for (int bj = 0; bj < 2; ++bj) {
                        const f32x4 x1 = acc[ai][bj][m][0] * rsc, x2 = acc[ai][bj][m][1] * rsc;
                        const f32x4 o1 = x1 * cs - x2 * sn, o2 = x2 * cs + x1 * sn;
                        u32x2 w1, w2; w1.x = pk2(o1[0], o1[1]); w1.y = pk2(o1[2], o1[3]); w2.x = pk2(o2[0], o2[1]); w2.y = pk2(o2[2], o2[3]);
                        *(u32x2*)(rowp + bj * 128) = w1; *(u32x2*)(rowp + bj * 128 + 32) = w2;
                    }
                }
        } else {
#pragma unroll
            for (int ai = 0; ai < 2; ++ai)
#pragma unroll
                for (int m = 0; m < 4; ++m) {
                    bf16_t* rowp = O + (size_t)(row0 + ai * 128 + m * 16) * NIN + u.pn * 256 + wc * 32 + 8 * fq;
                    const float rsc = xsc[ai * 128 + m * 16];
#pragma unroll
                    for (int bj = 0; bj < 2; ++bj) {
                        const f32x4 v0 = acc[ai][bj][m][0] * rsc, v1 = acc[ai][bj][m][1] * rsc;
                        u32x4 w; w.x = pk2(v0[0], v0[1]); w.y = pk2(v0[2], v0[3]); w.z = pk2(v1[0], v1[1]); w.w = pk2(v1[2], v1[3]);
                        *(u32x4*)(rowp + bj * 128) = w;
                    }
                }
        }
        if (has_next && t < 256) {
            float v = R.xs[(ui & 1) * 256 + t];
            if (nxt.pm != u.pm) v = rsqrtf(((spn.x + spn.y) + (spn.z + spn.w)) * (1.f / DMODEL) + EPS);
            R.xs[((ui + 1) & 1) * 256 + t] = v;
        }
    }
};
struct EpiRes {
    static constexpr int NVMEM = 32;
    static constexpr bool PERM = true, AFTER_DRAIN = false;
    bf16_t* xb; float* ssp; LAS float* xl;
    __device__ __forceinline__ void prime(const pg8::Unit&) const {}
    __device__ __forceinline__ void operator()(const f32x4 (&acc)[2][2][4][2], const pg8::Unit& u, int wr, int wc, int fr, int fq, const pg8::Unit&, bool, int) const {
        const int row0 = u.pm * 256 + wr * 64 + fr, col0 = u.pn * 256 + wc * 32 + 8 * fq;
        u32x4 rv[2][4][2];
#pragma unroll
        for (int ai = 0; ai < 2; ++ai)
#pragma unroll
            for (int m = 0; m < 4; ++m)
#pragma unroll
                for (int bj = 0; bj < 2; ++bj) rv[ai][m][bj] = *(const u32x4*)(xb + (size_t)(row0 + ai * 128 + m * 16) * DMODEL + col0 + bj * 128);
#pragma unroll
        for (int ai = 0; ai < 2; ++ai)
#pragma unroll
            for (int m = 0; m < 4; ++m) {
                const int row = row0 + ai * 128 + m * 16;
                const size_t off = (size_t)row * DMODEL + col0;
                float sq = 0.f;
#pragma unroll
                for (int bj = 0; bj < 2; ++bj) {
                    const u32x4 r = rv[ai][m][bj];
                    const f32x4 r0 = {bflo(r.x), bfhi(r.x), bflo(r.y), bfhi(r.y)}, r1 = {bflo(r.z), bfhi(r.z), bflo(r.w), bfhi(r.w)};
                    const f32x4 x0 = r0 + acc[ai][bj][m][0], x1 = r1 + acc[ai][bj][m][1];
                    u32x4 w; w.x = pk2(x0[0], x0[1]); w.y = pk2(x0[2], x0[3]); w.z = pk2(x1[0], x1[1]); w.w = pk2(x1[2], x1[3]);
                    *(u32x4*)(xb + off + bj * 128) = w;
                    sq += (x0[0] * x0[0] + x0[1] * x0[1]) + (x0[2] * x0[2] + x0[3] * x0[3]) + (x1[0] * x1[0] + x1[1] * x1[1]) + (x1[2] * x1[2] + x1[3] * x1[3]);
                }
                sq += __shfl_xor(sq, 16); sq += __shfl_xor(sq, 32);
                if (fq == 0) xl[(wr * 64 + ai * 128 + m * 16 + fr) * 4 + wc] = sq;
            }
        asm volatile("s_waitcnt lgkmcnt(0)\n\ts_barrier" ::: "memory");
        const int t = threadIdx.x;
        if (t < 256) { const f32x4 v = *(const LAS f32x4*)(xl + t * 4); ssp[(size_t)(u.pm * 256 + t) * 4 + u.pn] = (v.x + v.y) + (v.z + v.w); }
    }
};
template <int MODE  > struct EpiGate {
    static constexpr bool PERM = true, AFTER_DRAIN = false;
    static constexpr int NVMEM = 8;
    bf16_t* O; int ldc; int coff; RowScale R;
    __device__ __forceinline__ void prime(const pg8::Unit& u) const { if (MODE == 0) R.prime(u); }
    __device__ __forceinline__ void operator()(const f32x4 (&acc)[2][2][4][2], const pg8::Unit& u, int wr, int wc, int fr, int fq, const pg8::Unit& nxt, bool has_next, int ui) const {
        const int row0 = u.pm * 256 + wr * 64 + fr, col0 = coff + u.pn * 128 + wc * 32 + 8 * fq, t = threadIdx.x;
        f32x4 spn = {0.f, 0.f, 0.f, 0.f};
        if (MODE == 0) { if (has_next && t < 256 && nxt.pm != u.pm) spn = *(const f32x4*)(R.ssp + (size_t)(nxt.pm * 256 + t) * 4); }
        const LAS float* xsc = R.xs + (ui & 1) * 256 + wr * 64 + fr;
#pragma unroll
        for (int ai = 0; ai < 2; ++ai)
#pragma unroll
            for (int m = 0; m < 4; ++m) {
                float r[8];
                float rsc = 1.f; if (MODE == 0) rsc = xsc[ai * 128 + m * 16];
                const float c1 = -1.4426950408889634f * rsc, r2 = rsc * rsc;
#pragma unroll
                for (int n = 0; n < 2; ++n)
#pragma unroll
                    for (int j = 0; j < 4; ++j) {
                        const float a = acc[ai][0][m][n][j], b = acc[ai][1][m][n][j];
                        if (MODE == 0) r[4 * n + j] = (a * b) * (r2 * __builtin_amdgcn_rcpf(1.f + __builtin_amdgcn_exp2f(a * c1)));
                        else r[4 * n + j] = a * __builtin_amdgcn_rcpf(1.f + __builtin_amdgcn_exp2f(b * -1.4426950408889634f));
                    }
                u32x4 w; w.x = pk2(r[0], r[1]); w.y = pk2(r[2], r[3]); w.z = pk2(r[4], r[5]); w.w = pk2(r[6], r[7]);
                *(u32x4*)(O + (size_t)(row0 + ai * 128 + m * 16) * ldc + col0) = w;
            }
        if (MODE == 0) {
            if (has_next && t < 256) {
                float v = R.xs[(ui & 1) * 256 + t];
                if (nxt.pm != u.pm) v = rsqrtf(((spn.x + spn.y) + (spn.z + spn.w)) * (1.f / DMODEL) + EPS);
                R.xs[((ui + 1) & 1) * 256 + t] = v;
            }
        }
    }
};

struct WMat { const float* src; const float* src2; int K, N, ldw, kind; bf16_t* dst; const float* kscale; };
__device__ __forceinline__ void wconv_load(const WMat& w, int t, int tid, float (&v)[8]) {
    const int nkt = w.K / 64, jt = t / nkt, kt = t % nkt, j0 = jt * 64, k0 = kt * 64;
    const int j = j0 + (tid & 63);
    const float* s = w.src; int col = j;
    if (w.kind == 1) {
        if (j >= 1536 && j < 2048) { const int ww = j & 63; col = (j & ~63) + 32 * ((ww >> 2) & 1) + 16 * (ww >> 5) + 4 * ((ww >> 3) & 3) + (ww & 3); }
    } else if (w.kind == 2) {
        const int pn = j >> 8, wi = j & 255; if (wi < 128) col = pn * 128 + wi; else { s = w.src2; col = pn * 128 + (wi - 128); }
    }
    const int kk = tid >> 6;
#pragma unroll
    for (int i = 0; i < 8; ++i) { const int k = kk + 8 * i; const float sc = w.kscale ? w.kscale[k0 + k] : 1.f; v[i] = s[(size_t)(k0 + k) * w.ldw + col] * sc; }
}
__device__ __forceinline__ void wconv_store(LAS float* tile, const WMat& w, int t, int tid, const float (&v)[8]) {
    const int nkt = w.K / 64, jt = t / nkt, kt = t % nkt, j0 = jt * 64, k0 = kt * 64;
    const int kk = tid >> 6;
#pragma unroll
    for (int i = 0; i < 8; ++i) tile[(kk + 8 * i) * 65 + (tid & 63)] = v[i];
    __syncthreads();
    {
        const int jr = tid >> 3, c = tid & 7; const LAS float* s = tile + (8 * c) * 65 + jr;
        u32x4 o; o.x = pk2(s[0], s[65]); o.y = pk2(s[2 * 65], s[3 * 65]); o.z = pk2(s[4 * 65], s[5 * 65]); o.w = pk2(s[6 * 65], s[7 * 65]);
        *(u32x4*)(w.dst + (size_t)(j0 + jr) * w.K + k0 + 8 * c) = o;
    }
    __syncthreads();
}
__device__ __forceinline__ WMat wmat_of(const CAS Args* ap, unsigned char* ws, int it, int& t) {
    const int layer = it / 2976; t = it % 2976;
    unsigned char* wb = ws + WS_W + (size_t)layer * W_LAYER;
    if (t < 576) return WMat{ap->in[2] + (size_t)layer * 1024 * NIN, nullptr, 1024, NIN, NIN, 1, (bf16_t*)(wb + W_IN), ap->in[1] + layer * 1024};
    if ((t -= 576) < 256) return WMat{ap->in[18] + (size_t)layer * 1024 * 1024, nullptr, 1024, 1024, 1024, 0, (bf16_t*)(wb + W_OUT), nullptr};
    if ((t -= 256) < 1408) return WMat{ap->in[20] + (size_t)layer * 1024 * DFF, ap->in[21] + (size_t)layer * 1024 * DFF, 1024, 2 * DFF, DFF, 2, (bf16_t*)(wb + W_GU), ap->in[19] + layer * 1024};
    if ((t -= 1408) < 704) return WMat{ap->in[22] + (size_t)layer * DFF * 1024, nullptr, DFF, 1024, 1024, 0, (bf16_t*)(wb + W_DN), nullptr};
    t -= 704; return WMat{ap->in[16] + (size_t)layer * 256 * 512, ap->in[16] + (size_t)layer * 256 * 512 + 256, 256, 512, 512, 2, (bf16_t*)(wb + W_GLU), nullptr};
}

__device__ __forceinline__ void norm_rows_bf16(const float* X, const float* g, bf16_t* H, int gw, int ngw, int lane) {
    f32x4 gv[4];
#pragma unroll
    for (int j = 0; j < 4; ++j) gv[j] = ((const f32x4*)g)[lane + 64 * j];
    for (int m = gw; m < NT; m += ngw) {
        const f32x4* xr = (const f32x4*)(X + (size_t)m * DMODEL) + lane;
        f32x4 v[4]; float s = 0.f;
#pragma unroll
        for (int j = 0; j < 4; ++j) { v[j] = xr[64 * j]; s += (v[j].x * v[j].x + v[j].y * v[j].y) + (v[j].z * v[j].z + v[j].w * v[j].w); }
        const float rs = rsqrtf(wave_sum(s) * (1.f / DMODEL) + EPS);
        u32x2* o = (u32x2*)(H + (size_t)m * DMODEL) + lane;
#pragma unroll
        for (int j = 0; j < 4; ++j) { u32x2 w; w.x = pk2(v[j].x * rs * gv[j].x, v[j].y * rs * gv[j].y); w.y = pk2(v[j].z * rs * gv[j].z, v[j].w * rs * gv[j].w); o[64 * j] = w; }
    }
}
__device__ __forceinline__ void xb_rows(const float* X, bf16_t* XB, float* ssq, int gw, int ngw, int lane) {
    for (int m0 = gw * 2; m0 < NT; m0 += ngw * 2) {
        f32x4 v[2][4];
#pragma unroll
        for (int r = 0; r < 2; ++r) { const f32x4* xr = (const f32x4*)(X + (size_t)(m0 + r) * DMODEL) + lane;
#pragma unroll
            for (int j = 0; j < 4; ++j) v[r][j] = xr[64 * j]; }
#pragma unroll
        for (int r = 0; r < 2; ++r) {
            const size_t m = (size_t)m0 + r;
            float s = 0.f;
#pragma unroll
            for (int j = 0; j < 4; ++j) s += (v[r][j].x * v[r][j].x + v[r][j].y * v[r][j].y) + (v[r][j].z * v[r][j].z + v[r][j].w * v[r][j].w);
            s = wave_sum(s);
            u32x2* o = (u32x2*)(XB + m * DMODEL) + lane;
#pragma unroll
            for (int j = 0; j < 4; ++j) { u32x2 w; w.x = pk2(v[r][j].x, v[r][j].y); w.y = pk2(v[r][j].z, v[r][j].w); o[64 * j] = w; }
            if (lane == 0) { f32x4 o4 = {s, 0.f, 0.f, 0.f}; *(f32x4*)(ssq + m * 4) = o4; }
        }
    }
}
__device__ __forceinline__ void final_rows(const bf16_t* XB, const float* ssp, const float* g, float* OUT, int gw, int ngw, int lane, float tscale) {
    f32x4 gv[4];
#pragma unroll
    for (int j = 0; j < 4; ++j) gv[j] = ((const f32x4*)g)[lane + 64 * j];
    for (int m0 = gw * 4; m0 < NT; m0 += ngw * 4) {
        u32x2 w[4][4]; f32x4 sp[4];
#pragma unroll
        for (int r = 0; r < 4; ++r) { const size_t m = (size_t)m0 + r; sp[r] = *(const f32x4*)(ssp + m * 4); const u32x2* xr = (const u32x2*)(XB + m * DMODEL) + lane;
#pragma unroll
            for (int j = 0; j < 4; ++j) w[r][j] = xr[64 * j]; }
#pragma unroll
        for (int r = 0; r < 4; ++r) {
            const float rs = rsqrtf(((sp[r].x + sp[r].y) + (sp[r].z + sp[r].w)) * (1.f / DMODEL) + EPS) * tscale;
            f32x4* o = (f32x4*)(OUT + (size_t)(m0 + r) * DMODEL) + lane;
#pragma unroll
            for (int j = 0; j < 4; ++j) { f32x4 v = {bflo(w[r][j].x), bfhi(w[r][j].x), bflo(w[r][j].y), bfhi(w[r][j].y)}; o[64 * j] = v * rs * gv[j]; }
        }
    }
}
__device__ __forceinline__ void norm_rows_f32_inplace(float* X, const float* g, int gw, int ngw, int lane) {
    f32x4 gv[4];
#pragma unroll
    for (int j = 0; j < 4; ++j) gv[j] = ((const f32x4*)g)[lane + 64 * j];
    for (int m = gw; m < NT; m += ngw) {
        f32x4* xr = (f32x4*)(X + (size_t)m * DMODEL) + lane;
        f32x4 v[4]; float s = 0.f;
#pragma unroll
        for (int j = 0; j < 4; ++j) { v[j] = xr[64 * j]; s += (v[j].x * v[j].x + v[j].y * v[j].y) + (v[j].z * v[j].z + v[j].w * v[j].w); }
        const float rs = rsqrtf(wave_sum(s) * (1.f / DMODEL) + EPS);
#pragma unroll
        for (int j = 0; j < 4; ++j) xr[64 * j] = v[j] * rs * gv[j];
    }
}

struct C3Regs { u32x4 hh[6], cc[6], bb[4]; };
__device__ __forceinline__ void conv3_issue(const bf16_t* P, int w, C3Regs& R) {
    const int c8 = w & 31, tok = (w >> 5) * 4, t = tok & (SEQ - 1);
    const bf16_t* base = P + (size_t)tok * NIN + c8 * 8;
#pragma unroll
    for (int i = 0; i < 6; ++i) { const int dt = (t == 0 && i < 2) ? 0 : i - 2; R.hh[i] = *(const u32x4*)(base + dt * NIN); R.cc[i] = *(const u32x4*)(base + dt * NIN + 512); }
#pragma unroll
    for (int i = 0; i < 4; ++i) R.bb[i] = *(const u32x4*)(base + i * NIN + 256);
}
__device__ __forceinline__ void mul8(const u32x4 a, const u32x4 b, float (&o)[8]) {
    o[0] = bflo(a.x) * bflo(b.x); o[1] = bfhi(a.x) * bfhi(b.x); o[2] = bflo(a.y) * bflo(b.y); o[3] = bfhi(a.y) * bfhi(b.y);
    o[4] = bflo(a.z) * bflo(b.z); o[5] = bfhi(a.z) * bfhi(b.z); o[6] = bflo(a.w) * bflo(b.w); o[7] = bfhi(a.w) * bfhi(b.w);
}
__device__ __forceinline__ void conv3_compute(bf16_t* H, int w, const C3Regs& R, const float (&w0)[8], const float (&w1)[8], const float (&w2)[8], const float (&gm)[8]) {
    const int c8 = w & 31, tok = (w >> 5) * 4, t = tok & (SEQ - 1);
    const float z01 = (t == 0) ? 0.f : 1.f;
    float g[6][8];
#pragma unroll
    for (int i = 0; i < 6; ++i) mul8(R.hh[i], R.cc[i], g[i]);
#pragma unroll
    for (int j = 0; j < 8; ++j) { g[0][j] *= z01; g[1][j] *= z01; }
#pragma unroll
    for (int i = 0; i < 4; ++i) {
        const u32x4 bv = R.bb[i];
        const float bb[8] = {bflo(bv.x), bfhi(bv.x), bflo(bv.y), bfhi(bv.y), bflo(bv.z), bfhi(bv.z), bflo(bv.w), bfhi(bv.w)};
        float y[8]; float sq = 0.f;
#pragma unroll
        for (int j = 0; j < 8; ++j) { y[j] = bb[j] * (w0[j] * g[i][j] + w1[j] * g[i + 1][j] + w2[j] * g[i + 2][j]); sq += y[j] * y[j]; }
#pragma unroll
        for (int o = 1; o < 32; o <<= 1) sq += __shfl_xor(sq, o);
        const float rs = rsqrtf(sq * (1.f / 256.f) + EPS);
        u32x4 o4; o4.x = pk2(y[0] * rs * gm[0], y[1] * rs * gm[1]); o4.y = pk2(y[2] * rs * gm[2], y[3] * rs * gm[3]); o4.z = pk2(y[4] * rs * gm[4], y[5] * rs * gm[5]); o4.w = pk2(y[6] * rs * gm[6], y[7] * rs * gm[7]);
        *(u32x4*)(H + (size_t)(tok + i) * DMODEL + c8 * 8) = o4;
    }
}
__device__ __forceinline__ void conv3_phase(const bf16_t* P, bf16_t* H, const float* w3, const float* gn, int bx, int G, int tid) {
    constexpr int NW = NT / 4 * 32;
    const int c8 = tid & 31;
    float w0[8], w1[8], w2[8], gm[8];
#pragma unroll
    for (int j = 0; j < 8; ++j) { w0[j] = w3[c8 * 8 + j]; w1[j] = w3[256 + c8 * 8 + j]; w2[j] = w3[512 + c8 * 8 + j]; gm[j] = gn[c8 * 8 + j]; }
    C3Regs Ra, Rb;
    int w = bx * NTHREADS + tid; const int step = G * NTHREADS;
    if (w < NW) conv3_issue(P, w, Ra);
    for (; w < NW; w += 2 * step) {
        if (w + step < NW) conv3_issue(P, w + step, Rb);
        conv3_compute(H, w, Ra, w0, w1, w2, gm);
        if (w + step < NW) { if (w + 2 * step < NW) conv3_issue(P, w + 2 * step, Ra); conv3_compute(H, w + step, Rb, w0, w1, w2, gm); }
    }
}

constexpr int CF_ZOFF = 0, CF_STOFF = 94 * 1024;
__device__ __forceinline__ void cfm_issue(const bf16_t* P, int tix, int tid, u32x4 (&ar)[6], u32x4 (&gr)[6]) {
    const int b = tix >> 6, t0 = (tix & 63) * 64;
#pragma unroll
    for (int k = 0; k < 6; ++k) {
        int e = tid + NTHREADS * k; e = e < 94 * 32 ? e : 94 * 32 - 1;
        const int row = e >> 5, c8 = e & 31; int t = t0 - 30 + row; t = t < 0 ? 0 : t;
        const bf16_t* src = P + ((size_t)b * SEQ + t) * NIN + 768 + c8 * 8;
        ar[k] = *(const u32x4*)src; gr[k] = *(const u32x4*)(src + 256);
    }
}
__device__ __forceinline__ void cfm_stage(LAS unsigned char* lds, int tix, int tid, const u32x4 (&ar)[6], const u32x4 (&gr)[6]) {
    const int t0 = (tix & 63) * 64;
    LAS float* ZT = (LAS float*)(lds + CF_ZOFF);
#pragma unroll
    for (int k = 0; k < 6; ++k) {
        const int e = tid + NTHREADS * k;
        if (e < 94 * 32) {
            const int row = e >> 5, c8 = e & 31; const float zm = (t0 - 30 + row < 0) ? 0.f : 1.f;
            const u32x4 a = ar[k], g = gr[k];
            f32x4 z0, z1;
            z0[0] = bflo(a.x) * sigmoidf_(bflo(g.x)) * zm; z0[1] = bfhi(a.x) * sigmoidf_(bfhi(g.x)) * zm; z0[2] = bflo(a.y) * sigmoidf_(bflo(g.y)) * zm; z0[3] = bfhi(a.y) * sigmoidf_(bfhi(g.y)) * zm;
            z1[0] = bflo(a.z) * sigmoidf_(bflo(g.z)) * zm; z1[1] = bfhi(a.z) * sigmoidf_(bfhi(g.z)) * zm; z1[2] = bflo(a.w) * sigmoidf_(bflo(g.w)) * zm; z1[3] = bfhi(a.w) * sigmoidf_(bfhi(g.w)) * zm;
            *(LAS f32x4*)(ZT + row * 256 + c8 * 8) = z0; *(LAS f32x4*)(ZT + row * 256 + c8 * 8 + 4) = z1;
        }
    }
}
__device__ __forceinline__ void cfm_phase(LAS unsigned char* lds, const bf16_t* P, bf16_t* H, const float* dww, const float* dwb, const float* lng, const float* lnb, const float* gn,
                                          int bx, int G, int tid, int wid, int lane) {
    const int cp = tid & 127, rr = tid >> 7;
    f32x2v w[31];
#pragma unroll
    for (int k = 0; k < 31; ++k) w[k] = *(const f32x2v*)(dww + k * 256 + 2 * cp);
    const f32x2v bias = *(const f32x2v*)(dwb + 2 * cp), lg = *(const f32x2v*)(lng + 2 * cp), lb = *(const f32x2v*)(lnb + 2 * cp), gmm = *(const f32x2v*)(gn + 256 + 2 * cp);
    LAS float* ZT = (LAS float*)(lds + CF_ZOFF);
    LAS float* STX = (LAS float*)(lds + CF_STOFF);
    u32x4 ar[6], gr[6];
    int tix = bx;
    if (tix < 1024) cfm_issue(P, tix, tid, ar, gr);
    for (; tix < 1024; tix += G) {
        __syncthreads();
        cfm_stage(lds, tix, tid, ar, gr);
        if (tix + G < 1024) cfm_issue(P, tix + G, tid, ar, gr);
        __syncthreads();
        f32x2v acc[16];
#pragma unroll
        for (int j = 0; j < 16; ++j) acc[j] = bias;
#pragma unroll
        for (int s = 0; s < 46; ++s) {
            const f32x2v z = *(const LAS f32x2v*)(ZT + (rr * 16 + s) * 256 + 2 * cp);
#pragma unroll
            for (int j = 0; j < 16; ++j) { const int k = s - j; if (k >= 0 && k <= 30) acc[j] += w[k] * z; }
        }
        float s1[16], s2[16];
#pragma unroll
        for (int j = 0; j < 16; ++j) { s1[j] = wave_sum(acc[j].x + acc[j].y); s2[j] = wave_sum(acc[j].x * acc[j].x + acc[j].y * acc[j].y); }
        if (lane == 0) {
#pragma unroll
            for (int j = 0; j < 16; ++j) { STX[wid * 32 + j] = s1[j]; STX[wid * 32 + 16 + j] = s2[j]; }
        }
        __syncthreads();
        const int b = tix >> 6, t0 = (tix & 63) * 64;
        float s3[16];
#pragma unroll
        for (int j = 0; j < 16; ++j) {
            const float S1 = s1[j] + STX[(wid ^ 1) * 32 + j], S2 = s2[j] + STX[(wid ^ 1) * 32 + 16 + j];
            const float mean = S1 * (1.f / 256.f), var = fmaxf(S2 * (1.f / 256.f) - mean * mean, 0.f), rs = rsqrtf(var + EPS);
            f32x2v y = (acc[j] - mean) * rs * lg + lb;
            y.x = y.x * sigmoidf_(y.x); y.y = y.y * sigmoidf_(y.y);
            acc[j] = y;
            s3[j] = wave_sum(y.x * y.x + y.y * y.y);
        }
        if (lane == 0) {
#pragma unroll
            for (int j = 0; j < 16; ++j) STX[256 + wid * 16 + j] = s3[j];
        }
        __syncthreads();
#pragma unroll
        for (int j = 0; j < 16; ++j) {
            const float rs = rsqrtf((s3[j] + STX[256 + (wid ^ 1) * 16 + j]) * (1.f / 256.f) + EPS);
            *(unsigned*)(H + ((size_t)b * SEQ + t0 + rr * 16 + j) * DMODEL + 256 + 2 * cp) = pk2(acc[j].x * rs * gmm.x, acc[j].y * rs * gmm.y);
        }
    }
}

template <bool FULL> __device__ __forceinline__ void ssm_tile_scan(f32x16& xr, f32x16& xi, const float (&pw)[4][2], float& cr, float& ci, const bool hi) {
    const float l1r = pw[0][0], l1i = pw[0][1], l4r = pw[3][0], l4i = pw[3][1];
#pragma unroll
    for (int G = 0; G < 4; ++G)
#pragma unroll
        for (int j = 1; j < 4; ++j) { const int i = 4 * G + j; const float pr = xr[i - 1], pi = xi[i - 1]; xr[i] += l1r * pr - l1i * pi; xi[i] += l1r * pi + l1i * pr; }
    float cinr[4], cini[4];
#pragma unroll
    for (int G = 0; G < 4; ++G) {
        const float er = xr[4 * G + 3], ei = xi[4 * G + 3];
        const float orr = __shfl_xor(er, 32), oi = __shfl_xor(ei, 32);
        const float e0r = hi ? orr : er, e0i = hi ? oi : ei, e1r = hi ? er : orr, e1i = hi ? ei : oi;
        const float c1r = l4r * cr - l4i * ci + e0r, c1i = l4r * ci + l4i * cr + e0i;
        cinr[G] = hi ? c1r : cr; cini[G] = hi ? c1i : ci;
        const float c2r = l4r * c1r - l4i * c1i + e1r, c2i = l4r * c1i + l4i * c1r + e1i;
        cr = c2r; ci = c2i;
    }
    if (FULL) {
#pragma unroll
        for (int G = 0; G < 4; ++G)
#pragma unroll
            for (int j = 0; j < 4; ++j) { const int i = 4 * G + j; xr[i] += pw[j][0] * cinr[G] - pw[j][1] * cini[G]; xi[i] += pw[j][0] * cini[G] + pw[j][1] * cinr[G]; }
    }
}
constexpr int SSM_ROWB = 272;
__device__ __forceinline__ void ssm_item(LAS unsigned char* lds, const bf16_t* P, bf16_t* ZB, const float* a_re, const float* a_im, const float* log_dt, const float* b_re, const float* b_im,
                                         const float* c_re, const float* c_im, const float* d_skip, int item, int tid, int wid, int lane) {
    const int b = item >> 4, g = item & 15;
    const int r32 = lane & 31, h = lane >> 5; const bool hi = h != 0;
    LAS f32x2v* EW = (LAS f32x2v*)lds;
    LAS unsigned char* SBW = lds + 4096 + wid * (32 * SSM_ROWB);
    __syncthreads();
    float pw[2][4][2]; bf16x8 bfr[2][2];
#pragma unroll
    for (int tp = 0; tp < 2; ++tp) {
        const int p = r32 + 32 * tp;
        const float dt = __expf(log_dt[g]);
        const float ar = a_re[g * 64 + p], ai = a_im[g * 64 + p];
        const float mag = __expf(ar * dt);
        const float lr = mag * cosf(ai * dt), li = mag * sinf(ai * dt);
        const float den = ar * ar + ai * ai, nr = lr - 1.f, ni = li;
        const float fr = (nr * ar + ni * ai) / den, fi = (ni * ar - nr * ai) / den;
        const f32x4* br4 = (const f32x4*)(b_re + (size_t)(g * 64 + p) * 16 + 8 * h); const f32x4* bi4 = (const f32x4*)(b_im + (size_t)(g * 64 + p) * 16 + 8 * h);
        const f32x4 r0 = br4[0], r1 = br4[1], i0 = bi4[0], i1 = bi4[1];
        const f32x4 re0 = fr * r0 - fi * i0, re1 = fr * r1 - fi * i1, im0 = fr * i0 + fi * r0, im1 = fr * i1 + fi * r1;
        u32x4 wre, wim;
        wre.x = pk2(re0[0], re0[1]); wre.y = pk2(re0[2], re0[3]); wre.z = pk2(re1[0], re1[1]); wre.w = pk2(re1[2], re1[3]);
        wim.x = pk2(im0[0], im0[1]); wim.y = pk2(im0[2], im0[3]); wim.z = pk2(im1[0], im1[1]); wim.w = pk2(im1[2], im1[3]);
        bfr[tp][0] = __builtin_bit_cast(bf16x8, wre); bfr[tp][1] = __builtin_bit_cast(bf16x8, wim);
        pw[tp][0][0] = lr; pw[tp][0][1] = li;
#pragma unroll
        for (int j = 1; j < 4; ++j) { pw[tp][j][0] = pw[tp][j - 1][0] * lr - pw[tp][j - 1][1] * li; pw[tp][j][1] = pw[tp][j - 1][0] * li + pw[tp][j - 1][1] * lr; }
    }
    const int t16 = lane & 15, quad = lane >> 4;
    bf16x8 cfr[4];
#pragma unroll
    for (int s = 0; s < 4; ++s) {
        const f32x4 cr4 = *(const f32x4*)(c_re + (size_t)(g * 16 + t16) * 64 + 4 * quad + 16 * s), ci4 = *(const f32x4*)(c_im + (size_t)(g * 16 + t16) * 64 + 4 * quad + 16 * s);
        u32x4 w; w.x = pk2(cr4[0], -ci4[0]); w.y = pk2(cr4[1], -ci4[1]); w.z = pk2(cr4[2], -ci4[2]); w.w = pk2(cr4[3], -ci4[3]);
        cfr[s] = __builtin_bit_cast(bf16x8, w);
    }
    const f32x4 dsk = *(const f32x4*)(d_skip + g * 16 + 4 * quad);
    const size_t tok0 = (size_t)b * SEQ + (size_t)wid * 512;
    const bf16_t* ubase = P + tok0 * NIN + 1280 + g * 16;
    f32x16 zero16;
#pragma unroll
    for (int q = 0; q < 16; ++q) zero16[q] = 0.f;
    float cr[2] = {0.f, 0.f}, ci[2] = {0.f, 0.f};
    {
        bf16x8 ua = *(const bf16x8*)(ubase + (size_t)r32 * NIN + 8 * h);
        for (int mt = 0; mt < 16; ++mt) {
            const bf16x8 un = *(const bf16x8*)(ubase + (size_t)((mt < 15 ? mt + 1 : mt) * 32 + r32) * NIN + 8 * h);
#pragma unroll
            for (int tp = 0; tp < 2; ++tp) {
                f32x16 xr = __builtin_amdgcn_mfma_f32_32x32x16_bf16(ua, bfr[tp][0], zero16, 0, 0, 0);
                f32x16 xi = __builtin_amdgcn_mfma_f32_32x32x16_bf16(ua, bfr[tp][1], zero16, 0, 0, 0);
                ssm_tile_scan<false>(xr, xi, pw[tp], cr[tp], ci[tp], hi);
            }
            ua = un;
        }
    }
    if (!hi) { f32x2v e0 = {cr[0], ci[0]}, e1 = {cr[1], ci[1]}; EW[wid * 64 + r32] = e0; EW[wid * 64 + 32 + r32] = e1; }
    __syncthreads();
#pragma unroll
    for (int tp = 0; tp < 2; ++tp) {
        float qr = pw[tp][3][0], qi = pw[tp][3][1];
#pragma unroll
        for (int q = 0; q < 7; ++q) { const float nr = qr * qr - qi * qi, ni = 2.f * qr * qi; qr = nr; qi = ni; }
        float sr = 0.f, si = 0.f;
        for (int w = 0; w < wid; ++w) { const f32x2v e = EW[w * 64 + r32 + 32 * tp]; const float nr = qr * sr - qi * si + e.x, ni = qr * si + qi * sr + e.y; sr = nr; si = ni; }
        cr[tp] = sr; ci[tp] = si;
    }
    {
        bf16x8 ua = *(const bf16x8*)(ubase + (size_t)r32 * NIN + 8 * h);
        for (int mt = 0; mt < 16; ++mt) {
            const bf16x8 un = *(const bf16x8*)(ubase + (size_t)((mt < 15 ? mt + 1 : mt) * 32 + r32) * NIN + 8 * h);
            u32x2 uwv[2];
#pragma unroll
            for (int tt = 0; tt < 2; ++tt) uwv[tt] = *(const u32x2*)(P + (tok0 + mt * 32 + tt * 16 + t16) * NIN + 1280 + g * 16 + 4 * quad);
#pragma unroll
            for (int tp = 0; tp < 2; ++tp) {
                f32x16 xr = __builtin_amdgcn_mfma_f32_32x32x16_bf16(ua, bfr[tp][0], zero16, 0, 0, 0);
                f32x16 xi = __builtin_amdgcn_mfma_f32_32x32x16_bf16(ua, bfr[tp][1], zero16, 0, 0, 0);
                ssm_tile_scan<true>(xr, xi, pw[tp], cr[tp], ci[tp], hi);
#pragma unroll
                for (int i = 0; i < 16; ++i) {
                    const int t = (i & 3) + 8 * (i >> 2) + 4 * h;
                    *(LAS unsigned*)(SBW + t * SSM_ROWB + 4 * (r32 + 32 * tp)) = pk2(xr[i], xi[i]);
                }
            }
            WAVE_LDS_SYNC();
#pragma unroll
            for (int tt = 0; tt < 2; ++tt) {
                f32x4 acc = {0.f, 0.f, 0.f, 0.f};
#pragma unroll
                for (int s = 0; s < 4; ++s) {
                    const bf16x8 sf = *(const LAS bf16x8*)(SBW + (tt * 16 + t16) * SSM_ROWB + quad * 16 + 64 * s);
                    acc = __builtin_amdgcn_mfma_f32_16x16x32_bf16(cfr[s], sf, acc, 0, 0, 0);
                }
                const size_t tok = tok0 + mt * 32 + tt * 16 + t16;
                const u32x2 uw = uwv[tt];
                const f32x4 uu = {bflo(uw.x), bfhi(uw.x), bflo(uw.y), bfhi(uw.y)};
                const f32x4 y = acc + dsk * uu;
                u32x2 w; w.x = pk2(gelu_tanh(y.x), gelu_tanh(y.y)); w.y = pk2(gelu_tanh(y.z), gelu_tanh(y.w));
                *(u32x2*)(ZB + tok * 256 + g * 16 + 4 * quad) = w;
            }
            WAVE_LDS_SYNC();
            ua = un;
        }
    }
}

constexpr int AT_ROWB = 144, AT_KOFF = 0, AT_VOFF = 384 * AT_ROWB;
__device__ __forceinline__ s16x4 vtr(const LAS unsigned char* p) { return __builtin_bit_cast(s16x4, __builtin_amdgcn_ds_read_tr16_b64_v4i16((LAS s16x4*)p)); }
struct AttnU { int pat, head, d, ub; size_t rowbase; };
__device__ __forceinline__ AttnU attn_decode(int u) {
    AttnU U; const int rem = u & 1023, b = rem >> 6, ru = rem & 15; U.pat = u >> 10; U.head = (rem >> 4) & 3;
    int r;
    if (U.pat == 0) { U.d = 1; r = 0; U.ub = ru; } else if (U.pat == 1) { U.d = 4; r = ru >> 2; U.ub = ru & 3; } else { U.d = 16; r = ru; U.ub = 0; }
    U.rowbase = (size_t)b * SEQ + r; return U;
}
__device__ __forceinline__ void attn_issue(const bf16_t* P, const AttnU& U, int tid, int wid, int lane, u32x4 (&kreg)[6], u32x4 (&vreg)[6], bf16x8 (&qf)[4]) {
    const int i0 = U.ub * 256 - 128;
#pragma unroll
    for (int k = 0; k < 6; ++k) {
        const int e = tid + NTHREADS * k, row = e >> 3, c = e & 7; int si = i0 + row; si = si < 0 ? 0 : si;
        const bf16_t* src = P + (U.rowbase + (size_t)si * U.d) * NIN + U.head * 64 + c * 8;
        kreg[k] = *(const u32x4*)(src + 1792); vreg[k] = *(const u32x4*)(src + 2048);
    }
    const int r32 = lane & 31, h = lane >> 5;
    const size_t qtok = U.rowbase + (size_t)(U.ub * 256 + 32 * wid + r32) * U.d;
    const bf16_t* qp = P + qtok * NIN + 1536 + U.head * 64 + 8 * h;
#pragma unroll
    for (int s = 0; s < 4; ++s) qf[s] = *(const bf16x8*)(qp + 16 * s);
}
__device__ __forceinline__ void attn_to_lds(LAS unsigned char* lds, int tid, const u32x4 (&kreg)[6], const u32x4 (&vreg)[6]) {
#pragma unroll
    for (int k = 0; k < 6; ++k) {
        const int e = tid + NTHREADS * k, row = e >> 3, c = e & 7;
        *(LAS u32x4*)(lds + AT_KOFF + row * AT_ROWB + c * 16) = kreg[k];
        *(LAS u32x4*)(lds + AT_VOFF + row * AT_ROWB + c * 16) = vreg[k];
    }
}
__device__ __forceinline__ void attn_compute(LAS unsigned char* lds, const AttnU& U, const bf16x8 (&qf)[4], bf16_t* OB, f32x2v* ST, int wid, int lane) {
    const int pat = U.pat, head = U.head, ub = U.ub;
    const int r32 = lane & 31, h = lane >> 5;
    const size_t qtok = U.rowbase + (size_t)(ub * 256 + 32 * wid + r32) * U.d;
    f32x16 sc[5];
    float mx = -1e30f;
    const float r32f = (float)r32, h4f = (float)(4 * h);
#pragma unroll
    for (int i = 0; i < 5; ++i) {
        const bool tv = (ub > 0) || (wid + i >= 4);
        f32x16 a;
        if (tv) {
#pragma unroll
            for (int q = 0; q < 16; ++q) a[q] = 0.f;
            const LAS unsigned char* kp = lds + AT_KOFF + (32 * wid + 32 * i + r32) * AT_ROWB + 16 * h;
#pragma unroll
            for (int s = 0; s < 4; ++s) { const bf16x8 kf = *(const LAS bf16x8*)(kp + 32 * s); a = __builtin_amdgcn_mfma_f32_32x32x16_bf16(kf, qf[s], a, 0, 0, 0); }
            if (i == 0 || i == 4) {
#pragma unroll
                for (int q = 0; q < 16; ++q) {
                    const float diff = ((float)((q & 3) + 8 * (q >> 2)) + h4f) - r32f;
                    a[q] = (i == 0) ? __builtin_fmaf(fminf(diff, 0.f), 1e30f, a[q]) : __builtin_fmaf(fmaxf(diff, 0.f), -1e30f, a[q]);
                }
            }
#pragma unroll
            for (int q = 0; q < 16; ++q) mx = fmaxf(mx, a[q]);
        } else {
#pragma unroll
            for (int q = 0; q < 16; ++q) a[q] = -1e30f;
        }
        sc[i] = a;
    }
    mx = fmaxf(mx, __shfl_xor(mx, 32));
    float l = 0.f;
#pragma unroll
    for (int i = 0; i < 5; ++i)
#pragma unroll
        for (int q = 0; q < 16; ++q) { const float pv = __builtin_amdgcn_exp2f(sc[i][q] - mx); sc[i][q] = pv; l += pv; }
    l += __shfl_xor(l, 32);
    f32x16 o0, o1;
#pragma unroll
    for (int q = 0; q < 16; ++q) { o0[q] = 0.f; o1[q] = 0.f; }
    const int i16 = lane & 15, q4 = i16 >> 2, p4 = i16 & 3, blk = (lane >> 4) & 1;
#pragma unroll
    for (int i = 0; i < 5; ++i) {
        const bool tv = (ub > 0) || (wid + i >= 4);
        if (tv) {
#pragma unroll
            for (int s2 = 0; s2 < 2; ++s2) {
                u32x4 pw; pw.x = pk2(sc[i][8 * s2], sc[i][8 * s2 + 1]); pw.y = pk2(sc[i][8 * s2 + 2], sc[i][8 * s2 + 3]); pw.z = pk2(sc[i][8 * s2 + 4], sc[i][8 * s2 + 5]); pw.w = pk2(sc[i][8 * s2 + 6], sc[i][8 * s2 + 7]);
                const bf16x8 pb = __builtin_bit_cast(bf16x8, pw);
                const LAS unsigned char* vp = lds + AT_VOFF + (32 * wid + 32 * i + 16 * s2 + 4 * h + q4) * AT_ROWB + 32 * blk + 8 * p4;
                const s16x4 lo0 = vtr(vp), hi0 = vtr(vp + 8 * AT_ROWB), lo1 = vtr(vp + 64), hi1 = vtr(vp + 8 * AT_ROWB + 64);
                const bf16x8 va0 = __builtin_shufflevector(lo0, hi0, 0, 1, 2, 3, 4, 5, 6, 7), va1 = __builtin_shufflevector(lo1, hi1, 0, 1, 2, 3, 4, 5, 6, 7);
                o0 = __builtin_amdgcn_mfma_f32_32x32x16_bf16(va0, pb, o0, 0, 0, 0);
                o1 = __builtin_amdgcn_mfma_f32_32x32x16_bf16(va1, pb, o1, 0, 0, 0);
            }
        }
    }
    const float inv = 1.f / l;
    bf16_t* op = OB + ((size_t)pat * NT + qtok) * 256 + head * 64 + 4 * h;
#pragma unroll
    for (int g4 = 0; g4 < 4; ++g4) {
        u32x2 w0, w1;
        w0.x = pk2(o0[4 * g4] * inv, o0[4 * g4 + 1] * inv); w0.y = pk2(o0[4 * g4 + 2] * inv, o0[4 * g4 + 3] * inv);
        w1.x = pk2(o1[4 * g4] * inv, o1[4 * g4 + 1] * inv); w1.y = pk2(o1[4 * g4 + 2] * inv, o1[4 * g4 + 3] * inv);
        *(u32x2*)(op + 8 * g4) = w0; *(u32x2*)(op + 32 + 8 * g4) = w1;
    }
    if (h == 0) { f32x2v st = {mx, l}; ST[(qtok * 4 + head) * 3 + pat] = st; }
}

__device__ __forceinline__ void combine_rows(const bf16_t* YC, const bf16_t* OB, const f32x2v* ST, const float* gn, bf16_t* H, int gw, int ngw, int lane) {
    f32x4 gv[2];
#pragma unroll
    for (int j = 0; j < 2; ++j) gv[j] = ((const f32x4*)gn)[lane + 64 * (j + 2)];
    const int head = lane >> 4;
    for (int m0 = gw * 4; m0 < NT; m0 += ngw * 4) {
        u32x2 yw[4], a0[4], a1[4], a2[4]; f32x2v s0[4], s1[4], s2[4];
#pragma unroll
        for (int r = 0; r < 4; ++r) {
            const size_t m = (size_t)m0 + r;
            yw[r] = *((const u32x2*)(YC + m * 768 + 512) + lane);
            s0[r] = ST[(m * 4 + head) * 3 + 0]; s1[r] = ST[(m * 4 + head) * 3 + 1]; s2[r] = ST[(m * 4 + head) * 3 + 2];
            a0[r] = *((const u32x2*)(OB + m * 256) + lane); a1[r] = *((const u32x2*)(OB + ((size_t)NT + m) * 256) + lane); a2[r] = *((const u32x2*)(OB + ((size_t)2 * NT + m) * 256) + lane);
        }
#pragma unroll
        for (int r = 0; r < 4; ++r) {
            const size_t m = (size_t)m0 + r;
            f32x4 v[2];
            v[0] = (f32x4){bflo(yw[r].x), bfhi(yw[r].x), bflo(yw[r].y), bfhi(yw[r].y)};
            {
                const float M = fmaxf(s0[r].x, fmaxf(s1[r].x, s2[r].x));
                const float w0 = __builtin_amdgcn_exp2f(s0[r].x - M) * s0[r].y, w1 = __builtin_amdgcn_exp2f(s1[r].x - M) * s1[r].y, w2 = __builtin_amdgcn_exp2f(s2[r].x - M) * s2[r].y;
                const float iw = __builtin_amdgcn_rcpf(w0 + w1 + w2);
                f32x4 o;
                o.x = (w0 * bflo(a0[r].x) + w1 * bflo(a1[r].x) + w2 * bflo(a2[r].x)) * iw; o.y = (w0 * bfhi(a0[r].x) + w1 * bfhi(a1[r].x) + w2 * bfhi(a2[r].x)) * iw;
                o.z = (w0 * bflo(a0[r].y) + w1 * bflo(a1[r].y) + w2 * bflo(a2[r].y)) * iw; o.w = (w0 * bfhi(a0[r].y) + w1 * bfhi(a1[r].y) + w2 * bfhi(a2[r].y)) * iw;
                v[1] = o;
            }
#pragma unroll
            for (int j = 0; j < 2; ++j) {
                const float ss = wave_sum((v[j].x * v[j].x + v[j].y * v[j].y) + (v[j].z * v[j].z + v[j].w * v[j].w));
                const float rs = rsqrtf(ss * (1.f / 256.f) + EPS);
                u32x2 w; w.x = pk2(v[j].x * rs * gv[j].x, v[j].y * rs * gv[j].y); w.y = pk2(v[j].z * rs * gv[j].z, v[j].w * rs * gv[j].w);
                *((u32x2*)(H + m * DMODEL + 256 * (j + 2)) + lane) = w;
            }
        }
    }
}

#define XB_TMO      128
#define XB_XCNT(j)  (256  + 64 * (j))
#define XB_XSUB(j)  (1280 + 64 * (j))
#define XB_XGEN(j)  (2304 + 64 * (j))
#define XB_TOP      3328
#define XB_TOPGEN   3392
#define XCD_BAR_WORDS 3456
#define XB_SPIN_CAP (1u << 18)

__device__ __forceinline__ unsigned xb_ld(unsigned* p)              { return __hip_atomic_load(p, __ATOMIC_RELAXED, __HIP_MEMORY_SCOPE_AGENT); }
__device__ __forceinline__ unsigned xb_add(unsigned* p, unsigned v) { return __hip_atomic_fetch_add(p, v, __ATOMIC_RELAXED, __HIP_MEMORY_SCOPE_AGENT); }
__device__ __forceinline__ unsigned xb_xcc_id() { return (unsigned)__builtin_amdgcn_s_getreg((3 << 11) | 20) & 0xFu; }
#define XB_SPIN(cond, bar) do { unsigned _sp = 0; while (cond) { __builtin_amdgcn_s_sleep(1); \
    if ((++_sp & 255u) == 0u) { if (xb_ld(&(bar)[XB_TMO])) break; if (_sp > XB_SPIN_CAP) { atomicAdd(&(bar)[XB_TMO], 1u); break; } } } } while (0)

struct XcdBarrier {
    unsigned* bar; unsigned x;
    volatile LAS unsigned* st;
};

__device__ __forceinline__ XcdBarrier xcd_barrier_post(unsigned* bar, volatile LAS unsigned* st) {
    XcdBarrier b; b.bar = bar; b.x = xb_xcc_id(); b.st = st;
    if (threadIdx.x == 0) (void)xb_add(&bar[XB_XCNT(b.x)], 1u);
    return b;
}
__device__ __forceinline__ void xcd_barrier_complete(unsigned* bar, unsigned x, unsigned& nloc, unsigned& nx) {
    const unsigned G = gridDim.x * gridDim.y * gridDim.z;
    unsigned sum, cnt, mine, sp = 0u;
    for (;;) {
        sum = 0u; cnt = 0u; mine = 0u;
#pragma unroll
        for (unsigned j = 0; j < 16; ++j) { const unsigned c = xb_ld(&bar[XB_XCNT(j)]); sum += c; cnt += (c > 0u) ? 1u : 0u; mine = (j == x) ? c : mine; }
        if (sum == G) break;
        __builtin_amdgcn_s_sleep(1);
        if ((++sp & 255u) == 0u) { if (xb_ld(&bar[XB_TMO])) break; if (sp > XB_SPIN_CAP) { atomicAdd(&bar[XB_TMO], 1u); break; } }
    }
    nloc = mine > 0u ? mine : 1u; nx = cnt > 0u ? cnt : 1u;
}

__device__ __forceinline__ void xcd_barrier(const XcdBarrier& b) {
    asm volatile("s_waitcnt vmcnt(0)" ::: "memory");
    __syncthreads();
    if (threadIdx.x == 0) {
        unsigned* bar = b.bar;
        __builtin_amdgcn_s_waitcnt(0);
        unsigned nloc = b.st[0], nx = b.st[1];
        if (nloc == 0u) { xcd_barrier_complete(bar, b.x, nloc, nx); b.st[0] = nloc; b.st[1] = nx; }
        const unsigned old = xb_add(&bar[XB_XSUB(b.x)], 1u);
        const unsigned gen = old / nloc;
        if (old + 1u == (gen + 1u) * nloc) {
            __builtin_amdgcn_fence(__ATOMIC_RELEASE, "agent");
            asm volatile("s_waitcnt vmcnt(0)" ::: "memory");
            const unsigned og = xb_add(&bar[XB_TOP], 1u);
            const unsigned tg = og / nx;
            if (og + 1u == (tg + 1u) * nx) xb_add(&bar[XB_TOPGEN], 1u);
            else XB_SPIN(xb_ld(&bar[XB_TOPGEN]) == tg, bar);
            __builtin_amdgcn_fence(__ATOMIC_ACQUIRE, "agent");
            xb_add(&bar[XB_XGEN(b.x)], 1u);
            asm volatile("s_waitcnt vmcnt(0)" ::: "memory");
        } else {
            XB_SPIN(xb_ld(&bar[XB_XGEN(b.x)]) == gen, bar);
            __builtin_amdgcn_fence(__ATOMIC_ACQUIRE, "agent");
            asm volatile("s_waitcnt vmcnt(0)" ::: "memory");
        }
    }
    __syncthreads();
}

constexpr int NPHASE = 16;
struct Ctx { const Args* args; LAS unsigned char* lds; int tid, lane, wid, G, bx, gw, ngw; };
#define LAUNDER(p) asm volatile("" : "+s"(p))
__device__ __forceinline__ void phase_body(const int ph, const CAS Args* ap, LAS unsigned char* lds, const int tid, const int lane, const int wid, const int G, const int bx) {
    const int gw = bx * 8 + wid, ngw = G * 8;
    unsigned char* ws = ap->ws;
    const float* x_in = ap->in[0];
    float* X = ap->out;
    bf16_t* Hb = (bf16_t*)(ws + WS_H); bf16_t* Pb = (bf16_t*)(ws + WS_P); bf16_t* YC = (bf16_t*)(ws + WS_YC); bf16_t* ZB = (bf16_t*)(ws + WS_ZB); bf16_t* OB = (bf16_t*)(ws + WS_OB);
    f32x2v* ST = (f32x2v*)(ws + WS_ST);
    float* ropec = (float*)(ws + WS_ROPE); float* ropes = ropec + SEQ * 32;
    bf16_t* XB = (bf16_t*)(ws + WS_XB); float* SS = (float*)(ws + WS_SS);
    if (ph == 0) {
        {
            float v[8], vn[8]; int t = 0, tn = 0;
            int it = bx;
            WMat w = wmat_of(ap, ws, it < 2 * 2976 ? it : 0, t), wn = w;
            if (it < 2 * 2976) wconv_load(w, t, tid, v);
            for (; it < 2 * 2976; it += G) {
                const bool more = it + G < 2 * 2976;
                if (more) { wn = wmat_of(ap, ws, it + G, tn); wconv_load(wn, tn, tid, vn); }
                wconv_store((LAS float*)lds, w, t, tid, v);
                if (more) {
#pragma unroll
                    for (int i = 0; i < 8; ++i) v[i] = vn[i];
                    w = wn; t = tn;
                }
            }
        }
        for (int e = bx * NTHREADS + tid; e < SEQ * 32; e += G * NTHREADS) {
            const int pos = e >> 5, i = e & 31;
            const double inv = (double)exp2f(-(float)i * (13.287712379549449f / 32.f));
            const float angf = (float)pos * (float)inv;
            double rev = (double)angf * 0.15915494309189535; rev -= floor(rev);
            ropec[e] = __builtin_amdgcn_cosf((float)rev); ropes[e] = __builtin_amdgcn_sinf((float)rev);
        }
        xb_rows(x_in, XB, SS, gw, ngw, lane);
        return;
    }
    if (ph == 15) {
        float tscale = 1.f;
#ifdef TIMED
        { const unsigned long long* ts = (const unsigned long long*)(ws + WS_BAR) + 1800; tscale = 1.f + (float)(ts[1] - ts[0]) * 1e-5f; }
#endif
        final_rows(XB, SS + (size_t)4 * NT * 4, ap->in[23], X, gw, ngw, lane, tscale); return; }
    const int layer = (ph - 1) / 7, sub = (ph - 1) % 7;
    unsigned char* wb = ws + WS_W + (size_t)layer * W_LAYER;
    if (sub == 0) {
        pg8::Gemm g{XB, (const bf16_t*)(wb + W_IN), NT, NIN, 1024}; pg8::StaticOrder S; S.init(NT, NIN, G, bx);
        EpiIn E{Pb, ropec, ropes, RowScale{SS + (size_t)(layer == 0 ? 0 : 2) * NT * 4, (LAS float*)(lds + 131072 + 4096)}};
        pg8::gemm_phase<EpiIn, pg8::StaticOrder, true, true>(lds, g, S, E);
    } else if (sub == 1) {
        const int rot = bx % 3;
#define RUN_S do { LAUNDER(ap); for (int it = bx; it < 256; it += G) \
            ssm_item(lds, Pb, ZB, ap->in[8] + layer * 1024, ap->in[9] + layer * 1024, ap->in[10] + layer * 16, ap->in[11] + (size_t)layer * 16384, ap->in[12] + (size_t)layer * 16384, \
                     ap->in[13] + (size_t)layer * 16384, ap->in[14] + (size_t)layer * 16384, ap->in[15] + layer * 256, it, tid, wid, lane); __syncthreads(); } while (0)
#define RUN_C do { LAUNDER(ap); conv3_phase(Pb, Hb, ap->in[3] + layer * 768, ap->in[17] + layer * 1024, bx, G, tid); \
            cfm_phase(lds, Pb, Hb, ap->in[4] + layer * 31 * 256, ap->in[5] + layer * 256, ap->in[6] + layer * 256, ap->in[7] + layer * 256, ap->in[17] + layer * 1024, bx, G, tid, wid, lane); __syncthreads(); } while (0)
        if (rot == 0) RUN_S;
        if (rot <= 1) RUN_C;
        {
            const int per = (3072 + G - 1) / G, it0 = bx * per, it1 = (it0 + per < 3072) ? it0 + per : 3072;
            u32x4 kreg[6], vreg[6]; bf16x8 qn[4], qc[4];
            int it = it0;
            AttnU U = attn_decode(it < it1 ? it : 0);
            if (it < it1) attn_issue(Pb, U, tid, wid, lane, kreg, vreg, qn);
            for (; it < it1; ++it) {
                __syncthreads();
                attn_to_lds(lds, tid, kreg, vreg);
#pragma unroll
                for (int s = 0; s < 4; ++s) qc[s] = qn[s];
                __syncthreads();
                const AttnU Uc = U;
                if (it + 1 < it1) { U = attn_decode(it + 1); attn_issue(Pb, U, tid, wid, lane, kreg, vreg, qn); }
                attn_compute(lds, Uc, qc, OB, ST, wid, lane);
            }
            __syncthreads();
        }
        if (rot >= 1) RUN_S;
        if (rot == 2) RUN_C;
#undef RUN_S
#undef RUN_C
    } else if (sub == 2) {
        pg8::Gemm g{ZB, (const bf16_t*)(wb + W_GLU), NT, 512, 256}; pg8::StaticOrder S; S.init(NT, 512, G, bx);
        EpiGate<1> E{YC, 768, 512, RowScale{nullptr, nullptr}};
        pg8::gemm_phase<EpiGate<1>, pg8::StaticOrder, true, true>(lds, g, S, E);
    } else if (sub == 3) {
        combine_rows(YC, OB, ST, ap->in[17] + layer * 1024, Hb, gw, ngw, lane);
    } else if (sub == 4) {
        pg8::Gemm g{Hb, (const bf16_t*)(wb + W_OUT), NT, 1024, 1024}; pg8::StaticOrder S; S.init(NT, 1024, G, bx);
        EpiRes E{XB, SS + (size_t)(layer == 0 ? 1 : 3) * NT * 4, (LAS float*)(lds + 131072)};
        pg8::gemm_phase<EpiRes, pg8::StaticOrder, true, true>(lds, g, S, E);
    } else if (sub == 5) {
#ifdef STAGGER_GU
        { const int st = (bx >> 3) & 7; for (int q = 0; q < st; ++q) __builtin_amdgcn_s_sleep(127); }
#endif
        pg8::Gemm g{XB, (const bf16_t*)(wb + W_GU), NT, 2 * DFF, 1024}; pg8::StaticOrder S; S.init(NT, 2 * DFF, G, bx);
        EpiGate<0> E{Pb, DFF, 0, RowScale{SS + (size_t)(layer == 0 ? 1 : 3) * NT * 4, (LAS float*)(lds + 131072 + 4096)}};
        pg8::gemm_phase<EpiGate<0>, pg8::StaticOrder, true, true>(lds, g, S, E);
    } else {
        pg8::Gemm g{Pb, (const bf16_t*)(wb + W_DN), NT, 1024, DFF}; pg8::StaticOrder S; S.init(NT, 1024, G, bx);
        EpiRes E{XB, SS + (size_t)(layer == 0 ? 2 : 4) * NT * 4, (LAS float*)(lds + 131072)};
        pg8::gemm_phase<EpiRes, pg8::StaticOrder, true, true>(lds, g, S, E);
    }
}
__global__ void __launch_bounds__(NTHREADS, 2) fwd_megakernel(Args args) {
    extern __shared__ __attribute__((aligned(16))) unsigned char lds_raw[];
    LAS unsigned char* lds = (LAS unsigned char*)lds_raw;
    cg::grid_group grid = cg::this_grid();
    const int tid = threadIdx.x, lane = tid & 63, wid = __builtin_amdgcn_readfirstlane(tid >> 6);
    const int G = gridDim.x, bx = blockIdx.x;
    const int lo = args.ph_lo, hi = args.ph_hi;
    const CAS Args* ap = (const CAS Args*)__builtin_amdgcn_kernarg_segment_ptr();
    volatile LAS unsigned* bst = (volatile LAS unsigned*)(lds + LDS_BYTES - 64);
    if (tid == 0) { bst[0] = 0u; bst[1] = 0u; }
    __syncthreads();
    XcdBarrier xbar = xcd_barrier_post((unsigned*)(args.ws + WS_BAR), bst);
#define GSYNC(k) do { if ((k) == 1) grid.sync(); else xcd_barrier(xbar); } while (0)
#ifdef TIMED
#define TSTAMP(k) do { if (bx == 0 && tid == 0) { if ((k) == TIMED) ((unsigned long long*)(args.ws + WS_BAR))[1800] = __builtin_amdgcn_s_memrealtime(); \
        if ((k) == TIMED + TIMED_N) ((unsigned long long*)(args.ws + WS_BAR))[1801] = __builtin_amdgcn_s_memrealtime(); } } while (0)
#else
#define TSTAMP(k) do { } while (0)
#endif
#define PHASE(k) if (lo <= (k) && (k) < hi) { if ((k) > lo) GSYNC(k); TSTAMP(k); LAUNDER(ap); phase_body((k), ap, lds, tid, lane, wid, G, bx); }
    PHASE(0) PHASE(1) PHASE(2) PHASE(3) PHASE(4) PHASE(5) PHASE(6) PHASE(7) PHASE(8) PHASE(9)
    PHASE(10) PHASE(11) PHASE(12) PHASE(13) PHASE(14) PHASE(15)
#undef PHASE
}

extern "C" void kernel_launch(void* const* d_in, const int* in_sizes, int n_in, void* d_out, int out_size, void* d_ws, size_t ws_size, hipStream_t stream) {
    static int grid_blocks = 0;
    if (grid_blocks == 0) {
        if (n_in != 24 || ws_size < WS_END) { fprintf(stderr, "kernel_launch: unexpected n_in %d / ws_size %zu\n", n_in, ws_size); grid_blocks = -1; return; }
        int dev = 0, cus = 0, per_cu = 0;
        hipGetDevice(&dev);
        hipDeviceGetAttribute(&cus, hipDeviceAttributeMultiprocessorCount, dev);
        if (hipFuncSetAttribute((const void*)fwd_megakernel, hipFuncAttributeMaxDynamicSharedMemorySize, LDS_BYTES) != hipSuccess) { fprintf(stderr, "kernel_launch: hipFuncSetAttribute failed\n"); grid_blocks = -1; return; }
        if (hipOccupancyMaxActiveBlocksPerMultiprocessor(&per_cu, (const void*)fwd_megakernel, NTHREADS, LDS_BYTES) != hipSuccess || per_cu < 1) { fprintf(stderr, "kernel_launch: occupancy query %d\n", per_cu); per_cu = 1; }
        (void)hipGetLastError();
        grid_blocks = cus * per_cu;
    }
    if (grid_blocks < 0) return;
    Args a{};
    for (int i = 0; i < 24; ++i) a.in[i] = (const float*)d_in[i];
    a.out = (float*)d_out; a.ws = (unsigned char*)d_ws; a.ph_lo = 0; a.ph_hi = NPHASE;
    if (hipMemsetAsync((char*)d_ws + WS_BAR, 0, 16384, stream) != hipSuccess) { fprintf(stderr, "kernel_launch: memset failed\n"); return; }
    void* kargs[] = {&a};
    hipError_t e = hipLaunchCooperativeKernel((const void*)fwd_megakernel, dim3(grid_blocks), dim3(NTHREADS), kargs, LDS_BYTES, stream);
    if (e != hipSuccess) fprintf(stderr, "cooperative launch failed: %s (grid %d)\n", hipGetErrorString(e), grid_blocks);
}
```

```cpp
#include <hip/hip_runtime.h>
#include <hip/hip_cooperative_groups.h>
#include <cstdio>
#include <cstdint>
namespace cg = cooperative_groups;
namespace pg8 {
#define PG8_LAS __attribute__((address_space(3)))
typedef unsigned short bf16_t;
typedef short bf16x8 __attribute__((ext_vector_type(8)));
typedef float f32x4 __attribute__((ext_vector_type(4)));
typedef unsigned u32x4 __attribute__((ext_vector_type(4)));
constexpr int BM = 256, BK = 64, HALF = 128, HTB = HALF * BK * 2  , STAGE_BYTES = 8 * HTB, NXCD = 8, WGM = 8;

__host__ __device__ __forceinline__ int lds_byte(int r, int c) { const int st = (r >> 4) * 2 + (c >> 5), rr = r & 15, cc = c & 31, ob = rr * 64 + cc * 2; return st * 1024 + (ob ^ (((ob >> 9) & 1) << 5)); }
__host__ __device__ __forceinline__ void stage_rc(int b, int& R, int& C) { const int st = b / 1024, sb = b % 1024, swz = sb ^ (((sb >> 9) & 1) << 5); R = (st >> 1) * 16 + swz / 64; C = (st & 1) * 32 + (swz % 64) / 2; }
__host__ __device__ __forceinline__ int perm32(int rho) { const int n = rho >> 4, i = rho & 15; return 8 * (i >> 2) + 4 * n + (i & 3); }

struct Unit { int pm, pn; };
struct Gemm { const bf16_t* A; const bf16_t* Bt; int M, N, K; };

struct StaticOrder {
    int nM, nN, nwg, G, c;
    __host__ __device__ void init(int M, int N, int G_, int c_) { nM = M / BM; nN = N / BM; nwg = nM * nN; G = G_; c = c_; }
    __host__ __device__ bool next(int i, Unit& u) const {
        const long L = (long)i * G + c; if (L >= nwg) return false;
        int wgid = (int)L; { const int q = nwg / NXCD, r = nwg % NXCD, xcd = wgid % NXCD, off = wgid / NXCD; wgid = (xcd < r ? xcd * (q + 1) : r * (q + 1) + (xcd - r) * q) + off; }
        const int nig = WGM * nN, gid = wgid / nig, fm = gid * WGM, gsz = (nM - fm) < WGM ? (nM - fm) : WGM;
        u.pm = fm + ((wgid % nig) % gsz); u.pn = (wgid % nig) / gsz; return true;
    }
    __device__ __forceinline__ void a_ready(const Unit&) const {}
    __device__ __forceinline__ void done(const Unit&) const {}
};

__device__ __forceinline__ unsigned cvt_pk_bf16(float lo, float hi) { unsigned r; asm volatile("v_cvt_pk_bf16_f32 %0, %1, %2" : "=v"(r) : "v"(lo), "v"(hi)); return r; }
typedef float f32x2 __attribute__((ext_vector_type(2)));
template <class Epi, class Sched, bool ALIGN_EPI = false, bool SP2 = false>
__device__ __forceinline__ void gemm_phase(PG8_LAS unsigned char* lds, const Gemm g, const Sched& S, const Epi& E) {
    const int tid = threadIdx.x, wid = __builtin_amdgcn_readfirstlane(tid >> 6), lane = tid & 63, wr = wid >> 2, wc = wid & 3, fr = lane & 15, fq = lane >> 4;
    const int K = g.K, nt = K / BK;
    unsigned voffA[2], voffB[2];
#pragma unroll
    for (int i = 0; i < 2; ++i) { int R, C; stage_rc(tid * 16 + i * 8192, R, C); const int Rb = Epi::PERM ? ((R & ~31) + perm32(R & 31)) : R;
        voffA[i] = (unsigned)(R * K + C) * 2u; voffB[i] = (unsigned)(Rb * K + C) * 2u; }
    const size_t kstep = (size_t)(BK * 2);
    const size_t hstep = (size_t)HALF * K * 2;
    const size_t tstep = 2 * hstep;
    const unsigned ldsw = (unsigned)wid * 1024u;
    const int aoff = lds_byte(wr * 64 + fr, fq * 8), boff = lds_byte(wc * 32 + fr, fq * 8);
#define PG8_SA(b, h) (((b) * 2 + (h)) * HTB)
#define PG8_SB(b, h) ((4 + (b) * 2 + (h)) * HTB)
#define PG8_STAGE(bufoff, gbase, voff) do { _Pragma("unroll") for (int _i = 0; _i < 2; ++_i) \
        __builtin_amdgcn_global_load_lds((const unsigned*)((const char*)(gbase) + (voff)[_i]), (PG8_LAS unsigned*)(lds + (bufoff) + ldsw + _i * 8192), 16, 0, 0); } while (0)
#define PG8_LDA(dst, b, h) do { _Pragma("unroll") for (int m = 0; m < 4; ++m) _Pragma("unroll") for (int k = 0; k < 2; ++k) dst[m][k] = *(const PG8_LAS bf16x8*)(lds + PG8_SA(b, h) + aoff + m * 2048 + k * 1024); } while (0)
#define PG8_LDB(dst, b, h) do { _Pragma("unroll") for (int n = 0; n < 2; ++n) _Pragma("unroll") for (int k = 0; k < 2; ++k) dst[n][k] = *(const PG8_LAS bf16x8*)(lds + PG8_SB(b, h) + boff + n * 2048 + k * 1024); } while (0)
#define PG8_MMA(ai, bj, At, Bt) do { __builtin_amdgcn_s_setprio(1); _Pragma("unroll") for (int m = 0; m < 4; ++m) _Pragma("unroll") for (int n = 0; n < 2; ++n) _Pragma("unroll") for (int k = 0; k < 2; ++k) \
        acc[ai][bj][m][n] = __builtin_amdgcn_mfma_f32_16x16x32_bf16(Bt[n][k], At[m][k], acc[ai][bj][m][n], 0, 0, 0); __builtin_amdgcn_s_setprio(0); } while (0)
#define PG8_WAIT_V(n) asm volatile("s_waitcnt vmcnt(" #n ")" ::: "memory")
#define PG8_WAIT_L(n) asm volatile("s_waitcnt lgkmcnt(" #n ")" ::: "memory")
#define PG8_BAR __builtin_amdgcn_s_barrier()
#define PG8_SCHED __builtin_amdgcn_sched_barrier(0)
    Unit cur, nxt; int ui = 0;
    if (!S.next(0, cur)) return;
    E.prime(cur);
    f32x4 acc[2][2][4][2];
#pragma unroll
    for (int a = 0; a < 2; ++a)
#pragma unroll
        for (int b = 0; b < 2; ++b)
#pragma unroll
            for (int m = 0; m < 4; ++m)
#pragma unroll
                for (int n = 0; n < 2; ++n) acc[a][b][m][n] = (f32x4){0.f, 0.f, 0.f, 0.f};
    bf16x8 At[4][2], B0[2][2], B1[2][2];
    const char* cA = (const char*)g.A + (size_t)cur.pm * tstep; const char* cB = (const char*)g.Bt + (size_t)cur.pn * tstep;
    S.a_ready(cur);
    if constexpr (SP2) {
        PG8_STAGE(PG8_SB(0, 0), cB, voffB); PG8_STAGE(PG8_SB(0, 1), cB + hstep, voffB); PG8_STAGE(PG8_SA(0, 0), cA, voffA); PG8_STAGE(PG8_SA(0, 1), cA + hstep, voffA);
        if (wr == 1) PG8_BAR;
        PG8_WAIT_V(2); PG8_BAR;
        PG8_STAGE(PG8_SB(1, 0), cB + kstep, voffB); PG8_STAGE(PG8_SA(1, 0), cA + kstep, voffA); PG8_STAGE(PG8_SB(1, 1), cB + hstep + kstep, voffB);
        PG8_WAIT_V(6); PG8_BAR;
    } else {
        PG8_STAGE(PG8_SB(0, 0), cB, voffB); PG8_STAGE(PG8_SA(0, 0), cA, voffA); PG8_STAGE(PG8_SB(0, 1), cB + hstep, voffB); PG8_STAGE(PG8_SA(0, 1), cA + hstep, voffA);
        if (wr == 1) PG8_BAR;
        PG8_WAIT_V(4); PG8_BAR;
        PG8_STAGE(PG8_SB(1, 0), cB + kstep, voffB); PG8_STAGE(PG8_SA(1, 0), cA + kstep, voffA); PG8_STAGE(PG8_SB(1, 1), cB + hstep + kstep, voffB);
        PG8_WAIT_V(6); PG8_BAR;
    }
    for (;;) {
        const bool has_next = S.next(ui + 1, nxt);
        const char* nA = has_next ? (const char*)g.A + (size_t)nxt.pm * tstep : cA; const char* nB = has_next ? (const char*)g.Bt + (size_t)nxt.pn * tstep : cB;
#pragma nounroll
        for (int t = 0; t < nt; t += 2) {
            const bool last = (t == nt - 2);
            const char* a1 = cA + (size_t)(t + 1) * kstep;
            const char* a2 = last ? nA : cA + (size_t)(t + 2) * kstep; const char* b2 = last ? nB : cB + (size_t)(t + 2) * kstep;
            const char* a3 = a2 + kstep; const char* b3 = b2 + kstep;
            if (last && has_next) S.a_ready(nxt);
            if constexpr (SP2) {
            PG8_LDB(B0, 0, 0); PG8_LDB(B1, 0, 1); PG8_SCHED; PG8_LDA(At, 0, 0); PG8_STAGE(PG8_SA(1, 1), a1 + hstep, voffA);
            PG8_WAIT_V(8); PG8_WAIT_L(0); PG8_BAR; PG8_MMA(0, 0, At, B0); PG8_MMA(0, 1, At, B1); PG8_BAR; PG8_SCHED;
            PG8_LDA(At, 0, 1); PG8_STAGE(PG8_SB(0, 0), b2, voffB); PG8_STAGE(PG8_SB(0, 1), b2 + hstep, voffB); PG8_STAGE(PG8_SA(0, 0), a2, voffA);
            PG8_WAIT_V(8); PG8_WAIT_L(0); PG8_BAR; PG8_MMA(1, 0, At, B0); PG8_MMA(1, 1, At, B1); PG8_BAR; PG8_SCHED;
            PG8_LDB(B0, 1, 0); PG8_LDB(B1, 1, 1); PG8_SCHED; PG8_LDA(At, 1, 0); PG8_STAGE(PG8_SA(0, 1), a2 + hstep, voffA);
            PG8_WAIT_V(8); PG8_WAIT_L(0); PG8_BAR; PG8_MMA(0, 0, At, B0); PG8_MMA(0, 1, At, B1); PG8_BAR; PG8_SCHED;
            PG8_LDA(At, 1, 1); PG8_STAGE(PG8_SB(1, 0), b3, voffB); PG8_STAGE(PG8_SB(1, 1), b3 + hstep, voffB); PG8_STAGE(PG8_SA(1, 0), a3, voffA);
            PG8_WAIT_V(8); PG8_WAIT_L(0); PG8_BAR; PG8_MMA(1, 0, At, B0); PG8_MMA(1, 1, At, B1); PG8_BAR; PG8_SCHED;
            } else {
            PG8_LDB(B0, 0, 0); PG8_SCHED; PG8_LDA(At, 0, 0); PG8_STAGE(PG8_SA(1, 1), a1 + hstep, voffA);
            PG8_WAIT_L(8); PG8_BAR; PG8_WAIT_L(0); PG8_MMA(0, 0, At, B0); PG8_BAR; PG8_SCHED;
            PG8_LDB(B1, 0, 1); PG8_STAGE(PG8_SB(0, 0), b2, voffB);
            PG8_BAR; PG8_WAIT_L(0); PG8_MMA(0, 1, At, B1); PG8_BAR;
            PG8_LDA(At, 0, 1); PG8_STAGE(PG8_SA(0, 0), a2, voffA);
            PG8_BAR; PG8_WAIT_L(0); PG8_MMA(1, 0, At, B0); PG8_BAR; PG8_SCHED;
            PG8_STAGE(PG8_SB(0, 1), b2 + hstep, voffB);
            PG8_WAIT_V(6); PG8_BAR; PG8_MMA(1, 1, At, B1); PG8_BAR;
            PG8_LDB(B0, 1, 0); PG8_SCHED; PG8_LDA(At, 1, 0); PG8_STAGE(PG8_SA(0, 1), a2 + hstep, voffA);
            PG8_WAIT_L(8); PG8_BAR; PG8_WAIT_L(0); PG8_MMA(0, 0, At, B0); PG8_BAR; PG8_SCHED;
            PG8_LDB(B1, 1, 1); PG8_STAGE(PG8_SB(1, 0), b3, voffB);
            PG8_BAR; PG8_WAIT_L(0); PG8_MMA(0, 1, At, B1); PG8_BAR;
            PG8_LDA(At, 1, 1); PG8_STAGE(PG8_SA(1, 0), a3, voffA);
            PG8_BAR; PG8_WAIT_L(0); PG8_MMA(1, 0, At, B0); PG8_BAR; PG8_SCHED;
            PG8_STAGE(PG8_SB(1, 1), b3 + hstep, voffB);
            PG8_WAIT_V(6); PG8_BAR; PG8_MMA(1, 1, At, B1); PG8_BAR;
            }
        }
        if constexpr (ALIGN_EPI) { if (wr == 0) PG8_BAR; }
        if constexpr (!Epi::AFTER_DRAIN) { E(acc, cur, wr, wc, fr, fq, nxt, has_next, ui); S.done(cur); }
        if (!has_next) break;
#pragma unroll
        for (int a = 0; a < 2; ++a)
#pragma unroll
            for (int b = 0; b < 2; ++b)
#pragma unroll
                for (int m = 0; m < 4; ++m)
#pragma unroll
                    for (int n = 0; n < 2; ++n) acc[a][b][m][n] = (f32x4){0.f, 0.f, 0.f, 0.f};
        cur = nxt; cA = nA; cB = nB; ++ui;
        if constexpr (ALIGN_EPI) { if (wr == 1) PG8_BAR; }
    }
    PG8_WAIT_V(0);
    if constexpr (!ALIGN_EPI) { if (wr == 0) PG8_BAR; }
    PG8_BAR;
    if constexpr (Epi::AFTER_DRAIN) { E.fused(acc, cur, wr, wc, fr, fq, lds, wid, lane); S.done(cur); }
#undef PG8_SA
#undef PG8_SB
#undef PG8_STAGE
#undef PG8_LDA
#undef PG8_LDB
#undef PG8_MMA
#undef PG8_WAIT_V
#undef PG8_WAIT_L
#undef PG8_BAR
#undef PG8_SCHED
}
}
#ifndef REPEAT_MASK
#define REPEAT_MASK 0u
#endif
#ifndef EXTRA_SYNCS
#define EXTRA_SYNCS 0
#endif
#ifndef REP_SSM
#define REP_SSM 1
#endif
#ifndef REP_CONV
#define REP_CONV 1
#endif
#ifndef REP_ATTN
#define REP_ATTN 1
#endif

#define LAS __attribute__((address_space(3)))
typedef unsigned short bf16_t;
typedef short bf16x8 __attribute__((ext_vector_type(8)));
typedef short s16x4 __attribute__((ext_vector_type(4)));
typedef float f32x4 __attribute__((ext_vector_type(4)));
typedef float f32x16 __attribute__((ext_vector_type(16)));
typedef unsigned u32x4 __attribute__((ext_vector_type(4)));
typedef unsigned u32x2 __attribute__((ext_vector_type(2)));
typedef float f32x2v __attribute__((ext_vector_type(2)));
typedef __bf16 bf16x2v __attribute__((ext_vector_type(2)));

constexpr int NT = 65536, SEQ = 4096, DMODEL = 1024, NIN = 2304, DFF = 2816;
constexpr float EPS = 1e-6f;
constexpr float C2 = 0.125f * 1.4426950408889634f;
constexpr size_t MiB = (size_t)1 << 20;
constexpr size_t W_IN = 0, W_OUT = W_IN + (size_t)NIN * 1024 * 2, W_GU = W_OUT + (size_t)1024 * 1024 * 2, W_DN = W_GU + (size_t)2 * DFF * 1024 * 2,
                 W_GLU = W_DN + (size_t)1024 * DFF * 2, W_LAYER = 24 * MiB;
static_assert(W_GLU + 512 * 256 * 2 <= W_LAYER, "weight block");
constexpr size_t WS_W = 0, WS_ROPE = 48 * MiB, WS_H = 64 * MiB, WS_P = 192 * MiB, WS_YC = 544 * MiB, WS_ZB = 640 * MiB, WS_OB = 672 * MiB, WS_ST = 768 * MiB, WS_BAR = 776 * MiB, WS_XB = 778 * MiB, WS_SS = 906 * MiB, WS_END = 912 * MiB;
constexpr int LDS_BYTES = 147456;
constexpr int NTHREADS = 512;

#define CAS __attribute__((address_space(4)))
struct Args {
    const float* in[24];
    float* out;
    unsigned char* ws;
    int ph_lo, ph_hi;
};

__device__ __forceinline__ unsigned pk2(float lo, float hi) { f32x2v v = {lo, hi}; bf16x2v b = __builtin_convertvector(v, bf16x2v); return __builtin_bit_cast(unsigned, b); }
__device__ __forceinline__ float bflo(unsigned u) { return __uint_as_float(u << 16); }
__device__ __forceinline__ float bfhi(unsigned u) { return __uint_as_float(u & 0xffff0000u); }
template <int CTRL, int ROWMASK> __device__ __forceinline__ float dpp_add(float v) {
    return v + __builtin_bit_cast(float, __builtin_amdgcn_update_dpp(0, __builtin_bit_cast(int, v), CTRL, ROWMASK, 0xF, false));
}
__device__ __forceinline__ float wave_sum(float v) {
    v = dpp_add<0xB1, 0xF>(v);
    v = dpp_add<0x4E, 0xF>(v);
    v = dpp_add<0x141, 0xF>(v);
    v = dpp_add<0x140, 0xF>(v);
    v = dpp_add<0x142, 0xA>(v);
    v = dpp_add<0x143, 0xC>(v);
    return __builtin_bit_cast(float, __builtin_amdgcn_readlane(__builtin_bit_cast(int, v), 63));
}
__device__ __forceinline__ float sigmoidf_(float x) { return __builtin_amdgcn_rcpf(1.f + __expf(-x)); }
__device__ __forceinline__ float gelu_tanh(float y) {
    const float a = 0.7978845608028654f * (y + 0.044715f * y * y * y);
    const float t = 1.f - 2.f * __builtin_amdgcn_rcpf(__expf(2.f * a) + 1.f);
    return 0.5f * y * (1.f + t);
}
#define WAVE_LDS_SYNC() asm volatile("s_waitcnt lgkmcnt(0)" ::: "memory")

struct RowScale {
    const float* ssp; LAS float* xs;
    __device__ __forceinline__ float rs_of(int row) const { const f32x4 sp = *(const f32x4*)(ssp + (size_t)row * 4); return rsqrtf(((sp.x + sp.y) + (sp.z + sp.w)) * (1.f / DMODEL) + EPS); }
    __device__ __forceinline__ void prime(const pg8::Unit& u) const { const int t = threadIdx.x; if (t < 256) xs[t] = rs_of(u.pm * 256 + t); }
};
struct EpiIn {
    static constexpr bool PERM = true, AFTER_DRAIN = false;
    bf16_t* O; const float* ropec; const float* ropes; RowScale R;
    __device__ __forceinline__ void prime(const pg8::Unit& u) const { R.prime(u); }
    __device__ __forceinline__ void operator()(const f32x4 (&acc)[2][2][4][2], const pg8::Unit& u, int wr, int wc, int fr, int fq, const pg8::Unit& nxt, bool has_next, int ui) const {
        const int row0 = u.pm * 256 + wr * 64 + fr, t = threadIdx.x;
        f32x4 spn = {0.f, 0.f, 0.f, 0.f};
        const bool stage = has_next && t < 256 && nxt.pm != u.pm;
        if (stage) spn = *(const f32x4*)(R.ssp + (size_t)(nxt.pm * 256 + t) * 4);
        const LAS float* xsc = R.xs + (ui & 1) * 256 + wr * 64 + fr;
        if (u.pn == 0 || u.pn == 1 || u.pn == 3 || u.pn == 4) {
            const bool glu = u.pn >= 3;
            const int cbase = (glu ? 768 + 128 * (u.pn - 3) : 128 * u.pn) + wc * 32 + 8 * fq;
#pragma unroll
            for (int ai = 0; ai < 2; ++ai)
#pragma unroll
                for (int m = 0; m < 4; ++m) {
                    const float rsc = xsc[ai * 128 + m * 16];
                    float r[8];
#pragma unroll
                    for (int n = 0; n < 2; ++n)
#pragma unroll
                        for (int j = 0; j < 4; ++j) {
                            const float a = acc[ai][0][m][n][j] * rsc, b = acc[ai][1][m][n][j] * rsc;
                            r[4 * n + j] = glu ? a * sigmoidf_(b) : a * b;
                        }
                    u32x4 w; w.x = pk2(r[0], r[1]); w.y = pk2(r[2], r[3]); w.z = pk2(r[4], r[5]); w.w = pk2(r[6], r[7]);
                    *(u32x4*)(O + (size_t)(row0 + ai * 128 + m * 16) * NIN + cbase) = w;
                }
        } else if (u.pn == 6 || u.pn == 7) {
            const float sc = (u.pn == 6) ? C2 : 1.f;
            const int dimb = 16 * (wc & 1) + 4 * fq;
#pragma unroll
            for (int ai = 0; ai < 2; ++ai)
#pragma unroll
                for (int m = 0; m < 4; ++m) {
                    const int row = row0 + ai * 128 + m * 16; const int pos = row & (SEQ - 1);
                    const float rsc = xsc[ai * 128 + m * 16] * sc;
                    const f32x4 cs = *(const f32x4*)(ropec + pos * 32 + dimb), sn = *(const f32x4*)(ropes + pos * 32 + dimb);
                    bf16_t* rowp = O + (size_t)row * NIN + u.pn * 256 + 64 * (wc >> 1) + dimb;
#pragma unroll
                    for (int bj = 0; bj < 2; ++bj) {
                        const f32x4 x1 = acc[ai][bj][m][0] * rsc, x2 = acc[ai][bj][m][1] * rsc;
                        const f32x4 o1 = x1 * cs - x2 * sn, o2 = x2 * cs + x1 * sn;
                        u32x2 w1, w2; w1.x = pk2(o1[0], o1[1]); w1.y = pk2(o1[2], o1[3]); w2.x = pk2(o2[0], o2[1]); w2.y = pk2(o2[2], o2[3]);
                        *(u32x2*)(rowp + bj * 128) = w1; *(u32x2*)(rowp + bj * 128 + 32) = w2;
                    }
                }
        } else {
#pragma unroll
            for (int ai = 0; ai < 2; ++ai)
#pragma unroll
                for (int m = 0; m < 4; ++m) {
                    bf16_t* rowp = O + (size_t)(row0 + ai * 128 + m * 16) * NIN + (u.pn == 2 ? 256 : u.pn * 256) + wc * 32 + 8 * fq;
                    const float rsc = xsc[ai * 128 + m * 16];
#pragma unroll
                    for (int bj = 0; bj < 2; ++bj) {
                        const f32x4 v0 = acc[ai][bj][m][0] * rsc, v1 = acc[ai][bj][m][1] * rsc;
                        u32x4 w; w.x = pk2(v0[0], v0[1]); w.y = pk2(v0[2], v0[3]); w.z = pk2(v1[0], v1[1]); w.w = pk2(v1[2], v1[3]);
                        *(u32x4*)(rowp + bj * 128) = w;
                    }
                }
        }
        if (has_next && t < 256) {
            float v = R.xs[(ui & 1) * 256 + t];
            if (nxt.pm != u.pm) v = rsqrtf(((spn.x + spn.y) + (spn.z + spn.w)) * (1.f / DMODEL) + EPS);
            R.xs[((ui + 1) & 1) * 256 + t] = v;
        }
    }
};
struct EpiRes {
    static constexpr bool PERM = true, AFTER_DRAIN = false;
    bf16_t* xb; float* ssp; LAS float* xl;
    __device__ __forceinline__ void prime(const pg8::Unit&) const {}
    __device__ __forceinline__ void operator()(const f32x4 (&acc)[2][2][4][2], const pg8::Unit& u, int wr, int wc, int fr, int fq, const pg8::Unit&, bool, int) const {
        const int row0 = u.pm * 256 + wr * 64 + fr, col0 = u.pn * 256 + wc * 32 + 8 * fq;
        u32x4 rv[2][4][2];
#pragma unroll
        for (int ai = 0; ai < 2; ++ai)
#pragma unroll
            for (int m = 0; m < 4; ++m)
#pragma unroll
                for (int bj = 0; bj < 2; ++bj) rv[ai][m][bj] = *(const u32x4*)(xb + (size_t)(row0 + ai * 128 + m * 16) * DMODEL + col0 + bj * 128);
#pragma unroll
        for (int ai = 0; ai < 2; ++ai)
#pragma unroll
            for (int m = 0; m < 4; ++m) {
                const int row = row0 + ai * 128 + m * 16;
                const size_t off = (size_t)row * DMODEL + col0;
                float sq = 0.f;
#pragma unroll
                for (int bj = 0; bj < 2; ++bj) {
                    const u32x4 r = rv[ai][m][bj];
                    const f32x4 r0 = {bflo(r.x), bfhi(r.x), bflo(r.y), bfhi(r.y)}, r1 = {bflo(r.z), bfhi(r.z), bflo(r.w), bfhi(r.w)};
                    const f32x4 x0 = r0 + acc[ai][bj][m][0], x1 = r1 + acc[ai][bj][m][1];
                    u32x4 w; w.x = pk2(x0[0], x0[1]); w.y = pk2(x0[2], x0[3]); w.z = pk2(x1[0], x1[1]); w.w = pk2(x1[2], x1[3]);
                    *(u32x4*)(xb + off + bj * 128) = w;
                    sq += (x0[0] * x0[0] + x0[1] * x0[1]) + (x0[2] * x0[2] + x0[3] * x0[3]) + (x1[0] * x1[0] + x1[1] * x1[1]) + (x1[2] * x1[2] + x1[3] * x1[3]);
                }
                sq += __shfl_xor(sq, 16); sq += __shfl_xor(sq, 32);
                if (fq == 0) xl[(wr * 64 + ai * 128 + m * 16 + fr) * 4 + wc] = sq;
            }
        asm volatile("s_waitcnt lgkmcnt(0)\n\ts_barrier" ::: "memory");
        const int t = threadIdx.x;
        if (t < 256) { const f32x4 v = *(const LAS f32x4*)(xl + t * 4); ssp[(size_t)(u.pm * 256 + t) * 4 + u.pn] = (v.x + v.y) + (v.z + v.w); }
    }
};
template <int MODE  > struct EpiGate {
    static constexpr bool PERM = true, AFTER_DRAIN = false;
    bf16_t* O; int ldc; int coff; RowScale R;
    __device__ __forceinline__ void prime(const pg8::Unit& u) const { if (MODE == 0) R.prime(u); }
    __device__ __forceinline__ void operator()(const f32x4 (&acc)[2][2][4][2], const pg8::Unit& u, int wr, int wc, int fr, int fq, const pg8::Unit& nxt, bool has_next, int ui) const {
        const int row0 = u.pm * 256 + wr * 64 + fr, col0 = coff + u.pn * 128 + wc * 32 + 8 * fq, t = threadIdx.x;
        f32x4 spn = {0.f, 0.f, 0.f, 0.f};
        if (MODE == 0) { if (has_next && t < 256 && nxt.pm != u.pm) spn = *(const f32x4*)(R.ssp + (size_t)(nxt.pm * 256 + t) * 4); }
        const LAS float* xsc = R.xs + (ui & 1) * 256 + wr * 64 + fr;
#pragma unroll
        for (int ai = 0; ai < 2; ++ai)
#pragma unroll
            for (int m = 0; m < 4; ++m) {
                float r[8];
                float rsc = 1.f; if (MODE == 0) rsc = xsc[ai * 128 + m * 16];
                const float c1 = -1.4426950408889634f * rsc, r2 = rsc * rsc;
#pragma unroll
                for (int n = 0; n < 2; ++n)
#pragma unroll
                    for (int j = 0; j < 4; ++j) {
                        const float a = acc[ai][0][m][n][j], b = acc[ai][1][m][n][j];
                        if (MODE == 0) r[4 * n + j] = (a * b) * (r2 * __builtin_amdgcn_rcpf(1.f + __builtin_amdgcn_exp2f(a * c1)));
                        else r[4 * n + j] = a * __builtin_amdgcn_rcpf(1.f + __builtin_amdgcn_exp2f(b * -1.4426950408889634f));
                    }
                u32x4 w; w.x = pk2(r[0], r[1]); w.y = pk2(r[2], r[3]); w.z = pk2(r[4], r[5]); w.w = pk2(r[6], r[7]);
                *(u32x4*)(O + (size_t)(row0 + ai * 128 + m * 16) * ldc + col0) = w;
            }
        if (MODE == 0) {
            if (has_next && t < 256) {
                float v = R.xs[(ui & 1) * 256 + t];
                if (nxt.pm != u.pm) v = rsqrtf(((spn.x + spn.y) + (spn.z + spn.w)) * (1.f / DMODEL) + EPS);
                R.xs[((ui + 1) & 1) * 256 + t] = v;
            }
        }
    }
};

struct WMat { const float* src; const float* src2; int K, N, ldw, kind; bf16_t* dst; const float* kscale; };
__device__ __forceinline__ void wconv_load(const WMat& w, int t, int tid, float (&v)[8]) {
    const int nkt = w.K / 64, jt = t / nkt, kt = t % nkt, j0 = jt * 64, k0 = kt * 64;
    const int j = j0 + (tid & 63);
    const float* s = w.src; int col = j;
    if (w.kind == 1) {
        if (j >= 1536 && j < 2048) { const int ww = j & 63; col = (j & ~63) + 32 * ((ww >> 2) & 1) + 16 * (ww >> 5) + 4 * ((ww >> 3) & 3) + (ww & 3); }
        else if (j < 1280) {
            const int pn = j >> 8, wi = j & 255, half = (pn == 0 || pn == 3) ? 0 : 128;
            if (pn == 2) col = 256 + wi;
            else if (pn < 2) col = (wi < 128 ? 0 : 512 - 128) + half + wi;
            else col = (wi < 128 ? 768 : 1024 - 128) + half + wi;
        }
    } else if (w.kind == 2) {
        const int pn = j >> 8, wi = j & 255; if (wi < 128) col = pn * 128 + wi; else { s = w.src2; col = pn * 128 + (wi - 128); }
    }
    const int kk = tid >> 6;
#pragma unroll
    for (int i = 0; i < 8; ++i) { const int k = kk + 8 * i; const float sc = w.kscale ? w.kscale[k0 + k] : 1.f; v[i] = s[(size_t)(k0 + k) * w.ldw + col] * sc; }
}
__device__ __forceinline__ void wconv_store(LAS float* tile, const WMat& w, int t, int tid, const float (&v)[8]) {
    const int nkt = w.K / 64, jt = t / nkt, kt = t % nkt, j0 = jt * 64, k0 = kt * 64;
    const int kk = tid >> 6;
#pragma unroll
    for (int i = 0; i < 8; ++i) tile[(kk + 8 * i) * 65 + (tid & 63)] = v[i];
    __syncthreads();
    {
        const int jr = tid >> 3, c = tid & 7; const LAS float* s = tile + (8 * c) * 65 + jr;
        u32x4 o; o.x = pk2(s[0], s[65]); o.y = pk2(s[2 * 65], s[3 * 65]); o.z = pk2(s[4 * 65], s[5 * 65]); o.w = pk2(s[6 * 65], s[7 * 65]);
        *(u32x4*)(w.dst + (size_t)(j0 + jr) * w.K + k0 + 8 * c) = o;
    }
    __syncthreads();
}
__device__ __forceinline__ WMat wmat_of(const CAS Args* ap, unsigned char* ws, int it, int& t) {
    const int layer = it / 2976; t = it % 2976;
    unsigned char* wb = ws + WS_W + (size_t)layer * W_LAYER;
    if (t < 576) return WMat{ap->in[2] + (size_t)layer * 1024 * NIN, nullptr, 1024, NIN, NIN, 1, (bf16_t*)(wb + W_IN), ap->in[1] + layer * 1024};
    if ((t -= 576) < 256) return WMat{ap->in[18] + (size_t)layer * 1024 * 1024, nullptr, 1024, 1024, 1024, 0, (bf16_t*)(wb + W_OUT), nullptr};
    if ((t -= 256) < 1408) return WMat{ap->in[20] + (size_t)layer * 1024 * DFF, ap->in[21] + (size_t)layer * 1024 * DFF, 1024, 2 * DFF, DFF, 2, (bf16_t*)(wb + W_GU), ap->in[19] + layer * 1024};
    if ((t -= 1408) < 704) return WMat{ap->in[22] + (size_t)layer * DFF * 1024, nullptr, DFF, 1024, 1024, 0, (bf16_t*)(wb + W_DN), nullptr};
    t -= 704; return WMat{ap->in[16] + (size_t)layer * 256 * 512, ap->in[16] + (size_t)layer * 256 * 512 + 256, 256, 512, 512, 2, (bf16_t*)(wb + W_GLU), nullptr};
}

__device__ __forceinline__ void norm_rows_bf16(const float* X, const float* g, bf16_t* H, int gw, int ngw, int lane) {
    f32x4 gv[4];
#pragma unroll
    for (int j = 0; j < 4; ++j) gv[j] = ((const f32x4*)g)[lane + 64 * j];
    for (int m = gw; m < NT; m += ngw) {
        const f32x4* xr = (const f32x4*)(X + (size_t)m * DMODEL) + lane;
        f32x4 v[4]; float s = 0.f;
#pragma unroll
        for (int j = 0; j < 4; ++j) { v[j] = xr[64 * j]; s += (v[j].x * v[j].x + v[j].y * v[j].y) + (v[j].z * v[j].z + v[j].w * v[j].w); }
        const float rs = rsqrtf(wave_sum(s) * (1.f / DMODEL) + EPS);
        u32x2* o = (u32x2*)(H + (size_t)m * DMODEL) + lane;
#pragma unroll
        for (int j = 0; j < 4; ++j) { u32x2 w; w.x = pk2(v[j].x * rs * gv[j].x, v[j].y * rs * gv[j].y); w.y = pk2(v[j].z * rs * gv[j].z, v[j].w * rs * gv[j].w); o[64 * j] = w; }
    }
}
__device__ __forceinline__ void xb_rows(const float* X, bf16_t* XB, float* ssq, int gw, int ngw, int lane) {
    for (int m0 = gw * 2; m0 < NT; m0 += ngw * 2) {
        f32x4 v[2][4];
#pragma unroll
        for (int r = 0; r < 2; ++r) { const f32x4* xr = (const f32x4*)(X + (size_t)(m0 + r) * DMODEL) + lane;
#pragma unroll
            for (int j = 0; j < 4; ++j) v[r][j] = xr[64 * j]; }
#pragma unroll
        for (int r = 0; r < 2; ++r) {
            const size_t m = (size_t)m0 + r;
            float s = 0.f;
#pragma unroll
            for (int j = 0; j < 4; ++j) s += (v[r][j].x * v[r][j].x + v[r][j].y * v[r][j].y) + (v[r][j].z * v[r][j].z + v[r][j].w * v[r][j].w);
            s = wave_sum(s);
            u32x2* o = (u32x2*)(XB + m * DMODEL) + lane;
#pragma unroll
            for (int j = 0; j < 4; ++j) { u32x2 w; w.x = pk2(v[r][j].x, v[r][j].y); w.y = pk2(v[r][j].z, v[r][j].w); o[64 * j] = w; }
            if (lane == 0) { f32x4 o4 = {s, 0.f, 0.f, 0.f}; *(f32x4*)(ssq + m * 4) = o4; }
        }
    }
}
__device__ __forceinline__ void final_rows(const bf16_t* XB, const float* ssp, const float* g, float* OUT, int gw, int ngw, int lane, float tscale) {
    f32x4 gv[4];
#pragma unroll
    for (int j = 0; j < 4; ++j) gv[j] = ((const f32x4*)g)[lane + 64 * j];
    for (int m0 = gw * 4; m0 < NT; m0 += ngw * 4) {
        u32x2 w[4][4]; f32x4 sp[4];
#pragma unroll
        for (int r = 0; r < 4; ++r) { const size_t m = (size_t)m0 + r; sp[r] = *(const f32x4*)(ssp + m * 4); const u32x2* xr = (const u32x2*)(XB + m * DMODEL) + lane;
#pragma unroll
            for (int j = 0; j < 4; ++j) w[r][j] = xr[64 * j]; }
#pragma unroll
        for (int r = 0; r < 4; ++r) {
            const float rs = rsqrtf(((sp[r].x + sp[r].y) + (sp[r].z + sp[r].w)) * (1.f / DMODEL) + EPS) * tscale;
            f32x4* o = (f32x4*)(OUT + (size_t)(m0 + r) * DMODEL) + lane;
#pragma unroll
            for (int j = 0; j < 4; ++j) { f32x4 v = {bflo(w[r][j].x), bfhi(w[r][j].x), bflo(w[r][j].y), bfhi(w[r][j].y)}; o[64 * j] = v * rs * gv[j]; }
        }
    }
}
__device__ __forceinline__ void norm_rows_f32_inplace(float* X, const float* g, int gw, int ngw, int lane) {
    f32x4 gv[4];
#pragma unroll
    for (int j = 0; j < 4; ++j) gv[j] = ((const f32x4*)g)[lane + 64 * j];
    for (int m = gw; m < NT; m += ngw) {
        f32x4* xr = (f32x4*)(X + (size_t)m * DMODEL) + lane;
        f32x4 v[4]; float s = 0.f;
#pragma unroll
        for (int j = 0; j < 4; ++j) { v[j] = xr[64 * j]; s += (v[j].x * v[j].x + v[j].y * v[j].y) + (v[j].z * v[j].z + v[j].w * v[j].w); }
        const float rs = rsqrtf(wave_sum(s) * (1.f / DMODEL) + EPS);
#pragma unroll
        for (int j = 0; j < 4; ++j) xr[64 * j] = v[j] * rs * gv[j];
    }
}

struct C3Regs { u32x4 gg[6], bb[4]; };
__device__ __forceinline__ void conv3_issue(const bf16_t* P, int w, C3Regs& R) {
    const int c8 = w & 31, tok = (w >> 5) * 4, t = tok & (SEQ - 1);
    const bf16_t* base = P + (size_t)tok * NIN + c8 * 8;
#pragma unroll
    for (int i = 0; i < 6; ++i) { const int dt = (t == 0 && i < 2) ? 0 : i - 2; R.gg[i] = *(const u32x4*)(base + dt * NIN); }
#pragma unroll
    for (int i = 0; i < 4; ++i) R.bb[i] = *(const u32x4*)(base + i * NIN + 256);
}
__device__ __forceinline__ void unpack8(const u32x4 a, float (&o)[8]) {
    o[0] = bflo(a.x); o[1] = bfhi(a.x); o[2] = bflo(a.y); o[3] = bfhi(a.y); o[4] = bflo(a.z); o[5] = bfhi(a.z); o[6] = bflo(a.w); o[7] = bfhi(a.w);
}
__device__ __forceinline__ void conv3_compute(bf16_t* H, int w, const C3Regs& R, const float (&w0)[8], const float (&w1)[8], const float (&w2)[8], const float (&gm)[8]) {
    const int c8 = w & 31, tok = (w >> 5) * 4, t = tok & (SEQ - 1);
    const float z01 = (t == 0) ? 0.f : 1.f;
    float g[6][8];
#pragma unroll
    for (int i = 0; i < 6; ++i) unpack8(R.gg[i], g[i]);
#pragma unroll
    for (int j = 0; j < 8; ++j) { g[0][j] *= z01; g[1][j] *= z01; }
#pragma unroll
    for (int i = 0; i < 4; ++i) {
        float bb[8]; unpack8(R.bb[i], bb);
        float y[8]; float sq = 0.f;
#pragma unroll
        for (int j = 0; j < 8; ++j) { y[j] = bb[j] * (w0[j] * g[i][j] + w1[j] * g[i + 1][j] + w2[j] * g[i + 2][j]); sq += y[j] * y[j]; }
#pragma unroll
        for (int o = 1; o < 32; o <<= 1) sq += __shfl_xor(sq, o);
        const float rs = rsqrtf(sq * (1.f / 256.f) + EPS);
        u32x4 o4; o4.x = pk2(y[0] * rs * gm[0], y[1] * rs * gm[1]); o4.y = pk2(y[2] * rs * gm[2], y[3] * rs * gm[3]); o4.z = pk2(y[4] * rs * gm[4], y[5] * rs * gm[5]); o4.w = pk2(y[6] * rs * gm[6], y[7] * rs * gm[7]);
        *(u32x4*)(H + (size_t)(tok + i) * DMODEL + c8 * 8) = o4;
    }
}
__device__ __forceinline__ void conv3_phase(const bf16_t* P, bf16_t* H, const float* w3, const float* gn, int bx, int G, int tid) {
    constexpr int NW = NT / 4 * 32;
    const int c8 = tid & 31;
    float w0[8], w1[8], w2[8], gm[8];
#pragma unroll
    for (int j = 0; j < 8; ++j) { w0[j] = w3[c8 * 8 + j]; w1[j] = w3[256 + c8 * 8 + j]; w2[j] = w3[512 + c8 * 8 + j]; gm[j] = gn[c8 * 8 + j]; }
    C3Regs Ra, Rb;
    int w = bx * NTHREADS + tid; const int step = G * NTHREADS;
    if (w < NW) conv3_issue(P, w, Ra);
    for (; w < NW; w += 2 * step) {
        if (w + step < NW) conv3_issue(P, w + step, Rb);
        conv3_compute(H, w, Ra, w0, w1, w2, gm);
        if (w + step < NW) { if (w + 2 * step < NW) conv3_issue(P, w + 2 * step, Ra); conv3_compute(H, w + step, Rb, w0, w1, w2, gm); }
    }
}

constexpr int CF_ZOFF = 0, CF_STOFF = 94 * 1024;
__device__ __forceinline__ void cfm_issue(const bf16_t* P, int tix, int tid, u32x4 (&zr)[6]) {
    const int b = tix >> 6, t0 = (tix & 63) * 64;
#pragma unroll
    for (int k = 0; k < 6; ++k) {
        int e = tid + NTHREADS * k; e = e < 94 * 32 ? e : 94 * 32 - 1;
        const int row = e >> 5, c8 = e & 31; int t = t0 - 30 + row; t = t < 0 ? 0 : t;
        zr[k] = *(const u32x4*)(P + ((size_t)b * SEQ + t) * NIN + 768 + c8 * 8);
    }
}
__device__ __forceinline__ void cfm_stage(LAS unsigned char* lds, int tix, int tid, const u32x4 (&zr)[6]) {
    const int t0 = (tix & 63) * 64;
    LAS float* ZT = (LAS float*)(lds + CF_ZOFF);
#pragma unroll
    for (int k = 0; k < 6; ++k) {
        const int e = tid + NTHREADS * k;
        if (e < 94 * 32) {
            const int row = e >> 5, c8 = e & 31; const float zm = (t0 - 30 + row < 0) ? 0.f : 1.f;
            const u32x4 a = zr[k];
            f32x4 z0 = {bflo(a.x) * zm, bfhi(a.x) * zm, bflo(a.y) * zm, bfhi(a.y) * zm}, z1 = {bflo(a.z) * zm, bfhi(a.z) * zm, bflo(a.w) * zm, bfhi(a.w) * zm};
            *(LAS f32x4*)(ZT + row * 256 + c8 * 8) = z0; *(LAS f32x4*)(ZT + row * 256 + c8 * 8 + 4) = z1;
        }
    }
}
__device__ __forceinline__ void cfm_phase(LAS unsigned char* lds, const bf16_t* P, bf16_t* H, const float* dww, const float* dwb, const float* lng, const float* lnb, const float* gn,
                                          int bx, int G, int tid, int wid, int lane) {
    const int cp = tid & 127, rr = tid >> 7;
    f32x2v w[31];
#pragma unroll
    for (int k = 0; k < 31; ++k) w[k] = *(const f32x2v*)(dww + k * 256 + 2 * cp);
    const f32x2v bias = *(const f32x2v*)(dwb + 2 * cp), lg = *(const f32x2v*)(lng + 2 * cp), lb = *(const f32x2v*)(lnb + 2 * cp), gmm = *(const f32x2v*)(gn + 256 + 2 * cp);
    LAS float* ZT = (LAS float*)(lds + CF_ZOFF);
    LAS float* STX = (LAS float*)(lds + CF_STOFF);
    u32x4 zr[6];
    int tix = bx;
    if (tix < 1024) cfm_issue(P, tix, tid, zr);
    for (; tix < 1024; tix += G) {
        __syncthreads();
        cfm_stage(lds, tix, tid, zr);
        if (tix + G < 1024) cfm_issue(P, tix + G, tid, zr);
        __syncthreads();
        f32x2v acc[16];
#pragma unroll
        for (int j = 0; j < 16; ++j) acc[j] = bias;
#pragma unroll
        for (int s = 0; s < 46; ++s) {
            const f32x2v z = *(const LAS f32x2v*)(ZT + (rr * 16 + s) * 256 + 2 * cp);
#pragma unroll
            for (int j = 0; j < 16; ++j) { const int k = s - j; if (k >= 0 && k <= 30) acc[j] += w[k] * z; }
        }
        float s1[16], s2[16];
#pragma unroll
        for (int j = 0; j < 16; ++j) { s1[j] = wave_sum(acc[j].x + acc[j].y); s2[j] = wave_sum(acc[j].x * acc[j].x + acc[j].y * acc[j].y); }
        if (lane == 0) {
#pragma unroll
            for (int j = 0; j < 16; ++j) { STX[wid * 32 + j] = s1[j]; STX[wid * 32 + 16 + j] = s2[j]; }
        }
        __syncthreads();
        const int b = tix >> 6, t0 = (tix & 63) * 64;
        float s3[16];
#pragma unroll
        for (int j = 0; j < 16; ++j) {
            const float S1 = s1[j] + STX[(wid ^ 1) * 32 + j], S2 = s2[j] + STX[(wid ^ 1) * 32 + 16 + j];
            const float mean = S1 * (1.f / 256.f), var = fmaxf(S2 * (1.f / 256.f) - mean * mean, 0.f), rs = rsqrtf(var + EPS);
            f32x2v y = (acc[j] - mean) * rs * lg + lb;
            y.x = y.x * sigmoidf_(y.x); y.y = y.y * sigmoidf_(y.y);
            acc[j] = y;
            s3[j] = wave_sum(y.x * y.x + y.y * y.y);
        }
        if (lane == 0) {
#pragma unroll
            for (int j = 0; j < 16; ++j) STX[256 + wid * 16 + j] = s3[j];
        }
        __syncthreads();
#pragma unroll
        for (int j = 0; j < 16; ++j) {
            const float rs = rsqrtf((s3[j] + STX[256 + (wid ^ 1) * 16 + j]) * (1.f / 256.f) + EPS);
            *(unsigned*)(H + ((size_t)b * SEQ + t0 + rr * 16 + j) * DMODEL + 256 + 2 * cp) = pk2(acc[j].x * rs * gmm.x, acc[j].y * rs * gmm.y);
        }
    }
}

template <bool FULL> __device__ __forceinline__ void ssm_tile_scan(f32x16& xr, f32x16& xi, const float (&pw)[4][2], float& cr, float& ci, const bool hi) {
    const float l1r = pw[0][0], l1i = pw[0][1], l4r = pw[3][0], l4i = pw[3][1];
#pragma unroll
    for (int G = 0; G < 4; ++G)
#pragma unroll
        for (int j = 1; j < 4; ++j) { const int i = 4 * G + j; const float pr = xr[i - 1], pi = xi[i - 1]; xr[i] += l1r * pr - l1i * pi; xi[i] += l1r * pi + l1i * pr; }
    float cinr[4], cini[4];
#pragma unroll
    for (int G = 0; G < 4; ++G) {
        const float er = xr[4 * G + 3], ei = xi[4 * G + 3];
        const float orr = __shfl_xor(er, 32), oi = __shfl_xor(ei, 32);
        const float e0r = hi ? orr : er, e0i = hi ? oi : ei, e1r = hi ? er : orr, e1i = hi ? ei : oi;
        const float c1r = l4r * cr - l4i * ci + e0r, c1i = l4r * ci + l4i * cr + e0i;
        cinr[G] = hi ? c1r : cr; cini[G] = hi ? c1i : ci;
        const float c2r = l4r * c1r - l4i * c1i + e1r, c2i = l4r * c1i + l4i * c1r + e1i;
        cr = c2r; ci = c2i;
    }
    if (FULL) {
#pragma unroll
        for (int G = 0; G < 4; ++G)
#pragma unroll
            for (int j = 0; j < 4; ++j) { const int i = 4 * G + j; xr[i] += pw[j][0] * cinr[G] - pw[j][1] * cini[G]; xi[i] += pw[j][0] * cini[G] + pw[j][1] * cinr[G]; }
    }
}
constexpr int SSM_ROWB = 272;
__device__ __forceinline__ void ssm_item(LAS unsigned char* lds, const bf16_t* P, bf16_t* ZB, const float* a_re, const float* a_im, const float* log_dt, const float* b_re, const float* b_im,
                                         const float* c_re, const float* c_im, const float* d_skip, int item, int tid, int wid, int lane) {
    const int b = item >> 4, g = item & 15;
    const int r32 = lane & 31, h = lane >> 5; const bool hi = h != 0;
    LAS f32x2v* EW = (LAS f32x2v*)lds;
    LAS unsigned char* SBW = lds + 4096 + wid * (32 * SSM_ROWB);
    __syncthreads();
    float pw[2][4][2]; bf16x8 bfr[2][2];
#pragma unroll
    for (int tp = 0; tp < 2; ++tp) {
        const int p = r32 + 32 * tp;
        const float dt = __expf(log_dt[g]);
        const float ar = a_re[g * 64 + p], ai = a_im[g * 64 + p];
        const float mag = __expf(ar * dt);
        const float lr = mag * cosf(ai * dt), li = mag * sinf(ai * dt);
        const float den = ar * ar + ai * ai, nr = lr - 1.f, ni = li;
        const float fr = (nr * ar + ni * ai) / den, fi = (ni * ar - nr * ai) / den;
        const f32x4* br4 = (const f32x4*)(b_re + (size_t)(g * 64 + p) * 16 + 8 * h); const f32x4* bi4 = (const f32x4*)(b_im + (size_t)(g * 64 + p) * 16 + 8 * h);
        const f32x4 r0 = br4[0], r1 = br4[1], i0 = bi4[0], i1 = bi4[1];
        const f32x4 re0 = fr * r0 - fi * i0, re1 = fr * r1 - fi * i1, im0 = fr * i0 + fi * r0, im1 = fr * i1 + fi * r1;
        u32x4 wre, wim;
        wre.x = pk2(re0[0], re0[1]); wre.y = pk2(re0[2], re0[3]); wre.z = pk2(re1[0], re1[1]); wre.w = pk2(re1[2], re1[3]);
        wim.x = pk2(im0[0], im0[1]); wim.y = pk2(im0[2], im0[3]); wim.z = pk2(im1[0], im1[1]); wim.w = pk2(im1[2], im1[3]);
        bfr[tp][0] = __builtin_bit_cast(bf16x8, wre); bfr[tp][1] = __builtin_bit_cast(bf16x8, wim);
        pw[tp][0][0] = lr; pw[tp][0][1] = li;
#pragma unroll
        for (int j = 1; j < 4; ++j) { pw[tp][j][0] = pw[tp][j - 1][0] * lr - pw[tp][j - 1][1] * li; pw[tp][j][1] = pw[tp][j - 1][0] * li + pw[tp][j - 1][1] * lr; }
    }
    const int t16 = lane & 15, quad = lane >> 4;
    bf16x8 cfr[4];
#pragma unroll
    for (int s = 0; s < 4; ++s) {
        const f32x4 cr4 = *(const f32x4*)(c_re + (size_t)(g * 16 + t16) * 64 + 4 * quad + 16 * s), ci4 = *(const f32x4*)(c_im + (size_t)(g * 16 + t16) * 64 + 4 * quad + 16 * s);
        u32x4 w; w.x = pk2(cr4[0], -ci4[0]); w.y = pk2(cr4[1], -ci4[1]); w.z = pk2(cr4[2], -ci4[2]); w.w = pk2(cr4[3], -ci4[3]);
        cfr[s] = __builtin_bit_cast(bf16x8, w);
    }
    const f32x4 dsk = *(const f32x4*)(d_skip + g * 16 + 4 * quad);
    const size_t tok0 = (size_t)b * SEQ + (size_t)wid * 512;
    const bf16_t* ubase = P + tok0 * NIN + 1280 + g * 16;
    f32x16 zero16;
#pragma unroll
    for (int q = 0; q < 16; ++q) zero16[q] = 0.f;
    float cr[2] = {0.f, 0.f}, ci[2] = {0.f, 0.f};
    {
        bf16x8 ua = *(const bf16x8*)(ubase + (size_t)r32 * NIN + 8 * h);
        for (int mt = 0; mt < 16; ++mt) {
            const bf16x8 un = *(const bf16x8*)(ubase + (size_t)((mt < 15 ? mt + 1 : mt) * 32 + r32) * NIN + 8 * h);
#pragma unroll
            for (int tp = 0; tp < 2; ++tp) {
                f32x16 xr = __builtin_amdgcn_mfma_f32_32x32x16_bf16(ua, bfr[tp][0], zero16, 0, 0, 0);
                f32x16 xi = __builtin_amdgcn_mfma_f32_32x32x16_bf16(ua, bfr[tp][1], zero16, 0, 0, 0);
                ssm_tile_scan<false>(xr, xi, pw[tp], cr[tp], ci[tp], hi);
            }
            ua = un;
        }
    }
    if (!hi) { f32x2v e0 = {cr[0], ci[0]}, e1 = {cr[1], ci[1]}; EW[wid * 64 + r32] = e0; EW[wid * 64 + 32 + r32] = e1; }
    __syncthreads();
#pragma unroll
    for (int tp = 0; tp < 2; ++tp) {
        float qr = pw[tp][3][0], qi = pw[tp][3][1];
#pragma unroll
        for (int q = 0; q < 7; ++q) { const float nr = qr * qr - qi * qi, ni = 2.f * qr * qi; qr = nr; qi = ni; }
        float sr = 0.f, si = 0.f;
        for (int w = 0; w < wid; ++w) { const f32x2v e = EW[w * 64 + r32 + 32 * tp]; const float nr = qr * sr - qi * si + e.x, ni = qr * si + qi * sr + e.y; sr = nr; si = ni; }
        cr[tp] = sr; ci[tp] = si;
    }
    {
        bf16x8 ua = *(const bf16x8*)(ubase + (size_t)r32 * NIN + 8 * h);
        for (int mt = 0; mt < 16; ++mt) {
            const bf16x8 un = *(const bf16x8*)(ubase + (size_t)((mt < 15 ? mt + 1 : mt) * 32 + r32) * NIN + 8 * h);
            u32x2 uwv[2];
#pragma unroll
            for (int tt = 0; tt < 2; ++tt) uwv[tt] = *(const u32x2*)(P + (tok0 + mt * 32 + tt * 16 + t16) * NIN + 1280 + g * 16 + 4 * quad);
#pragma unroll
            for (int tp = 0; tp < 2; ++tp) {
                f32x16 xr = __builtin_amdgcn_mfma_f32_32x32x16_bf16(ua, bfr[tp][0], zero16, 0, 0, 0);
                f32x16 xi = __builtin_amdgcn_mfma_f32_32x32x16_bf16(ua, bfr[tp][1], zero16, 0, 0, 0);
                ssm_tile_scan<true>(xr, xi, pw[tp], cr[tp], ci[tp], hi);
#pragma unroll
                for (int i = 0; i < 16; ++i) {
                    const int t = (i & 3) + 8 * (i >> 2) + 4 * h;
                    *(LAS unsigned*)(SBW + t * SSM_ROWB + 4 * (r32 + 32 * tp)) = pk2(xr[i], xi[i]);
                }
            }
            WAVE_LDS_SYNC();
#pragma unroll
            for (int tt = 0; tt < 2; ++tt) {
                f32x4 acc = {0.f, 0.f, 0.f, 0.f};
#pragma unroll
                for (int s = 0; s < 4; ++s) {
                    const bf16x8 sf = *(const LAS bf16x8*)(SBW + (tt * 16 + t16) * SSM_ROWB + quad * 16 + 64 * s);
                    acc = __builtin_amdgcn_mfma_f32_16x16x32_bf16(cfr[s], sf, acc, 0, 0, 0);
                }
                const size_t tok = tok0 + mt * 32 + tt * 16 + t16;
                const u32x2 uw = uwv[tt];
                const f32x4 uu = {bflo(uw.x), bfhi(uw.x), bflo(uw.y), bfhi(uw.y)};
                const f32x4 y = acc + dsk * uu;
                u32x2 w; w.x = pk2(gelu_tanh(y.x), gelu_tanh(y.y)); w.y = pk2(gelu_tanh(y.z), gelu_tanh(y.w));
                *(u32x2*)(ZB + tok * 256 + g * 16 + 4 * quad) = w;
            }
            WAVE_LDS_SYNC();
            ua = un;
        }
    }
}

constexpr int AT_ROWB = 144, AT_KOFF = 0, AT_VOFF = 384 * AT_ROWB;
__device__ __forceinline__ s16x4 vtr(const LAS unsigned char* p) { return __builtin_bit_cast(s16x4, __builtin_amdgcn_ds_read_tr16_b64_v4i16((LAS s16x4*)p)); }
struct AttnU { int pat, head, d, ub; size_t rowbase; };
__device__ __forceinline__ AttnU attn_decode(int u) {
    AttnU U; const int rem = u & 1023, b = rem >> 6, ru = rem & 15; U.pat = u >> 10; U.head = (rem >> 4) & 3;
    int r;
    if (U.pat == 0) { U.d = 1; r = 0; U.ub = ru; } else if (U.pat == 1) { U.d = 4; r = ru >> 2; U.ub = ru & 3; } else { U.d = 16; r = ru; U.ub = 0; }
    U.rowbase = (size_t)b * SEQ + r; return U;
}
__device__ __forceinline__ void attn_issue(const bf16_t* P, const AttnU& U, int tid, int wid, int lane, u32x4 (&kreg)[6], u32x4 (&vreg)[6], bf16x8 (&qf)[4]) {
    const int i0 = U.ub * 256 - 128;
#pragma unroll
    for (int k = 0; k < 6; ++k) {
        const int e = tid + NTHREADS * k, row = e >> 3, c = e & 7; int si = i0 + row; si = si < 0 ? 0 : si;
        const bf16_t* src = P + (U.rowbase + (size_t)si * U.d) * NIN + U.head * 64 + c * 8;
        kreg[k] = *(const u32x4*)(src + 1792); vreg[k] = *(const u32x4*)(src + 2048);
    }
    const int r32 = lane & 31, h = lane >> 5;
    const size_t qtok = U.rowbase + (size_t)(U.ub * 256 + 32 * wid + r32) * U.d;
    const bf16_t* qp = P + qtok * NIN + 1536 + U.head * 64 + 8 * h;
#pragma unroll
    for (int s = 0; s < 4; ++s) qf[s] = *(const bf16x8*)(qp + 16 * s);
}
__device__ __forceinline__ void attn_to_lds(LAS unsigned char* lds, int tid, const u32x4 (&kreg)[6], const u32x4 (&vreg)[6]) {
#pragma unroll
    for (int k = 0; k < 6; ++k) {
        const int e = tid + NTHREADS * k, row = e >> 3, c = e & 7;
        *(LAS u32x4*)(lds + AT_KOFF + row * AT_ROWB + c * 16) = kreg[k];
        *(LAS u32x4*)(lds + AT_VOFF + row * AT_ROWB + c * 16) = vreg[k];
    }
}
__device__ __forceinline__ void attn_compute(LAS unsigned char* lds, const AttnU& U, const bf16x8 (&qf)[4], bf16_t* OB, f32x2v* ST, int wid, int lane) {
    const int pat = U.pat, head = U.head, ub = U.ub;
    const int r32 = lane & 31, h = lane >> 5;
    const size_t qtok = U.rowbase + (size_t)(ub * 256 + 32 * wid + r32) * U.d;
    f32x16 sc[5];
    float mx = -1e30f;
    const float r32f = (float)r32, h4f = (float)(4 * h);
#pragma unroll
    for (int i = 0; i < 5; ++i) {
        const bool tv = (ub > 0) || (wid + i >= 4);
        f32x16 a;
        if (tv) {
#pragma unroll
            for (int q = 0; q < 16; ++q) a[q] = 0.f;
            const LAS unsigned char* kp = lds + AT_KOFF + (32 * wid + 32 * i + r32) * AT_ROWB + 16 * h;
#pragma unroll
            for (int s = 0; s < 4; ++s) { const bf16x8 kf = *(const LAS bf16x8*)(kp + 32 * s); a = __builtin_amdgcn_mfma_f32_32x32x16_bf16(kf, qf[s], a, 0, 0, 0); }
            if (i == 0 || i == 4) {
#pragma unroll
                for (int q = 0; q < 16; ++q) {
                    const float diff = ((float)((q & 3) + 8 * (q >> 2)) + h4f) - r32f;
                    a[q] = (i == 0) ? __builtin_fmaf(fminf(diff, 0.f), 1e30f, a[q]) : __builtin_fmaf(fmaxf(diff, 0.f), -1e30f, a[q]);
                }
            }
#pragma unroll
            for (int q = 0; q < 16; ++q) mx = fmaxf(mx, a[q]);
        } else {
#pragma unroll
            for (int q = 0; q < 16; ++q) a[q] = -1e30f;
        }
        sc[i] = a;
    }
    mx = fmaxf(mx, __shfl_xor(mx, 32));
    float l = 0.f;
#pragma unroll
    for (int i = 0; i < 5; ++i)
#pragma unroll
        for (int q = 0; q < 16; ++q) { const float pv = __builtin_amdgcn_exp2f(sc[i][q] - mx); sc[i][q] = pv; l += pv; }
    l += __shfl_xor(l, 32);
    f32x16 o0, o1;
#pragma unroll
    for (int q = 0; q < 16; ++q) { o0[q] = 0.f; o1[q] = 0.f; }
    const int i16 = lane & 15, q4 = i16 >> 2, p4 = i16 & 3, blk = (lane >> 4) & 1;
#pragma unroll
    for (int i = 0; i < 5; ++i) {
        const bool tv = (ub > 0) || (wid + i >= 4);
        if (tv) {
#pragma unroll
            for (int s2 = 0; s2 < 2; ++s2) {
                u32x4 pw; pw.x = pk2(sc[i][8 * s2], sc[i][8 * s2 + 1]); pw.y = pk2(sc[i][8 * s2 + 2], sc[i][8 * s2 + 3]); pw.z = pk2(sc[i][8 * s2 + 4], sc[i][8 * s2 + 5]); pw.w = pk2(sc[i][8 * s2 + 6], sc[i][8 * s2 + 7]);
                const bf16x8 pb = __builtin_bit_cast(bf16x8, pw);
                const LAS unsigned char* vp = lds + AT_VOFF + (32 * wid + 32 * i + 16 * s2 + 4 * h + q4) * AT_ROWB + 32 * blk + 8 * p4;
                const s16x4 lo0 = vtr(vp), hi0 = vtr(vp + 8 * AT_ROWB), lo1 = vtr(vp + 64), hi1 = vtr(vp + 8 * AT_ROWB + 64);
                const bf16x8 va0 = __builtin_shufflevector(lo0, hi0, 0, 1, 2, 3, 4, 5, 6, 7), va1 = __builtin_shufflevector(lo1, hi1, 0, 1, 2, 3, 4, 5, 6, 7);
                o0 = __builtin_amdgcn_mfma_f32_32x32x16_bf16(va0, pb, o0, 0, 0, 0);
                o1 = __builtin_amdgcn_mfma_f32_32x32x16_bf16(va1, pb, o1, 0, 0, 0);
            }
        }
    }
    const float inv = 1.f / l;
    bf16_t* op = OB + ((size_t)pat * NT + qtok) * 256 + head * 64 + 4 * h;
#pragma unroll
    for (int g4 = 0; g4 < 4; ++g4) {
        u32x2 w0, w1;
        w0.x = pk2(o0[4 * g4] * inv, o0[4 * g4 + 1] * inv); w0.y = pk2(o0[4 * g4 + 2] * inv, o0[4 * g4 + 3] * inv);
        w1.x = pk2(o1[4 * g4] * inv, o1[4 * g4 + 1] * inv); w1.y = pk2(o1[4 * g4 + 2] * inv, o1[4 * g4 + 3] * inv);
        *(u32x2*)(op + 8 * g4) = w0; *(u32x2*)(op + 32 + 8 * g4) = w1;
    }
    if (h == 0) { f32x2v st = {mx, l}; ST[(qtok * 4 + head) * 3 + pat] = st; }
}

__device__ __forceinline__ void combine_rows(const bf16_t* YC, const bf16_t* OB, const f32x2v* ST, const float* gn, bf16_t* H, int gw, int ngw, int lane) {
    f32x4 gv[2];
#pragma unroll
    for (int j = 0; j < 2; ++j) gv[j] = ((const f32x4*)gn)[lane + 64 * (j + 2)];
    const int head = lane >> 4;
    for (int m0 = gw * 4; m0 < NT; m0 += ngw * 4) {
        u32x2 yw[4], a0[4], a1[4], a2[4]; f32x2v s0[4], s1[4], s2[4];
#pragma unroll
        for (int r = 0; r < 4; ++r) {
            const size_t m = (size_t)m0 + r;
            yw[r] = *((const u32x2*)(YC + m * 768 + 512) + lane);
            s0[r] = ST[(m * 4 + head) * 3 + 0]; s1[r] = ST[(m * 4 + head) * 3 + 1]; s2[r] = ST[(m * 4 + head) * 3 + 2];
            a0[r] = *((const u32x2*)(OB + m * 256) + lane); a1[r] = *((const u32x2*)(OB + ((size_t)NT + m) * 256) + lane); a2[r] = *((const u32x2*)(OB + ((size_t)2 * NT + m) * 256) + lane);
        }
#pragma unroll
        for (int r = 0; r < 4; ++r) {
            const size_t m = (size_t)m0 + r;
            f32x4 v[2];
            v[0] = (f32x4){bflo(yw[r].x), bfhi(yw[r].x), bflo(yw[r].y), bfhi(yw[r].y)};
            {
                const float M = fmaxf(s0[r].x, fmaxf(s1[r].x, s2[r].x));
                const float w0 = __builtin_amdgcn_exp2f(s0[r].x - M) * s0[r].y, w1 = __builtin_amdgcn_exp2f(s1[r].x - M) * s1[r].y, w2 = __builtin_amdgcn_exp2f(s2[r].x - M) * s2[r].y;
                const float iw = __builtin_amdgcn_rcpf(w0 + w1 + w2);
                f32x4 o;
                o.x = (w0 * bflo(a0[r].x) + w1 * bflo(a1[r].x) + w2 * bflo(a2[r].x)) * iw; o.y = (w0 * bfhi(a0[r].x) + w1 * bfhi(a1[r].x) + w2 * bfhi(a2[r].x)) * iw;
                o.z = (w0 * bflo(a0[r].y) + w1 * bflo(a1[r].y) + w2 * bflo(a2[r].y)) * iw; o.w = (w0 * bfhi(a0[r].y) + w1 * bfhi(a1[r].y) + w2 * bfhi(a2[r].y)) * iw;
                v[1] = o;
            }
#pragma unroll
            for (int j = 0; j < 2; ++j) {
                const float ss = wave_sum((v[j].x * v[j].x + v[j].y * v[j].y) + (v[j].z * v[j].z + v[j].w * v[j].w));
                const float rs = rsqrtf(ss * (1.f / 256.f) + EPS);
                u32x2 w; w.x = pk2(v[j].x * rs * gv[j].x, v[j].y * rs * gv[j].y); w.y = pk2(v[j].z * rs * gv[j].z, v[j].w * rs * gv[j].w);
                *((u32x2*)(H + m * DMODEL + 256 * (j + 2)) + lane) = w;
            }
        }
    }
}

#define XB_TMO      128
#define XB_XCNT(j)  (256  + 64 * (j))
#define XB_XSUB(j)  (1280 + 64 * (j))
#define XB_XGEN(j)  (2304 + 64 * (j))
#define XB_TOP      3328
#define XB_TOPGEN   3392
#define XCD_BAR_WORDS 3456
#define XB_SPIN_CAP (1u << 18)

__device__ __forceinline__ unsigned xb_ld(unsigned* p)              { return __hip_atomic_load(p, __ATOMIC_RELAXED, __HIP_MEMORY_SCOPE_AGENT); }
__device__ __forceinline__ unsigned xb_add(unsigned* p, unsigned v) { return __hip_atomic_fetch_add(p, v, __ATOMIC_RELAXED, __HIP_MEMORY_SCOPE_AGENT); }
__device__ __forceinline__ unsigned xb_xcc_id() { return (unsigned)__builtin_amdgcn_s_getreg((3 << 11) | 20) & 0xFu; }
#define XB_SPIN(cond, bar) do { unsigned _sp = 0; while (cond) { __builtin_amdgcn_s_sleep(1); \
    if ((++_sp & 255u) == 0u) { if (xb_ld(&(bar)[XB_TMO])) break; if (_sp > XB_SPIN_CAP) { atomicAdd(&(bar)[XB_TMO], 1u); break; } } } } while (0)

struct XcdBarrier {
    unsigned* bar; unsigned x;
    volatile LAS unsigned* st;
};

__device__ __forceinline__ XcdBarrier xcd_barrier_post(unsigned* bar, volatile LAS unsigned* st) {
    XcdBarrier b; b.bar = bar; b.x = xb_xcc_id(); b.st = st;
    if (threadIdx.x == 0) (void)xb_add(&bar[XB_XCNT(b.x)], 1u);
    return b;
}
__device__ __forceinline__ void xcd_barrier_complete(unsigned* bar, unsigned x, unsigned& nloc, unsigned& nx) {
    const unsigned G = gridDim.x * gridDim.y * gridDim.z;
    unsigned sum, cnt, mine, sp = 0u;
    for (;;) {
        sum = 0u; cnt = 0u; mine = 0u;
#pragma unroll
        for (unsigned j = 0; j < 16; ++j) { const unsigned c = xb_ld(&bar[XB_XCNT(j)]); sum += c; cnt += (c > 0u) ? 1u : 0u; mine = (j == x) ? c : mine; }
        if (sum == G) break;
        __builtin_amdgcn_s_sleep(1);
        if ((++sp & 255u) == 0u) { if (xb_ld(&bar[XB_TMO])) break; if (sp > XB_SPIN_CAP) { atomicAdd(&bar[XB_TMO], 1u); break; } }
    }
    nloc = mine > 0u ? mine : 1u; nx = cnt > 0u ? cnt : 1u;
}

__device__ __forceinline__ void xcd_barrier(const XcdBarrier& b) {
    asm volatile("s_waitcnt vmcnt(0)" ::: "memory");
    __syncthreads();
    if (threadIdx.x == 0) {
        unsigned* bar = b.bar;
        __builtin_amdgcn_s_waitcnt(0);
        unsigned nloc = b.st[0], nx = b.st[1];
        if (nloc == 0u) { xcd_barrier_complete(bar, b.x, nloc, nx); b.st[0] = nloc; b.st[1] = nx; }
        const unsigned old = xb_add(&bar[XB_XSUB(b.x)], 1u);
        const unsigned gen = old / nloc;
        if (old + 1u == (gen + 1u) * nloc) {
            __builtin_amdgcn_fence(__ATOMIC_RELEASE, "agent");
            asm volatile("s_waitcnt vmcnt(0)" ::: "memory");
            const unsigned og = xb_add(&bar[XB_TOP], 1u);
            const unsigned tg = og / nx;
            if (og + 1u == (tg + 1u) * nx) xb_add(&bar[XB_TOPGEN], 1u);
            else XB_SPIN(xb_ld(&bar[XB_TOPGEN]) == tg, bar);
            __builtin_amdgcn_fence(__ATOMIC_ACQUIRE, "agent");
            xb_add(&bar[XB_XGEN(b.x)], 1u);
            asm volatile("s_waitcnt vmcnt(0)" ::: "memory");
        } else {
            XB_SPIN(xb_ld(&bar[XB_XGEN(b.x)]) == gen, bar);
            __builtin_amdgcn_fence(__ATOMIC_ACQUIRE, "agent");
            asm volatile("s_waitcnt vmcnt(0)" ::: "memory");
        }
    }
    __syncthreads();
}

constexpr int NPHASE = 16;
struct Ctx { const Args* args; LAS unsigned char* lds; int tid, lane, wid, G, bx, gw, ngw; };
#define LAUNDER(p) asm volatile("" : "+s"(p))
__device__ __forceinline__ void phase_body(const int ph, const CAS Args* ap, LAS unsigned char* lds, const int tid, const int lane, const int wid, const int G, const int bx) {
    const int gw = bx * 8 + wid, ngw = G * 8;
    unsigned char* ws = ap->ws;
    const float* x_in = ap->in[0];
    float* X = ap->out;
    bf16_t* Hb = (bf16_t*)(ws + WS_H); bf16_t* Pb = (bf16_t*)(ws + WS_P); bf16_t* YC = (bf16_t*)(ws + WS_YC); bf16_t* ZB = (bf16_t*)(ws + WS_ZB); bf16_t* OB = (bf16_t*)(ws + WS_OB);
    f32x2v* ST = (f32x2v*)(ws + WS_ST);
    float* ropec = (float*)(ws + WS_ROPE); float* ropes = ropec + SEQ * 32;
    bf16_t* XB = (bf16_t*)(ws + WS_XB); float* SS = (float*)(ws + WS_SS);
    if (ph == 0) {
        {
            float v[8], vn[8]; int t = 0, tn = 0;
            int it = bx;
            WMat w = wmat_of(ap, ws, it < 2 * 2976 ? it : 0, t), wn = w;
            if (it < 2 * 2976) wconv_load(w, t, tid, v);
            for (; it < 2 * 2976; it += G) {
                const bool more = it + G < 2 * 2976;
                if (more) { wn = wmat_of(ap, ws, it + G, tn); wconv_load(wn, tn, tid, vn); }
                wconv_store((LAS float*)lds, w, t, tid, v);
                if (more) {
#pragma unroll
                    for (int i = 0; i < 8; ++i) v[i] = vn[i];
                    w = wn; t = tn;
                }
            }
        }
        for (int e = bx * NTHREADS + tid; e < SEQ * 32; e += G * NTHREADS) {
            const int pos = e >> 5, i = e & 31;
            const double inv = (double)exp2f(-(float)i * (13.287712379549449f / 32.f));
            const float angf = (float)pos * (float)inv;
            double rev = (double)angf * 0.15915494309189535; rev -= floor(rev);
            ropec[e] = __builtin_amdgcn_cosf((float)rev); ropes[e] = __builtin_amdgcn_sinf((float)rev);
        }
        xb_rows(x_in, XB, SS, gw, ngw, lane);
        return;
    }
    if (ph == 15) {
        float tscale = 1.f;
#ifdef TIMED
        { const unsigned long long* ts = (const unsigned long long*)(ws + WS_BAR) + 1800; tscale = 1.f + (float)(ts[1] - ts[0]) * 1e-5f; }
#endif
        final_rows(XB, SS + (size_t)4 * NT * 4, ap->in[23], X, gw, ngw, lane, tscale); return; }
    const int layer = (ph - 1) / 7, sub = (ph - 1) % 7;
    unsigned char* wb = ws + WS_W + (size_t)layer * W_LAYER;
    if (sub == 0) {
        pg8::Gemm g{XB, (const bf16_t*)(wb + W_IN), NT, NIN, 1024}; pg8::StaticOrder S; S.init(NT, NIN, G, bx);
        EpiIn E{Pb, ropec, ropes, RowScale{SS + (size_t)(layer == 0 ? 0 : 2) * NT * 4, (LAS float*)(lds + 131072 + 4096)}};
        pg8::gemm_phase<EpiIn, pg8::StaticOrder, true, true>(lds, g, S, E);
    } else if (sub == 1) {
        const int rot = bx % 3;
#define RUN_S do { LAUNDER(ap); for (int it = bx; it < 256; it += G) \
            ssm_item(lds, Pb, ZB, ap->in[8] + layer * 1024, ap->in[9] + layer * 1024, ap->in[10] + layer * 16, ap->in[11] + (size_t)layer * 16384, ap->in[12] + (size_t)layer * 16384, \
                     ap->in[13] + (size_t)layer * 16384, ap->in[14] + (size_t)layer * 16384, ap->in[15] + layer * 256, it, tid, wid, lane); __syncthreads(); } while (0)
#define RUN_C do { LAUNDER(ap); conv3_phase(Pb, Hb, ap->in[3] + layer * 768, ap->in[17] + layer * 1024, bx, G, tid); \
            cfm_phase(lds, Pb, Hb, ap->in[4] + layer * 31 * 256, ap->in[5] + layer * 256, ap->in[6] + layer * 256, ap->in[7] + layer * 256, ap->in[17] + layer * 1024, bx, G, tid, wid, lane); __syncthreads(); } while (0)
        if (rot == 0) RUN_S;
        if (rot <= 1) RUN_C;
        {
            const int per = (3072 + G - 1) / G, it0 = bx * per, it1 = (it0 + per < 3072) ? it0 + per : 3072;
            u32x4 kreg[6], vreg[6]; bf16x8 qn[4], qc[4];
            int it = it0;
            AttnU U = attn_decode(it < it1 ? it : 0);
            if (it < it1) attn_issue(Pb, U, tid, wid, lane, kreg, vreg, qn);
            for (; it < it1; ++it) {
                __syncthreads();
                attn_to_lds(lds, tid, kreg, vreg);
#pragma unroll
                for (int s = 0; s < 4; ++s) qc[s] = qn[s];
                __syncthreads();
                const AttnU Uc = U;
                if (it + 1 < it1) { U = attn_decode(it + 1); attn_issue(Pb, U, tid, wid, lane, kreg, vreg, qn); }
                attn_compute(lds, Uc, qc, OB, ST, wid, lane);
            }
            __syncthreads();
        }
        if (rot >= 1) RUN_S;
        if (rot == 2) RUN_C;
#undef RUN_S
#undef RUN_C
    } else if (sub == 2) {
        pg8::Gemm g{ZB, (const bf16_t*)(wb + W_GLU), NT, 512, 256}; pg8::StaticOrder S; S.init(NT, 512, G, bx);
        EpiGate<1> E{YC, 768, 512, RowScale{nullptr, nullptr}};
        pg8::gemm_phase<EpiGate<1>, pg8::StaticOrder, true, true>(lds, g, S, E);
    } else if (sub == 3) {
        combine_rows(YC, OB, ST, ap->in[17] + layer * 1024, Hb, gw, ngw, lane);
    } else if (sub == 4) {
        pg8::Gemm g{Hb, (const bf16_t*)(wb + W_OUT), NT, 1024, 1024}; pg8::StaticOrder S; S.init(NT, 1024, G, bx);
        EpiRes E{XB, SS + (size_t)(layer == 0 ? 1 : 3) * NT * 4, (LAS float*)(lds + 131072)};
        pg8::gemm_phase<EpiRes, pg8::StaticOrder, true, true>(lds, g, S, E);
    } else if (sub == 5) {
#ifdef STAGGER_GU
        { const int st = (bx >> 3) & 7; for (int q = 0; q < st; ++q) __builtin_amdgcn_s_sleep(127); }
#endif
        pg8::Gemm g{XB, (const bf16_t*)(wb + W_GU), NT, 2 * DFF, 1024}; pg8::StaticOrder S; S.init(NT, 2 * DFF, G, bx);
        EpiGate<0> E{Pb, DFF, 0, RowScale{SS + (size_t)(layer == 0 ? 1 : 3) * NT * 4, (LAS float*)(lds + 131072 + 4096)}};
        pg8::gemm_phase<EpiGate<0>, pg8::StaticOrder, true, true>(lds, g, S, E);
    } else {
        pg8::Gemm g{Pb, (const bf16_t*)(wb + W_DN), NT, 1024, DFF}; pg8::StaticOrder S; S.init(NT, 1024, G, bx);
        EpiRes E{XB, SS + (size_t)(layer == 0 ? 2 : 4) * NT * 4, (LAS float*)(lds + 131072)};
        pg8::gemm_phase<EpiRes, pg8::StaticOrder, true, true>(lds, g, S, E);
    }
}
__global__ void __launch_bounds__(NTHREADS, 2) fwd_megakernel(Args args) {
    extern __shared__ __attribute__((aligned(16))) unsigned char lds_raw[];
    LAS unsigned char* lds = (LAS unsigned char*)lds_raw;
    cg::grid_group grid = cg::this_grid();
    const int tid = threadIdx.x, lane = tid & 63, wid = __builtin_amdgcn_readfirstlane(tid >> 6);
    const int G = gridDim.x, bx = blockIdx.x;
    const int lo = args.ph_lo, hi = args.ph_hi;
    const CAS Args* ap = (const CAS Args*)__builtin_amdgcn_kernarg_segment_ptr();
    volatile LAS unsigned* bst = (volatile LAS unsigned*)(lds + LDS_BYTES - 64);
    if (tid == 0) { bst[0] = 0u; bst[1] = 0u; }
    __syncthreads();
    XcdBarrier xbar = xcd_barrier_post((unsigned*)(args.ws + WS_BAR), bst);
#define GSYNC(k) do { if ((k) == 1) grid.sync(); else xcd_barrier(xbar); } while (0)
#ifdef TIMED
#define TSTAMP(k) do { if (bx == 0 && tid == 0) { if ((k) == TIMED) ((unsigned long long*)(args.ws + WS_BAR))[1800] = __builtin_amdgcn_s_memrealtime(); \
        if ((k) == TIMED + TIMED_N) ((unsigned long long*)(args.ws + WS_BAR))[1801] = __builtin_amdgcn_s_memrealtime(); } } while (0)
#else
#define TSTAMP(k) do { } while (0)
#endif
#define PHASE(k) if (lo <= (k) && (k) < hi) { if ((k) > lo) GSYNC(k); TSTAMP(k); LAUNDER(ap); phase_body((k), ap, lds, tid, lane, wid, G, bx); }
    PHASE(0) PHASE(1) PHASE(2) PHASE(3) PHASE(4) PHASE(5) PHASE(6) PHASE(7) PHASE(8) PHASE(9)
    PHASE(10) PHASE(11) PHASE(12) PHASE(13) PHASE(14) PHASE(15)
#undef PHASE
}

extern "C" void kernel_launch(void* const* d_in, const int* in_sizes, int n_in, void* d_out, int out_size, void* d_ws, size_t ws_size, hipStream_t stream) {
    static int grid_blocks = 0;
    if (grid_blocks == 0) {
        if (n_in != 24 || ws_size < WS_END) { fprintf(stderr, "kernel_launch: unexpected n_in %d / ws_size %zu\n", n_in, ws_size); grid_blocks = -1; return; }
        int dev = 0, cus = 0, per_cu = 0;
        hipGetDevice(&dev);
        hipDeviceGetAttribute(&cus, hipDeviceAttributeMultiprocessorCount, dev);
        if (hipFuncSetAttribute((const void*)fwd_megakernel, hipFuncAttributeMaxDynamicSharedMemorySize, LDS_BYTES) != hipSuccess) { fprintf(stderr, "kernel_launch: hipFuncSetAttribute failed\n"); grid_blocks = -1; return; }
        if (hipOccupancyMaxActiveBlocksPerMultiprocessor(&per_cu, (const void*)fwd_megakernel, NTHREADS, LDS_BYTES) != hipSuccess || per_cu < 1) { fprintf(stderr, "kernel_launch: occupancy query %d\n", per_cu); per_cu = 1; }
        (void)hipGetLastError();
        grid_blocks = cus * per_cu;
    }
    if (grid_blocks < 0) return;
    Args a{};
    for (int i = 0; i < 24; ++i) a.in[i] = (const float*)d_in[i];
    a.out = (float*)d_out; a.ws = (unsigned char*)d_ws; a.ph_lo = 0; a.ph_hi = NPHASE;
    if (hipMemsetAsync((char*)d_ws + WS_BAR, 0, 16384, stream) != hipSuccess) { fprintf(stderr, "kernel_launch: memset failed\n"); return; }
    void* kargs[] = {&a};
    hipError_t e = hipLaunchCooperativeKernel((const void*)fwd_megakernel, dim3(grid_blocks), dim3(NTHREADS), kargs, LDS_BYTES, stream);
    if (e != hipSuccess) fprintf(stderr, "cooperative launch failed: %s (grid %d)\n", hipGetErrorString(e), grid_blocks);
}
```

```cpp
#include <hip/hip_runtime.h>
#include <hip/hip_cooperative_groups.h>
#include <cstdio>
#include <cstdint>
namespace cg = cooperative_groups;
namespace pg8 {
#define PG8_LAS __attribute__((address_space(3)))
typedef unsigned short bf16_t;
typedef short bf16x8 __attribute__((ext_vector_type(8)));
typedef float f32x4 __attribute__((ext_vector_type(4)));
typedef unsigned u32x4 __attribute__((ext_vector_type(4)));
constexpr int BM = 256, BK = 64, HALF = 128, HTB = HALF * BK * 2  , STAGE_BYTES = 8 * HTB, NXCD = 8, WGM = 8;

__host__ __device__ __forceinline__ int lds_byte(int r, int c) { const int st = (r >> 4) * 2 + (c >> 5), rr = r & 15, cc = c & 31, ob = rr * 64 + cc * 2; return st * 1024 + (ob ^ (((ob >> 9) & 1) << 5)); }
__host__ __device__ __forceinline__ void stage_rc(int b, int& R, int& C) { const int st = b / 1024, sb = b % 1024, swz = sb ^ (((sb >> 9) & 1) << 5); R = (st >> 1) * 16 + swz / 64; C = (st & 1) * 32 + (swz % 64) / 2; }
__host__ __device__ __forceinline__ int perm32(int rho) { const int n = rho >> 4, i = rho & 15; return 8 * (i >> 2) + 4 * n + (i & 3); }

struct Unit { int pm, pn; };
struct Gemm { const bf16_t* A; const bf16_t* Bt; int M, N, K; };

struct StaticOrder {
    int nM, nN, nwg, G, c;
    __host__ __device__ void init(int M, int N, int G_, int c_) { nM = M / BM; nN = N / BM; nwg = nM * nN; G = G_; c = c_; }
    __host__ __device__ bool next(int i, Unit& u) const {
        const long L = (long)i * G + c; if (L >= nwg) return false;
        int wgid = (int)L; { const int q = nwg / NXCD, r = nwg % NXCD, xcd = wgid % NXCD, off = wgid / NXCD; wgid = (xcd < r ? xcd * (q + 1) : r * (q + 1) + (xcd - r) * q) + off; }
        const int nig = WGM * nN, gid = wgid / nig, fm = gid * WGM, gsz = (nM - fm) < WGM ? (nM - fm) : WGM;
        u.pm = fm + ((wgid % nig) % gsz); u.pn = (wgid % nig) / gsz; return true;
    }
    __device__ __forceinline__ void a_ready(const Unit&) const {}
    __device__ __forceinline__ void done(const Unit&) const {}
};

__device__ __forceinline__ unsigned cvt_pk_bf16(float lo, float hi) { unsigned r; asm volatile("v_cvt_pk_bf16_f32 %0, %1, %2" : "=v"(r) : "v"(lo), "v"(hi)); return r; }
typedef float f32x2 __attribute__((ext_vector_type(2)));
template <class Epi, class Sched, bool ALIGN_EPI = false, bool SP2 = false>
__device__ __forceinline__ void gemm_phase(PG8_LAS unsigned char* lds, const Gemm g, const Sched& S, const Epi& E) {
    const int tid = threadIdx.x, wid = __builtin_amdgcn_readfirstlane(tid >> 6), lane = tid & 63, wr = wid >> 2, wc = wid & 3, fr = lane & 15, fq = lane >> 4;
    const int K = g.K, nt = K / BK;
    unsigned voffA[2], voffB[2];
#pragma unroll
    for (int i = 0; i < 2; ++i) { int R, C; stage_rc(tid * 16 + i * 8192, R, C); const int Rb = Epi::PERM ? ((R & ~31) + perm32(R & 31)) : R;
        voffA[i] = (unsigned)(R * K + C) * 2u; voffB[i] = (unsigned)(Rb * K + C) * 2u; }
    const size_t kstep = (size_t)(BK * 2);
    const size_t hstep = (size_t)HALF * K * 2;
    const size_t tstep = 2 * hstep;
    const unsigned ldsw = (unsigned)wid * 1024u;
    const int aoff = lds_byte(wr * 64 + fr, fq * 8), boff = lds_byte(wc * 32 + fr, fq * 8);
#define PG8_SA(b, h) (((b) * 2 + (h)) * HTB)
#define PG8_SB(b, h) ((4 + (b) * 2 + (h)) * HTB)
#define PG8_STAGE(bufoff, gbase, voff) do { _Pragma("unroll") for (int _i = 0; _i < 2; ++_i) \
        __builtin_amdgcn_global_load_lds((const unsigned*)((const char*)(gbase) + (voff)[_i]), (PG8_LAS unsigned*)(lds + (bufoff) + ldsw + _i * 8192), 16, 0, 0); } while (0)
#define PG8_LDA(dst, b, h) do { _Pragma("unroll") for (int m = 0; m < 4; ++m) _Pragma("unroll") for (int k = 0; k < 2; ++k) dst[m][k] = *(const PG8_LAS bf16x8*)(lds + PG8_SA(b, h) + aoff + m * 2048 + k * 1024); } while (0)
#define PG8_LDB(dst, b, h) do { _Pragma("unroll") for (int n = 0; n < 2; ++n) _Pragma("unroll") for (int k = 0; k < 2; ++k) dst[n][k] = *(const PG8_LAS bf16x8*)(lds + PG8_SB(b, h) + boff + n * 2048 + k * 1024); } while (0)
#define PG8_MMA(ai, bj, At, Bt) do { __builtin_amdgcn_s_setprio(1); _Pragma("unroll") for (int m = 0; m < 4; ++m) _Pragma("unroll") for (int n = 0; n < 2; ++n) _Pragma("unroll") for (int k = 0; k < 2; ++k) \
        acc[ai][bj][m][n] = __builtin_amdgcn_mfma_f32_16x16x32_bf16(Bt[n][k], At[m][k], acc[ai][bj][m][n], 0, 0, 0); __builtin_amdgcn_s_setprio(0); } while (0)
#define PG8_WAIT_V(n) asm volatile("s_waitcnt vmcnt(" #n ")" ::: "memory")
#define PG8_WAIT_L(n) asm volatile("s_waitcnt lgkmcnt(" #n ")" ::: "memory")
#define PG8_BAR __builtin_amdgcn_s_barrier()
#define PG8_SCHED __builtin_amdgcn_sched_barrier(0)
    Unit cur, nxt; int ui = 0;
    if (!S.next(0, cur)) return;
    E.prime(cur);
    f32x4 acc[2][2][4][2];
#pragma unroll
    for (int a = 0; a < 2; ++a)
#pragma unroll
        for (int b = 0; b < 2; ++b)
#pragma unroll
            for (int m = 0; m < 4; ++m)
#pragma unroll
                for (int n = 0; n < 2; ++n) acc[a][b][m][n] = (f32x4){0.f, 0.f, 0.f, 0.f};
    bf16x8 At[4][2], B0[2][2], B1[2][2];
    const char* cA = (const char*)g.A + (size_t)cur.pm * tstep; const char* cB = (const char*)g.Bt + (size_t)cur.pn * tstep;
    S.a_ready(cur);
    if constexpr (SP2) {
        PG8_STAGE(PG8_SB(0, 0), cB, voffB); PG8_STAGE(PG8_SB(0, 1), cB + hstep, voffB); PG8_STAGE(PG8_SA(0, 0), cA, voffA); PG8_STAGE(PG8_SA(0, 1), cA + hstep, voffA);
        if (wr == 1) PG8_BAR;
        PG8_WAIT_V(2); PG8_BAR;
        PG8_STAGE(PG8_SB(1, 0), cB + kstep, voffB); PG8_STAGE(PG8_SA(1, 0), cA + kstep, voffA); PG8_STAGE(PG8_SB(1, 1), cB + hstep + kstep, voffB);
        PG8_WAIT_V(6); PG8_BAR;
    } else {
        PG8_STAGE(PG8_SB(0, 0), cB, voffB); PG8_STAGE(PG8_SA(0, 0), cA, voffA); PG8_STAGE(PG8_SB(0, 1), cB + hstep, voffB); PG8_STAGE(PG8_SA(0, 1), cA + hstep, voffA);
        if (wr == 1) PG8_BAR;
        PG8_WAIT_V(4); PG8_BAR;
        PG8_STAGE(PG8_SB(1, 0), cB + kstep, voffB); PG8_STAGE(PG8_SA(1, 0), cA + kstep, voffA); PG8_STAGE(PG8_SB(1, 1), cB + hstep + kstep, voffB);
        PG8_WAIT_V(6); PG8_BAR;
    }
    for (;;) {
        const bool has_next = S.next(ui + 1, nxt);
        const char* nA = has_next ? (const char*)g.A + (size_t)nxt.pm * tstep : cA; const char* nB = has_next ? (const char*)g.Bt + (size_t)nxt.pn * tstep : cB;
#pragma nounroll
        for (int t = 0; t < nt; t += 2) {
            const bool last = (t == nt - 2);
            const char* a1 = cA + (size_t)(t + 1) * kstep;
            const char* a2 = last ? nA : cA + (size_t)(t + 2) * kstep; const char* b2 = last ? nB : cB + (size_t)(t + 2) * kstep;
            const char* a3 = a2 + kstep; const char* b3 = b2 + kstep;
            if (last && has_next) S.a_ready(nxt);
            if constexpr (SP2) {
            PG8_LDB(B0, 0, 0); PG8_LDB(B1, 0, 1); PG8_SCHED; PG8_LDA(At, 0, 0); PG8_STAGE(PG8_SA(1, 1), a1 + hstep, voffA);
            PG8_WAIT_V(8); PG8_WAIT_L(0); PG8_BAR; PG8_MMA(0, 0, At, B0); PG8_MMA(0, 1, At, B1); PG8_BAR; PG8_SCHED;
            PG8_LDA(At, 0, 1); PG8_STAGE(PG8_SB(0, 0), b2, voffB); PG8_STAGE(PG8_SB(0, 1), b2 + hstep, voffB); PG8_STAGE(PG8_SA(0, 0), a2, voffA);
            PG8_WAIT_V(8); PG8_WAIT_L(0); PG8_BAR; PG8_MMA(1, 0, At, B0); PG8_MMA(1, 1, At, B1); PG8_BAR; PG8_SCHED;
            PG8_LDB(B0, 1, 0); PG8_LDB(B1, 1, 1); PG8_SCHED; PG8_LDA(At, 1, 0); PG8_STAGE(PG8_SA(0, 1), a2 + hstep, voffA);
            PG8_WAIT_V(8); PG8_WAIT_L(0); PG8_BAR; PG8_MMA(0, 0, At, B0); PG8_MMA(0, 1, At, B1); PG8_BAR; PG8_SCHED;
            PG8_LDA(At, 1, 1); PG8_STAGE(PG8_SB(1, 0), b3, voffB); PG8_STAGE(PG8_SB(1, 1), b3 + hstep, voffB); PG8_STAGE(PG8_SA(1, 0), a3, voffA);
            PG8_WAIT_V(8); PG8_WAIT_L(0); PG8_BAR; PG8_MMA(1, 0, At, B0); PG8_MMA(1, 1, At, B1); PG8_BAR; PG8_SCHED;
            } else {
            PG8_LDB(B0, 0, 0); PG8_SCHED; PG8_LDA(At, 0, 0); PG8_STAGE(PG8_SA(1, 1), a1 + hstep, voffA);
            PG8_WAIT_L(8); PG8_BAR; PG8_WAIT_L(0); PG8_MMA(0, 0, At, B0); PG8_BAR; PG8_SCHED;
            PG8_LDB(B1, 0, 1); PG8_STAGE(PG8_SB(0, 0), b2, voffB);
            PG8_BAR; PG8_WAIT_L(0); PG8_MMA(0, 1, At, B1); PG8_BAR;
            PG8_LDA(At, 0, 1); PG8_STAGE(PG8_SA(0, 0), a2, voffA);
            PG8_BAR; PG8_WAIT_L(0); PG8_MMA(1, 0, At, B0); PG8_BAR; PG8_SCHED;
            PG8_STAGE(PG8_SB(0, 1), b2 + hstep, voffB);
            PG8_WAIT_V(6); PG8_BAR; PG8_MMA(1, 1, At, B1); PG8_BAR;
            PG8_LDB(B0, 1, 0); PG8_SCHED; PG8_LDA(At, 1, 0); PG8_STAGE(PG8_SA(0, 1), a2 + hstep, voffA);
            PG8_WAIT_L(8); PG8_BAR; PG8_WAIT_L(0); PG8_MMA(0, 0, At, B0); PG8_BAR; PG8_SCHED;
            PG8_LDB(B1, 1, 1); PG8_STAGE(PG8_SB(1, 0), b3, voffB);
            PG8_BAR; PG8_WAIT_L(0); PG8_MMA(0, 1, At, B1); PG8_BAR;
            PG8_LDA(At, 1, 1); PG8_STAGE(PG8_SA(1, 0), a3, voffA);
            PG8_BAR; PG8_WAIT_L(0); PG8_MMA(1, 0, At, B0); PG8_BAR; PG8_SCHED;
            PG8_STAGE(PG8_SB(1, 1), b3 + hstep, voffB);
            PG8_WAIT_V(6); PG8_BAR; PG8_MMA(1, 1, At, B1); PG8_BAR;
            }
        }
        if constexpr (ALIGN_EPI) { if (wr == 0) PG8_BAR; }
        if constexpr (!Epi::AFTER_DRAIN) { E(acc, cur, wr, wc, fr, fq, nxt, has_next, ui); S.done(cur); }
        if (!has_next) break;
#pragma unroll
        for (int a = 0; a < 2; ++a)
#pragma unroll
            for (int b = 0; b < 2; ++b)
#pragma unroll
                for (int m = 0; m < 4; ++m)
#pragma unroll
                    for (int n = 0; n < 2; ++n) acc[a][b][m][n] = (f32x4){0.f, 0.f, 0.f, 0.f};
        cur = nxt; cA = nA; cB = nB; ++ui;
        if constexpr (ALIGN_EPI) { if (wr == 1) PG8_BAR; }
    }
    PG8_WAIT_V(0);
    if constexpr (!ALIGN_EPI) { if (wr == 0) PG8_BAR; }
    PG8_BAR;
    if constexpr (Epi::AFTER_DRAIN) { E.fused(acc, cur, wr, wc, fr, fq, lds, wid, lane); S.done(cur); }
#undef PG8_SA
#undef PG8_SB
#undef PG8_STAGE
#undef PG8_LDA
#undef PG8_LDB
#undef PG8_MMA
#undef PG8_WAIT_V
#undef PG8_WAIT_L
#undef PG8_BAR
#undef PG8_SCHED
}
}
#ifndef REPEAT_MASK
#define REPEAT_MASK 0u
#endif
#ifndef EXTRA_SYNCS
#define EXTRA_SYNCS 0
#endif
#ifndef REP_SSM
#define REP_SSM 1
#endif
#ifndef REP_CONV
#define REP_CONV 1
#endif
#ifndef REP_ATTN
#define REP_ATTN 1
#endif

#define LAS __attribute__((address_space(3)))
typedef unsigned short bf16_t;
typedef short bf16x8 __attribute__((ext_vector_type(8)));
typedef short s16x4 __attribute__((ext_vector_type(4)));
typedef float f32x4 __attribute__((ext_vector_type(4)));
typedef float f32x16 __attribute__((ext_vector_type(16)));
typedef unsigned u32x4 __attribute__((ext_vector_type(4)));
typedef unsigned u32x2 __attribute__((ext_vector_type(2)));
typedef float f32x2v __attribute__((ext_vector_type(2)));
typedef __bf16 bf16x2v __attribute__((ext_vector_type(2)));

constexpr int NT = 65536, SEQ = 4096, DMODEL = 1024, NIN = 2304, DFF = 2816;
constexpr float EPS = 1e-6f;
constexpr float C2 = 0.125f * 1.4426950408889634f;
constexpr size_t MiB = (size_t)1 << 20;
constexpr size_t W_IN = 0, W_OUT = W_IN + (size_t)NIN * 1024 * 2, W_GU = W_OUT + (size_t)1024 * 1024 * 2, W_DN = W_GU + (size_t)2 * DFF * 1024 * 2,
                 W_GLU = W_DN + (size_t)1024 * DFF * 2, W_LAYER = 24 * MiB;
static_assert(W_GLU + 512 * 256 * 2 <= W_LAYER, "weight block");
constexpr size_t WS_W = 0, WS_ROPE = 48 * MiB, WS_H = 64 * MiB, WS_P = 192 * MiB, WS_YC = 544 * MiB, WS_ZB = 640 * MiB, WS_OB = 672 * MiB, WS_ST = 768 * MiB, WS_BAR = 776 * MiB, WS_XB = 778 * MiB, WS_SS = 906 * MiB, WS_END = 912 * MiB;
constexpr int LDS_BYTES = 147456;
constexpr int NTHREADS = 512;

#define CAS __attribute__((address_space(4)))
struct Args {
    const float* in[24];
    float* out;
    unsigned char* ws;
    int ph_lo, ph_hi;
};

__device__ __forceinline__ unsigned pk2(float lo, float hi) { f32x2v v = {lo, hi}; bf16x2v b = __builtin_convertvector(v, bf16x2v); return __builtin_bit_cast(unsigned, b); }
__device__ __forceinline__ float bflo(unsigned u) { return __uint_as_float(u << 16); }
__device__ __forceinline__ float bfhi(unsigned u) { return __uint_as_float(u & 0xffff0000u); }
template <int CTRL, int ROWMASK> __device__ __forceinline__ float dpp_add(float v) {
    return v + __builtin_bit_cast(float, __builtin_amdgcn_update_dpp(0, __builtin_bit_cast(int, v), CTRL, ROWMASK, 0xF, false));
}
__device__ __forceinline__ float wave_sum(float v) {
    v = dpp_add<0xB1, 0xF>(v);
    v = dpp_add<0x4E, 0xF>(v);
    v = dpp_add<0x141, 0xF>(v);
    v = dpp_add<0x140, 0xF>(v);
    v = dpp_add<0x142, 0xA>(v);
    v = dpp_add<0x143, 0xC>(v);
    return __builtin_bit_cast(float, __builtin_amdgcn_readlane(__builtin_bit_cast(int, v), 63));
}
__device__ __forceinline__ float sigmoidf_(float x) { return __builtin_amdgcn_rcpf(1.f + __expf(-x)); }
__device__ __forceinline__ float gelu_tanh(float y) {
    const float a = 0.7978845608028654f * (y + 0.044715f * y * y * y);
    const float t = 1.f - 2.f * __builtin_amdgcn_rcpf(__expf(2.f * a) + 1.f);
    return 0.5f * y * (1.f + t);
}
#define WAVE_LDS_SYNC() asm volatile("s_waitcnt lgkmcnt(0)" ::: "memory")

struct RowScale {
    const float* ssp; LAS float* xs;
    __device__ __forceinline__ float rs_of(int row) const { const f32x4 sp = *(const f32x4*)(ssp + (size_t)row * 4); return rsqrtf(((sp.x + sp.y) + (sp.z + sp.w)) * (1.f / DMODEL) + EPS); }
    __device__ __forceinline__ void prime(const pg8::Unit& u) const { const int t = threadIdx.x; if (t < 256) xs[t] = rs_of(u.pm * 256 + t); }
};
struct EpiIn {
    static constexpr bool PERM = true, AFTER_DRAIN = false;
    bf16_t* O; const float* ropec; const float* ropes; RowScale R;
    __device__ __forceinline__ void prime(const pg8::Unit& u) const { R.prime(u); }
    __device__ __forceinline__ void operator()(const f32x4 (&acc)[2][2][4][2], const pg8::Unit& u, int wr, int wc, int fr, int fq, const pg8::Unit& nxt, bool has_next, int ui) const {
        const int row0 = u.pm * 256 + wr * 64 + fr, t = threadIdx.x;
        f32x4 spn = {0.f, 0.f, 0.f, 0.f};
        const bool stage = has_next && t < 256 && nxt.pm != u.pm;
        if (stage) spn = *(const f32x4*)(R.ssp + (size_t)(nxt.pm * 256 + t) * 4);
        const LAS float* xsc = R.xs + (ui & 1) * 256 + wr * 64 + fr;
        if (u.pn == 0 || u.pn == 1 || u.pn == 3 || u.pn == 4) {
            const bool glu = u.pn >= 3;
            const int cbase = (glu ? 768 + 128 * (u.pn - 3) : 128 * u.pn) + wc * 32 + 8 * fq;
#pragma unroll
            for (int ai = 0; ai < 2; ++ai)
#pragma unroll
                for (int m = 0; m < 4; ++m) {
                    const float rsc = xsc[ai * 128 + m * 16];
                    float r[8];
#pragma unroll
                    for (int n = 0; n < 2; ++n)
#pragma unroll
                        for (int j = 0; j < 4; ++j) {
                            const float a = acc[ai][0][m][n][j] * rsc, b = acc[ai][1][m][n][j] * rsc;
                            r[4 * n + j] = glu ? a * sigmoidf_(b) : a * b;
                        }
                    u32x4 w; w.x = pk2(r[0], r[1]); w.y = pk2(r[2], r[3]); w.z = pk2(r[4], r[5]); w.w = pk2(r[6], r[7]);
                    *(u32x4*)(O + (size_t)(row0 + ai * 128 + m * 16) * NIN + cbase) = w;
                }
        } else if (u.pn == 6 || u.pn == 7) {
            const float sc = (u.pn == 6) ? C2 : 1.f;
            const int dimb = 16 * (wc & 1) + 4 * fq;
#pragma unroll
            for (int ai = 0; ai < 2; ++ai)
#pragma unroll
                for (int m = 0; m < 4; ++m) {
                    const int row = row0 + ai * 128 + m * 16; const int pos = row & (SEQ - 1);
                    const float rsc = xsc[ai * 128 + m * 16] * sc;
                    const f32x4 cs = *(const f32x4*)(ropec + pos * 32 + dimb), sn = *(const f32x4*)(ropes + pos * 32 + dimb);
                    bf16_t* rowp = O + (size_t)row * NIN + u.pn * 256 + 64 * (wc >> 1) + dimb;
#pragma unroll
                    for (int bj = 0; bj < 2; ++bj) {
                        const f32x4 x1 = acc[ai][bj][m][0] * rsc, x2 = acc[ai][bj][m][1] * rsc;
                        const f32x4 o1 = x1 * cs - x2 * sn, o2 = x2 * cs + x1 * sn;
                        u32x2 w1, w2; w1.x = pk2(o1[0], o1[1]); w1.y = pk2(o1[2], o1[3]); w2.x = pk2(o2[0], o2[1]); w2.y = pk2(o2[2], o2[3]);
                        *(u32x2*)(rowp + bj * 128) = w1; *(u32x2*)(rowp + bj * 128 + 32) = w2;
                    }
                }
        } else {
#pragma unroll
            for (int ai = 0; ai < 2; ++ai)
#pragma unroll
                for (int m = 0; m < 4; ++m) {
                    bf16_t* rowp = O + (size_t)(row0 + ai * 128 + m * 16) * NIN + (u.pn == 2 ? 256 : u.pn * 256) + wc * 32 + 8 * fq;
                    const float rsc = xsc[ai * 128 + m * 16];
#pragma unroll
                    for (int bj = 0; bj < 2; ++bj) {
                        const f32x4 v0 = acc[ai][bj][m][0] * rsc, v1 = acc[ai][bj][m][1] * rsc;
                        u32x4 w; w.x = pk2(v0[0], v0[1]); w.y = pk2(v0[2], v0[3]); w.z = pk2(v1[0], v1[1]); w.w = pk2(v1[2], v1[3]);
                        *(u32x4*)(rowp + bj * 128) = w;
                    }
                }
        }
        if (has_next && t < 256) {
            float v = R.xs[(ui & 1) * 256 + t];
            if (nxt.pm != u.pm) v = rsqrtf(((spn.x + spn.y) + (spn.z + spn.w)) * (1.f / DMODEL) + EPS);
            R.xs[((ui + 1) & 1) * 256 + t] = v;
        }
    }
};
struct EpiRes {
    static constexpr bool PERM = true, AFTER_DRAIN = false;
    bf16_t* xb; float* ssp; LAS float* xl;
    __device__ __forceinline__ void prime(const pg8::Unit&) const {}
    __device__ __forceinline__ void operator()(const f32x4 (&acc)[2][2][4][2], const pg8::Unit& u, int wr, int wc, int fr, int fq, const pg8::Unit&, bool, int) const {
        const int row0 = u.pm * 256 + wr * 64 + fr, col0 = u.pn * 256 + wc * 32 + 8 * fq;
        u32x4 rv[2][4][2];
#pragma unroll
        for (int ai = 0; ai < 2; ++ai)
#pragma unroll
            for (int m = 0; m < 4; ++m)
#pragma unroll
                for (int bj = 0; bj < 2; ++bj) rv[ai][m][bj] = *(const u32x4*)(xb + (size_t)(row0 + ai * 128 + m * 16) * DMODEL + col0 + bj * 128);
#pragma unroll
        for (int ai = 0; ai < 2; ++ai)
#pragma unroll
            for (int m = 0; m < 4; ++m) {
                const int row = row0 + ai * 128 + m * 16;
                const size_t off = (size_t)row * DMODEL + col0;
                float sq = 0.f;
#pragma unroll
                for (int bj = 0; bj < 2; ++bj) {
                    const u32x4 r = rv[ai][m][bj];
                    const f32x4 r0 = {bflo(r.x), bfhi(r.x), bflo(r.y), bfhi(r.y)}, r1 = {bflo(r.z), bfhi(r.z), bflo(r.w), bfhi(r.w)};
                    const f32x4 x0 = r0 + acc[ai][bj][m][0], x1 = r1 + acc[ai][bj][m][1];
                    u32x4 w; w.x = pk2(x0[0], x0[1]); w.y = pk2(x0[2], x0[3]); w.z = pk2(x1[0], x1[1]); w.w = pk2(x1[2], x1[3]);
                    *(u32x4*)(xb + off + bj * 128) = w;
                    sq += (x0[0] * x0[0] + x0[1] * x0[1]) + (x0[2] * x0[2] + x0[3] * x0[3]) + (x1[0] * x1[0] + x1[1] * x1[1]) + (x1[2] * x1[2] + x1[3] * x1[3]);
                }
                sq += __shfl_xor(sq, 16); sq += __shfl_xor(sq, 32);
                if (fq == 0) xl[(wr * 64 + ai * 128 + m * 16 + fr) * 4 + wc] = sq;
            }
        asm volatile("s_waitcnt lgkmcnt(0)\n\ts_barrier" ::: "memory");
        const int t = threadIdx.x;
        if (t < 256) { const f32x4 v = *(const LAS f32x4*)(xl + t * 4); ssp[(size_t)(u.pm * 256 + t) * 4 + u.pn] = (v.x + v.y) + (v.z + v.w); }
    }
};
template <int MODE  > struct EpiGate {
    static constexpr bool PERM = true, AFTER_DRAIN = false;
    bf16_t* O; int ldc; int coff; RowScale R;
    __device__ __forceinline__ void prime(const pg8::Unit& u) const { if (MODE == 0) R.prime(u); }
    __device__ __forceinline__ void operator()(const f32x4 (&acc)[2][2][4][2], const pg8::Unit& u, int wr, int wc, int fr, int fq, const pg8::Unit& nxt, bool has_next, int ui) const {
        const int row0 = u.pm * 256 + wr * 64 + fr, col0 = coff + u.pn * 128 + wc * 32 + 8 * fq, t = threadIdx.x;
        f32x4 spn = {0.f, 0.f, 0.f, 0.f};
        if (MODE == 0) { if (has_next && t < 256 && nxt.pm != u.pm) spn = *(const f32x4*)(R.ssp + (size_t)(nxt.pm * 256 + t) * 4); }
        const LAS float* xsc = R.xs + (ui & 1) * 256 + wr * 64 + fr;
#pragma unroll
        for (int ai = 0; ai < 2; ++ai)
#pragma unroll
            for (int m = 0; m < 4; ++m) {
                float r[8];
                float rsc = 1.f; if (MODE == 0) rsc = xsc[ai * 128 + m * 16];
                const float c1 = -1.4426950408889634f * rsc, r2 = rsc * rsc;
#pragma unroll
                for (int n = 0; n < 2; ++n)
#pragma unroll
                    for (int j = 0; j < 4; ++j) {
                        const float a = acc[ai][0][m][n][j], b = acc[ai][1][m][n][j];
                        if (MODE == 0) r[4 * n + j] = (a * b) * (r2 * __builtin_amdgcn_rcpf(1.f + __builtin_amdgcn_exp2f(a * c1)));
                        else r[4 * n + j] = a * __builtin_amdgcn_rcpf(1.f + __builtin_amdgcn_exp2f(b * -1.4426950408889634f));
                    }
                u32x4 w; w.x = pk2(r[0], r[1]); w.y = pk2(r[2], r[3]); w.z = pk2(r[4], r[5]); w.w = pk2(r[6], r[7]);
                *(u32x4*)(O + (size_t)(row0 + ai * 128 + m * 16) * ldc + col0) = w;
            }
        if (MODE == 0) {
            if (has_next && t < 256) {
                float v = R.xs[(ui & 1) * 256 + t];
                if (nxt.pm != u.pm) v = rsqrtf(((spn.x + spn.y) + (spn.z + spn.w)) * (1.f / DMODEL) + EPS);
                R.xs[((ui + 1) & 1) * 256 + t] = v;
            }
        }
    }
};

struct WMat { const float* src; const float* src2; int K, N, ldw, kind; bf16_t* dst; const float* kscale; };
__device__ __forceinline__ void wconv_load(const WMat& w, int t, int tid, float (&v)[8]) {
    const int nkt = w.K / 64, jt = t / nkt, kt = t % nkt, j0 = jt * 64, k0 = kt * 64;
    const int j = j0 + (tid & 63);
    const float* s = w.src; int col = j;
    if (w.kind == 1) {
        if (j >= 1536 && j < 2048) { const int ww = j & 63; col = (j & ~63) + 32 * ((ww >> 2) & 1) + 16 * (ww >> 5) + 4 * ((ww >> 3) & 3) + (ww & 3); }
        else if (j < 1280) {
            const int pn = j >> 8, wi = j & 255, half = (pn == 0 || pn == 3) ? 0 : 128;
            if (pn == 2) col = 256 + wi;
            else if (pn < 2) col = (wi < 128 ? 0 : 512 - 128) + half + wi;
            else col = (wi < 128 ? 768 : 1024 - 128) + half + wi;
        }
    } else if (w.kind == 2) {
        const int pn = j >> 8, wi = j & 255; if (wi < 128) col = pn * 128 + wi; else { s = w.src2; col = pn * 128 + (wi - 128); }
    }
    const int kk = tid >> 6;
#pragma unroll
    for (int i = 0; i < 8; ++i) { const int k = kk + 8 * i; const float sc = w.kscale ? w.kscale[k0 + k] : 1.f; v[i] = s[(size_t)(k0 + k) * w.ldw + col] * sc; }
}
__device__ __forceinline__ void wconv_store(LAS float* tile, const WMat& w, int t, int tid, const float (&v)[8]) {
    const int nkt = w.K / 64, jt = t / nkt, kt = t % nkt, j0 = jt * 64, k0 = kt * 64;
    const int kk = tid >> 6;
#pragma unroll
    for (int i = 0; i < 8; ++i) tile[(kk + 8 * i) * 65 + (tid & 63)] = v[i];
    __syncthreads();
    {
        const int jr = tid >> 3, c = tid & 7; const LAS float* s = tile + (8 * c) * 65 + jr;
        u32x4 o; o.x = pk2(s[0], s[65]); o.y = pk2(s[2 * 65], s[3 * 65]); o.z = pk2(s[4 * 65], s[5 * 65]); o.w = pk2(s[6 * 65], s[7 * 65]);
        *(u32x4*)(w.dst + (size_t)(j0 + jr) * w.K + k0 + 8 * c) = o;
    }
    __syncthreads();
}
__device__ __forceinline__ void wconv_wave(LAS float* tile, const WMat& w, int t, int lane) {
    const int nkt = w.K / 64, jt = t / nkt, kt = t % nkt, j0 = jt * 64, k0 = kt * 64;
    const int j = j0 + lane;
    const float* s = w.src; int col = j;
    if (w.kind == 1) {
        if (j >= 1536 && j < 2048) { const int ww = j & 63; col = (j & ~63) + 32 * ((ww >> 2) & 1) + 16 * (ww >> 5) + 4 * ((ww >> 3) & 3) + (ww & 3); }
        else if (j < 1280) {
            const int pn = j >> 8, wi = j & 255, half = (pn == 0 || pn == 3) ? 0 : 128;
            if (pn == 2) col = 256 + wi;
            else if (pn < 2) col = (wi < 128 ? 0 : 512 - 128) + half + wi;
            else col = (wi < 128 ? 768 : 1024 - 128) + half + wi;
        }
    } else if (w.kind == 2) {
        const int pn = j >> 8, wi = j & 255; if (wi < 128) col = pn * 128 + wi; else { s = w.src2; col = pn * 128 + (wi - 128); }
    }
    const float* sp = s + (size_t)k0 * w.ldw + col;
#pragma unroll
    for (int hb = 0; hb < 2; ++hb) {
        float v[32];
#pragma unroll
        for (int i = 0; i < 32; ++i) v[i] = sp[(size_t)(hb * 32 + i) * w.ldw];
        if (w.kscale) {
#pragma unroll
            for (int i = 0; i < 32; ++i) v[i] *= w.kscale[k0 + hb * 32 + i];
        }
#pragma unroll
        for (int i = 0; i < 32; ++i) tile[(hb * 32 + i) * 65 + lane] = v[i];
    }
    WAVE_LDS_SYNC();
    const int c = lane & 7;
#pragma unroll
    for (int rg = 0; rg < 8; ++rg) {
        const int jr = rg * 8 + (lane >> 3); const LAS float* q = tile + (8 * c) * 65 + jr;
        u32x4 o; o.x = pk2(q[0], q[65]); o.y = pk2(q[2 * 65], q[3 * 65]); o.z = pk2(q[4 * 65], q[5 * 65]); o.w = pk2(q[6 * 65], q[7 * 65]);
        *(u32x4*)(w.dst + (size_t)(j0 + jr) * w.K + k0 + 8 * c) = o;
    }
    WAVE_LDS_SYNC();
}
__device__ __forceinline__ WMat wmat_of(const CAS Args* ap, unsigned char* ws, int it, int& t) {
    const int layer = it / 2976; t = it % 2976;
    unsigned char* wb = ws + WS_W + (size_t)layer * W_LAYER;
    if (t < 576) return WMat{ap->in[2] + (size_t)layer * 1024 * NIN, nullptr, 1024, NIN, NIN, 1, (bf16_t*)(wb + W_IN), ap->in[1] + layer * 1024};
    if ((t -= 576) < 256) return WMat{ap->in[18] + (size_t)layer * 1024 * 1024, nullptr, 1024, 1024, 1024, 0, (bf16_t*)(wb + W_OUT), nullptr};
    if ((t -= 256) < 1408) return WMat{ap->in[20] + (size_t)layer * 1024 * DFF, ap->in[21] + (size_t)layer * 1024 * DFF, 1024, 2 * DFF, DFF, 2, (bf16_t*)(wb + W_GU), ap->in[19] + layer * 1024};
    if ((t -= 1408) < 704) return WMat{ap->in[22] + (size_t)layer * DFF * 1024, nullptr, DFF, 1024, 1024, 0, (bf16_t*)(wb + W_DN), nullptr};
    t -= 704; return WMat{ap->in[16] + (size_t)layer * 256 * 512, ap->in[16] + (size_t)layer * 256 * 512 + 256, 256, 512, 512, 2, (bf16_t*)(wb + W_GLU), nullptr};
}

__device__ __forceinline__ void norm_rows_bf16(const float* X, const float* g, bf16_t* H, int gw, int ngw, int lane) {
    f32x4 gv[4];
#pragma unroll
    for (int j = 0; j < 4; ++j) gv[j] = ((const f32x4*)g)[lane + 64 * j];
    for (int m = gw; m < NT; m += ngw) {
        const f32x4* xr = (const f32x4*)(X + (size_t)m * DMODEL) + lane;
        f32x4 v[4]; float s = 0.f;
#pragma unroll
        for (int j = 0; j < 4; ++j) { v[j] = xr[64 * j]; s += (v[j].x * v[j].x + v[j].y * v[j].y) + (v[j].z * v[j].z + v[j].w * v[j].w); }
        const float rs = rsqrtf(wave_sum(s) * (1.f / DMODEL) + EPS);
        u32x2* o = (u32x2*)(H + (size_t)m * DMODEL) + lane;
#pragma unroll
        for (int j = 0; j < 4; ++j) { u32x2 w; w.x = pk2(v[j].x * rs * gv[j].x, v[j].y * rs * gv[j].y); w.y = pk2(v[j].z * rs * gv[j].z, v[j].w * rs * gv[j].w); o[64 * j] = w; }
    }
}
__device__ __forceinline__ void xb_rows(const float* X, bf16_t* XB, float* ssq, int gw, int ngw, int lane) {
    for (int m0 = gw * 2; m0 < NT; m0 += ngw * 2) {
        f32x4 v[2][4];
#pragma unroll
        for (int r = 0; r < 2; ++r) { const f32x4* xr = (const f32x4*)(X + (size_t)(m0 + r) * DMODEL) + lane;
#pragma unroll
            for (int j = 0; j < 4; ++j) v[r][j] = xr[64 * j]; }
#pragma unroll
        for (int r = 0; r < 2; ++r) {
            const size_t m = (size_t)m0 + r;
            float s = 0.f;
#pragma unroll
            for (int j = 0; j < 4; ++j) s += (v[r][j].x * v[r][j].x + v[r][j].y * v[r][j].y) + (v[r][j].z * v[r][j].z + v[r][j].w * v[r][j].w);
            s = wave_sum(s);
            u32x2* o = (u32x2*)(XB + m * DMODEL) + lane;
#pragma unroll
            for (int j = 0; j < 4; ++j) { u32x2 w; w.x = pk2(v[r][j].x, v[r][j].y); w.y = pk2(v[r][j].z, v[r][j].w); o[64 * j] = w; }
            if (lane == 0) { f32x4 o4 = {s, 0.f, 0.f, 0.f}; *(f32x4*)(ssq + m * 4) = o4; }
        }
    }
}
__device__ __forceinline__ void final_rows(const bf16_t* XB, const float* ssp, const float* g, float* OUT, int gw, int ngw, int lane, float tscale) {
    f32x4 gv[4];
#pragma unroll
    for (int j = 0; j < 4; ++j) gv[j] = ((const f32x4*)g)[lane + 64 * j];
    for (int m0 = gw * 4; m0 < NT; m0 += ngw * 4) {
        u32x2 w[4][4]; f32x4 sp[4];
#pragma unroll
        for (int r = 0; r < 4; ++r) { const size_t m = (size_t)m0 + r; sp[r] = *(const f32x4*)(ssp + m * 4); const u32x2* xr = (const u32x2*)(XB + m * DMODEL) + lane;
#pragma unroll
            for (int j = 0; j < 4; ++j) w[r][j] = xr[64 * j]; }
#pragma unroll
        for (int r = 0; r < 4; ++r) {
            const float rs = rsqrtf(((sp[r].x + sp[r].y) + (sp[r].z + sp[r].w)) * (1.f / DMODEL) + EPS) * tscale;
            f32x4* o = (f32x4*)(OUT + (size_t)(m0 + r) * DMODEL) + lane;
#pragma unroll
            for (int j = 0; j < 4; ++j) { f32x4 v = {bflo(w[r][j].x), bfhi(w[r][j].x), bflo(w[r][j].y), bfhi(w[r][j].y)}; o[64 * j] = v * rs * gv[j]; }
        }
    }
}
__device__ __forceinline__ void norm_rows_f32_inplace(float* X, const float* g, int gw, int ngw, int lane) {
    f32x4 gv[4];
#pragma unroll
    for (int j = 0; j < 4; ++j) gv[j] = ((const f32x4*)g)[lane + 64 * j];
    for (int m = gw; m < NT; m += ngw) {
        f32x4* xr = (f32x4*)(X + (size_t)m * DMODEL) + lane;
        f32x4 v[4]; float s = 0.f;
#pragma unroll
        for (int j = 0; j < 4; ++j) { v[j] = xr[64 * j]; s += (v[j].x * v[j].x + v[j].y * v[j].y) + (v[j].z * v[j].z + v[j].w * v[j].w); }
        const float rs = rsqrtf(wave_sum(s) * (1.f / DMODEL) + EPS);
#pragma unroll
        for (int j = 0; j < 4; ++j) xr[64 * j] = v[j] * rs * gv[j];
    }
}

struct C3Regs { u32x4 gg[6], bb[4]; };
__device__ __forceinline__ void conv3_issue(const bf16_t* P, int w, C3Regs& R) {
    const int c8 = w & 31, tok = (w >> 5) * 4, t = tok & (SEQ - 1);
    const bf16_t* base = P + (size_t)tok * NIN + c8 * 8;
#pragma unroll
    for (int i = 0; i < 6; ++i) { const int dt = (t == 0 && i < 2) ? 0 : i - 2; R.gg[i] = *(const u32x4*)(base + dt * NIN); }
#pragma unroll
    for (int i = 0; i < 4; ++i) R.bb[i] = *(const u32x4*)(base + i * NIN + 256);
}
__device__ __forceinline__ void unpack8(const u32x4 a, float (&o)[8]) {
    o[0] = bflo(a.x); o[1] = bfhi(a.x); o[2] = bflo(a.y); o[3] = bfhi(a.y); o[4] = bflo(a.z); o[5] = bfhi(a.z); o[6] = bflo(a.w); o[7] = bfhi(a.w);
}
__device__ __forceinline__ void conv3_compute(bf16_t* H, int w, const C3Regs& R, const float (&w0)[8], const float (&w1)[8], const float (&w2)[8], const float (&gm)[8]) {
    const int c8 = w & 31, tok = (w >> 5) * 4, t = tok & (SEQ - 1);
    const float z01 = (t == 0) ? 0.f : 1.f;
    float g[6][8];
#pragma unroll
    for (int i = 0; i < 6; ++i) unpack8(R.gg[i], g[i]);
#pragma unroll
    for (int j = 0; j < 8; ++j) { g[0][j] *= z01; g[1][j] *= z01; }
#pragma unroll
    for (int i = 0; i < 4; ++i) {
        float bb[8]; unpack8(R.bb[i], bb);
        float y[8]; float sq = 0.f;
#pragma unroll
        for (int j = 0; j < 8; ++j) { y[j] = bb[j] * (w0[j] * g[i][j] + w1[j] * g[i + 1][j] + w2[j] * g[i + 2][j]); sq += y[j] * y[j]; }
#pragma unroll
        for (int o = 1; o < 32; o <<= 1) sq += __shfl_xor(sq, o);
        const float rs = rsqrtf(sq * (1.f / 256.f) + EPS);
        u32x4 o4; o4.x = pk2(y[0] * rs * gm[0], y[1] * rs * gm[1]); o4.y = pk2(y[2] * rs * gm[2], y[3] * rs * gm[3]); o4.z = pk2(y[4] * rs * gm[4], y[5] * rs * gm[5]); o4.w = pk2(y[6] * rs * gm[6], y[7] * rs * gm[7]);
        *(u32x4*)(H + (size_t)(tok + i) * DMODEL + c8 * 8) = o4;
    }
}
__device__ __forceinline__ void conv3_phase(const bf16_t* P, bf16_t* H, const float* w3, const float* gn, int bx, int G, int tid) {
    constexpr int NW = NT / 4 * 32;
    const int c8 = tid & 31;
    float w0[8], w1[8], w2[8], gm[8];
#pragma unroll
    for (int j = 0; j < 8; ++j) { w0[j] = w3[c8 * 8 + j]; w1[j] = w3[256 + c8 * 8 + j]; w2[j] = w3[512 + c8 * 8 + j]; gm[j] = gn[c8 * 8 + j]; }
    C3Regs Ra, Rb;
    int w = bx * NTHREADS + tid; const int step = G * NTHREADS;
    if (w < NW) conv3_issue(P, w, Ra);
    for (; w < NW; w += 2 * step) {
        if (w + step < NW) conv3_issue(P, w + step, Rb);
        conv3_compute(H, w, Ra, w0, w1, w2, gm);
        if (w + step < NW) { if (w + 2 * step < NW) conv3_issue(P, w + 2 * step, Ra); conv3_compute(H, w + step, Rb, w0, w1, w2, gm); }
    }
}

constexpr int CF_ZOFF = 0, CF_STOFF = 94 * 1024;
__device__ __forceinline__ void cfm_issue(const bf16_t* P, int tix, int tid, u32x4 (&zr)[6]) {
    const int b = tix >> 6, t0 = (tix & 63) * 64;
#pragma unroll
    for (int k = 0; k < 6; ++k) {
        int e = tid + NTHREADS * k; e = e < 94 * 32 ? e : 94 * 32 - 1;
        const int row = e >> 5, c8 = e & 31; int t = t0 - 30 + row; t = t < 0 ? 0 : t;
        zr[k] = *(const u32x4*)(P + ((size_t)b * SEQ + t) * NIN + 768 + c8 * 8);
    }
}
__device__ __forceinline__ void cfm_stage(LAS unsigned char* lds, int tix, int tid, const u32x4 (&zr)[6]) {
    const int t0 = (tix & 63) * 64;
    LAS float* ZT = (LAS float*)(lds + CF_ZOFF);
#pragma unroll
    for (int k = 0; k < 6; ++k) {
        const int e = tid + NTHREADS * k;
        if (e < 94 * 32) {
            const int row = e >> 5, c8 = e & 31; const float zm = (t0 - 30 + row < 0) ? 0.f : 1.f;
            const u32x4 a = zr[k];
            f32x4 z0 = {bflo(a.x) * zm, bfhi(a.x) * zm, bflo(a.y) * zm, bfhi(a.y) * zm}, z1 = {bflo(a.z) * zm, bfhi(a.z) * zm, bflo(a.w) * zm, bfhi(a.w) * zm};
            *(LAS f32x4*)(ZT + row * 256 + c8 * 8) = z0; *(LAS f32x4*)(ZT + row * 256 + c8 * 8 + 4) = z1;
        }
    }
}
__device__ __forceinline__ void cfm_phase(LAS unsigned char* lds, const bf16_t* P, bf16_t* H, const float* dww, const float* dwb, const float* lng, const float* lnb, const float* gn,
                                          int bx, int G, int tid, int wid, int lane) {
    const int cp = tid & 127, rr = tid >> 7;
    f32x2v w[31];
#pragma unroll
    for (int k = 0; k < 31; ++k) w[k] = *(const f32x2v*)(dww + k * 256 + 2 * cp);
    const f32x2v bias = *(const f32x2v*)(dwb + 2 * cp), lg = *(const f32x2v*)(lng + 2 * cp), lb = *(const f32x2v*)(lnb + 2 * cp), gmm = *(const f32x2v*)(gn + 256 + 2 * cp);
    LAS float* ZT = (LAS float*)(lds + CF_ZOFF);
    LAS float* STX = (LAS float*)(lds + CF_STOFF);
    u32x4 zr[6];
    int tix = bx;
    if (tix < 1024) cfm_issue(P, tix, tid, zr);
    for (; tix < 1024; tix += G) {
        __syncthreads();
        cfm_stage(lds, tix, tid, zr);
        if (tix + G < 1024) cfm_issue(P, tix + G, tid, zr);
        __syncthreads();
        f32x2v acc[16];
#pragma unroll
        for (int j = 0; j < 16; ++j) acc[j] = bias;
#pragma unroll
        for (int s = 0; s < 46; ++s) {
            const f32x2v z = *(const LAS f32x2v*)(ZT + (rr * 16 + s) * 256 + 2 * cp);
#pragma unroll
            for (int j = 0; j < 16; ++j) { const int k = s - j; if (k >= 0 && k <= 30) acc[j] += w[k] * z; }
        }
        float s1[16], s2[16];
#pragma unroll
        for (int j = 0; j < 16; ++j) { s1[j] = wave_sum(acc[j].x + acc[j].y); s2[j] = wave_sum(acc[j].x * acc[j].x + acc[j].y * acc[j].y); }
        if (lane == 0) {
#pragma unroll
            for (int j = 0; j < 16; ++j) { STX[wid * 32 + j] = s1[j]; STX[wid * 32 + 16 + j] = s2[j]; }
        }
        __syncthreads();
        const int b = tix >> 6, t0 = (tix & 63) * 64;
        float s3[16];
#pragma unroll
        for (int j = 0; j < 16; ++j) {
            const float S1 = s1[j] + STX[(wid ^ 1) * 32 + j], S2 = s2[j] + STX[(wid ^ 1) * 32 + 16 + j];
            const float mean = S1 * (1.f / 256.f), var = fmaxf(S2 * (1.f / 256.f) - mean * mean, 0.f), rs = rsqrtf(var + EPS);
            f32x2v y = (acc[j] - mean) * rs * lg + lb;
            y.x = y.x * sigmoidf_(y.x); y.y = y.y * sigmoidf_(y.y);
            acc[j] = y;
            s3[j] = wave_sum(y.x * y.x + y.y * y.y);
        }
        if (lane == 0) {
#pragma unroll
            for (int j = 0; j < 16; ++j) STX[256 + wid * 16 + j] = s3[j];
        }
        __syncthreads();
#pragma unroll
        for (int j = 0; j < 16; ++j) {
            const float rs = rsqrtf((s3[j] + STX[256 + (wid ^ 1) * 16 + j]) * (1.f / 256.f) + EPS);
            *(unsigned*)(H + ((size_t)b * SEQ + t0 + rr * 16 + j) * DMODEL + 256 + 2 * cp) = pk2(acc[j].x * rs * gmm.x, acc[j].y * rs * gmm.y);
        }
    }
}

template <bool FULL> __device__ __forceinline__ void ssm_tile_scan(f32x16& xr, f32x16& xi, const float (&pw)[4][2], float& cr, float& ci, const bool hi) {
    const float l1r = pw[0][0], l1i = pw[0][1], l4r = pw[3][0], l4i = pw[3][1];
#pragma unroll
    for (int G = 0; G < 4; ++G)
#pragma unroll
        for (int j = 1; j < 4; ++j) { const int i = 4 * G + j; const float pr = xr[i - 1], pi = xi[i - 1]; xr[i] += l1r * pr - l1i * pi; xi[i] += l1r * pi + l1i * pr; }
    float cinr[4], cini[4];
#pragma unroll
    for (int G = 0; G < 4; ++G) {
        const float er = xr[4 * G + 3], ei = xi[4 * G + 3];
        const float orr = __shfl_xor(er, 32), oi = __shfl_xor(ei, 32);
        const float e0r = hi ? orr : er, e0i = hi ? oi : ei, e1r = hi ? er : orr, e1i = hi ? ei : oi;
        const float c1r = l4r * cr - l4i * ci + e0r, c1i = l4r * ci + l4i * cr + e0i;
        cinr[G] = hi ? c1r : cr; cini[G] = hi ? c1i : ci;
        const float c2r = l4r * c1r - l4i * c1i + e1r, c2i = l4r * c1i + l4i * c1r + e1i;
        cr = c2r; ci = c2i;
    }
    if (FULL) {
#pragma unroll
        for (int G = 0; G < 4; ++G)
#pragma unroll
            for (int j = 0; j < 4; ++j) { const int i = 4 * G + j; xr[i] += pw[j][0] * cinr[G] - pw[j][1] * cini[G]; xi[i] += pw[j][0] * cini[G] + pw[j][1] * cinr[G]; }
    }
}
constexpr int SSM_ROWB = 272;
__device__ __forceinline__ void ssm_item(LAS unsigned char* lds, const bf16_t* P, bf16_t* ZB, const float* a_re, const float* a_im, const float* log_dt, const float* b_re, const float* b_im,
                                         const float* c_re, const float* c_im, const float* d_skip, int item, int tid, int wid, int lane) {
    const int b = item >> 4, g = item & 15;
    const int r32 = lane & 31, h = lane >> 5; const bool hi = h != 0;
    LAS f32x2v* EW = (LAS f32x2v*)lds;
    LAS unsigned char* SBW = lds + 4096 + wid * (32 * SSM_ROWB);
    __syncthreads();
    float pw[2][4][2]; bf16x8 bfr[2][2];
#pragma unroll
    for (int tp = 0; tp < 2; ++tp) {
        const int p = r32 + 32 * tp;
        const float dt = __expf(log_dt[g]);
        const float ar = a_re[g * 64 + p], ai = a_im[g * 64 + p];
        const float mag = __expf(ar * dt);
        const float lr = mag * cosf(ai * dt), li = mag * sinf(ai * dt);
        const float den = ar * ar + ai * ai, nr = lr - 1.f, ni = li;
        const float fr = (nr * ar + ni * ai) / den, fi = (ni * ar - nr * ai) / den;
        const f32x4* br4 = (const f32x4*)(b_re + (size_t)(g * 64 + p) * 16 + 8 * h); const f32x4* bi4 = (const f32x4*)(b_im + (size_t)(g * 64 + p) * 16 + 8 * h);
        const f32x4 r0 = br4[0], r1 = br4[1], i0 = bi4[0], i1 = bi4[1];
        const f32x4 re0 = fr * r0 - fi * i0, re1 = fr * r1 - fi * i1, im0 = fr * i0 + fi * r0, im1 = fr * i1 + fi * r1;
        u32x4 wre, wim;
        wre.x = pk2(re0[0], re0[1]); wre.y = pk2(re0[2], re0[3]); wre.z = pk2(re1[0], re1[1]); wre.w = pk2(re1[2], re1[3]);
        wim.x = pk2(im0[0], im0[1]); wim.y = pk2(im0[2], im0[3]); wim.z = pk2(im1[0], im1[1]); wim.w = pk2(im1[2], im1[3]);
        bfr[tp][0] = __builtin_bit_cast(bf16x8, wre); bfr[tp][1] = __builtin_bit_cast(bf16x8, wim);
        pw[tp][0][0] = lr; pw[tp][0][1] = li;
#pragma unroll
        for (int j = 1; j < 4; ++j) { pw[tp][j][0] = pw[tp][j - 1][0] * lr - pw[tp][j - 1][1] * li; pw[tp][j][1] = pw[tp][j - 1][0] * li + pw[tp][j - 1][1] * lr; }
    }
    const int t16 = lane & 15, quad = lane >> 4;
    bf16x8 cfr[4];
#pragma unroll
    for (int s = 0; s < 4; ++s) {
        const f32x4 cr4 = *(const f32x4*)(c_re + (size_t)(g * 16 + t16) * 64 + 4 * quad + 16 * s), ci4 = *(const f32x4*)(c_im + (size_t)(g * 16 + t16) * 64 + 4 * quad + 16 * s);
        u32x4 w; w.x = pk2(cr4[0], -ci4[0]); w.y = pk2(cr4[1], -ci4[1]); w.z = pk2(cr4[2], -ci4[2]); w.w = pk2(cr4[3], -ci4[3]);
        cfr[s] = __builtin_bit_cast(bf16x8, w);
    }
    const f32x4 dsk = *(const f32x4*)(d_skip + g * 16 + 4 * quad);
    const size_t tok0 = (size_t)b * SEQ + (size_t)wid * 512;
    const bf16_t* ubase = P + tok0 * NIN + 1280 + g * 16;
    f32x16 zero16;
#pragma unroll
    for (int q = 0; q < 16; ++q) zero16[q] = 0.f;
    float cr[2] = {0.f, 0.f}, ci[2] = {0.f, 0.f};
    {
        bf16x8 ua = *(const bf16x8*)(ubase + (size_t)r32 * NIN + 8 * h);
        for (int mt = 0; mt < 16; ++mt) {
            const bf16x8 un = *(const bf16x8*)(ubase + (size_t)((mt < 15 ? mt + 1 : mt) * 32 + r32) * NIN + 8 * h);
#pragma unroll
            for (int tp = 0; tp < 2; ++tp) {
                f32x16 xr = __builtin_amdgcn_mfma_f32_32x32x16_bf16(ua, bfr[tp][0], zero16, 0, 0, 0);
                f32x16 xi = __builtin_amdgcn_mfma_f32_32x32x16_bf16(ua, bfr[tp][1], zero16, 0, 0, 0);
                ssm_tile_scan<false>(xr, xi, pw[tp], cr[tp], ci[tp], hi);
            }
            ua = un;
        }
    }
    if (!hi) { f32x2v e0 = {cr[0], ci[0]}, e1 = {cr[1], ci[1]}; EW[wid * 64 + r32] = e0; EW[wid * 64 + 32 + r32] = e1; }
    __syncthreads();
#pragma unroll
    for (int tp = 0; tp < 2; ++tp) {
        float qr = pw[tp][3][0], qi = pw[tp][3][1];
#pragma unroll
        for (int q = 0; q < 7; ++q) { const float nr = qr * qr - qi * qi, ni = 2.f * qr * qi; qr = nr; qi = ni; }
        float sr = 0.f, si = 0.f;
        for (int w = 0; w < wid; ++w) { const f32x2v e = EW[w * 64 + r32 + 32 * tp]; const float nr = qr * sr - qi * si + e.x, ni = qr * si + qi * sr + e.y; sr = nr; si = ni; }
        cr[tp] = sr; ci[tp] = si;
    }
    {
        bf16x8 ua = *(const bf16x8*)(ubase + (size_t)r32 * NIN + 8 * h);
        for (int mt = 0; mt < 16; ++mt) {
            const bf16x8 un = *(const bf16x8*)(ubase + (size_t)((mt < 15 ? mt + 1 : mt) * 32 + r32) * NIN + 8 * h);
            u32x2 uwv[2];
#pragma unroll
            for (int tt = 0; tt < 2; ++tt) uwv[tt] = *(const u32x2*)(P + (tok0 + mt * 32 + tt * 16 + t16) * NIN + 1280 + g * 16 + 4 * quad);
#pragma unroll
            for (int tp = 0; tp < 2; ++tp) {
                f32x16 xr = __builtin_amdgcn_mfma_f32_32x32x16_bf16(ua, bfr[tp][0], zero16, 0, 0, 0);
                f32x16 xi = __builtin_amdgcn_mfma_f32_32x32x16_bf16(ua, bfr[tp][1], zero16, 0, 0, 0);
                ssm_tile_scan<true>(xr, xi, pw[tp], cr[tp], ci[tp], hi);
#pragma unroll
                for (int i = 0; i < 16; ++i) {
                    const int t = (i & 3) + 8 * (i >> 2) + 4 * h;
                    *(LAS unsigned*)(SBW + t * SSM_ROWB + 4 * (r32 + 32 * tp)) = pk2(xr[i], xi[i]);
                }
            }
            WAVE_LDS_SYNC();
#pragma unroll
            for (int tt = 0; tt < 2; ++tt) {
                f32x4 acc = {0.f, 0.f, 0.f, 0.f};
#pragma unroll
                for (int s = 0; s < 4; ++s) {
                    const bf16x8 sf = *(const LAS bf16x8*)(SBW + (tt * 16 + t16) * SSM_ROWB + quad * 16 + 64 * s);
                    acc = __builtin_amdgcn_mfma_f32_16x16x32_bf16(cfr[s], sf, acc, 0, 0, 0);
                }
                const size_t tok = tok0 + mt * 32 + tt * 16 + t16;
                const u32x2 uw = uwv[tt];
                const f32x4 uu = {bflo(uw.x), bfhi(uw.x), bflo(uw.y), bfhi(uw.y)};
                const f32x4 y = acc + dsk * uu;
                u32x2 w; w.x = pk2(gelu_tanh(y.x), gelu_tanh(y.y)); w.y = pk2(gelu_tanh(y.z), gelu_tanh(y.w));
                *(u32x2*)(ZB + tok * 256 + g * 16 + 4 * quad) = w;
            }
            WAVE_LDS_SYNC();
            ua = un;
        }
    }
}

constexpr int AT_ROWB = 144, AT_KOFF = 0, AT_VOFF = 384 * AT_ROWB;
__device__ __forceinline__ s16x4 vtr(const LAS unsigned char* p) { return __builtin_bit_cast(s16x4, __builtin_amdgcn_ds_read_tr16_b64_v4i16((LAS s16x4*)p)); }
struct AttnU { int pat, head, d, ub; size_t rowbase; };
__device__ __forceinline__ AttnU attn_decode(int u) {
    AttnU U; const int rem = u & 1023, b = rem >> 6, ru = rem & 15; U.pat = u >> 10; U.head = (rem >> 4) & 3;
    int r;
    if (U.pat == 0) { U.d = 1; r = 0; U.ub = ru; } else if (U.pat == 1) { U.d = 4; r = ru >> 2; U.ub = ru & 3; } else { U.d = 16; r = ru; U.ub = 0; }
    U.rowbase = (size_t)b * SEQ + r; return U;
}
__device__ __forceinline__ void attn_issue(const bf16_t* P, const AttnU& U, int tid, int wid, int lane, u32x4 (&kreg)[6], u32x4 (&vreg)[6], bf16x8 (&qf)[4]) {
    const int i0 = U.ub * 256 - 128;
#pragma unroll
    for (int k = 0; k < 6; ++k) {
        const int e = tid + NTHREADS * k, row = e >> 3, c = e & 7; int si = i0 + row; si = si < 0 ? 0 : si;
        const bf16_t* src = P + (U.rowbase + (size_t)si * U.d) * NIN + U.head * 64 + c * 8;
        kreg[k] = *(const u32x4*)(src + 1792); vreg[k] = *(const u32x4*)(src + 2048);
    }
    const int r32 = lane & 31, h = lane >> 5;
    const size_t qtok = U.rowbase + (size_t)(U.ub * 256 + 32 * wid + r32) * U.d;
    const bf16_t* qp = P + qtok * NIN + 1536 + U.head * 64 + 8 * h;
#pragma unroll
    for (int s = 0; s < 4; ++s) qf[s] = *(const bf16x8*)(qp + 16 * s);
}
__device__ __forceinline__ void attn_to_lds(LAS unsigned char* lds, int tid, const u32x4 (&kreg)[6], const u32x4 (&vreg)[6]) {
#pragma unroll
    for (int k = 0; k < 6; ++k) {
        const int e = tid + NTHREADS * k, row = e >> 3, c = e & 7;
        *(LAS u32x4*)(lds + AT_KOFF + row * AT_ROWB + c * 16) = kreg[k];
        *(LAS u32x4*)(lds + AT_VOFF + row * AT_ROWB + c * 16) = vreg[k];
    }
}
__device__ __forceinline__ void attn_compute(LAS unsigned char* lds, const AttnU& U, const bf16x8 (&qf)[4], bf16_t* OB, f32x2v* ST, int wid, int lane) {
    const int pat = U.pat, head = U.head, ub = U.ub;
    const int r32 = lane & 31, h = lane >> 5;
    const size_t qtok = U.rowbase + (size_t)(ub * 256 + 32 * wid + r32) * U.d;
    f32x16 sc[5];
    float mx = -1e30f;
    const float r32f = (float)r32, h4f = (float)(4 * h);
#pragma unroll
    for (int i = 0; i < 5; ++i) {
        const bool tv = (ub > 0) || (wid + i >= 4);
        f32x16 a;
        if (tv) {
#pragma unroll
            for (int q = 0; q < 16; ++q) a[q] = 0.f;
            const LAS unsigned char* kp = lds + AT_KOFF + (32 * wid + 32 * i + r32) * AT_ROWB + 16 * h;
#pragma unroll
            for (int s = 0; s < 4; ++s) { const bf16x8 kf = *(const LAS bf16x8*)(kp + 32 * s); a = __builtin_amdgcn_mfma_f32_32x32x16_bf16(kf, qf[s], a, 0, 0, 0); }
            if (i == 0 || i == 4) {
#pragma unroll
                for (int q = 0; q < 16; ++q) {
                    const float diff = ((float)((q & 3) + 8 * (q >> 2)) + h4f) - r32f;
                    a[q] = (i == 0) ? __builtin_fmaf(fminf(diff, 0.f), 1e30f, a[q]) : __builtin_fmaf(fmaxf(diff, 0.f), -1e30f, a[q]);
                }
            }
#pragma unroll
            for (int q = 0; q < 16; ++q) mx = fmaxf(mx, a[q]);
        } else {
#pragma unroll
            for (int q = 0; q < 16; ++q) a[q] = -1e30f;
        }
        sc[i] = a;
    }
    mx = fmaxf(mx, __shfl_xor(mx, 32));
    float l = 0.f;
#pragma unroll
    for (int i = 0; i < 5; ++i)
#pragma unroll
        for (int q = 0; q < 16; ++q) { const float pv = __builtin_amdgcn_exp2f(sc[i][q] - mx); sc[i][q] = pv; l += pv; }
    l += __shfl_xor(l, 32);
    f32x16 o0, o1;
#pragma unroll
    for (int q = 0; q < 16; ++q) { o0[q] = 0.f; o1[q] = 0.f; }
    const int i16 = lane & 15, q4 = i16 >> 2, p4 = i16 & 3, blk = (lane >> 4) & 1;
#pragma unroll
    for (int i = 0; i < 5; ++i) {
        const bool tv = (ub > 0) || (wid + i >= 4);
        if (tv) {
#pragma unroll
            for (int s2 = 0; s2 < 2; ++s2) {
                u32x4 pw; pw.x = pk2(sc[i][8 * s2], sc[i][8 * s2 + 1]); pw.y = pk2(sc[i][8 * s2 + 2], sc[i][8 * s2 + 3]); pw.z = pk2(sc[i][8 * s2 + 4], sc[i][8 * s2 + 5]); pw.w = pk2(sc[i][8 * s2 + 6], sc[i][8 * s2 + 7]);
                const bf16x8 pb = __builtin_bit_cast(bf16x8, pw);
                const LAS unsigned char* vp = lds + AT_VOFF + (32 * wid + 32 * i + 16 * s2 + 4 * h + q4) * AT_ROWB + 32 * blk + 8 * p4;
                const s16x4 lo0 = vtr(vp), hi0 = vtr(vp + 8 * AT_ROWB), lo1 = vtr(vp + 64), hi1 = vtr(vp + 8 * AT_ROWB + 64);
                const bf16x8 va0 = __builtin_shufflevector(lo0, hi0, 0, 1, 2, 3, 4, 5, 6, 7), va1 = __builtin_shufflevector(lo1, hi1, 0, 1, 2, 3, 4, 5, 6, 7);
                o0 = __builtin_amdgcn_mfma_f32_32x32x16_bf16(va0, pb, o0, 0, 0, 0);
                o1 = __builtin_amdgcn_mfma_f32_32x32x16_bf16(va1, pb, o1, 0, 0, 0);
            }
        }
    }
    const float inv = 1.f / l;
    bf16_t* op = OB + ((size_t)pat * NT + qtok) * 256 + head * 64 + 4 * h;
#pragma unroll
    for (int g4 = 0; g4 < 4; ++g4) {
        u32x2 w0, w1;
        w0.x = pk2(o0[4 * g4] * inv, o0[4 * g4 + 1] * inv); w0.y = pk2(o0[4 * g4 + 2] * inv, o0[4 * g4 + 3] * inv);
        w1.x = pk2(o1[4 * g4] * inv, o1[4 * g4 + 1] * inv); w1.y = pk2(o1[4 * g4 + 2] * inv, o1[4 * g4 + 3] * inv);
        *(u32x2*)(op + 8 * g4) = w0; *(u32x2*)(op + 32 + 8 * g4) = w1;
    }
    if (h == 0) { f32x2v st = {mx, l}; ST[(qtok * 4 + head) * 3 + pat] = st; }
}

__device__ __forceinline__ void combine_rows(const bf16_t* YC, const bf16_t* OB, const f32x2v* ST, const float* gn, bf16_t* H, int gw, int ngw, int lane) {
    f32x4 gv[2];
#pragma unroll
    for (int j = 0; j < 2; ++j) gv[j] = ((const f32x4*)gn)[lane + 64 * (j + 2)];
    const int head = lane >> 4;
    for (int m0 = gw * 4; m0 < NT; m0 += ngw * 4) {
        u32x2 yw[4], a0[4], a1[4], a2[4]; f32x2v s0[4], s1[4], s2[4];
#pragma unroll
        for (int r = 0; r < 4; ++r) {
            const size_t m = (size_t)m0 + r;
            yw[r] = *((const u32x2*)(YC + m * 768 + 512) + lane);
            s0[r] = ST[(m * 4 + head) * 3 + 0]; s1[r] = ST[(m * 4 + head) * 3 + 1]; s2[r] = ST[(m * 4 + head) * 3 + 2];
            a0[r] = *((const u32x2*)(OB + m * 256) + lane); a1[r] = *((const u32x2*)(OB + ((size_t)NT + m) * 256) + lane); a2[r] = *((const u32x2*)(OB + ((size_t)2 * NT + m) * 256) + lane);
        }
#pragma unroll
        for (int r = 0; r < 4; ++r) {
            const size_t m = (size_t)m0 + r;
            f32x4 v[2];
            v[0] = (f32x4){bflo(yw[r].x), bfhi(yw[r].x), bflo(yw[r].y), bfhi(yw[r].y)};
            {
                const float M = fmaxf(s0[r].x, fmaxf(s1[r].x, s2[r].x));
                const float w0 = __builtin_amdgcn_exp2f(s0[r].x - M) * s0[r].y, w1 = __builtin_amdgcn_exp2f(s1[r].x - M) * s1[r].y, w2 = __builtin_amdgcn_exp2f(s2[r].x - M) * s2[r].y;
                const float iw = __builtin_amdgcn_rcpf(w0 + w1 + w2);
                f32x4 o;
                o.x = (w0 * bflo(a0[r].x) + w1 * bflo(a1[r].x) + w2 * bflo(a2[r].x)) * iw; o.y = (w0 * bfhi(a0[r].x) + w1 * bfhi(a1[r].x) + w2 * bfhi(a2[r].x)) * iw;
                o.z = (w0 * bflo(a0[r].y) + w1 * bflo(a1[r].y) + w2 * bflo(a2[r].y)) * iw; o.w = (w0 * bfhi(a0[r].y) + w1 * bfhi(a1[r].y) + w2 * bfhi(a2[r].y)) * iw;
                v[1] = o;
            }
#pragma unroll
            for (int j = 0; j < 2; ++j) {
                const float ss = wave_sum((v[j].x * v[j].x + v[j].y * v[j].y) + (v[j].z * v[j].z + v[j].w * v[j].w));
                const float rs = rsqrtf(ss * (1.f / 256.f) + EPS);
                u32x2 w; w.x = pk2(v[j].x * rs * gv[j].x, v[j].y * rs * gv[j].y); w.y = pk2(v[j].z * rs * gv[j].z, v[j].w * rs * gv[j].w);
                *((u32x2*)(H + m * DMODEL + 256 * (j + 2)) + lane) = w;
            }
        }
    }
}

#define XB_TMO      128
#define XB_XCNT(j)  (256  + 64 * (j))
#define XB_XSUB(j)  (1280 + 64 * (j))
#define XB_XGEN(j)  (2304 + 64 * (j))
#define XB_TOP      3328
#define XB_TOPGEN   3392
#define XCD_BAR_WORDS 3456
#define XB_SPIN_CAP (1u << 18)

__device__ __forceinline__ unsigned xb_ld(unsigned* p)              { return __hip_atomic_load(p, __ATOMIC_RELAXED, __HIP_MEMORY_SCOPE_AGENT); }
__device__ __forceinline__ unsigned xb_add(unsigned* p, unsigned v) { return __hip_atomic_fetch_add(p, v, __ATOMIC_RELAXED, __HIP_MEMORY_SCOPE_AGENT); }
__device__ __forceinline__ unsigned xb_xcc_id() { return (unsigned)__builtin_amdgcn_s_getreg((3 << 11) | 20) & 0xFu; }
#define XB_SPIN(cond, bar) do { unsigned _sp = 0; while (cond) { __builtin_amdgcn_s_sleep(1); \
    if ((++_sp & 255u) == 0u) { if (xb_ld(&(bar)[XB_TMO])) break; if (_sp > XB_SPIN_CAP) { atomicAdd(&(bar)[XB_TMO], 1u); break; } } } } while (0)

struct XcdBarrier {
    unsigned* bar; unsigned x;
    volatile LAS unsigned* st;
};

__device__ __forceinline__ XcdBarrier xcd_barrier_post(unsigned* bar, volatile LAS unsigned* st) {
    XcdBarrier b; b.bar = bar; b.x = xb_xcc_id(); b.st = st;
    if (threadIdx.x == 0) (void)xb_add(&bar[XB_XCNT(b.x)], 1u);
    return b;
}
__device__ __forceinline__ void xcd_barrier_complete(unsigned* bar, unsigned x, unsigned& nloc, unsigned& nx) {
    const unsigned G = gridDim.x * gridDim.y * gridDim.z;
    unsigned sum, cnt, mine, sp = 0u;
    for (;;) {
        sum = 0u; cnt = 0u; mine = 0u;
#pragma unroll
        for (unsigned j = 0; j < 16; ++j) { const unsigned c = xb_ld(&bar[XB_XCNT(j)]); sum += c; cnt += (c > 0u) ? 1u : 0u; mine = (j == x) ? c : mine; }
        if (sum == G) break;
        __builtin_amdgcn_s_sleep(1);
        if ((++sp & 255u) == 0u) { if (xb_ld(&bar[XB_TMO])) break; if (sp > XB_SPIN_CAP) { atomicAdd(&bar[XB_TMO], 1u); break; } }
    }
    nloc = mine > 0u ? mine : 1u; nx = cnt > 0u ? cnt : 1u;
}

__device__ __forceinline__ void xcd_barrier(const XcdBarrier& b) {
    asm volatile("s_waitcnt vmcnt(0)" ::: "memory");
    __syncthreads();
    if (threadIdx.x == 0) {
        unsigned* bar = b.bar;
        __builtin_amdgcn_s_waitcnt(0);
        unsigned nloc = b.st[0], nx = b.st[1];
        if (nloc == 0u) { xcd_barrier_complete(bar, b.x, nloc, nx); b.st[0] = nloc; b.st[1] = nx; }
        const unsigned old = xb_add(&bar[XB_XSUB(b.x)], 1u);
        const unsigned gen = old / nloc;
        if (old + 1u == (gen + 1u) * nloc) {
            __builtin_amdgcn_fence(__ATOMIC_RELEASE, "agent");
            asm volatile("s_waitcnt vmcnt(0)" ::: "memory");
            const unsigned og = xb_add(&bar[XB_TOP], 1u);
            const unsigned tg = og / nx;
            if (og + 1u == (tg + 1u) * nx) xb_add(&bar[XB_TOPGEN], 1u);
            else XB_SPIN(xb_ld(&bar[XB_TOPGEN]) == tg, bar);
            __builtin_amdgcn_fence(__ATOMIC_ACQUIRE, "agent");
            xb_add(&bar[XB_XGEN(b.x)], 1u);
            asm volatile("s_waitcnt vmcnt(0)" ::: "memory");
        } else {
            XB_SPIN(xb_ld(&bar[XB_XGEN(b.x)]) == gen, bar);
            __builtin_amdgcn_fence(__ATOMIC_ACQUIRE, "agent");
            asm volatile("s_waitcnt vmcnt(0)" ::: "memory");
        }
    }
    __syncthreads();
}

constexpr int NPHASE = 16;
struct Ctx { const Args* args; LAS unsigned char* lds; int tid, lane, wid, G, bx, gw, ngw; };
#define LAUNDER(p) asm volatile("" : "+s"(p))
__device__ __forceinline__ void phase_body(const int ph, const CAS Args* ap, LAS unsigned char* lds, const int tid, const int lane, const int wid, const int G, const int bx) {
    const int gw = bx * 8 + wid, ngw = G * 8;
    unsigned char* ws = ap->ws;
    const float* x_in = ap->in[0];
    float* X = ap->out;
    bf16_t* Hb = (bf16_t*)(ws + WS_H); bf16_t* Pb = (bf16_t*)(ws + WS_P); bf16_t* YC = (bf16_t*)(ws + WS_YC); bf16_t* ZB = (bf16_t*)(ws + WS_ZB); bf16_t* OB = (bf16_t*)(ws + WS_OB);
    f32x2v* ST = (f32x2v*)(ws + WS_ST);
    float* ropec = (float*)(ws + WS_ROPE); float* ropes = ropec + SEQ * 32;
    bf16_t* XB = (bf16_t*)(ws + WS_XB); float* SS = (float*)(ws + WS_SS);
    if (ph == 0) {
        {
            LAS float* wt = (LAS float*)(lds + wid * (64 * 65 * 4));
            for (int it = gw; it < 2 * 2976; it += ngw) { int t = 0; const WMat w = wmat_of(ap, ws, it, t); wconv_wave(wt, w, t, lane); }
        }
        for (int e = bx * NTHREADS + tid; e < SEQ * 32; e += G * NTHREADS) {
            const int pos = e >> 5, i = e & 31;
            const double inv = (double)exp2f(-(float)i * (13.287712379549449f / 32.f));
            const float angf = (float)pos * (float)inv;
            double rev = (double)angf * 0.15915494309189535; rev -= floor(rev);
            ropec[e] = __builtin_amdgcn_cosf((float)rev); ropes[e] = __builtin_amdgcn_sinf((float)rev);
        }
        xb_rows(x_in, XB, SS, gw, ngw, lane);
        return;
    }
    if (ph == 15) {
        float tscale = 1.f;
#ifdef TIMED
        { const unsigned long long* ts = (const unsigned long long*)(ws + WS_BAR) + 1800; tscale = 1.f + (float)(ts[1] - ts[0]) * 1e-5f; }
#endif
        final_rows(XB, SS + (size_t)4 * NT * 4, ap->in[23], X, gw, ngw, lane, tscale); return; }
    const int layer = (ph - 1) / 7, sub = (ph - 1) % 7;
    unsigned char* wb = ws + WS_W + (size_t)layer * W_LAYER;
    if (sub == 0) {
        pg8::Gemm g{XB, (const bf16_t*)(wb + W_IN), NT, NIN, 1024}; pg8::StaticOrder S; S.init(NT, NIN, G, bx);
        EpiIn E{Pb, ropec, ropes, RowScale{SS + (size_t)(layer == 0 ? 0 : 2) * NT * 4, (LAS float*)(lds + 131072 + 4096)}};
        pg8::gemm_phase<EpiIn, pg8::StaticOrder, true, true>(lds, g, S, E);
    } else if (sub == 1) {
        const int rot = bx % 3;
#define RUN_S do { LAUNDER(ap); for (int it = bx; it < 256; it += G) \
            ssm_item(lds, Pb, ZB, ap->in[8] + layer * 1024, ap->in[9] + layer * 1024, ap->in[10] + layer * 16, ap->in[11] + (size_t)layer * 16384, ap->in[12] + (size_t)layer * 16384, \
                     ap->in[13] + (size_t)layer * 16384, ap->in[14] + (size_t)layer * 16384, ap->in[15] + layer * 256, it, tid, wid, lane); __syncthreads(); } while (0)
#define RUN_C do { LAUNDER(ap); conv3_phase(Pb, Hb, ap->in[3] + layer * 768, ap->in[17] + layer * 1024, bx, G, tid); \
            cfm_phase(lds, Pb, Hb, ap->in[4] + layer * 31 * 256, ap->in[5] + layer * 256, ap->in[6] + layer * 256, ap->in[7] + layer * 256, ap->in[17] + layer * 1024, bx, G, tid, wid, lane); __syncthreads(); } while (0)
        if (rot == 0) RUN_S;
        if (rot <= 1) RUN_C;
        {
            const int per = (3072 + G - 1) / G, it0 = bx * per, it1 = (it0 + per < 3072) ? it0 + per : 3072;
            u32x4 kreg[6], vreg[6]; bf16x8 qn[4], qc[4];
            int it = it0;
            AttnU U = attn_decode(it < it1 ? it : 0);
            if (it < it1) attn_issue(Pb, U, tid, wid, lane, kreg, vreg, qn);
            for (; it < it1; ++it) {
                __syncthreads();
                attn_to_lds(lds, tid, kreg, vreg);
#pragma unroll
                for (int s = 0; s < 4; ++s) qc[s] = qn[s];
                __syncthreads();
                const AttnU Uc = U;
                if (it + 1 < it1) { U = attn_decode(it + 1); attn_issue(Pb, U, tid, wid, lane, kreg, vreg, qn); }
                attn_compute(lds, Uc, qc, OB, ST, wid, lane);
            }
            __syncthreads();
        }
        if (rot >= 1) RUN_S;
        if (rot == 2) RUN_C;
#undef RUN_S
#undef RUN_C
    } else if (sub == 2) {
        pg8::Gemm g{ZB, (const bf16_t*)(wb + W_GLU), NT, 512, 256}; pg8::StaticOrder S; S.init(NT, 512, G, bx);
        EpiGate<1> E{YC, 768, 512, RowScale{nullptr, nullptr}};
        pg8::gemm_phase<EpiGate<1>, pg8::StaticOrder, true, true>(lds, g, S, E);
    } else if (sub == 3) {
        combine_rows(YC, OB, ST, ap->in[17] + layer * 1024, Hb, gw, ngw, lane);
    } else if (sub == 4) {
        pg8::Gemm g{Hb, (const bf16_t*)(wb + W_OUT), NT, 1024, 1024}; pg8::StaticOrder S; S.init(NT, 1024, G, bx);
        EpiRes E{XB, SS + (size_t)(layer == 0 ? 1 : 3) * NT * 4, (LAS float*)(lds + 131072)};
        pg8::gemm_phase<EpiRes, pg8::StaticOrder, true, true>(lds, g, S, E);
    } else if (sub == 5) {
#ifdef STAGGER_GU
        { const int st = (bx >> 3) & 7; for (int q = 0; q < st; ++q) __builtin_amdgcn_s_sleep(127); }
#endif
        pg8::Gemm g{XB, (const bf16_t*)(wb + W_GU), NT, 2 * DFF, 1024}; pg8::StaticOrder S; S.init(NT, 2 * DFF, G, bx);
        EpiGate<0> E{Pb, DFF, 0, RowScale{SS + (size_t)(layer == 0 ? 1 : 3) * NT * 4, (LAS float*)(lds + 131072 + 4096)}};
        pg8::gemm_phase<EpiGate<0>, pg8::StaticOrder, true, true>(lds, g, S, E);
    } else {
        pg8::Gemm g{Pb, (const bf16_t*)(wb + W_DN), NT, 1024, DFF}; pg8::StaticOrder S; S.init(NT, 1024, G, bx);
        EpiRes E{XB, SS + (size_t)(layer == 0 ? 2 : 4) * NT * 4, (LAS float*)(lds + 131072)};
        pg8::gemm_phase<EpiRes, pg8::StaticOrder, true, true>(lds, g, S, E);
    }
}
__global__ void __launch_bounds__(NTHREADS, 2) fwd_megakernel(Args args) {
    extern __shared__ __attribute__((aligned(16))) unsigned char lds_raw[];
    LAS unsigned char* lds = (LAS unsigned char*)lds_raw;
    cg::grid_group grid = cg::this_grid();
    const int tid = threadIdx.x, lane = tid & 63, wid = __builtin_amdgcn_readfirstlane(tid >> 6);
    const int G = gridDim.x, bx = blockIdx.x;
    const int lo = args.ph_lo, hi = args.ph_hi;
    const CAS Args* ap = (const CAS Args*)__builtin_amdgcn_kernarg_segment_ptr();
    volatile LAS unsigned* bst = (volatile LAS unsigned*)(lds + LDS_BYTES - 64);
    if (tid == 0) { bst[0] = 0u; bst[1] = 0u; }
    __syncthreads();
    XcdBarrier xbar = xcd_barrier_post((unsigned*)(args.ws + WS_BAR), bst);
#define GSYNC(k) do { if ((k) == 1) grid.sync(); else xcd_barrier(xbar); } while (0)
#ifdef TIMED
#define TSTAMP(k) do { if (bx == 0 && tid == 0) { if ((k) == TIMED) ((unsigned long long*)(args.ws + WS_BAR))[1800] = __builtin_amdgcn_s_memrealtime(); \
        if ((k) == TIMED + TIMED_N) ((unsigned long long*)(args.ws + WS_BAR))[1801] = __builtin_amdgcn_s_memrealtime(); } } while (0)
#else
#define TSTAMP(k) do { } while (0)
#endif
#define PHASE(k) if (lo <= (k) && (k) < hi) { if ((k) > lo) GSYNC(k); TSTAMP(k); LAUNDER(ap); phase_body((k), ap, lds, tid, lane, wid, G, bx); }
    PHASE(0) PHASE(1) PHASE(2) PHASE(3) PHASE(4) PHASE(5) PHASE(6) PHASE(7) PHASE(8) PHASE(9)
    PHASE(10) PHASE(11) PHASE(12) PHASE(13) PHASE(14) PHASE(15)
#undef PHASE
}

extern "C" void kernel_launch(void* const* d_in, const int* in_sizes, int n_in, void* d_out, int out_size, void* d_ws, size_t ws_size, hipStream_t stream) {
    static int grid_blocks = 0;
    if (grid_blocks == 0) {
        if (n_in != 24 || ws_size < WS_END) { fprintf(stderr, "kernel_launch: unexpected n_in %d / ws_size %zu\n", n_in, ws_size); grid_blocks = -1; return; }
        int dev = 0, cus = 0, per_cu = 0;
        hipGetDevice(&dev);
        hipDeviceGetAttribute(&cus, hipDeviceAttributeMultiprocessorCount, dev);
        if (hipFuncSetAttribute((const void*)fwd_megakernel, hipFuncAttributeMaxDynamicSharedMemorySize, LDS_BYTES) != hipSuccess) { fprintf(stderr, "kernel_launch: hipFuncSetAttribute failed\n"); grid_blocks = -1; return; }
        if (hipOccupancyMaxActiveBlocksPerMultiprocessor(&per_cu, (const void*)fwd_megakernel, NTHREADS, LDS_BYTES) != hipSuccess || per_cu < 1) { fprintf(stderr, "kernel_launch: occupancy query %d\n", per_cu); per_cu = 1; }
        (void)hipGetLastError();
        grid_blocks = cus * per_cu;
    }
    if (grid_blocks < 0) return;
    Args a{};
    for (int i = 0; i < 24; ++i) a.in[i] = (const float*)d_in[i];
    a.out = (float*)d_out; a.ws = (unsigned char*)d_ws; a.ph_lo = 0; a.ph_hi = NPHASE;
    if (hipMemsetAsync((char*)d_ws + WS_BAR, 0, 16384, stream) != hipSuccess) { fprintf(stderr, "kernel_launch: memset failed\n"); return; }
    void* kargs[] = {&a};
    hipError_t e = hipLaunchCooperativeKernel((const void*)fwd_megakernel, dim3(grid_blocks), dim3(NTHREADS), kargs, LDS_BYTES, stream);
    if (e != hipSuccess) fprintf(stderr, "cooperative launch failed: %s (grid %d)\n", hipGetErrorString(e), grid_blocks);
}
```

```cpp
#include <hip/hip_runtime.h>
#include <hip/hip_cooperative_groups.h>
#include <cstdio>
#include <cstdint>
namespace cg = cooperative_groups;
namespace pg8 {
#define PG8_LAS __attribute__((address_space(3)))
typedef unsigned short bf16_t;
typedef short bf16x8 __attribute__((ext_vector_type(8)));
typedef float f32x4 __attribute__((ext_vector_type(4)));
typedef unsigned u32x4 __attribute__((ext_vector_type(4)));
constexpr int BM = 256, BK = 64, HALF = 128, HTB = HALF * BK * 2  , STAGE_BYTES = 8 * HTB, NXCD = 8, WGM = 8;

__host__ __device__ __forceinline__ int lds_byte(int r, int c) { const int st = (r >> 4) * 2 + (c >> 5), rr = r & 15, cc = c & 31, ob = rr * 64 + cc * 2; return st * 1024 + (ob ^ (((ob >> 9) & 1) << 5)); }
__host__ __device__ __forceinline__ void stage_rc(int b, int& R, int& C) { const int st = b / 1024, sb = b % 1024, swz = sb ^ (((sb >> 9) & 1) << 5); R = (st >> 1) * 16 + swz / 64; C = (st & 1) * 32 + (swz % 64) / 2; }
__host__ __device__ __forceinline__ int perm32(int rho) { const int n = rho >> 4, i = rho & 15; return 8 * (i >> 2) + 4 * n + (i & 3); }

struct Unit { int pm, pn; };
struct Gemm { const bf16_t* A; const bf16_t* Bt; int M, N, K; };

struct StaticOrder {
    int nM, nN, nwg, G, c;
    __host__ __device__ void init(int M, int N, int G_, int c_) { nM = M / BM; nN = N / BM; nwg = nM * nN; G = G_; c = c_; }
    __host__ __device__ bool next(int i, Unit& u) const {
        const long L = (long)i * G + c; if (L >= nwg) return false;
        int wgid = (int)L; { const int q = nwg / NXCD, r = nwg % NXCD, xcd = wgid % NXCD, off = wgid / NXCD; wgid = (xcd < r ? xcd * (q + 1) : r * (q + 1) + (xcd - r) * q) + off; }
        const int nig = WGM * nN, gid = wgid / nig, fm = gid * WGM, gsz = (nM - fm) < WGM ? (nM - fm) : WGM;
        u.pm = fm + ((wgid % nig) % gsz); u.pn = (wgid % nig) / gsz; return true;
    }
    __device__ __forceinline__ void a_ready(const Unit&) const {}
    __device__ __forceinline__ void done(const Unit&) const {}
};

__device__ __forceinline__ unsigned cvt_pk_bf16(float lo, float hi) { unsigned r; asm volatile("v_cvt_pk_bf16_f32 %0, %1, %2" : "=v"(r) : "v"(lo), "v"(hi)); return r; }
typedef float f32x2 __attribute__((ext_vector_type(2)));
template <class Epi, class Sched, bool ALIGN_EPI = false, bool SP2 = false>
__device__ __forceinline__ void gemm_phase(PG8_LAS unsigned char* lds, const Gemm g, const Sched& S, const Epi& E) {
    const int tid = threadIdx.x, wid = __builtin_amdgcn_readfirstlane(tid >> 6), lane = tid & 63, wr = wid >> 2, wc = wid & 3, fr = lane & 15, fq = lane >> 4;
    const int K = g.K, nt = K / BK;
    unsigned voffA[2], voffB[2];
#pragma unroll
    for (int i = 0; i < 2; ++i) { int R, C; stage_rc(tid * 16 + i * 8192, R, C); const int Rb = Epi::PERM ? ((R & ~31) + perm32(R & 31)) : R;
        voffA[i] = (unsigned)(R * K + C) * 2u; voffB[i] = (unsigned)(Rb * K + C) * 2u; }
    const size_t kstep = (size_t)(BK * 2);
    const size_t hstep = (size_t)HALF * K * 2;
    const size_t tstep = 2 * hstep;
    const unsigned ldsw = (unsigned)wid * 1024u;
    const int aoff = lds_byte(wr * 64 + fr, fq * 8), boff = lds_byte(wc * 32 + fr, fq * 8);
#define PG8_SA(b, h) (((b) * 2 + (h)) * HTB)
#define PG8_SB(b, h) ((4 + (b) * 2 + (h)) * HTB)
#define PG8_STAGE(bufoff, gbase, voff) do { _Pragma("unroll") for (int _i = 0; _i < 2; ++_i) \
        __builtin_amdgcn_global_load_lds((const unsigned*)((const char*)(gbase) + (voff)[_i]), (PG8_LAS unsigned*)(lds + (bufoff) + ldsw + _i * 8192), 16, 0, 0); } while (0)
#define PG8_LDA(dst, b, h) do { _Pragma("unroll") for (int m = 0; m < 4; ++m) _Pragma("unroll") for (int k = 0; k < 2; ++k) dst[m][k] = *(const PG8_LAS bf16x8*)(lds + PG8_SA(b, h) + aoff + m * 2048 + k * 1024); } while (0)
#define PG8_LDB(dst, b, h) do { _Pragma("unroll") for (int n = 0; n < 2; ++n) _Pragma("unroll") for (int k = 0; k < 2; ++k) dst[n][k] = *(const PG8_LAS bf16x8*)(lds + PG8_SB(b, h) + boff + n * 2048 + k * 1024); } while (0)
#define PG8_MMA(ai, bj, At, Bt) do { __builtin_amdgcn_s_setprio(1); _Pragma("unroll") for (int m = 0; m < 4; ++m) _Pragma("unroll") for (int n = 0; n < 2; ++n) _Pragma("unroll") for (int k = 0; k < 2; ++k) \
        acc[ai][bj][m][n] = __builtin_amdgcn_mfma_f32_16x16x32_bf16(Bt[n][k], At[m][k], acc[ai][bj][m][n], 0, 0, 0); __builtin_amdgcn_s_setprio(0); } while (0)
#define PG8_WAIT_V(n) asm volatile("s_waitcnt vmcnt(" #n ")" ::: "memory")
#define PG8_WAIT_L(n) asm volatile("s_waitcnt lgkmcnt(" #n ")" ::: "memory")
#define PG8_BAR __builtin_amdgcn_s_barrier()
#define PG8_SCHED __builtin_amdgcn_sched_barrier(0)
    Unit cur, nxt; int ui = 0;
    if (!S.next(0, cur)) return;
    E.prime(cur);
    f32x4 acc[2][2][4][2];
#pragma unroll
    for (int a = 0; a < 2; ++a)
#pragma unroll
        for (int b = 0; b < 2; ++b)
#pragma unroll
            for (int m = 0; m < 4; ++m)
#pragma unroll
                for (int n = 0; n < 2; ++n) acc[a][b][m][n] = (f32x4){0.f, 0.f, 0.f, 0.f};
    bf16x8 At[4][2], B0[2][2], B1[2][2];
    const char* cA = (const char*)g.A + (size_t)cur.pm * tstep; const char* cB = (const char*)g.Bt + (size_t)cur.pn * tstep;
    S.a_ready(cur);
    if constexpr (SP2) {
        PG8_STAGE(PG8_SB(0, 0), cB, voffB); PG8_STAGE(PG8_SB(0, 1), cB + hstep, voffB); PG8_STAGE(PG8_SA(0, 0), cA, voffA); PG8_STAGE(PG8_SA(0, 1), cA + hstep, voffA);
        if (wr == 1) PG8_BAR;
        PG8_WAIT_V(2); PG8_BAR;
        PG8_STAGE(PG8_SB(1, 0), cB + kstep, voffB); PG8_STAGE(PG8_SA(1, 0), cA + kstep, voffA); PG8_STAGE(PG8_SB(1, 1), cB + hstep + kstep, voffB);
        PG8_WAIT_V(6); PG8_BAR;
    } else {
        PG8_STAGE(PG8_SB(0, 0), cB, voffB); PG8_STAGE(PG8_SA(0, 0), cA, voffA); PG8_STAGE(PG8_SB(0, 1), cB + hstep, voffB); PG8_STAGE(PG8_SA(0, 1), cA + hstep, voffA);
        if (wr == 1) PG8_BAR;
        PG8_WAIT_V(4); PG8_BAR;
        PG8_STAGE(PG8_SB(1, 0), cB + kstep, voffB); PG8_STAGE(PG8_SA(1, 0), cA + kstep, voffA); PG8_STAGE(PG8_SB(1, 1), cB + hstep + kstep, voffB);
        PG8_WAIT_V(6); PG8_BAR;
    }
    for (;;) {
        const bool has_next = S.next(ui + 1, nxt);
        const char* nA = has_next ? (const char*)g.A + (size_t)nxt.pm * tstep : cA; const char* nB = has_next ? (const char*)g.Bt + (size_t)nxt.pn * tstep : cB;
#pragma nounroll
        for (int t = 0; t < nt; t += 2) {
            const bool last = (t == nt - 2);
            const char* a1 = cA + (size_t)(t + 1) * kstep;
            const char* a2 = last ? nA : cA + (size_t)(t + 2) * kstep; const char* b2 = last ? nB : cB + (size_t)(t + 2) * kstep;
            const char* a3 = a2 + kstep; const char* b3 = b2 + kstep;
            if (last && has_next) S.a_ready(nxt);
            if constexpr (SP2) {
            PG8_LDB(B0, 0, 0); PG8_LDB(B1, 0, 1); PG8_SCHED; PG8_LDA(At, 0, 0); PG8_STAGE(PG8_SA(1, 1), a1 + hstep, voffA);
            PG8_WAIT_V(8); PG8_WAIT_L(0); PG8_BAR; PG8_MMA(0, 0, At, B0); PG8_MMA(0, 1, At, B1); PG8_BAR; PG8_SCHED;
            PG8_LDA(At, 0, 1); PG8_STAGE(PG8_SB(0, 0), b2, voffB); PG8_STAGE(PG8_SB(0, 1), b2 + hstep, voffB); PG8_STAGE(PG8_SA(0, 0), a2, voffA);
            PG8_WAIT_V(8); PG8_WAIT_L(0); PG8_BAR; PG8_MMA(1, 0, At, B0); PG8_MMA(1, 1, At, B1); PG8_BAR; PG8_SCHED;
            PG8_LDB(B0, 1, 0); PG8_LDB(B1, 1, 1); PG8_SCHED; PG8_LDA(At, 1, 0); PG8_STAGE(PG8_SA(0, 1), a2 + hstep, voffA);
            PG8_WAIT_V(8); PG8_WAIT_L(0); PG8_BAR; PG8_MMA(0, 0, At, B0); PG8_MMA(0, 1, At, B1); PG8_BAR; PG8_SCHED;
            PG8_LDA(At, 1, 1); PG8_STAGE(PG8_SB(1, 0), b3, voffB); PG8_STAGE(PG8_SB(1, 1), b3 + hstep, voffB); PG8_STAGE(PG8_SA(1, 0), a3, voffA);
            PG8_WAIT_V(8); PG8_WAIT_L(0); PG8_BAR; PG8_MMA(1, 0, At, B0); PG8_MMA(1, 1, At, B1); PG8_BAR; PG8_SCHED;
            } else {
            PG8_LDB(B0, 0, 0); PG8_SCHED; PG8_LDA(At, 0, 0); PG8_STAGE(PG8_SA(1, 1), a1 + hstep, voffA);
            PG8_WAIT_L(8); PG8_BAR; PG8_WAIT_L(0); PG8_MMA(0, 0, At, B0); PG8_BAR; PG8_SCHED;
            PG8_LDB(B1, 0, 1); PG8_STAGE(PG8_SB(0, 0), b2, voffB);
            PG8_BAR; PG8_WAIT_L(0); PG8_MMA(0, 1, At, B1); PG8_BAR;
            PG8_LDA(At, 0, 1); PG8_STAGE(PG8_SA(0, 0), a2, voffA);
            PG8_BAR; PG8_WAIT_L(0); PG8_MMA(1, 0, At, B0); PG8_BAR; PG8_SCHED;
            PG8_STAGE(PG8_SB(0, 1), b2 + hstep, voffB);
            PG8_WAIT_V(6); PG8_BAR; PG8_MMA(1, 1, At, B1); PG8_BAR;
            PG8_LDB(B0, 1, 0); PG8_SCHED; PG8_LDA(At, 1, 0); PG8_STAGE(PG8_SA(0, 1), a2 + hstep, voffA);
            PG8_WAIT_L(8); PG8_BAR; PG8_WAIT_L(0); PG8_MMA(0, 0, At, B0); PG8_BAR; PG8_SCHED;
            PG8_LDB(B1, 1, 1); PG8_STAGE(PG8_SB(1, 0), b3, voffB);
            PG8_BAR; PG8_WAIT_L(0); PG8_MMA(0, 1, At, B1); PG8_BAR;
            PG8_LDA(At, 1, 1); PG8_STAGE(PG8_SA(1, 0), a3, voffA);
            PG8_BAR; PG8_WAIT_L(0); PG8_MMA(1, 0, At, B0); PG8_BAR; PG8_SCHED;
            PG8_STAGE(PG8_SB(1, 1), b3 + hstep, voffB);
            PG8_WAIT_V(6); PG8_BAR; PG8_MMA(1, 1, At, B1); PG8_BAR;
            }
        }
        if constexpr (ALIGN_EPI) { if (wr == 0) PG8_BAR; }
        if constexpr (!Epi::AFTER_DRAIN) { E(acc, cur, wr, wc, fr, fq, nxt, has_next, ui); S.done(cur); }
        if (!has_next) break;
#pragma unroll
        for (int a = 0; a < 2; ++a)
#pragma unroll
            for (int b = 0; b < 2; ++b)
#pragma unroll
                for (int m = 0; m < 4; ++m)
#pragma unroll
                    for (int n = 0; n < 2; ++n) acc[a][b][m][n] = (f32x4){0.f, 0.f, 0.f, 0.f};
        cur = nxt; cA = nA; cB = nB; ++ui;
        if constexpr (ALIGN_EPI) { if (wr == 1) PG8_BAR; }
    }
    PG8_WAIT_V(0);
    if constexpr (!ALIGN_EPI) { if (wr == 0) PG8_BAR; }
    PG8_BAR;
    if constexpr (Epi::AFTER_DRAIN) { E.fused(acc, cur, wr, wc, fr, fq, lds, wid, lane); S.done(cur); }
#undef PG8_SA
#undef PG8_SB
#undef PG8_STAGE
#undef PG8_LDA
#undef PG8_LDB
#undef PG8_MMA
#undef PG8_WAIT_V
#undef PG8_WAIT_L
#undef PG8_BAR
#undef PG8_SCHED
}
}
#ifndef REPEAT_MASK
#define REPEAT_MASK 0u
#endif
#ifndef EXTRA_SYNCS
#define EXTRA_SYNCS 0
#endif
#ifndef REP_SSM
#define REP_SSM 1
#endif
#ifndef REP_CONV
#define REP_CONV 1
#endif
#ifndef REP_ATTN
#define REP_ATTN 1
#endif

#define LAS __attribute__((address_space(3)))
typedef unsigned short bf16_t;
typedef short bf16x8 __attribute__((ext_vector_type(8)));
typedef short s16x4 __attribute__((ext_vector_type(4)));
typedef float f32x4 __attribute__((ext_vector_type(4)));
typedef float f32x16 __attribute__((ext_vector_type(16)));
typedef unsigned u32x4 __attribute__((ext_vector_type(4)));
typedef unsigned u32x2 __attribute__((ext_vector_type(2)));
typedef float f32x2v __attribute__((ext_vector_type(2)));
typedef __bf16 bf16x2v __attribute__((ext_vector_type(2)));

constexpr int NT = 65536, SEQ = 4096, DMODEL = 1024, NIN = 2304, DFF = 2816;
constexpr float EPS = 1e-6f;
constexpr float C2 = 0.125f * 1.4426950408889634f;
constexpr size_t MiB = (size_t)1 << 20;
constexpr size_t W_IN = 0, W_OUT = W_IN + (size_t)NIN * 1024 * 2, W_GU = W_OUT + (size_t)1024 * 1024 * 2, W_DN = W_GU + (size_t)2 * DFF * 1024 * 2,
                 W_GLU = W_DN + (size_t)1024 * DFF * 2, W_LAYER = 24 * MiB;
static_assert(W_GLU + 512 * 256 * 2 <= W_LAYER, "weight block");
constexpr size_t WS_W = 0, WS_ROPE = 48 * MiB, WS_H = 64 * MiB, WS_P = 192 * MiB, WS_YC = 544 * MiB, WS_ZB = 640 * MiB, WS_OB = 672 * MiB, WS_ST = 768 * MiB, WS_BAR = 776 * MiB, WS_XB = 778 * MiB, WS_SS = 906 * MiB, WS_END = 912 * MiB;
constexpr int LDS_BYTES = 147456;
constexpr int NTHREADS = 512;

#define CAS __attribute__((address_space(4)))
struct Args {
    const float* in[24];
    float* out;
    unsigned char* ws;
    int ph_lo, ph_hi;
};

__device__ __forceinline__ unsigned pk2(float lo, float hi) { f32x2v v = {lo, hi}; bf16x2v b = __builtin_convertvector(v, bf16x2v); return __builtin_bit_cast(unsigned, b); }
__device__ __forceinline__ float bflo(unsigned u) { return __uint_as_float(u << 16); }
__device__ __forceinline__ float bfhi(unsigned u) { return __uint_as_float(u & 0xffff0000u); }
template <int CTRL, int ROWMASK> __device__ __forceinline__ float dpp_add(float v) {
    return v + __builtin_bit_cast(float, __builtin_amdgcn_update_dpp(0, __builtin_bit_cast(int, v), CTRL, ROWMASK, 0xF, false));
}
__device__ __forceinline__ float wave_sum(float v) {
    v = dpp_add<0xB1, 0xF>(v);
    v = dpp_add<0x4E, 0xF>(v);
    v = dpp_add<0x141, 0xF>(v);
    v = dpp_add<0x140, 0xF>(v);
    v = dpp_add<0x142, 0xA>(v);
    v = dpp_add<0x143, 0xC>(v);
    return __builtin_bit_cast(float, __builtin_amdgcn_readlane(__builtin_bit_cast(int, v), 63));
}
__device__ __forceinline__ float sigmoidf_(float x) { return __builtin_amdgcn_rcpf(1.f + __expf(-x)); }
__device__ __forceinline__ float gelu_tanh(float y) {
    const float a = 0.7978845608028654f * (y + 0.044715f * y * y * y);
    const float t = 1.f - 2.f * __builtin_amdgcn_rcpf(__expf(2.f * a) + 1.f);
    return 0.5f * y * (1.f + t);
}
#define WAVE_LDS_SYNC() asm volatile("s_waitcnt lgkmcnt(0)" ::: "memory")

struct RowScale {
    const float* ssp; LAS float* xs;
    __device__ __forceinline__ float rs_of(int row) const { const f32x4 sp = *(const f32x4*)(ssp + (size_t)row * 4); return rsqrtf(((sp.x + sp.y) + (sp.z + sp.w)) * (1.f / DMODEL) + EPS); }
    __device__ __forceinline__ void prime(const pg8::Unit& u) const { const int t = threadIdx.x; if (t < 256) xs[t] = rs_of(u.pm * 256 + t); }
};
struct EpiIn {
    static constexpr bool PERM = true, AFTER_DRAIN = false;
    bf16_t* O; const float* ropec; const float* ropes; RowScale R;
    __device__ __forceinline__ void prime(const pg8::Unit& u) const { R.prime(u); }
    __device__ __forceinline__ void operator()(const f32x4 (&acc)[2][2][4][2], const pg8::Unit& u, int wr, int wc, int fr, int fq, const pg8::Unit& nxt, bool has_next, int ui) const {
        const int row0 = u.pm * 256 + wr * 64 + fr, t = threadIdx.x;
        f32x4 spn = {0.f, 0.f, 0.f, 0.f};
        const bool stage = has_next && t < 256 && nxt.pm != u.pm;
        if (stage) spn = *(const f32x4*)(R.ssp + (size_t)(nxt.pm * 256 + t) * 4);
        const LAS float* xsc = R.xs + (ui & 1) * 256 + wr * 64 + fr;
        if (u.pn == 0 || u.pn == 1 || u.pn == 3 || u.pn == 4) {
            const bool glu = u.pn >= 3;
            const int cbase = (glu ? 768 + 128 * (u.pn - 3) : 128 * u.pn) + wc * 32 + 8 * fq;
#pragma unroll
            for (int ai = 0; ai < 2; ++ai)
#pragma unroll
                for (int m = 0; m < 4; ++m) {
                    const float rsc = xsc[ai * 128 + m * 16];
                    float r[8];
#pragma unroll
                    for (int n = 0; n < 2; ++n)
#pragma unroll
                        for (int j = 0; j < 4; ++j) {
                            const float a = acc[ai][0][m][n][j] * rsc, b = acc[ai][1][m][n][j] * rsc;
                            r[4 * n + j] = glu ? a * sigmoidf_(b) : a * b;
                        }
                    u32x4 w; w.x = pk2(r[0], r[1]); w.y = pk2(r[2], r[3]); w.z = pk2(r[4], r[5]); w.w = pk2(r[6], r[7]);
                    *(u32x4*)(O + (size_t)(row0 + ai * 128 + m * 16) * NIN + cbase) = w;
                }
        } else if (u.pn == 6 || u.pn == 7) {
            const float sc = (u.pn == 6) ? C2 : 1.f;
            const int dimb = 16 * (wc & 1) + 4 * fq;
            float invf[4];
#pragma unroll
            for (int j = 0; j < 4; ++j) invf[j] = __builtin_amdgcn_exp2f(-(float)(dimb + j) * (13.287712379549449f / 32.f));
#pragma unroll
            for (int ai = 0; ai < 2; ++ai)
#pragma unroll
                for (int m = 0; m < 4; ++m) {
                    const int row = row0 + ai * 128 + m * 16; const int pos = row & (SEQ - 1);
                    const float rsc = xsc[ai * 128 + m * 16] * sc;
                    f32x4 cs, sn;
#pragma unroll
                    for (int j = 0; j < 4; ++j) { const float rev = __builtin_amdgcn_fractf(((float)pos * invf[j]) * 0.15915494309189535f); cs[j] = __builtin_amdgcn_cosf(rev); sn[j] = __builtin_amdgcn_sinf(rev); }
                    bf16_t* rowp = O + (size_t)row * NIN + u.pn * 256 + 64 * (wc >> 1) + dimb;
#pragma unroll
                    for (int bj = 0; bj < 2; ++bj) {
                        const f32x4 x1 = acc[ai][bj][m][0] * rsc, x2 = acc[ai][bj][m][1] * rsc;
                        const f32x4 o1 = x1 * cs - x2 * sn, o2 = x2 * cs + x1 * sn;
                        u32x2 w1, w2; w1.x = pk2(o1[0], o1[1]); w1.y = pk2(o1[2], o1[3]); w2.x = pk2(o2[0], o2[1]); w2.y = pk2(o2[2], o2[3]);
                        *(u32x2*)(rowp + bj * 128) = w1; *(u32x2*)(rowp + bj * 128 + 32) = w2;
                    }
                }
        } else {
#pragma unroll
            for (int ai = 0; ai < 2; ++ai)
#pragma unroll
                for (int m = 0; m < 4; ++m) {
                    bf16_t* rowp = O + (size_t)(row0 + ai * 128 + m * 16) * NIN + (u.pn == 2 ? 256 : u.pn * 256) + wc * 32 + 8 * fq;
                    const float rsc = xsc[ai * 128 + m * 16];
#pragma unroll
                    for (int bj = 0; bj < 2; ++bj) {
                        const f32x4 v0 = acc[ai][bj][m][0] * rsc, v1 = acc[ai][bj][m][1] * rsc;
                        u32x4 w; w.x = pk2(v0[0], v0[1]); w.y = pk2(v0[2], v0[3]); w.z = pk2(v1[0], v1[1]); w.w = pk2(v1[2], v1[3]);
                        *(u32x4*)(rowp + bj * 128) = w;
                    }
                }
        }
        if (has_next && t < 256) {
            float v = R.xs[(ui & 1) * 256 + t];
            if (nxt.pm != u.pm) v = rsqrtf(((spn.x + spn.y) + (spn.z + spn.w)) * (1.f / DMODEL) + EPS);
            R.xs[((ui + 1) & 1) * 256 + t] = v;
        }
    }
};
struct EpiRes {
    static constexpr bool PERM = true, AFTER_DRAIN = false;
    bf16_t* xb; float* ssp; LAS float* xl;
    __device__ __forceinline__ void prime(const pg8::Unit&) const {}
    __device__ __forceinline__ void operator()(const f32x4 (&acc)[2][2][4][2], const pg8::Unit& u, int wr, int wc, int fr, int fq, const pg8::Unit&, bool, int) const {
        const int row0 = u.pm * 256 + wr * 64 + fr, col0 = u.pn * 256 + wc * 32 + 8 * fq;
        u32x4 rv[2][4][2];
#pragma unroll
        for (int ai = 0; ai < 2; ++ai)
#pragma unroll
            for (int m = 0; m < 4; ++m)
#pragma unroll
                for (int bj = 0; bj < 2; ++bj) rv[ai][m][bj] = *(const u32x4*)(xb + (size_t)(row0 + ai * 128 + m * 16) * DMODEL + col0 + bj * 128);
#pragma unroll
        for (int ai = 0; ai < 2; ++ai)
#pragma unroll
            for (int m = 0; m < 4; ++m) {
                const int row = row0 + ai * 128 + m * 16;
                const size_t off = (size_t)row * DMODEL + col0;
                float sq = 0.f;
#pragma unroll
                for (int bj = 0; bj < 2; ++bj) {
                    const u32x4 r = rv[ai][m][bj];
                    const f32x4 r0 = {bflo(r.x), bfhi(r.x), bflo(r.y), bfhi(r.y)}, r1 = {bflo(r.z), bfhi(r.z), bflo(r.w), bfhi(r.w)};
                    const f32x4 x0 = r0 + acc[ai][bj][m][0], x1 = r1 + acc[ai][bj][m][1];
                    u32x4 w; w.x = pk2(x0[0], x0[1]); w.y = pk2(x0[2], x0[3]); w.z = pk2(x1[0], x1[1]); w.w = pk2(x1[2], x1[3]);
                    *(u32x4*)(xb + off + bj * 128) = w;
                    sq += (x0[0] * x0[0] + x0[1] * x0[1]) + (x0[2] * x0[2] + x0[3] * x0[3]) + (x1[0] * x1[0] + x1[1] * x1[1]) + (x1[2] * x1[2] + x1[3] * x1[3]);
                }
                sq += __shfl_xor(sq, 16); sq += __shfl_xor(sq, 32);
                if (fq == 0) xl[(wr * 64 + ai * 128 + m * 16 + fr) * 4 + wc] = sq;
            }
        asm volatile("s_waitcnt lgkmcnt(0)\n\ts_barrier" ::: "memory");
        const int t = threadIdx.x;
        if (t < 256) { const f32x4 v = *(const LAS f32x4*)(xl + t * 4); ssp[(size_t)(u.pm * 256 + t) * 4 + u.pn] = (v.x + v.y) + (v.z + v.w); }
    }
};
template <int MODE  > struct EpiGate {
    static constexpr bool PERM = true, AFTER_DRAIN = false;
    bf16_t* O; int ldc; int coff; RowScale R;
    __device__ __forceinline__ void prime(const pg8::Unit& u) const { if (MODE == 0) R.prime(u); }
    __device__ __forceinline__ void operator()(const f32x4 (&acc)[2][2][4][2], const pg8::Unit& u, int wr, int wc, int fr, int fq, const pg8::Unit& nxt, bool has_next, int ui) const {
        const int row0 = u.pm * 256 + wr * 64 + fr, col0 = coff + u.pn * 128 + wc * 32 + 8 * fq, t = threadIdx.x;
        f32x4 spn = {0.f, 0.f, 0.f, 0.f};
        if (MODE == 0) { if (has_next && t < 256 && nxt.pm != u.pm) spn = *(const f32x4*)(R.ssp + (size_t)(nxt.pm * 256 + t) * 4); }
        const LAS float* xsc = R.xs + (ui & 1) * 256 + wr * 64 + fr;
#pragma unroll
        for (int ai = 0; ai < 2; ++ai)
#pragma unroll
            for (int m = 0; m < 4; ++m) {
                float r[8];
                float rsc = 1.f; if (MODE == 0) rsc = xsc[ai * 128 + m * 16];
                const float c1 = -1.4426950408889634f * rsc, r2 = rsc * rsc;
#pragma unroll
                for (int n = 0; n < 2; ++n)
#pragma unroll
                    for (int j = 0; j < 4; ++j) {
                        const float a = acc[ai][0][m][n][j], b = acc[ai][1][m][n][j];
                        if (MODE == 0) r[4 * n + j] = (a * b) * (r2 * __builtin_amdgcn_rcpf(1.f + __builtin_amdgcn_exp2f(a * c1)));
                        else r[4 * n + j] = a * __builtin_amdgcn_rcpf(1.f + __builtin_amdgcn_exp2f(b * -1.4426950408889634f));
                    }
                u32x4 w; w.x = pk2(r[0], r[1]); w.y = pk2(r[2], r[3]); w.z = pk2(r[4], r[5]); w.w = pk2(r[6], r[7]);
                *(u32x4*)(O + (size_t)(row0 + ai * 128 + m * 16) * ldc + col0) = w;
            }
        if (MODE == 0) {
            if (has_next && t < 256) {
                float v = R.xs[(ui & 1) * 256 + t];
                if (nxt.pm != u.pm) v = rsqrtf(((spn.x + spn.y) + (spn.z + spn.w)) * (1.f / DMODEL) + EPS);
                R.xs[((ui + 1) & 1) * 256 + t] = v;
            }
        }
    }
};

struct WMat { const float* src; const float* src2; int K, N, ldw, kind; bf16_t* dst; const float* kscale; };
__device__ __forceinline__ void wconv_load(const WMat& w, int t, int tid, float (&v)[8]) {
    const int nkt = w.K / 64, jt = t / nkt, kt = t % nkt, j0 = jt * 64, k0 = kt * 64;
    const int j = j0 + (tid & 63);
    const float* s = w.src; int col = j;
    if (w.kind == 1) {
        if (j >= 1536 && j < 2048) { const int ww = j & 63; col = (j & ~63) + 32 * ((ww >> 2) & 1) + 16 * (ww >> 5) + 4 * ((ww >> 3) & 3) + (ww & 3); }
        else if (j < 1280) {
            const int pn = j >> 8, wi = j & 255, half = (pn == 0 || pn == 3) ? 0 : 128;
            if (pn == 2) col = 256 + wi;
            else if (pn < 2) col = (wi < 128 ? 0 : 512 - 128) + half + wi;
            else col = (wi < 128 ? 768 : 1024 - 128) + half + wi;
        }
    } else if (w.kind == 2) {
        const int pn = j >> 8, wi = j & 255; if (wi < 128) col = pn * 128 + wi; else { s = w.src2; col = pn * 128 + (wi - 128); }
    }
    const int kk = tid >> 6;
#pragma unroll
    for (int i = 0; i < 8; ++i) { const int k = kk + 8 * i; const float sc = w.kscale ? w.kscale[k0 + k] : 1.f; v[i] = s[(size_t)(k0 + k) * w.ldw + col] * sc; }
}
__device__ __forceinline__ void wconv_store(LAS float* tile, const WMat& w, int t, int tid, const float (&v)[8]) {
    const int nkt = w.K / 64, jt = t / nkt, kt = t % nkt, j0 = jt * 64, k0 = kt * 64;
    const int kk = tid >> 6;
#pragma unroll
    for (int i = 0; i < 8; ++i) tile[(kk + 8 * i) * 65 + (tid & 63)] = v[i];
    __syncthreads();
    {
        const int jr = tid >> 3, c = tid & 7; const LAS float* s = tile + (8 * c) * 65 + jr;
        u32x4 o; o.x = pk2(s[0], s[65]); o.y = pk2(s[2 * 65], s[3 * 65]); o.z = pk2(s[4 * 65], s[5 * 65]); o.w = pk2(s[6 * 65], s[7 * 65]);
        *(u32x4*)(w.dst + (size_t)(j0 + jr) * w.K + k0 + 8 * c) = o;
    }
    __syncthreads();
}
__device__ __forceinline__ void wconv_wave(LAS float* tile, const WMat& w, int t, int lane) {
    const int nkt = w.K / 64, jt = t / nkt, kt = t % nkt, j0 = jt * 64, k0 = kt * 64;
    const int j = j0 + lane;
    const float* s = w.src; int col = j;
    if (w.kind == 1) {
        if (j >= 1536 && j < 2048) { const int ww = j & 63; col = (j & ~63) + 32 * ((ww >> 2) & 1) + 16 * (ww >> 5) + 4 * ((ww >> 3) & 3) + (ww & 3); }
        else if (j < 1280) {
            const int pn = j >> 8, wi = j & 255, half = (pn == 0 || pn == 3) ? 0 : 128;
            if (pn == 2) col = 256 + wi;
            else if (pn < 2) col = (wi < 128 ? 0 : 512 - 128) + half + wi;
            else col = (wi < 128 ? 768 : 1024 - 128) + half + wi;
        }
    } else if (w.kind == 2) {
        const int pn = j >> 8, wi = j & 255; if (wi < 128) col = pn * 128 + wi; else { s = w.src2; col = pn * 128 + (wi - 128); }
    }
    const float* sp = s + (size_t)k0 * w.ldw + col;
#pragma unroll
    for (int hb = 0; hb < 2; ++hb) {
        float v[32];
#pragma unroll
        for (int i = 0; i < 32; ++i) v[i] = sp[(size_t)(hb * 32 + i) * w.ldw];
        if (w.kscale) {
#pragma unroll
            for (int i = 0; i < 32; ++i) v[i] *= w.kscale[k0 + hb * 32 + i];
        }
#pragma unroll
        for (int i = 0; i < 32; ++i) tile[(hb * 32 + i) * 65 + lane] = v[i];
    }
    WAVE_LDS_SYNC();
    const int c = lane & 7;
#pragma unroll
    for (int rg = 0; rg < 8; ++rg) {
        const int jr = rg * 8 + (lane >> 3); const LAS float* q = tile + (8 * c) * 65 + jr;
        u32x4 o; o.x = pk2(q[0], q[65]); o.y = pk2(q[2 * 65], q[3 * 65]); o.z = pk2(q[4 * 65], q[5 * 65]); o.w = pk2(q[6 * 65], q[7 * 65]);
        *(u32x4*)(w.dst + (size_t)(j0 + jr) * w.K + k0 + 8 * c) = o;
    }
    WAVE_LDS_SYNC();
}
__device__ __forceinline__ WMat wmat_of(const CAS Args* ap, unsigned char* ws, int it, int& t) {
    const int layer = it / 2976; t = it % 2976;
    unsigned char* wb = ws + WS_W + (size_t)layer * W_LAYER;
    if (t < 576) return WMat{ap->in[2] + (size_t)layer * 1024 * NIN, nullptr, 1024, NIN, NIN, 1, (bf16_t*)(wb + W_IN), ap->in[1] + layer * 1024};
    if ((t -= 576) < 256) return WMat{ap->in[18] + (size_t)layer * 1024 * 1024, nullptr, 1024, 1024, 1024, 0, (bf16_t*)(wb + W_OUT), nullptr};
    if ((t -= 256) < 1408) return WMat{ap->in[20] + (size_t)layer * 1024 * DFF, ap->in[21] + (size_t)layer * 1024 * DFF, 1024, 2 * DFF, DFF, 2, (bf16_t*)(wb + W_GU), ap->in[19] + layer * 1024};
    if ((t -= 1408) < 704) return WMat{ap->in[22] + (size_t)layer * DFF * 1024, nullptr, DFF, 1024, 1024, 0, (bf16_t*)(wb + W_DN), nullptr};
    t -= 704; return WMat{ap->in[16] + (size_t)layer * 256 * 512, ap->in[16] + (size_t)layer * 256 * 512 + 256, 256, 512, 512, 2, (bf16_t*)(wb + W_GLU), nullptr};
}

__device__ __forceinline__ void norm_rows_bf16(const float* X, const float* g, bf16_t* H, int gw, int ngw, int lane) {
    f32x4 gv[4];
#pragma unroll
    for (int j = 0; j < 4; ++j) gv[j] = ((const f32x4*)g)[lane + 64 * j];
    for (int m = gw; m < NT; m += ngw) {
        const f32x4* xr = (const f32x4*)(X + (size_t)m * DMODEL) + lane;
        f32x4 v[4]; float s = 0.f;
#pragma unroll
        for (int j = 0; j < 4; ++j) { v[j] = xr[64 * j]; s += (v[j].x * v[j].x + v[j].y * v[j].y) + (v[j].z * v[j].z + v[j].w * v[j].w); }
        const float rs = rsqrtf(wave_sum(s) * (1.f / DMODEL) + EPS);
        u32x2* o = (u32x2*)(H + (size_t)m * DMODEL) + lane;
#pragma unroll
        for (int j = 0; j < 4; ++j) { u32x2 w; w.x = pk2(v[j].x * rs * gv[j].x, v[j].y * rs * gv[j].y); w.y = pk2(v[j].z * rs * gv[j].z, v[j].w * rs * gv[j].w); o[64 * j] = w; }
    }
}
__device__ __forceinline__ void xb_rows(const float* X, bf16_t* XB, float* ssq, int gw, int ngw, int lane) {
    for (int m0 = gw * 2; m0 < NT; m0 += ngw * 2) {
        f32x4 v[2][4];
#pragma unroll
        for (int r = 0; r < 2; ++r) { const f32x4* xr = (const f32x4*)(X + (size_t)(m0 + r) * DMODEL) + lane;
#pragma unroll
            for (int j = 0; j < 4; ++j) v[r][j] = xr[64 * j]; }
#pragma unroll
        for (int r = 0; r < 2; ++r) {
            const size_t m = (size_t)m0 + r;
            float s = 0.f;
#pragma unroll
            for (int j = 0; j < 4; ++j) s += (v[r][j].x * v[r][j].x + v[r][j].y * v[r][j].y) + (v[r][j].z * v[r][j].z + v[r][j].w * v[r][j].w);
            s = wave_sum(s);
            u32x2* o = (u32x2*)(XB + m * DMODEL) + lane;
#pragma unroll
            for (int j = 0; j < 4; ++j) { u32x2 w; w.x = pk2(v[r][j].x, v[r][j].y); w.y = pk2(v[r][j].z, v[r][j].w); o[64 * j] = w; }
            if (lane == 0) { f32x4 o4 = {s, 0.f, 0.f, 0.f}; *(f32x4*)(ssq + m * 4) = o4; }
        }
    }
}
__device__ __forceinline__ void final_rows(const bf16_t* XB, const float* ssp, const float* g, float* OUT, int gw, int ngw, int lane, float tscale) {
    f32x4 gv[4];
#pragma unroll
    for (int j = 0; j < 4; ++j) gv[j] = ((const f32x4*)g)[lane + 64 * j];
    for (int m0 = gw * 4; m0 < NT; m0 += ngw * 4) {
        u32x2 w[4][4]; f32x4 sp[4];
#pragma unroll
        for (int r = 0; r < 4; ++r) { const size_t m = (size_t)m0 + r; sp[r] = *(const f32x4*)(ssp + m * 4); const u32x2* xr = (const u32x2*)(XB + m * DMODEL) + lane;
#pragma unroll
            for (int j = 0; j < 4; ++j) w[r][j] = xr[64 * j]; }
#pragma unroll
        for (int r = 0; r < 4; ++r) {
            const float rs = rsqrtf(((sp[r].x + sp[r].y) + (sp[r].z + sp[r].w)) * (1.f / DMODEL) + EPS) * tscale;
            f32x4* o = (f32x4*)(OUT + (size_t)(m0 + r) * DMODEL) + lane;
#pragma unroll
            for (int j = 0; j < 4; ++j) { f32x4 v = {bflo(w[r][j].x), bfhi(w[r][j].x), bflo(w[r][j].y), bfhi(w[r][j].y)}; o[64 * j] = v * rs * gv[j]; }
        }
    }
}
__device__ __forceinline__ void norm_rows_f32_inplace(float* X, const float* g, int gw, int ngw, int lane) {
    f32x4 gv[4];
#pragma unroll
    for (int j = 0; j < 4; ++j) gv[j] = ((const f32x4*)g)[lane + 64 * j];
    for (int m = gw; m < NT; m += ngw) {
        f32x4* xr = (f32x4*)(X + (size_t)m * DMODEL) + lane;
        f32x4 v[4]; float s = 0.f;
#pragma unroll
        for (int j = 0; j < 4; ++j) { v[j] = xr[64 * j]; s += (v[j].x * v[j].x + v[j].y * v[j].y) + (v[j].z * v[j].z + v[j].w * v[j].w); }
        const float rs = rsqrtf(wave_sum(s) * (1.f / DMODEL) + EPS);
#pragma unroll
        for (int j = 0; j < 4; ++j) xr[64 * j] = v[j] * rs * gv[j];
    }
}

struct C3Regs { u32x4 gg[6], bb[4]; };
__device__ __forceinline__ void conv3_issue(const bf16_t* P, int w, C3Regs& R) {
    const int c8 = w & 31, tok = (w >> 5) * 4, t = tok & (SEQ - 1);
    const bf16_t* base = P + (size_t)tok * NIN + c8 * 8;
#pragma unroll
    for (int i = 0; i < 6; ++i) { const int dt = (t == 0 && i < 2) ? 0 : i - 2; R.gg[i] = *(const u32x4*)(base + dt * NIN); }
#pragma unroll
    for (int i = 0; i < 4; ++i) R.bb[i] = *(const u32x4*)(base + i * NIN + 256);
}
__device__ __forceinline__ void unpack8(const u32x4 a, float (&o)[8]) {
    o[0] = bflo(a.x); o[1] = bfhi(a.x); o[2] = bflo(a.y); o[3] = bfhi(a.y); o[4] = bflo(a.z); o[5] = bfhi(a.z); o[6] = bflo(a.w); o[7] = bfhi(a.w);
}
__device__ __forceinline__ void conv3_compute(bf16_t* H, int w, const C3Regs& R, const float (&w0)[8], const float (&w1)[8], const float (&w2)[8], const float (&gm)[8]) {
    const int c8 = w & 31, tok = (w >> 5) * 4, t = tok & (SEQ - 1);
    const float z01 = (t == 0) ? 0.f : 1.f;
    float g[6][8];
#pragma unroll
    for (int i = 0; i < 6; ++i) unpack8(R.gg[i], g[i]);
#pragma unroll
    for (int j = 0; j < 8; ++j) { g[0][j] *= z01; g[1][j] *= z01; }
#pragma unroll
    for (int i = 0; i < 4; ++i) {
        float bb[8]; unpack8(R.bb[i], bb);
        float y[8]; float sq = 0.f;
#pragma unroll
        for (int j = 0; j < 8; ++j) { y[j] = bb[j] * (w0[j] * g[i][j] + w1[j] * g[i + 1][j] + w2[j] * g[i + 2][j]); sq += y[j] * y[j]; }
#pragma unroll
        for (int o = 1; o < 32; o <<= 1) sq += __shfl_xor(sq, o);
        const float rs = rsqrtf(sq * (1.f / 256.f) + EPS);
        u32x4 o4; o4.x = pk2(y[0] * rs * gm[0], y[1] * rs * gm[1]); o4.y = pk2(y[2] * rs * gm[2], y[3] * rs * gm[3]); o4.z = pk2(y[4] * rs * gm[4], y[5] * rs * gm[5]); o4.w = pk2(y[6] * rs * gm[6], y[7] * rs * gm[7]);
        *(u32x4*)(H + (size_t)(tok + i) * DMODEL + c8 * 8) = o4;
    }
}
__device__ __forceinline__ void conv3_phase(const bf16_t* P, bf16_t* H, const float* w3, const float* gn, int bx, int G, int tid) {
    constexpr int NW = NT / 4 * 32;
    const int c8 = tid & 31;
    float w0[8], w1[8], w2[8], gm[8];
#pragma unroll
    for (int j = 0; j < 8; ++j) { w0[j] = w3[c8 * 8 + j]; w1[j] = w3[256 + c8 * 8 + j]; w2[j] = w3[512 + c8 * 8 + j]; gm[j] = gn[c8 * 8 + j]; }
    C3Regs Ra, Rb;
    int w = bx * NTHREADS + tid; const int step = G * NTHREADS;
    if (w < NW) conv3_issue(P, w, Ra);
    for (; w < NW; w += 2 * step) {
        if (w + step < NW) conv3_issue(P, w + step, Rb);
        conv3_compute(H, w, Ra, w0, w1, w2, gm);
        if (w + step < NW) { if (w + 2 * step < NW) conv3_issue(P, w + 2 * step, Ra); conv3_compute(H, w + step, Rb, w0, w1, w2, gm); }
    }
}

constexpr int CF_ZOFF = 0, CF_STOFF = 94 * 1024;
__device__ __forceinline__ void cfm_issue(const bf16_t* P, int tix, int tid, u32x4 (&zr)[6]) {
    const int b = tix >> 6, t0 = (tix & 63) * 64;
#pragma unroll
    for (int k = 0; k < 6; ++k) {
        int e = tid + NTHREADS * k; e = e < 94 * 32 ? e : 94 * 32 - 1;
        const int row = e >> 5, c8 = e & 31; int t = t0 - 30 + row; t = t < 0 ? 0 : t;
        zr[k] = *(const u32x4*)(P + ((size_t)b * SEQ + t) * NIN + 768 + c8 * 8);
    }
}
__device__ __forceinline__ void cfm_stage(LAS unsigned char* lds, int tix, int tid, const u32x4 (&zr)[6]) {
    const int t0 = (tix & 63) * 64;
    LAS float* ZT = (LAS float*)(lds + CF_ZOFF);
#pragma unroll
    for (int k = 0; k < 6; ++k) {
        const int e = tid + NTHREADS * k;
        if (e < 94 * 32) {
            const int row = e >> 5, c8 = e & 31; const float zm = (t0 - 30 + row < 0) ? 0.f : 1.f;
            const u32x4 a = zr[k];
            f32x4 z0 = {bflo(a.x) * zm, bfhi(a.x) * zm, bflo(a.y) * zm, bfhi(a.y) * zm}, z1 = {bflo(a.z) * zm, bfhi(a.z) * zm, bflo(a.w) * zm, bfhi(a.w) * zm};
            *(LAS f32x4*)(ZT + row * 256 + c8 * 8) = z0; *(LAS f32x4*)(ZT + row * 256 + c8 * 8 + 4) = z1;
        }
    }
}
__device__ __forceinline__ void cfm_phase(LAS unsigned char* lds, const bf16_t* P, bf16_t* H, const float* dww, const float* dwb, const float* lng, const float* lnb, const float* gn,
                                          int bx, int G, int tid, int wid, int lane) {
    const int cp = tid & 127, rr = tid >> 7;
    f32x2v w[31];
#pragma unroll
    for (int k = 0; k < 31; ++k) w[k] = *(const f32x2v*)(dww + k * 256 + 2 * cp);
    const f32x2v bias = *(const f32x2v*)(dwb + 2 * cp), lg = *(const f32x2v*)(lng + 2 * cp), lb = *(const f32x2v*)(lnb + 2 * cp), gmm = *(const f32x2v*)(gn + 256 + 2 * cp);
    LAS float* ZT = (LAS float*)(lds + CF_ZOFF);
    LAS float* STX = (LAS float*)(lds + CF_STOFF);
    u32x4 zr[6];
    int tix = bx;
    if (tix < 1024) cfm_issue(P, tix, tid, zr);
    for (; tix < 1024; tix += G) {
        __syncthreads();
        cfm_stage(lds, tix, tid, zr);
        if (tix + G < 1024) cfm_issue(P, tix + G, tid, zr);
        __syncthreads();
        f32x2v acc[16];
#pragma unroll
        for (int j = 0; j < 16; ++j) acc[j] = bias;
#pragma unroll
        for (int s = 0; s < 46; ++s) {
            const f32x2v z = *(const LAS f32x2v*)(ZT + (rr * 16 + s) * 256 + 2 * cp);
#pragma unroll
            for (int j = 0; j < 16; ++j) { const int k = s - j; if (k >= 0 && k <= 30) acc[j] += w[k] * z; }
        }
        float s1[16], s2[16];
#pragma unroll
        for (int j = 0; j < 16; ++j) { s1[j] = wave_sum(acc[j].x + acc[j].y); s2[j] = wave_sum(acc[j].x * acc[j].x + acc[j].y * acc[j].y); }
        if (lane == 0) {
#pragma unroll
            for (int j = 0; j < 16; ++j) { STX[wid * 32 + j] = s1[j]; STX[wid * 32 + 16 + j] = s2[j]; }
        }
        __syncthreads();
        const int b = tix >> 6, t0 = (tix & 63) * 64;
        float s3[16];
#pragma unroll
        for (int j = 0; j < 16; ++j) {
            const float S1 = s1[j] + STX[(wid ^ 1) * 32 + j], S2 = s2[j] + STX[(wid ^ 1) * 32 + 16 + j];
            const float mean = S1 * (1.f / 256.f), var = fmaxf(S2 * (1.f / 256.f) - mean * mean, 0.f), rs = rsqrtf(var + EPS);
            f32x2v y = (acc[j] - mean) * rs * lg + lb;
            y.x = y.x * sigmoidf_(y.x); y.y = y.y * sigmoidf_(y.y);
            acc[j] = y;
            s3[j] = wave_sum(y.x * y.x + y.y * y.y);
        }
        if (lane == 0) {
#pragma unroll
            for (int j = 0; j < 16; ++j) STX[256 + wid * 16 + j] = s3[j];
        }
        __syncthreads();
#pragma unroll
        for (int j = 0; j < 16; ++j) {
            const float rs = rsqrtf((s3[j] + STX[256 + (wid ^ 1) * 16 + j]) * (1.f / 256.f) + EPS);
            *(unsigned*)(H + ((size_t)b * SEQ + t0 + rr * 16 + j) * DMODEL + 256 + 2 * cp) = pk2(acc[j].x * rs * gmm.x, acc[j].y * rs * gmm.y);
        }
    }
}

template <bool FULL> __device__ __forceinline__ void ssm_tile_scan(f32x16& xr, f32x16& xi, const float (&pw)[4][2], float& cr, float& ci, const bool hi) {
    const float l1r = pw[0][0], l1i = pw[0][1], l4r = pw[3][0], l4i = pw[3][1];
#pragma unroll
    for (int G = 0; G < 4; ++G)
#pragma unroll
        for (int j = 1; j < 4; ++j) { const int i = 4 * G + j; const float pr = xr[i - 1], pi = xi[i - 1]; xr[i] += l1r * pr - l1i * pi; xi[i] += l1r * pi + l1i * pr; }
    float cinr[4], cini[4];
#pragma unroll
    for (int G = 0; G < 4; ++G) {
        const float er = xr[4 * G + 3], ei = xi[4 * G + 3];
        const float orr = __shfl_xor(er, 32), oi = __shfl_xor(ei, 32);
        const float e0r = hi ? orr : er, e0i = hi ? oi : ei, e1r = hi ? er : orr, e1i = hi ? ei : oi;
        const float c1r = l4r * cr - l4i * ci + e0r, c1i = l4r * ci + l4i * cr + e0i;
        cinr[G] = hi ? c1r : cr; cini[G] = hi ? c1i : ci;
        const float c2r = l4r * c1r - l4i * c1i + e1r, c2i = l4r * c1i + l4i * c1r + e1i;
        cr = c2r; ci = c2i;
    }
    if (FULL) {
#pragma unroll
        for (int G = 0; G < 4; ++G)
#pragma unroll
            for (int j = 0; j < 4; ++j) { const int i = 4 * G + j; xr[i] += pw[j][0] * cinr[G] - pw[j][1] * cini[G]; xi[i] += pw[j][0] * cini[G] + pw[j][1] * cinr[G]; }
    }
}
constexpr int SSM_ROWB = 272;
__device__ __forceinline__ void ssm_item(LAS unsigned char* lds, const bf16_t* P, bf16_t* ZB, const float* a_re, const float* a_im, const float* log_dt, const float* b_re, const float* b_im,
                                         const float* c_re, const float* c_im, const float* d_skip, int item, int tid, int wid, int lane) {
    const int b = item >> 4, g = item & 15;
    const int r32 = lane & 31, h = lane >> 5; const bool hi = h != 0;
    LAS f32x2v* EW = (LAS f32x2v*)lds;
    LAS unsigned char* SBW = lds + 4096 + wid * (32 * SSM_ROWB);
    __syncthreads();
    float pw[2][4][2]; bf16x8 bfr[2][2];
#pragma unroll
    for (int tp = 0; tp < 2; ++tp) {
        const int p = r32 + 32 * tp;
        const float dt = __expf(log_dt[g]);
        const float ar = a_re[g * 64 + p], ai = a_im[g * 64 + p];
        const float mag = __expf(ar * dt);
        const float lr = mag * cosf(ai * dt), li = mag * sinf(ai * dt);
        const float den = ar * ar + ai * ai, nr = lr - 1.f, ni = li;
        const float fr = (nr * ar + ni * ai) / den, fi = (ni * ar - nr * ai) / den;
        const f32x4* br4 = (const f32x4*)(b_re + (size_t)(g * 64 + p) * 16 + 8 * h); const f32x4* bi4 = (const f32x4*)(b_im + (size_t)(g * 64 + p) * 16 + 8 * h);
        const f32x4 r0 = br4[0], r1 = br4[1], i0 = bi4[0], i1 = bi4[1];
        const f32x4 re0 = fr * r0 - fi * i0, re1 = fr * r1 - fi * i1, im0 = fr * i0 + fi * r0, im1 = fr * i1 + fi * r1;
        u32x4 wre, wim;
        wre.x = pk2(re0[0], re0[1]); wre.y = pk2(re0[2], re0[3]); wre.z = pk2(re1[0], re1[1]); wre.w = pk2(re1[2], re1[3]);
        wim.x = pk2(im0[0], im0[1]); wim.y = pk2(im0[2], im0[3]); wim.z = pk2(im1[0], im1[1]); wim.w = pk2(im1[2], im1[3]);
        bfr[tp][0] = __builtin_bit_cast(bf16x8, wre); bfr[tp][1] = __builtin_bit_cast(bf16x8, wim);
        pw[tp][0][0] = lr; pw[tp][0][1] = li;
#pragma unroll
        for (int j = 1; j < 4; ++j) { pw[tp][j][0] = pw[tp][j - 1][0] * lr - pw[tp][j - 1][1] * li; pw[tp][j][1] = pw[tp][j - 1][0] * li + pw[tp][j - 1][1] * lr; }
    }
    const int t16 = lane & 15, quad = lane >> 4;
    bf16x8 cfr[4];
#pragma unroll
    for (int s = 0; s < 4; ++s) {
        const f32x4 cr4 = *(const f32x4*)(c_re + (size_t)(g * 16 + t16) * 64 + 4 * quad + 16 * s), ci4 = *(const f32x4*)(c_im + (size_t)(g * 16 + t16) * 64 + 4 * quad + 16 * s);
        u32x4 w; w.x = pk2(cr4[0], -ci4[0]); w.y = pk2(cr4[1], -ci4[1]); w.z = pk2(cr4[2], -ci4[2]); w.w = pk2(cr4[3], -ci4[3]);
        cfr[s] = __builtin_bit_cast(bf16x8, w);
    }
    const f32x4 dsk = *(const f32x4*)(d_skip + g * 16 + 4 * quad);
    const size_t tok0 = (size_t)b * SEQ + (size_t)wid * 512;
    const bf16_t* ubase = P + tok0 * NIN + 1280 + g * 16;
    f32x16 zero16;
#pragma unroll
    for (int q = 0; q < 16; ++q) zero16[q] = 0.f;
    float cr[2] = {0.f, 0.f}, ci[2] = {0.f, 0.f};
    {
        bf16x8 ua = *(const bf16x8*)(ubase + (size_t)r32 * NIN + 8 * h);
        for (int mt = 0; mt < 16; ++mt) {
            const bf16x8 un = *(const bf16x8*)(ubase + (size_t)((mt < 15 ? mt + 1 : mt) * 32 + r32) * NIN + 8 * h);
#pragma unroll
            for (int tp = 0; tp < 2; ++tp) {
                f32x16 xr = __builtin_amdgcn_mfma_f32_32x32x16_bf16(ua, bfr[tp][0], zero16, 0, 0, 0);
                f32x16 xi = __builtin_amdgcn_mfma_f32_32x32x16_bf16(ua, bfr[tp][1], zero16, 0, 0, 0);
                ssm_tile_scan<false>(xr, xi, pw[tp], cr[tp], ci[tp], hi);
            }
            ua = un;
        }
    }
    if (!hi) { f32x2v e0 = {cr[0], ci[0]}, e1 = {cr[1], ci[1]}; EW[wid * 64 + r32] = e0; EW[wid * 64 + 32 + r32] = e1; }
    __syncthreads();
#pragma unroll
    for (int tp = 0; tp < 2; ++tp) {
        float qr = pw[tp][3][0], qi = pw[tp][3][1];
#pragma unroll
        for (int q = 0; q < 7; ++q) { const float nr = qr * qr - qi * qi, ni = 2.f * qr * qi; qr = nr; qi = ni; }
        float sr = 0.f, si = 0.f;
        for (int w = 0; w < wid; ++w) { const f32x2v e = EW[w * 64 + r32 + 32 * tp]; const float nr = qr * sr - qi * si + e.x, ni = qr * si + qi * sr + e.y; sr = nr; si = ni; }
        cr[tp] = sr; ci[tp] = si;
    }
    {
        bf16x8 ua = *(const bf16x8*)(ubase + (size_t)r32 * NIN + 8 * h);
        for (int mt = 0; mt < 16; ++mt) {
            const bf16x8 un = *(const bf16x8*)(ubase + (size_t)((mt < 15 ? mt + 1 : mt) * 32 + r32) * NIN + 8 * h);
            u32x2 uwv[2];
#pragma unroll
            for (int tt = 0; tt < 2; ++tt) uwv[tt] = *(const u32x2*)(P + (tok0 + mt * 32 + tt * 16 + t16) * NIN + 1280 + g * 16 + 4 * quad);
#pragma unroll
            for (int tp = 0; tp < 2; ++tp) {
                f32x16 xr = __builtin_amdgcn_mfma_f32_32x32x16_bf16(ua, bfr[tp][0], zero16, 0, 0, 0);
                f32x16 xi = __builtin_amdgcn_mfma_f32_32x32x16_bf16(ua, bfr[tp][1], zero16, 0, 0, 0);
                ssm_tile_scan<true>(xr, xi, pw[tp], cr[tp], ci[tp], hi);
#pragma unroll
                for (int i = 0; i < 16; ++i) {
                    const int t = (i & 3) + 8 * (i >> 2) + 4 * h;
                    *(LAS unsigned*)(SBW + t * SSM_ROWB + 4 * (r32 + 32 * tp)) = pk2(xr[i], xi[i]);
                }
            }
            WAVE_LDS_SYNC();
#pragma unroll
            for (int tt = 0; tt < 2; ++tt) {
                f32x4 acc = {0.f, 0.f, 0.f, 0.f};
#pragma unroll
                for (int s = 0; s < 4; ++s) {
                    const bf16x8 sf = *(const LAS bf16x8*)(SBW + (tt * 16 + t16) * SSM_ROWB + quad * 16 + 64 * s);
                    acc = __builtin_amdgcn_mfma_f32_16x16x32_bf16(cfr[s], sf, acc, 0, 0, 0);
                }
                const size_t tok = tok0 + mt * 32 + tt * 16 + t16;
                const u32x2 uw = uwv[tt];
                const f32x4 uu = {bflo(uw.x), bfhi(uw.x), bflo(uw.y), bfhi(uw.y)};
                const f32x4 y = acc + dsk * uu;
                u32x2 w; w.x = pk2(gelu_tanh(y.x), gelu_tanh(y.y)); w.y = pk2(gelu_tanh(y.z), gelu_tanh(y.w));
                *(u32x2*)(ZB + tok * 256 + g * 16 + 4 * quad) = w;
            }
            WAVE_LDS_SYNC();
            ua = un;
        }
    }
}

constexpr int AT_ROWB = 144, AT_KOFF = 0, AT_VOFF = 384 * AT_ROWB;
__device__ __forceinline__ s16x4 vtr(const LAS unsigned char* p) { return __builtin_bit_cast(s16x4, __builtin_amdgcn_ds_read_tr16_b64_v4i16((LAS s16x4*)p)); }
struct AttnU { int pat, head, d, ub; size_t rowbase; };
__device__ __forceinline__ AttnU attn_decode(int u) {
    AttnU U; const int rem = u & 1023, b = rem >> 6, ru = rem & 15; U.pat = u >> 10; U.head = (rem >> 4) & 3;
    int r;
    if (U.pat == 0) { U.d = 1; r = 0; U.ub = ru; } else if (U.pat == 1) { U.d = 4; r = ru >> 2; U.ub = ru & 3; } else { U.d = 16; r = ru; U.ub = 0; }
    U.rowbase = (size_t)b * SEQ + r; return U;
}
__device__ __forceinline__ void attn_issue(const bf16_t* P, const AttnU& U, int tid, int wid, int lane, u32x4 (&kreg)[6], u32x4 (&vreg)[6], bf16x8 (&qf)[4]) {
    const int i0 = U.ub * 256 - 128;
#pragma unroll
    for (int k = 0; k < 6; ++k) {
        const int e = tid + NTHREADS * k, row = e >> 3, c = e & 7; int si = i0 + row; si = si < 0 ? 0 : si;
        const bf16_t* src = P + (U.rowbase + (size_t)si * U.d) * NIN + U.head * 64 + c * 8;
        kreg[k] = *(const u32x4*)(src + 1792); vreg[k] = *(const u32x4*)(src + 2048);
    }
    const int r32 = lane & 31, h = lane >> 5;
    const size_t qtok = U.rowbase + (size_t)(U.ub * 256 + 32 * wid + r32) * U.d;
    const bf16_t* qp = P + qtok * NIN + 1536 + U.head * 64 + 8 * h;
#pragma unroll
    for (int s = 0; s < 4; ++s) qf[s] = *(const bf16x8*)(qp + 16 * s);
}
__device__ __forceinline__ void attn_to_lds(LAS unsigned char* lds, int tid, const u32x4 (&kreg)[6], const u32x4 (&vreg)[6]) {
#pragma unroll
    for (int k = 0; k < 6; ++k) {
        const int e = tid + NTHREADS * k, row = e >> 3, c = e & 7;
        *(LAS u32x4*)(lds + AT_KOFF + row * AT_ROWB + c * 16) = kreg[k];
        *(LAS u32x4*)(lds + AT_VOFF + row * AT_ROWB + c * 16) = vreg[k];
    }
}
__device__ __forceinline__ void attn_compute(LAS unsigned char* lds, const AttnU& U, const bf16x8 (&qf)[4], bf16_t* OB, f32x2v* ST, int wid, int lane) {
    const int pat = U.pat, head = U.head, ub = U.ub;
    const int r32 = lane & 31, h = lane >> 5;
    const size_t qtok = U.rowbase + (size_t)(ub * 256 + 32 * wid + r32) * U.d;
    f32x16 sc[5];
    float mx = -1e30f;
    const float r32f = (float)r32, h4f = (float)(4 * h);
#pragma unroll
    for (int i = 0; i < 5; ++i) {
        const bool tv = (ub > 0) || (wid + i >= 4);
        f32x16 a;
        if (tv) {
#pragma unroll
            for (int q = 0; q < 16; ++q) a[q] = 0.f;
            const LAS unsigned char* kp = lds + AT_KOFF + (32 * wid + 32 * i + r32) * AT_ROWB + 16 * h;
#pragma unroll
            for (int s = 0; s < 4; ++s) { const bf16x8 kf = *(const LAS bf16x8*)(kp + 32 * s); a = __builtin_amdgcn_mfma_f32_32x32x16_bf16(kf, qf[s], a, 0, 0, 0); }
            if (i == 0 || i == 4) {
#pragma unroll
                for (int q = 0; q < 16; ++q) {
                    const float diff = ((float)((q & 3) + 8 * (q >> 2)) + h4f) - r32f;
                    a[q] = (i == 0) ? __builtin_fmaf(fminf(diff, 0.f), 1e30f, a[q]) : __builtin_fmaf(fmaxf(diff, 0.f), -1e30f, a[q]);
                }
            }
#pragma unroll
            for (int q = 0; q < 16; ++q) mx = fmaxf(mx, a[q]);
        } else {
#pragma unroll
            for (int q = 0; q < 16; ++q) a[q] = -1e30f;
        }
        sc[i] = a;
    }
    mx = fmaxf(mx, __shfl_xor(mx, 32));
    float l = 0.f;
#pragma unroll
    for (int i = 0; i < 5; ++i)
#pragma unroll
        for (int q = 0; q < 16; ++q) { const float pv = __builtin_amdgcn_exp2f(sc[i][q] - mx); sc[i][q] = pv; l += pv; }
    l += __shfl_xor(l, 32);
    f32x16 o0, o1;
#pragma unroll
    for (int q = 0; q < 16; ++q) { o0[q] = 0.f; o1[q] = 0.f; }
    const int i16 = lane & 15, q4 = i16 >> 2, p4raw = i16 & 3, p4 = (p4raw == 1) ? 2 : (p4raw == 2) ? 1 : p4raw, blk = (lane >> 4) & 1;
#pragma unroll
    for (int i = 0; i < 5; ++i) {
        const bool tv = (ub > 0) || (wid + i >= 4);
        if (tv) {
#pragma unroll
            for (int s2 = 0; s2 < 2; ++s2) {
                u32x4 pw; pw.x = pk2(sc[i][8 * s2], sc[i][8 * s2 + 1]); pw.y = pk2(sc[i][8 * s2 + 2], sc[i][8 * s2 + 3]); pw.z = pk2(sc[i][8 * s2 + 4], sc[i][8 * s2 + 5]); pw.w = pk2(sc[i][8 * s2 + 6], sc[i][8 * s2 + 7]);
                const bf16x8 pb = __builtin_bit_cast(bf16x8, pw);
                const LAS unsigned char* vp = lds + AT_VOFF + (32 * wid + 32 * i + 16 * s2 + 4 * h + q4) * AT_ROWB + 32 * blk + 8 * p4;
                const s16x4 lo0 = vtr(vp), hi0 = vtr(vp + 8 * AT_ROWB), lo1 = vtr(vp + 64), hi1 = vtr(vp + 8 * AT_ROWB + 64);
                const bf16x8 va0 = __builtin_shufflevector(lo0, hi0, 0, 1, 2, 3, 4, 5, 6, 7), va1 = __builtin_shufflevector(lo1, hi1, 0, 1, 2, 3, 4, 5, 6, 7);
                o0 = __builtin_amdgcn_mfma_f32_32x32x16_bf16(va0, pb, o0, 0, 0, 0);
                o1 = __builtin_amdgcn_mfma_f32_32x32x16_bf16(va1, pb, o1, 0, 0, 0);
            }
        }
    }
    const float inv = __builtin_amdgcn_rcpf(l);
    bf16_t* op = OB + ((size_t)pat * NT + qtok) * 256 + head * 64 + 8 * h;
#pragma unroll
    for (int g = 0; g < 2; ++g) {
        u32x4 w0, w1;
        w0.x = pk2(o0[8 * g] * inv, o0[8 * g + 1] * inv); w0.y = pk2(o0[8 * g + 2] * inv, o0[8 * g + 3] * inv); w0.z = pk2(o0[8 * g + 4] * inv, o0[8 * g + 5] * inv); w0.w = pk2(o0[8 * g + 6] * inv, o0[8 * g + 7] * inv);
        w1.x = pk2(o1[8 * g] * inv, o1[8 * g + 1] * inv); w1.y = pk2(o1[8 * g + 2] * inv, o1[8 * g + 3] * inv); w1.z = pk2(o1[8 * g + 4] * inv, o1[8 * g + 5] * inv); w1.w = pk2(o1[8 * g + 6] * inv, o1[8 * g + 7] * inv);
        *(u32x4*)(op + 16 * g) = w0; *(u32x4*)(op + 32 + 16 * g) = w1;
    }
    if (h == 0) { f32x2v st = {mx, l}; ST[(qtok * 4 + head) * 3 + pat] = st; }
}

__device__ __forceinline__ void combine_rows(const bf16_t* YC, const bf16_t* OB, const f32x2v* ST, const float* gn, bf16_t* H, int gw, int ngw, int lane) {
    f32x4 gv[2];
#pragma unroll
    for (int j = 0; j < 2; ++j) gv[j] = ((const f32x4*)gn)[lane + 64 * (j + 2)];
    const int head = lane >> 4;
    for (int m0 = gw * 4; m0 < NT; m0 += ngw * 4) {
        u32x2 yw[4], a0[4], a1[4], a2[4]; f32x2v s0[4], s1[4], s2[4];
#pragma unroll
        for (int r = 0; r < 4; ++r) {
            const size_t m = (size_t)m0 + r;
            yw[r] = *((const u32x2*)(YC + m * 768 + 512) + lane);
            s0[r] = ST[(m * 4 + head) * 3 + 0]; s1[r] = ST[(m * 4 + head) * 3 + 1]; s2[r] = ST[(m * 4 + head) * 3 + 2];
            a0[r] = *((const u32x2*)(OB + m * 256) + lane); a1[r] = *((const u32x2*)(OB + ((size_t)NT + m) * 256) + lane); a2[r] = *((const u32x2*)(OB + ((size_t)2 * NT + m) * 256) + lane);
        }
#pragma unroll
        for (int r = 0; r < 4; ++r) {
            const size_t m = (size_t)m0 + r;
            f32x4 v[2];
            v[0] = (f32x4){bflo(yw[r].x), bfhi(yw[r].x), bflo(yw[r].y), bfhi(yw[r].y)};
            {
                const float M = fmaxf(s0[r].x, fmaxf(s1[r].x, s2[r].x));
                const float w0 = __builtin_amdgcn_exp2f(s0[r].x - M) * s0[r].y, w1 = __builtin_amdgcn_exp2f(s1[r].x - M) * s1[r].y, w2 = __builtin_amdgcn_exp2f(s2[r].x - M) * s2[r].y;
                const float iw = __builtin_amdgcn_rcpf(w0 + w1 + w2);
                f32x4 o;
                o.x = (w0 * bflo(a0[r].x) + w1 * bflo(a1[r].x) + w2 * bflo(a2[r].x)) * iw; o.y = (w0 * bfhi(a0[r].x) + w1 * bfhi(a1[r].x) + w2 * bfhi(a2[r].x)) * iw;
                o.z = (w0 * bflo(a0[r].y) + w1 * bflo(a1[r].y) + w2 * bflo(a2[r].y)) * iw; o.w = (w0 * bfhi(a0[r].y) + w1 * bfhi(a1[r].y) + w2 * bfhi(a2[r].y)) * iw;
                v[1] = o;
            }
#pragma unroll
            for (int j = 0; j < 2; ++j) {
                const float ss = wave_sum((v[j].x * v[j].x + v[j].y * v[j].y) + (v[j].z * v[j].z + v[j].w * v[j].w));
                const float rs = rsqrtf(ss * (1.f / 256.f) + EPS);
                u32x2 w; w.x = pk2(v[j].x * rs * gv[j].x, v[j].y * rs * gv[j].y); w.y = pk2(v[j].z * rs * gv[j].z, v[j].w * rs * gv[j].w);
                *((u32x2*)(H + m * DMODEL + 256 * (j + 2)) + lane) = w;
            }
        }
    }
}

#define XB_TMO      128
#define XB_XCNT(j)  (256  + 64 * (j))
#define XB_XSUB(j)  (1280 + 64 * (j))
#define XB_XGEN(j)  (2304 + 64 * (j))
#define XB_TOP      3328
#define XB_TOPGEN   3392
#define XCD_BAR_WORDS 3456
#define XB_SPIN_CAP (1u << 18)

__device__ __forceinline__ unsigned xb_ld(unsigned* p)              { return __hip_atomic_load(p, __ATOMIC_RELAXED, __HIP_MEMORY_SCOPE_AGENT); }
__device__ __forceinline__ unsigned xb_add(unsigned* p, unsigned v) { return __hip_atomic_fetch_add(p, v, __ATOMIC_RELAXED, __HIP_MEMORY_SCOPE_AGENT); }
__device__ __forceinline__ unsigned xb_xcc_id() { return (unsigned)__builtin_amdgcn_s_getreg((3 << 11) | 20) & 0xFu; }
#define XB_SPIN(cond, bar) do { unsigned _sp = 0; while (cond) { __builtin_amdgcn_s_sleep(1); \
    if ((++_sp & 255u) == 0u) { if (xb_ld(&(bar)[XB_TMO])) break; if (_sp > XB_SPIN_CAP) { atomicAdd(&(bar)[XB_TMO], 1u); break; } } } } while (0)

struct XcdBarrier {
    unsigned* bar; unsigned x;
    volatile LAS unsigned* st;
};

__device__ __forceinline__ XcdBarrier xcd_barrier_post(unsigned* bar, volatile LAS unsigned* st) {
    XcdBarrier b; b.bar = bar; b.x = xb_xcc_id(); b.st = st;
    if (threadIdx.x == 0) (void)xb_add(&bar[XB_XCNT(b.x)], 1u);
    return b;
}
__device__ __forceinline__ void xcd_barrier_complete(unsigned* bar, unsigned x, unsigned& nloc, unsigned& nx) {
    const unsigned G = gridDim.x * gridDim.y * gridDim.z;
    unsigned sum, cnt, mine, sp = 0u;
    for (;;) {
        sum = 0u; cnt = 0u; mine = 0u;
#pragma unroll
        for (unsigned j = 0; j < 16; ++j) { const unsigned c = xb_ld(&bar[XB_XCNT(j)]); sum += c; cnt += (c > 0u) ? 1u : 0u; mine = (j == x) ? c : mine; }
        if (sum == G) break;
        __builtin_amdgcn_s_sleep(1);
        if ((++sp & 255u) == 0u) { if (xb_ld(&bar[XB_TMO])) break; if (sp > XB_SPIN_CAP) { atomicAdd(&bar[XB_TMO], 1u); break; } }
    }
    nloc = mine > 0u ? mine : 1u; nx = cnt > 0u ? cnt : 1u;
}

__device__ __forceinline__ void xcd_barrier(const XcdBarrier& b) {
    asm volatile("s_waitcnt vmcnt(0)" ::: "memory");
    __syncthreads();
    if (threadIdx.x == 0) {
        unsigned* bar = b.bar;
        __builtin_amdgcn_s_waitcnt(0);
        unsigned nloc = b.st[0], nx = b.st[1];
        if (nloc == 0u) { xcd_barrier_complete(bar, b.x, nloc, nx); b.st[0] = nloc; b.st[1] = nx; }
        const unsigned old = xb_add(&bar[XB_XSUB(b.x)], 1u);
        const unsigned gen = old / nloc;
        if (old + 1u == (gen + 1u) * nloc) {
            __builtin_amdgcn_fence(__ATOMIC_RELEASE, "agent");
            asm volatile("s_waitcnt vmcnt(0)" ::: "memory");
            const unsigned og = xb_add(&bar[XB_TOP], 1u);
            const unsigned tg = og / nx;
            if (og + 1u == (tg + 1u) * nx) xb_add(&bar[XB_TOPGEN], 1u);
            else XB_SPIN(xb_ld(&bar[XB_TOPGEN]) == tg, bar);
            __builtin_amdgcn_fence(__ATOMIC_ACQUIRE, "agent");
            xb_add(&bar[XB_XGEN(b.x)], 1u);
            asm volatile("s_waitcnt vmcnt(0)" ::: "memory");
        } else {
            XB_SPIN(xb_ld(&bar[XB_XGEN(b.x)]) == gen, bar);
            __builtin_amdgcn_fence(__ATOMIC_ACQUIRE, "agent");
            asm volatile("s_waitcnt vmcnt(0)" ::: "memory");
        }
    }
    __syncthreads();
}

constexpr int NPHASE = 16;
struct Ctx { const Args* args; LAS unsigned char* lds; int tid, lane, wid, G, bx, gw, ngw; };
#define LAUNDER(p) asm volatile("" : "+s"(p))
__device__ __forceinline__ void phase_body(const int ph, const CAS Args* ap, LAS unsigned char* lds, const int tid, const int lane, const int wid, const int G, const int bx) {
    const int gw = bx * 8 + wid, ngw = G * 8;
    unsigned char* ws = ap->ws;
    const float* x_in = ap->in[0];
    float* X = ap->out;
    bf16_t* Hb = (bf16_t*)(ws + WS_H); bf16_t* Pb = (bf16_t*)(ws + WS_P); bf16_t* YC = (bf16_t*)(ws + WS_YC); bf16_t* ZB = (bf16_t*)(ws + WS_ZB); bf16_t* OB = (bf16_t*)(ws + WS_OB);
    f32x2v* ST = (f32x2v*)(ws + WS_ST);
    float* ropec = (float*)(ws + WS_ROPE); float* ropes = ropec + SEQ * 32;
    bf16_t* XB = (bf16_t*)(ws + WS_XB); float* SS = (float*)(ws + WS_SS);
    if (ph == 0) {
        {
            LAS float* wt = (LAS float*)(lds + wid * (64 * 65 * 4));
            for (int it = gw; it < 2 * 2976; it += ngw) { int t = 0; const WMat w = wmat_of(ap, ws, it, t); wconv_wave(wt, w, t, lane); }
        }
        for (int e = bx * NTHREADS + tid; e < SEQ * 32; e += G * NTHREADS) {
            const int pos = e >> 5, i = e & 31;
            const double inv = (double)exp2f(-(float)i * (13.287712379549449f / 32.f));
            const float angf = (float)pos * (float)inv;
            double rev = (double)angf * 0.15915494309189535; rev -= floor(rev);
            ropec[e] = __builtin_amdgcn_cosf((float)rev); ropes[e] = __builtin_amdgcn_sinf((float)rev);
        }
        xb_rows(x_in, XB, SS, gw, ngw, lane);
        return;
    }
    if (ph == 15) {
        float tscale = 1.f;
#ifdef TIMED
        { const unsigned long long* ts = (const unsigned long long*)(ws + WS_BAR) + 1800; tscale = 1.f + (float)(ts[1] - ts[0]) * 1e-5f; }
#endif
        final_rows(XB, SS + (size_t)4 * NT * 4, ap->in[23], X, gw, ngw, lane, tscale); return; }
    const int layer = (ph - 1) / 7, sub = (ph - 1) % 7;
    unsigned char* wb = ws + WS_W + (size_t)layer * W_LAYER;
    if (sub == 0) {
        pg8::Gemm g{XB, (const bf16_t*)(wb + W_IN), NT, NIN, 1024}; pg8::StaticOrder S; S.init(NT, NIN, G, bx);
        EpiIn E{Pb, ropec, ropes, RowScale{SS + (size_t)(layer == 0 ? 0 : 2) * NT * 4, (LAS float*)(lds + 131072 + 4096)}};
        pg8::gemm_phase<EpiIn, pg8::StaticOrder, true, true>(lds, g, S, E);
    } else if (sub == 1) {
        const int rot = bx % 3;
#define RUN_S do { LAUNDER(ap); for (int it = bx; it < 256; it += G) \
            ssm_item(lds, Pb, ZB, ap->in[8] + layer * 1024, ap->in[9] + layer * 1024, ap->in[10] + layer * 16, ap->in[11] + (size_t)layer * 16384, ap->in[12] + (size_t)layer * 16384, \
                     ap->in[13] + (size_t)layer * 16384, ap->in[14] + (size_t)layer * 16384, ap->in[15] + layer * 256, it, tid, wid, lane); __syncthreads(); } while (0)
#define RUN_C do { LAUNDER(ap); conv3_phase(Pb, Hb, ap->in[3] + layer * 768, ap->in[17] + layer * 1024, bx, G, tid); \
            cfm_phase(lds, Pb, Hb, ap->in[4] + layer * 31 * 256, ap->in[5] + layer * 256, ap->in[6] + layer * 256, ap->in[7] + layer * 256, ap->in[17] + layer * 1024, bx, G, tid, wid, lane); __syncthreads(); } while (0)
        if (rot == 0) RUN_S;
        if (rot <= 1) RUN_C;
        {
            const int per = (3072 + G - 1) / G, it0 = bx * per, it1 = (it0 + per < 3072) ? it0 + per : 3072;
            u32x4 kreg[6], vreg[6]; bf16x8 qn[4], qc[4];
            int it = it0;
            AttnU U = attn_decode(it < it1 ? it : 0);
            if (it < it1) attn_issue(Pb, U, tid, wid, lane, kreg, vreg, qn);
            for (; it < it1; ++it) {
                __syncthreads();
                attn_to_lds(lds, tid, kreg, vreg);
#pragma unroll
                for (int s = 0; s < 4; ++s) qc[s] = qn[s];
                __syncthreads();
                const AttnU Uc = U;
                if (it + 1 < it1) { U = attn_decode(it + 1); attn_issue(Pb, U, tid, wid, lane, kreg, vreg, qn); }
                attn_compute(lds, Uc, qc, OB, ST, wid, lane);
            }
            __syncthreads();
        }
        if (rot >= 1) RUN_S;
        if (rot == 2) RUN_C;
#undef RUN_S
#undef RUN_C
    } else if (sub == 2) {
        pg8::Gemm g{ZB, (const bf16_t*)(wb + W_GLU), NT, 512, 256}; pg8::StaticOrder S; S.init(NT, 512, G, bx);
        EpiGate<1> E{YC, 768, 512, RowScale{nullptr, nullptr}};
        pg8::gemm_phase<EpiGate<1>, pg8::StaticOrder, true, true>(lds, g, S, E);
    } else if (sub == 3) {
        combine_rows(YC, OB, ST, ap->in[17] + layer * 1024, Hb, gw, ngw, lane);
    } else if (sub == 4) {
        pg8::Gemm g{Hb, (const bf16_t*)(wb + W_OUT), NT, 1024, 1024}; pg8::StaticOrder S; S.init(NT, 1024, G, bx);
        EpiRes E{XB, SS + (size_t)(layer == 0 ? 1 : 3) * NT * 4, (LAS float*)(lds + 131072)};
        pg8::gemm_phase<EpiRes, pg8::StaticOrder, true, true>(lds, g, S, E);
    } else if (sub == 5) {
#ifdef STAGGER_GU
        { const int st = (bx >> 3) & 7; for (int q = 0; q < st; ++q) __builtin_amdgcn_s_sleep(127); }
#endif
        pg8::Gemm g{XB, (const bf16_t*)(wb + W_GU), NT, 2 * DFF, 1024}; pg8::StaticOrder S; S.init(NT, 2 * DFF, G, bx);
        EpiGate<0> E{Pb, DFF, 0, RowScale{SS + (size_t)(layer == 0 ? 1 : 3) * NT * 4, (LAS float*)(lds + 131072 + 4096)}};
        pg8::gemm_phase<EpiGate<0>, pg8::StaticOrder, true, true>(lds, g, S, E);
    } else {
        pg8::Gemm g{Pb, (const bf16_t*)(wb + W_DN), NT, 1024, DFF}; pg8::StaticOrder S; S.init(NT, 1024, G, bx);
        EpiRes E{XB, SS + (size_t)(layer == 0 ? 2 : 4) * NT * 4, (LAS float*)(lds + 131072)};
        pg8::gemm_phase<EpiRes, pg8::StaticOrder, true, true>(lds, g, S, E);
    }
}
__global__ void __launch_bounds__(NTHREADS, 2) fwd_megakernel(Args args) {
    extern __shared__ __attribute__((aligned(16))) unsigned char lds_raw[];
    LAS unsigned char* lds = (LAS unsigned char*)lds_raw;
    cg::grid_group grid = cg::this_grid();
    const int tid = threadIdx.x, lane = tid & 63, wid = __builtin_amdgcn_readfirstlane(tid >> 6);
    const int G = gridDim.x, bx = blockIdx.x;
    const int lo = args.ph_lo, hi = args.ph_hi;
    const CAS Args* ap = (const CAS Args*)__builtin_amdgcn_kernarg_segment_ptr();
    volatile LAS unsigned* bst = (volatile LAS unsigned*)(lds + LDS_BYTES - 64);
    if (tid == 0) { bst[0] = 0u; bst[1] = 0u; }
    __syncthreads();
    XcdBarrier xbar = xcd_barrier_post((unsigned*)(args.ws + WS_BAR), bst);
#define GSYNC(k) do { if ((k) == 1) grid.sync(); else xcd_barrier(xbar); } while (0)
#ifdef TIMED
#define TSTAMP(k) do { if (bx == 0 && tid == 0) { if ((k) == TIMED) ((unsigned long long*)(args.ws + WS_BAR))[1800] = __builtin_amdgcn_s_memrealtime(); \
        if ((k) == TIMED + TIMED_N) ((unsigned long long*)(args.ws + WS_BAR))[1801] = __builtin_amdgcn_s_memrealtime(); } } while (0)
#else
#define TSTAMP(k) do { } while (0)
#endif
#define PHASE(k) if (lo <= (k) && (k) < hi) { if ((k) > lo) GSYNC(k); TSTAMP(k); LAUNDER(ap); phase_body((k), ap, lds, tid, lane, wid, G, bx); }
    PHASE(0) PHASE(1) PHASE(2) PHASE(3) PHASE(4) PHASE(5) PHASE(6) PHASE(7) PHASE(8) PHASE(9)
    PHASE(10) PHASE(11) PHASE(12) PHASE(13) PHASE(14) PHASE(15)
#undef PHASE
}

extern "C" void kernel_launch(void* const* d_in, const int* in_sizes, int n_in, void* d_out, int out_size, void* d_ws, size_t ws_size, hipStream_t stream) {
    static int grid_blocks = 0;
    if (grid_blocks == 0) {
        if (n_in != 24 || ws_size < WS_END) { fprintf(stderr, "kernel_launch: unexpected n_in %d / ws_size %zu\n", n_in, ws_size); grid_blocks = -1; return; }
        int dev = 0, cus = 0, per_cu = 0;
        hipGetDevice(&dev);
        hipDeviceGetAttribute(&cus, hipDeviceAttributeMultiprocessorCount, dev);
        if (hipFuncSetAttribute((const void*)fwd_megakernel, hipFuncAttributeMaxDynamicSharedMemorySize, LDS_BYTES) != hipSuccess) { fprintf(stderr, "kernel_launch: hipFuncSetAttribute failed\n"); grid_blocks = -1; return; }
        if (hipOccupancyMaxActiveBlocksPerMultiprocessor(&per_cu, (const void*)fwd_megakernel, NTHREADS, LDS_BYTES) != hipSuccess || per_cu < 1) { fprintf(stderr, "kernel_launch: occupancy query %d\n", per_cu); per_cu = 1; }
        (void)hipGetLastError();
        grid_blocks = cus * per_cu;
    }
    if (grid_blocks < 0) return;
    Args a{};
    for (int i = 0; i < 24; ++i) a.in[i] = (const float*)d_in[i];
    a.out = (float*)d_out; a.ws = (unsigned char*)d_ws; a.ph_lo = 0; a.ph_hi = NPHASE;
    if (hipMemsetAsync((char*)d_ws + WS_BAR, 0, 16384, stream) != hipSuccess) { fprintf(stderr, "kernel_launch: memset failed\n"); return; }
    void* kargs[] = {&a};
    hipError_t e = hipLaunchCooperativeKernel((const void*)fwd_megakernel, dim3(grid_blocks), dim3(NTHREADS), kargs, LDS_BYTES, stream);
    if (e != hipSuccess) fprintf(stderr, "cooperative launch failed: %s (grid %d)\n", hipGetErrorString(e), grid_blocks);
}
```

```cpp
#include <hip/hip_runtime.h>
#include <hip/hip_cooperative_groups.h>
#include <cstdio>
#include <cstdint>
namespace cg = cooperative_groups;
namespace pg8 {
#define PG8_LAS __attribute__((address_space(3)))
typedef unsigned short bf16_t;
typedef short bf16x8 __attribute__((ext_vector_type(8)));
typedef float f32x4 __attribute__((ext_vector_type(4)));
typedef unsigned u32x4 __attribute__((ext_vector_type(4)));
constexpr int BM = 256, BK = 64, HALF = 128, HTB = HALF * BK * 2  , STAGE_BYTES = 8 * HTB, NXCD = 8, WGM = 8;

__host__ __device__ __forceinline__ int lds_byte(int r, int c) { const int st = (r >> 4) * 2 + (c >> 5), rr = r & 15, cc = c & 31, ob = rr * 64 + cc * 2; return st * 1024 + (ob ^ (((ob >> 9) & 1) << 5)); }
__host__ __device__ __forceinline__ void stage_rc(int b, int& R, int& C) { const int st = b / 1024, sb = b % 1024, swz = sb ^ (((sb >> 9) & 1) << 5); R = (st >> 1) * 16 + swz / 64; C = (st & 1) * 32 + (swz % 64) / 2; }
__host__ __device__ __forceinline__ int perm32(int rho) { const int n = rho >> 4, i = rho & 15; return 8 * (i >> 2) + 4 * n + (i & 3); }

struct Unit { int pm, pn; };
struct Gemm { const bf16_t* A; const bf16_t* Bt; int M, N, K; };

struct StaticOrder {
    int nM, nN, nwg, G, c;
    __host__ __device__ void init(int M, int N, int G_, int c_) { nM = M / BM; nN = N / BM; nwg = nM * nN; G = G_; c = c_; }
    __host__ __device__ bool next(int i, Unit& u) const {
        const long L = (long)i * G + c; if (L >= nwg) return false;
        int wgid = (int)L; { const int q = nwg / NXCD, r = nwg % NXCD, xcd = wgid % NXCD, off = wgid / NXCD; wgid = (xcd < r ? xcd * (q + 1) : r * (q + 1) + (xcd - r) * q) + off; }
        const int nig = WGM * nN, gid = wgid / nig, fm = gid * WGM, gsz = (nM - fm) < WGM ? (nM - fm) : WGM;
        u.pm = fm + ((wgid % nig) % gsz); u.pn = (wgid % nig) / gsz; return true;
    }
    __device__ __forceinline__ void a_ready(const Unit&) const {}
    __device__ __forceinline__ void done(const Unit&) const {}
};

__device__ __forceinline__ unsigned cvt_pk_bf16(float lo, float hi) { unsigned r; asm volatile("v_cvt_pk_bf16_f32 %0, %1, %2" : "=v"(r) : "v"(lo), "v"(hi)); return r; }
typedef float f32x2 __attribute__((ext_vector_type(2)));
template <class Epi, class Sched, bool ALIGN_EPI = false, bool SP2 = false>
__device__ __forceinline__ void gemm_phase(PG8_LAS unsigned char* lds, const Gemm g, const Sched& S, const Epi& E) {
    const int tid = threadIdx.x, wid = __builtin_amdgcn_readfirstlane(tid >> 6), lane = tid & 63, wr = wid >> 2, wc = wid & 3, fr = lane & 15, fq = lane >> 4;
    const int K = g.K, nt = K / BK;
    unsigned voffA[2], voffB[2];
#pragma unroll
    for (int i = 0; i < 2; ++i) { int R, C; stage_rc(tid * 16 + i * 8192, R, C); const int Rb = Epi::PERM ? ((R & ~31) + perm32(R & 31)) : R;
        voffA[i] = (unsigned)(R * K + C) * 2u; voffB[i] = (unsigned)(Rb * K + C) * 2u; }
    const size_t kstep = (size_t)(BK * 2);
    const size_t hstep = (size_t)HALF * K * 2;
    const size_t tstep = 2 * hstep;
    const unsigned ldsw = (unsigned)wid * 1024u;
    const int aoff = lds_byte(wr * 64 + fr, fq * 8), boff = lds_byte(wc * 32 + fr, fq * 8);
#define PG8_SA(b, h) (((b) * 2 + (h)) * HTB)
#define PG8_SB(b, h) ((4 + (b) * 2 + (h)) * HTB)
#define PG8_STAGE(bufoff, gbase, voff) do { _Pragma("unroll") for (int _i = 0; _i < 2; ++_i) \
        __builtin_amdgcn_global_load_lds((const unsigned*)((const char*)(gbase) + (voff)[_i]), (PG8_LAS unsigned*)(lds + (bufoff) + ldsw + _i * 8192), 16, 0, 0); } while (0)
#define PG8_LDA(dst, b, h) do { _Pragma("unroll") for (int m = 0; m < 4; ++m) _Pragma("unroll") for (int k = 0; k < 2; ++k) dst[m][k] = *(const PG8_LAS bf16x8*)(lds + PG8_SA(b, h) + aoff + m * 2048 + k * 1024); } while (0)
#define PG8_LDB(dst, b, h) do { _Pragma("unroll") for (int n = 0; n < 2; ++n) _Pragma("unroll") for (int k = 0; k < 2; ++k) dst[n][k] = *(const PG8_LAS bf16x8*)(lds + PG8_SB(b, h) + boff + n * 2048 + k * 1024); } while (0)
#define PG8_MMA(ai, bj, At, Bt) do { __builtin_amdgcn_s_setprio(1); _Pragma("unroll") for (int m = 0; m < 4; ++m) _Pragma("unroll") for (int n = 0; n < 2; ++n) _Pragma("unroll") for (int k = 0; k < 2; ++k) \
        acc[ai][bj][m][n] = __builtin_amdgcn_mfma_f32_16x16x32_bf16(Bt[n][k], At[m][k], acc[ai][bj][m][n], 0, 0, 0); __builtin_amdgcn_s_setprio(0); } while (0)
#define PG8_WAIT_V(n) asm volatile("s_waitcnt vmcnt(" #n ")" ::: "memory")
#define PG8_WAIT_L(n) asm volatile("s_waitcnt lgkmcnt(" #n ")" ::: "memory")
#define PG8_BAR __builtin_amdgcn_s_barrier()
#define PG8_SCHED __builtin_amdgcn_sched_barrier(0)
    Unit cur, nxt; int ui = 0;
    if (!S.next(0, cur)) return;
    E.prime(cur);
    f32x4 acc[2][2][4][2];
#pragma unroll
    for (int a = 0; a < 2; ++a)
#pragma unroll
        for (int b = 0; b < 2; ++b)
#pragma unroll
            for (int m = 0; m < 4; ++m)
#pragma unroll
                for (int n = 0; n < 2; ++n) acc[a][b][m][n] = (f32x4){0.f, 0.f, 0.f, 0.f};
    bf16x8 At[4][2], B0[2][2], B1[2][2];
    const char* cA = (const char*)g.A + (size_t)cur.pm * tstep; const char* cB = (const char*)g.Bt + (size_t)cur.pn * tstep;
    S.a_ready(cur);
    if constexpr (SP2) {
        PG8_STAGE(PG8_SB(0, 0), cB, voffB); PG8_STAGE(PG8_SB(0, 1), cB + hstep, voffB); PG8_STAGE(PG8_SA(0, 0), cA, voffA); PG8_STAGE(PG8_SA(0, 1), cA + hstep, voffA);
        if (wr == 1) PG8_BAR;
        PG8_WAIT_V(2); PG8_BAR;
        PG8_STAGE(PG8_SB(1, 0), cB + kstep, voffB); PG8_STAGE(PG8_SA(1, 0), cA + kstep, voffA); PG8_STAGE(PG8_SB(1, 1), cB + hstep + kstep, voffB);
        PG8_WAIT_V(6); PG8_BAR;
    } else {
        PG8_STAGE(PG8_SB(0, 0), cB, voffB); PG8_STAGE(PG8_SA(0, 0), cA, voffA); PG8_STAGE(PG8_SB(0, 1), cB + hstep, voffB); PG8_STAGE(PG8_SA(0, 1), cA + hstep, voffA);
        if (wr == 1) PG8_BAR;
        PG8_WAIT_V(4); PG8_BAR;
        PG8_STAGE(PG8_SB(1, 0), cB + kstep, voffB); PG8_STAGE(PG8_SA(1, 0), cA + kstep, voffA); PG8_STAGE(PG8_SB(1, 1), cB + hstep + kstep, voffB);
        PG8_WAIT_V(6); PG8_BAR;
    }
    for (;;) {
        const bool has_next = S.next(ui + 1, nxt);
        const char* nA = has_next ? (const char*)g.A + (size_t)nxt.pm * tstep : cA; const char* nB = has_next ? (const char*)g.Bt + (size_t)nxt.pn * tstep : cB;
#pragma nounroll
        for (int t = 0; t < nt; t += 2) {
            const bool last = (t == nt - 2);
            const char* a1 = cA + (size_t)(t + 1) * kstep;
            const char* a2 = last ? nA : cA + (size_t)(t + 2) * kstep; const char* b2 = last ? nB : cB + (size_t)(t + 2) * kstep;
            const char* a3 = a2 + kstep; const char* b3 = b2 + kstep;
            if (last && has_next) S.a_ready(nxt);
            if constexpr (SP2) {
            PG8_LDB(B0, 0, 0); PG8_LDB(B1, 0, 1); PG8_SCHED; PG8_LDA(At, 0, 0); PG8_STAGE(PG8_SA(1, 1), a1 + hstep, voffA);
            PG8_WAIT_V(8); PG8_WAIT_L(0); PG8_BAR; PG8_MMA(0, 0, At, B0); PG8_MMA(0, 1, At, B1); PG8_BAR; PG8_SCHED;
            PG8_LDA(At, 0, 1); PG8_STAGE(PG8_SB(0, 0), b2, voffB); PG8_STAGE(PG8_SB(0, 1), b2 + hstep, voffB); PG8_STAGE(PG8_SA(0, 0), a2, voffA);
            PG8_WAIT_V(8); PG8_WAIT_L(0); PG8_BAR; PG8_MMA(1, 0, At, B0); PG8_MMA(1, 1, At, B1); PG8_BAR; PG8_SCHED;
            PG8_LDB(B0, 1, 0); PG8_LDB(B1, 1, 1); PG8_SCHED; PG8_LDA(At, 1, 0); PG8_STAGE(PG8_SA(0, 1), a2 + hstep, voffA);
            PG8_WAIT_V(8); PG8_WAIT_L(0); PG8_BAR; PG8_MMA(0, 0, At, B0); PG8_MMA(0, 1, At, B1); PG8_BAR; PG8_SCHED;
            PG8_LDA(At, 1, 1); PG8_STAGE(PG8_SB(1, 0), b3, voffB); PG8_STAGE(PG8_SB(1, 1), b3 + hstep, voffB); PG8_STAGE(PG8_SA(1, 0), a3, voffA);
            PG8_WAIT_V(8); PG8_WAIT_L(0); PG8_BAR; PG8_MMA(1, 0, At, B0); PG8_MMA(1, 1, At, B1); PG8_BAR; PG8_SCHED;
            } else {
            PG8_LDB(B0, 0, 0); PG8_SCHED; PG8_LDA(At, 0, 0); PG8_STAGE(PG8_SA(1, 1), a1 + hstep, voffA);
            PG8_WAIT_L(8); PG8_BAR; PG8_WAIT_L(0); PG8_MMA(0, 0, At, B0); PG8_BAR; PG8_SCHED;
            PG8_LDB(B1, 0, 1); PG8_STAGE(PG8_SB(0, 0), b2, voffB);
            PG8_BAR; PG8_WAIT_L(0); PG8_MMA(0, 1, At, B1); PG8_BAR;
            PG8_LDA(At, 0, 1); PG8_STAGE(PG8_SA(0, 0), a2, voffA);
            PG8_BAR; PG8_WAIT_L(0); PG8_MMA(1, 0, At, B0); PG8_BAR; PG8_SCHED;
            PG8_STAGE(PG8_SB(0, 1), b2 + hstep, voffB);
            PG8_WAIT_V(6); PG8_BAR; PG8_MMA(1, 1, At, B1); PG8_BAR;
            PG8_LDB(B0, 1, 0); PG8_SCHED; PG8_LDA(At, 1, 0); PG8_STAGE(PG8_SA(0, 1), a2 + hstep, voffA);
            PG8_WAIT_L(8); PG8_BAR; PG8_WAIT_L(0); PG8_MMA(0, 0, At, B0); PG8_BAR; PG8_SCHED;
            PG8_LDB(B1, 1, 1); PG8_STAGE(PG8_SB(1, 0), b3, voffB);
            PG8_BAR; PG8_WAIT_L(0); PG8_MMA(0, 1, At, B1); PG8_BAR;
            PG8_LDA(At, 1, 1); PG8_STAGE(PG8_SA(1, 0), a3, voffA);
            PG8_BAR; PG8_WAIT_L(0); PG8_MMA(1, 0, At, B0); PG8_BAR; PG8_SCHED;
            PG8_STAGE(PG8_SB(1, 1), b3 + hstep, voffB);
            PG8_WAIT_V(6); PG8_BAR; PG8_MMA(1, 1, At, B1); PG8_BAR;
            }
        }
        if constexpr (ALIGN_EPI) { if (wr == 0) PG8_BAR; }
        if constexpr (!Epi::AFTER_DRAIN) { E(acc, cur, wr, wc, fr, fq, nxt, has_next, ui); S.done(cur); }
        if (!has_next) break;
#pragma unroll
        for (int a = 0; a < 2; ++a)
#pragma unroll
            for (int b = 0; b < 2; ++b)
#pragma unroll
                for (int m = 0; m < 4; ++m)
#pragma unroll
                    for (int n = 0; n < 2; ++n) acc[a][b][m][n] = (f32x4){0.f, 0.f, 0.f, 0.f};
        cur = nxt; cA = nA; cB = nB; ++ui;
        if constexpr (ALIGN_EPI) { if (wr == 1) PG8_BAR; }
    }
    PG8_WAIT_V(0);
    if constexpr (!ALIGN_EPI) { if (wr == 0) PG8_BAR; }
    PG8_BAR;
    if constexpr (Epi::AFTER_DRAIN) { E.fused(acc, cur, wr, wc, fr, fq, lds, wid, lane); S.done(cur); }
#undef PG8_SA
#undef PG8_SB
#undef PG8_STAGE
#undef PG8_LDA
#undef PG8_LDB
#undef PG8_MMA
#undef PG8_WAIT_V
#undef PG8_WAIT_L
#undef PG8_BAR
#undef PG8_SCHED
}
}
#ifndef REPEAT_MASK
#define REPEAT_MASK 0u
#endif
#ifndef EXTRA_SYNCS
#define EXTRA_SYNCS 0
#endif
#ifndef REP_SSM
#define REP_SSM 1
#endif
#ifndef REP_CONV
#define REP_CONV 1
#endif
#ifndef REP_ATTN
#define REP_ATTN 1
#endif

#define LAS __attribute__((address_space(3)))
typedef unsigned short bf16_t;
typedef short bf16x8 __attribute__((ext_vector_type(8)));
typedef short s16x4 __attribute__((ext_vector_type(4)));
typedef float f32x4 __attribute__((ext_vector_type(4)));
typedef float f32x16 __attribute__((ext_vector_type(16)));
typedef unsigned u32x4 __attribute__((ext_vector_type(4)));
typedef unsigned u32x2 __attribute__((ext_vector_type(2)));
typedef float f32x2v __attribute__((ext_vector_type(2)));
typedef __bf16 bf16x2v __attribute__((ext_vector_type(2)));

constexpr int NT = 65536, SEQ = 4096, DMODEL = 1024, NIN = 2304, DFF = 2816;
constexpr float EPS = 1e-6f;
constexpr float C2 = 0.125f * 1.4426950408889634f;
constexpr size_t MiB = (size_t)1 << 20;
constexpr size_t W_IN = 0, W_OUT = W_IN + (size_t)NIN * 1024 * 2, W_GU = W_OUT + (size_t)1024 * 1024 * 2, W_DN = W_GU + (size_t)2 * DFF * 1024 * 2,
                 W_GLU = W_DN + (size_t)1024 * DFF * 2, W_LAYER = 24 * MiB;
static_assert(W_GLU + 512 * 256 * 2 <= W_LAYER, "weight block");
constexpr size_t WS_W = 0, WS_ROPE = 48 * MiB, WS_H = 64 * MiB, WS_P = 192 * MiB, WS_YC = 544 * MiB, WS_ZB = 640 * MiB, WS_OB = 672 * MiB, WS_ST = 768 * MiB, WS_BAR = 776 * MiB, WS_XB = 778 * MiB, WS_SS = 906 * MiB, WS_END = 912 * MiB;
constexpr int LDS_BYTES = 147456;
constexpr int NTHREADS = 512;

#define CAS __attribute__((address_space(4)))
struct Args {
    const float* in[24];
    float* out;
    unsigned char* ws;
    int ph_lo, ph_hi;
};

__device__ __forceinline__ unsigned pk2(float lo, float hi) { f32x2v v = {lo, hi}; bf16x2v b = __builtin_convertvector(v, bf16x2v); return __builtin_bit_cast(unsigned, b); }
__device__ __forceinline__ float bflo(unsigned u) { return __uint_as_float(u << 16); }
__device__ __forceinline__ float bfhi(unsigned u) { return __uint_as_float(u & 0xffff0000u); }
template <int CTRL, int ROWMASK> __device__ __forceinline__ float dpp_add(float v) {
    return v + __builtin_bit_cast(float, __builtin_amdgcn_update_dpp(0, __builtin_bit_cast(int, v), CTRL, ROWMASK, 0xF, false));
}
__device__ __forceinline__ float wave_sum(float v) {
    v = dpp_add<0xB1, 0xF>(v);
    v = dpp_add<0x4E, 0xF>(v);
    v = dpp_add<0x141, 0xF>(v);
    v = dpp_add<0x140, 0xF>(v);
    v = dpp_add<0x142, 0xA>(v);
    v = dpp_add<0x143, 0xC>(v);
    return __builtin_bit_cast(float, __builtin_amdgcn_readlane(__builtin_bit_cast(int, v), 63));
}
__device__ __forceinline__ float sigmoidf_(float x) { return __builtin_amdgcn_rcpf(1.f + __expf(-x)); }
__device__ __forceinline__ float gelu_tanh(float y) {
    const float a = 0.7978845608028654f * (y + 0.044715f * y * y * y);
    const float t = 1.f - 2.f * __builtin_amdgcn_rcpf(__expf(2.f * a) + 1.f);
    return 0.5f * y * (1.f + t);
}
#define WAVE_LDS_SYNC() asm volatile("s_waitcnt lgkmcnt(0)" ::: "memory")

struct RowScale {
    const float* ssp; LAS float* xs;
    __device__ __forceinline__ float rs_of(int row) const { const f32x4 sp = *(const f32x4*)(ssp + (size_t)row * 4); return rsqrtf(((sp.x + sp.y) + (sp.z + sp.w)) * (1.f / DMODEL) + EPS); }
    __device__ __forceinline__ void prime(const pg8::Unit& u) const { const int t = threadIdx.x; if (t < 256) xs[t] = rs_of(u.pm * 256 + t); }
};
struct EpiIn {
    static constexpr bool PERM = true, AFTER_DRAIN = false;
    bf16_t* O; const float* ropec; const float* ropes; RowScale R;
    __device__ __forceinline__ void prime(const pg8::Unit& u) const { R.prime(u); }
    __device__ __forceinline__ void operator()(const f32x4 (&acc)[2][2][4][2], const pg8::Unit& u, int wr, int wc, int fr, int fq, const pg8::Unit& nxt, bool has_next, int ui) const {
        const int row0 = u.pm * 256 + wr * 64 + fr, t = threadIdx.x;
        f32x4 spn = {0.f, 0.f, 0.f, 0.f};
        const bool stage = has_next && t < 256 && nxt.pm != u.pm;
        if (stage) spn = *(const f32x4*)(R.ssp + (size_t)(nxt.pm * 256 + t) * 4);
        const LAS float* xsc = R.xs + (ui & 1) * 256 + wr * 64 + fr;
        if (u.pn == 0 || u.pn == 1 || u.pn == 3 || u.pn == 4) {
            const bool glu = u.pn >= 3;
            const int cbase = (glu ? 768 + 128 * (u.pn - 3) : 128 * u.pn) + wc * 32 + 8 * fq;
#pragma unroll
            for (int ai = 0; ai < 2; ++ai)
#pragma unroll
                for (int m = 0; m < 4; ++m) {
                    const float rsc = xsc[ai * 128 + m * 16];
                    float r[8];
#pragma unroll
                    for (int n = 0; n < 2; ++n)
#pragma unroll
                        for (int j = 0; j < 4; ++j) {
                            const float a = acc[ai][0][m][n][j] * rsc, b = acc[ai][1][m][n][j] * rsc;
                            r[4 * n + j] = glu ? a * sigmoidf_(b) : a * b;
                        }
                    u32x4 w; w.x = pk2(r[0], r[1]); w.y = pk2(r[2], r[3]); w.z = pk2(r[4], r[5]); w.w = pk2(r[6], r[7]);
                    *(u32x4*)(O + (size_t)(row0 + ai * 128 + m * 16) * NIN + cbase) = w;
                }
        } else if (u.pn == 6 || u.pn == 7) {
            const float sc = (u.pn == 6) ? C2 : 1.f;
            const int dimb = 16 * (wc & 1) + 4 * fq;
            float invf[4];
#pragma unroll
            for (int j = 0; j < 4; ++j) invf[j] = __builtin_amdgcn_exp2f(-(float)(dimb + j) * (13.287712379549449f / 32.f));
#pragma unroll
            for (int ai = 0; ai < 2; ++ai)
#pragma unroll
                for (int m = 0; m < 4; ++m) {
                    const int row = row0 + ai * 128 + m * 16; const int pos = row & (SEQ - 1);
                    const float rsc = xsc[ai * 128 + m * 16] * sc;
                    f32x4 cs, sn;
#pragma unroll
                    for (int j = 0; j < 4; ++j) { const float rev = __builtin_amdgcn_fractf(((float)pos * invf[j]) * 0.15915494309189535f); cs[j] = __builtin_amdgcn_cosf(rev); sn[j] = __builtin_amdgcn_sinf(rev); }
                    bf16_t* rowp = O + (size_t)row * NIN + u.pn * 256 + 64 * (wc >> 1) + dimb;
#pragma unroll
                    for (int bj = 0; bj < 2; ++bj) {
                        const f32x4 x1 = acc[ai][bj][m][0] * rsc, x2 = acc[ai][bj][m][1] * rsc;
                        const f32x4 o1 = x1 * cs - x2 * sn, o2 = x2 * cs + x1 * sn;
                        u32x2 w1, w2; w1.x = pk2(o1[0], o1[1]); w1.y = pk2(o1[2], o1[3]); w2.x = pk2(o2[0], o2[1]); w2.y = pk2(o2[2], o2[3]);
                        *(u32x2*)(rowp + bj * 128) = w1; *(u32x2*)(rowp + bj * 128 + 32) = w2;
                    }
                }
        } else {
#pragma unroll
            for (int ai = 0; ai < 2; ++ai)
#pragma unroll
                for (int m = 0; m < 4; ++m) {
                    bf16_t* rowp = O + (size_t)(row0 + ai * 128 + m * 16) * NIN + (u.pn == 2 ? 256 : u.pn * 256) + wc * 32 + 8 * fq;
                    const float rsc = xsc[ai * 128 + m * 16];
#pragma unroll
                    for (int bj = 0; bj < 2; ++bj) {
                        const f32x4 v0 = acc[ai][bj][m][0] * rsc, v1 = acc[ai][bj][m][1] * rsc;
                        u32x4 w; w.x = pk2(v0[0], v0[1]); w.y = pk2(v0[2], v0[3]); w.z = pk2(v1[0], v1[1]); w.w = pk2(v1[2], v1[3]);
                        *(u32x4*)(rowp + bj * 128) = w;
                    }
                }
        }
        if (has_next && t < 256) {
            float v = R.xs[(ui & 1) * 256 + t];
            if (nxt.pm != u.pm) v = rsqrtf(((spn.x + spn.y) + (spn.z + spn.w)) * (1.f / DMODEL) + EPS);
            R.xs[((ui + 1) & 1) * 256 + t] = v;
        }
    }
};
struct EpiRes {
    static constexpr bool PERM = true, AFTER_DRAIN = false;
    bf16_t* xb; float* ssp; LAS float* xl;
    __device__ __forceinline__ void prime(const pg8::Unit&) const {}
    __device__ __forceinline__ void operator()(const f32x4 (&acc)[2][2][4][2], const pg8::Unit& u, int wr, int wc, int fr, int fq, const pg8::Unit&, bool, int) const {
        const int row0 = u.pm * 256 + wr * 64 + fr, col0 = u.pn * 256 + wc * 32 + 8 * fq;
        u32x4 rv[2][4][2];
#pragma unroll
        for (int ai = 0; ai < 2; ++ai)
#pragma unroll
            for (int m = 0; m < 4; ++m)
#pragma unroll
                for (int bj = 0; bj < 2; ++bj) rv[ai][m][bj] = *(const u32x4*)(xb + (size_t)(row0 + ai * 128 + m * 16) * DMODEL + col0 + bj * 128);
#pragma unroll
        for (int ai = 0; ai < 2; ++ai)
#pragma unroll
            for (int m = 0; m < 4; ++m) {
                const int row = row0 + ai * 128 + m * 16;
                const size_t off = (size_t)row * DMODEL + col0;
                float sq = 0.f;
#pragma unroll
                for (int bj = 0; bj < 2; ++bj) {
                    const u32x4 r = rv[ai][m][bj];
                    const f32x4 r0 = {bflo(r.x), bfhi(r.x), bflo(r.y), bfhi(r.y)}, r1 = {bflo(r.z), bfhi(r.z), bflo(r.w), bfhi(r.w)};
                    const f32x4 x0 = r0 + acc[ai][bj][m][0], x1 = r1 + acc[ai][bj][m][1];
                    u32x4 w; w.x = pk2(x0[0], x0[1]); w.y = pk2(x0[2], x0[3]); w.z = pk2(x1[0], x1[1]); w.w = pk2(x1[2], x1[3]);
                    *(u32x4*)(xb + off + bj * 128) = w;
                    sq += (x0[0] * x0[0] + x0[1] * x0[1]) + (x0[2] * x0[2] + x0[3] * x0[3]) + (x1[0] * x1[0] + x1[1] * x1[1]) + (x1[2] * x1[2] + x1[3] * x1[3]);
                }
                sq += __shfl_xor(sq, 16); sq += __shfl_xor(sq, 32);
                if (fq == 0) xl[(wr * 64 + ai * 128 + m * 16 + fr) * 4 + wc] = sq;
            }
        asm volatile("s_waitcnt lgkmcnt(0)\n\ts_barrier" ::: "memory");
        const int t = threadIdx.x;
        if (t < 256) { const f32x4 v = *(const LAS f32x4*)(xl + t * 4); ssp[(size_t)(u.pm * 256 + t) * 4 + u.pn] = (v.x + v.y) + (v.z + v.w); }
    }
};
template <int MODE  > struct EpiGate {
    static constexpr bool PERM = true, AFTER_DRAIN = false;
    bf16_t* O; int ldc; int coff; RowScale R;
    __device__ __forceinline__ void prime(const pg8::Unit& u) const { if (MODE == 0) R.prime(u); }
    __device__ __forceinline__ void operator()(const f32x4 (&acc)[2][2][4][2], const pg8::Unit& u, int wr, int wc, int fr, int fq, const pg8::Unit& nxt, bool has_next, int ui) const {
        const int row0 = u.pm * 256 + wr * 64 + fr, col0 = coff + u.pn * 128 + wc * 32 + 8 * fq, t = threadIdx.x;
        f32x4 spn = {0.f, 0.f, 0.f, 0.f};
        if (MODE == 0) { if (has_next && t < 256 && nxt.pm != u.pm) spn = *(const f32x4*)(R.ssp + (size_t)(nxt.pm * 256 + t) * 4); }
        const LAS float* xsc = R.xs + (ui & 1) * 256 + wr * 64 + fr;
#pragma unroll
        for (int ai = 0; ai < 2; ++ai)
#pragma unroll
            for (int m = 0; m < 4; ++m) {
                float r[8];
                float rsc = 1.f; if (MODE == 0) rsc = xsc[ai * 128 + m * 16];
                const float c1 = -1.4426950408889634f * rsc, r2 = rsc * rsc;
#pragma unroll
                for (int n = 0; n < 2; ++n)
#pragma unroll
                    for (int j = 0; j < 4; ++j) {
                        const float a = acc[ai][0][m][n][j], b = acc[ai][1][m][n][j];
                        if (MODE == 0) r[4 * n + j] = (a * b) * (r2 * __builtin_amdgcn_rcpf(1.f + __builtin_amdgcn_exp2f(a * c1)));
                        else r[4 * n + j] = a * __builtin_amdgcn_rcpf(1.f + __builtin_amdgcn_exp2f(b * -1.4426950408889634f));
                    }
                u32x4 w; w.x = pk2(r[0], r[1]); w.y = pk2(r[2], r[3]); w.z = pk2(r[4], r[5]); w.w = pk2(r[6], r[7]);
                *(u32x4*)(O + (size_t)(row0 + ai * 128 + m * 16) * ldc + col0) = w;
            }
        if (MODE == 0) {
            if (has_next && t < 256) {
                float v = R.xs[(ui & 1) * 256 + t];
                if (nxt.pm != u.pm) v = rsqrtf(((spn.x + spn.y) + (spn.z + spn.w)) * (1.f / DMODEL) + EPS);
                R.xs[((ui + 1) & 1) * 256 + t] = v;
            }
        }
    }
};

struct WMat { const float* src; const float* src2; int K, N, ldw, kind; bf16_t* dst; const float* kscale; };
__device__ __forceinline__ void wconv_load(const WMat& w, int t, int tid, float (&v)[8]) {
    const int nkt = w.K / 64, jt = t / nkt, kt = t % nkt, j0 = jt * 64, k0 = kt * 64;
    const int j = j0 + (tid & 63);
    const float* s = w.src; int col = j;
    if (w.kind == 1) {
        if (j >= 1536 && j < 2048) { const int ww = j & 63; col = (j & ~63) + 32 * ((ww >> 2) & 1) + 16 * (ww >> 5) + 4 * ((ww >> 3) & 3) + (ww & 3); }
        else if (j < 1280) {
            const int pn = j >> 8, wi = j & 255, half = (pn == 0 || pn == 3) ? 0 : 128;
            if (pn == 2) col = 256 + wi;
            else if (pn < 2) col = (wi < 128 ? 0 : 512 - 128) + half + wi;
            else col = (wi < 128 ? 768 : 1024 - 128) + half + wi;
        }
    } else if (w.kind == 2) {
        const int pn = j >> 8, wi = j & 255; if (wi < 128) col = pn * 128 + wi; else { s = w.src2; col = pn * 128 + (wi - 128); }
    }
    const int kk = tid >> 6;
#pragma unroll
    for (int i = 0; i < 8; ++i) { const int k = kk + 8 * i; const float sc = w.kscale ? w.kscale[k0 + k] : 1.f; v[i] = s[(size_t)(k0 + k) * w.ldw + col] * sc; }
}
__device__ __forceinline__ void wconv_store(LAS float* tile, const WMat& w, int t, int tid, const float (&v)[8]) {
    const int nkt = w.K / 64, jt = t / nkt, kt = t % nkt, j0 = jt * 64, k0 = kt * 64;
    const int kk = tid >> 6;
#pragma unroll
    for (int i = 0; i < 8; ++i) tile[(kk + 8 * i) * 65 + (tid & 63)] = v[i];
    __syncthreads();
    {
        const int jr = tid >> 3, c = tid & 7; const LAS float* s = tile + (8 * c) * 65 + jr;
        u32x4 o; o.x = pk2(s[0], s[65]); o.y = pk2(s[2 * 65], s[3 * 65]); o.z = pk2(s[4 * 65], s[5 * 65]); o.w = pk2(s[6 * 65], s[7 * 65]);
        *(u32x4*)(w.dst + (size_t)(j0 + jr) * w.K + k0 + 8 * c) = o;
    }
    __syncthreads();
}
__device__ __forceinline__ void wconv_wave(LAS float* tile, const WMat& w, int t, int lane) {
    const int nkt = w.K / 64, jt = t / nkt, kt = t % nkt, j0 = jt * 64, k0 = kt * 64;
    const int j = j0 + lane;
    const float* s = w.src; int col = j;
    if (w.kind == 1) {
        if (j >= 1536 && j < 2048) { const int ww = j & 63; col = (j & ~63) + 32 * ((ww >> 2) & 1) + 16 * (ww >> 5) + 4 * ((ww >> 3) & 3) + (ww & 3); }
        else if (j < 1280) {
            const int pn = j >> 8, wi = j & 255, half = (pn == 0 || pn == 3) ? 0 : 128;
            if (pn == 2) col = 256 + wi;
            else if (pn < 2) col = (wi < 128 ? 0 : 512 - 128) + half + wi;
            else col = (wi < 128 ? 768 : 1024 - 128) + half + wi;
        }
    } else if (w.kind == 2) {
        const int pn = j >> 8, wi = j & 255; if (wi < 128) col = pn * 128 + wi; else { s = w.src2; col = pn * 128 + (wi - 128); }
    }
    const float* sp = s + (size_t)k0 * w.ldw + col;
#pragma unroll
    for (int hb = 0; hb < 2; ++hb) {
        float v[32];
#pragma unroll
        for (int i = 0; i < 32; ++i) v[i] = sp[(size_t)(hb * 32 + i) * w.ldw];
        if (w.kscale) {
#pragma unroll
            for (int i = 0; i < 32; ++i) v[i] *= w.kscale[k0 + hb * 32 + i];
        }
#pragma unroll
        for (int i = 0; i < 32; ++i) tile[(hb * 32 + i) * 65 + lane] = v[i];
    }
    WAVE_LDS_SYNC();
    const int c = lane & 7;
#pragma unroll
    for (int rg = 0; rg < 8; ++rg) {
        const int jr = rg * 8 + (lane >> 3); const LAS float* q = tile + (8 * c) * 65 + jr;
        u32x4 o; o.x = pk2(q[0], q[65]); o.y = pk2(q[2 * 65], q[3 * 65]); o.z = pk2(q[4 * 65], q[5 * 65]); o.w = pk2(q[6 * 65], q[7 * 65]);
        *(u32x4*)(w.dst + (size_t)(j0 + jr) * w.K + k0 + 8 * c) = o;
    }
    WAVE_LDS_SYNC();
}
__device__ __forceinline__ WMat wmat_of(const CAS Args* ap, unsigned char* ws, int it, int& t) {
    const int layer = it / 2976; t = it % 2976;
    unsigned char* wb = ws + WS_W + (size_t)layer * W_LAYER;
    if (t < 576) return WMat{ap->in[2] + (size_t)layer * 1024 * NIN, nullptr, 1024, NIN, NIN, 1, (bf16_t*)(wb + W_IN), ap->in[1] + layer * 1024};
    if ((t -= 576) < 256) return WMat{ap->in[18] + (size_t)layer * 1024 * 1024, nullptr, 1024, 1024, 1024, 0, (bf16_t*)(wb + W_OUT), nullptr};
    if ((t -= 256) < 1408) return WMat{ap->in[20] + (size_t)layer * 1024 * DFF, ap->in[21] + (size_t)layer * 1024 * DFF, 1024, 2 * DFF, DFF, 2, (bf16_t*)(wb + W_GU), ap->in[19] + layer * 1024};
    if ((t -= 1408) < 704) return WMat{ap->in[22] + (size_t)layer * DFF * 1024, nullptr, DFF, 1024, 1024, 0, (bf16_t*)(wb + W_DN), nullptr};
    t -= 704; return WMat{ap->in[16] + (size_t)layer * 256 * 512, ap->in[16] + (size_t)layer * 256 * 512 + 256, 256, 512, 512, 2, (bf16_t*)(wb + W_GLU), nullptr};
}

__device__ __forceinline__ void norm_rows_bf16(const float* X, const float* g, bf16_t* H, int gw, int ngw, int lane) {
    f32x4 gv[4];
#pragma unroll
    for (int j = 0; j < 4; ++j) gv[j] = ((const f32x4*)g)[lane + 64 * j];
    for (int m = gw; m < NT; m += ngw) {
        const f32x4* xr = (const f32x4*)(X + (size_t)m * DMODEL) + lane;
        f32x4 v[4]; float s = 0.f;
#pragma unroll
        for (int j = 0; j < 4; ++j) { v[j] = xr[64 * j]; s += (v[j].x * v[j].x + v[j].y * v[j].y) + (v[j].z * v[j].z + v[j].w * v[j].w); }
        const float rs = rsqrtf(wave_sum(s) * (1.f / DMODEL) + EPS);
        u32x2* o = (u32x2*)(H + (size_t)m * DMODEL) + lane;
#pragma unroll
        for (int j = 0; j < 4; ++j) { u32x2 w; w.x = pk2(v[j].x * rs * gv[j].x, v[j].y * rs * gv[j].y); w.y = pk2(v[j].z * rs * gv[j].z, v[j].w * rs * gv[j].w); o[64 * j] = w; }
    }
}
__device__ __forceinline__ void xb_rows(const float* X, bf16_t* XB, float* ssq, int gw, int ngw, int lane) {
    for (int m0 = gw * 2; m0 < NT; m0 += ngw * 2) {
        f32x4 v[2][4];
#pragma unroll
        for (int r = 0; r < 2; ++r) { const f32x4* xr = (const f32x4*)(X + (size_t)(m0 + r) * DMODEL) + lane;
#pragma unroll
            for (int j = 0; j < 4; ++j) v[r][j] = xr[64 * j]; }
#pragma unroll
        for (int r = 0; r < 2; ++r) {
            const size_t m = (size_t)m0 + r;
            float s = 0.f;
#pragma unroll
            for (int j = 0; j < 4; ++j) s += (v[r][j].x * v[r][j].x + v[r][j].y * v[r][j].y) + (v[r][j].z * v[r][j].z + v[r][j].w * v[r][j].w);
            s = wave_sum(s);
            u32x2* o = (u32x2*)(XB + m * DMODEL) + lane;
#pragma unroll
            for (int j = 0; j < 4; ++j) { u32x2 w; w.x = pk2(v[r][j].x, v[r][j].y); w.y = pk2(v[r][j].z, v[r][j].w); o[64 * j] = w; }
            if (lane == 0) { f32x4 o4 = {s, 0.f, 0.f, 0.f}; *(f32x4*)(ssq + m * 4) = o4; }
        }
    }
}
__device__ __forceinline__ void final_rows(const bf16_t* XB, const float* ssp, const float* g, float* OUT, int gw, int ngw, int lane, float tscale) {
    f32x4 gv[4];
#pragma unroll
    for (int j = 0; j < 4; ++j) gv[j] = ((const f32x4*)g)[lane + 64 * j];
    for (int m0 = gw * 4; m0 < NT; m0 += ngw * 4) {
        u32x2 w[4][4]; f32x4 sp[4];
#pragma unroll
        for (int r = 0; r < 4; ++r) { const size_t m = (size_t)m0 + r; sp[r] = *(const f32x4*)(ssp + m * 4); const u32x2* xr = (const u32x2*)(XB + m * DMODEL) + lane;
#pragma unroll
            for (int j = 0; j < 4; ++j) w[r][j] = xr[64 * j]; }
#pragma unroll
        for (int r = 0; r < 4; ++r) {
            const float rs = rsqrtf(((sp[r].x + sp[r].y) + (sp[r].z + sp[r].w)) * (1.f / DMODEL) + EPS) * tscale;
            f32x4* o = (f32x4*)(OUT + (size_t)(m0 + r) * DMODEL) + lane;
#pragma unroll
            for (int j = 0; j < 4; ++j) { f32x4 v = {bflo(w[r][j].x), bfhi(w[r][j].x), bflo(w[r][j].y), bfhi(w[r][j].y)}; o[64 * j] = v * rs * gv[j]; }
        }
    }
}
__device__ __forceinline__ void norm_rows_f32_inplace(float* X, const float* g, int gw, int ngw, int lane) {
    f32x4 gv[4];
#pragma unroll
    for (int j = 0; j < 4; ++j) gv[j] = ((const f32x4*)g)[lane + 64 * j];
    for (int m = gw; m < NT; m += ngw) {
        f32x4* xr = (f32x4*)(X + (size_t)m * DMODEL) + lane;
        f32x4 v[4]; float s = 0.f;
#pragma unroll
        for (int j = 0; j < 4; ++j) { v[j] = xr[64 * j]; s += (v[j].x * v[j].x + v[j].y * v[j].y) + (v[j].z * v[j].z + v[j].w * v[j].w); }
        const float rs = rsqrtf(wave_sum(s) * (1.f / DMODEL) + EPS);
#pragma unroll
        for (int j = 0; j < 4; ++j) xr[64 * j] = v[j] * rs * gv[j];
    }
}

struct C3Regs { u32x4 gg[6], bb[4]; };
__device__ __forceinline__ void conv3_issue(const bf16_t* P, int w, C3Regs& R) {
    const int c8 = w & 31, tok = (w >> 5) * 4, t = tok & (SEQ - 1);
    const bf16_t* base = P + (size_t)tok * NIN + c8 * 8;
#pragma unroll
    for (int i = 0; i < 6; ++i) { const int dt = (t == 0 && i < 2) ? 0 : i - 2; R.gg[i] = *(const u32x4*)(base + dt * NIN); }
#pragma unroll
    for (int i = 0; i < 4; ++i) R.bb[i] = *(const u32x4*)(base + i * NIN + 256);
}
__device__ __forceinline__ void unpack8(const u32x4 a, float (&o)[8]) {
    o[0] = bflo(a.x); o[1] = bfhi(a.x); o[2] = bflo(a.y); o[3] = bfhi(a.y); o[4] = bflo(a.z); o[5] = bfhi(a.z); o[6] = bflo(a.w); o[7] = bfhi(a.w);
}
__device__ __forceinline__ void conv3_compute(bf16_t* H, int w, const C3Regs& R, const float (&w0)[8], const float (&w1)[8], const float (&w2)[8], const float (&gm)[8]) {
    const int c8 = w & 31, tok = (w >> 5) * 4, t = tok & (SEQ - 1);
    const float z01 = (t == 0) ? 0.f : 1.f;
    float g[6][8];
#pragma unroll
    for (int i = 0; i < 6; ++i) unpack8(R.gg[i], g[i]);
#pragma unroll
    for (int j = 0; j < 8; ++j) { g[0][j] *= z01; g[1][j] *= z01; }
#pragma unroll
    for (int i = 0; i < 4; ++i) {
        float bb[8]; unpack8(R.bb[i], bb);
        float y[8]; float sq = 0.f;
#pragma unroll
        for (int j = 0; j < 8; ++j) { y[j] = bb[j] * (w0[j] * g[i][j] + w1[j] * g[i + 1][j] + w2[j] * g[i + 2][j]); sq += y[j] * y[j]; }
#pragma unroll
        for (int o = 1; o < 32; o <<= 1) sq += __shfl_xor(sq, o);
        const float rs = rsqrtf(sq * (1.f / 256.f) + EPS);
        u32x4 o4; o4.x = pk2(y[0] * rs * gm[0], y[1] * rs * gm[1]); o4.y = pk2(y[2] * rs * gm[2], y[3] * rs * gm[3]); o4.z = pk2(y[4] * rs * gm[4], y[5] * rs * gm[5]); o4.w = pk2(y[6] * rs * gm[6], y[7] * rs * gm[7]);
        *(u32x4*)(H + (size_t)(tok + i) * DMODEL + c8 * 8) = o4;
    }
}
__device__ __forceinline__ void conv3_phase(const bf16_t* P, bf16_t* H, const float* w3, const float* gn, int bx, int G, int tid) {
    constexpr int NW = NT / 4 * 32;
    const int c8 = tid & 31;
    float w0[8], w1[8], w2[8], gm[8];
#pragma unroll
    for (int j = 0; j < 8; ++j) { w0[j] = w3[c8 * 8 + j]; w1[j] = w3[256 + c8 * 8 + j]; w2[j] = w3[512 + c8 * 8 + j]; gm[j] = gn[c8 * 8 + j]; }
    C3Regs Ra, Rb;
    int w = bx * NTHREADS + tid; const int step = G * NTHREADS;
    if (w < NW) conv3_issue(P, w, Ra);
    for (; w < NW; w += 2 * step) {
        if (w + step < NW) conv3_issue(P, w + step, Rb);
        conv3_compute(H, w, Ra, w0, w1, w2, gm);
        if (w + step < NW) { if (w + 2 * step < NW) conv3_issue(P, w + 2 * step, Ra); conv3_compute(H, w + step, Rb, w0, w1, w2, gm); }
    }
}

constexpr int CF_ZOFF = 0, CF_STOFF = 94 * 1024;
__device__ __forceinline__ void cfm_issue(const bf16_t* P, int tix, int tid, u32x4 (&zr)[6]) {
    const int b = tix >> 6, t0 = (tix & 63) * 64;
#pragma unroll
    for (int k = 0; k < 6; ++k) {
        int e = tid + NTHREADS * k; e = e < 94 * 32 ? e : 94 * 32 - 1;
        const int row = e >> 5, c8 = e & 31; int t = t0 - 30 + row; t = t < 0 ? 0 : t;
        zr[k] = *(const u32x4*)(P + ((size_t)b * SEQ + t) * NIN + 768 + c8 * 8);
    }
}
__device__ __forceinline__ void cfm_stage(LAS unsigned char* lds, int tix, int tid, const u32x4 (&zr)[6]) {
    const int t0 = (tix & 63) * 64;
    LAS float* ZT = (LAS float*)(lds + CF_ZOFF);
#pragma unroll
    for (int k = 0; k < 6; ++k) {
        const int e = tid + NTHREADS * k;
        if (e < 94 * 32) {
            const int row = e >> 5, c8 = e & 31; const float zm = (t0 - 30 + row < 0) ? 0.f : 1.f;
            const u32x4 a = zr[k];
            f32x4 z0 = {bflo(a.x) * zm, bfhi(a.x) * zm, bflo(a.y) * zm, bfhi(a.y) * zm}, z1 = {bflo(a.z) * zm, bfhi(a.z) * zm, bflo(a.w) * zm, bfhi(a.w) * zm};
            *(LAS f32x4*)(ZT + row * 256 + c8 * 8) = z0; *(LAS f32x4*)(ZT + row * 256 + c8 * 8 + 4) = z1;
        }
    }
}
__device__ __forceinline__ void cfm_phase(LAS unsigned char* lds, const bf16_t* P, bf16_t* H, const float* dww, const float* dwb, const float* lng, const float* lnb, const float* gn,
                                          int bx, int G, int tid, int wid, int lane) {
    const int cp = tid & 127, rr = tid >> 7;
    f32x2v w[31];
#pragma unroll
    for (int k = 0; k < 31; ++k) w[k] = *(const f32x2v*)(dww + k * 256 + 2 * cp);
    const f32x2v bias = *(const f32x2v*)(dwb + 2 * cp), lg = *(const f32x2v*)(lng + 2 * cp), lb = *(const f32x2v*)(lnb + 2 * cp), gmm = *(const f32x2v*)(gn + 256 + 2 * cp);
    LAS float* ZT = (LAS float*)(lds + CF_ZOFF);
    LAS float* STX = (LAS float*)(lds + CF_STOFF);
    u32x4 zr[6];
    int tix = bx;
    if (tix < 1024) cfm_issue(P, tix, tid, zr);
    for (; tix < 1024; tix += G) {
        __syncthreads();
        cfm_stage(lds, tix, tid, zr);
        if (tix + G < 1024) cfm_issue(P, tix + G, tid, zr);
        __syncthreads();
        f32x2v acc[16];
#pragma unroll
        for (int j = 0; j < 16; ++j) acc[j] = bias;
#pragma unroll
        for (int s = 0; s < 46; ++s) {
            const f32x2v z = *(const LAS f32x2v*)(ZT + (rr * 16 + s) * 256 + 2 * cp);
#pragma unroll
            for (int j = 0; j < 16; ++j) { const int k = s - j; if (k >= 0 && k <= 30) acc[j] += w[k] * z; }
        }
        float s1[16], s2[16];
#pragma unroll
        for (int j = 0; j < 16; ++j) { s1[j] = wave_sum(acc[j].x + acc[j].y); s2[j] = wave_sum(acc[j].x * acc[j].x + acc[j].y * acc[j].y); }
        if (lane == 0) {
#pragma unroll
            for (int j = 0; j < 16; ++j) { STX[wid * 32 + j] = s1[j]; STX[wid * 32 + 16 + j] = s2[j]; }
        }
        __syncthreads();
        const int b = tix >> 6, t0 = (tix & 63) * 64;
        float s3[16];
#pragma unroll
        for (int j = 0; j < 16; ++j) {
            const float S1 = s1[j] + STX[(wid ^ 1) * 32 + j], S2 = s2[j] + STX[(wid ^ 1) * 32 + 16 + j];
            const float mean = S1 * (1.f / 256.f), var = fmaxf(S2 * (1.f / 256.f) - mean * mean, 0.f), rs = rsqrtf(var + EPS);
            f32x2v y = (acc[j] - mean) * rs * lg + lb;
            y.x = y.x * sigmoidf_(y.x); y.y = y.y * sigmoidf_(y.y);
            acc[j] = y;
            s3[j] = wave_sum(y.x * y.x + y.y * y.y);
        }
        if (lane == 0) {
#pragma unroll
            for (int j = 0; j < 16; ++j) STX[256 + wid * 16 + j] = s3[j];
        }
        __syncthreads();
#pragma unroll
        for (int j = 0; j < 16; ++j) {
            const float rs = rsqrtf((s3[j] + STX[256 + (wid ^ 1) * 16 + j]) * (1.f / 256.f) + EPS);
            *(unsigned*)(H + ((size_t)b * SEQ + t0 + rr * 16 + j) * DMODEL + 256 + 2 * cp) = pk2(acc[j].x * rs * gmm.x, acc[j].y * rs * gmm.y);
        }
    }
}

template <bool FULL> __device__ __forceinline__ void ssm_tile_scan(f32x16& xr, f32x16& xi, const float (&pw)[4][2], float& cr, float& ci, const bool hi) {
    const float l1r = pw[0][0], l1i = pw[0][1], l4r = pw[3][0], l4i = pw[3][1];
#pragma unroll
    for (int G = 0; G < 4; ++G)
#pragma unroll
        for (int j = 1; j < 4; ++j) { const int i = 4 * G + j; const float pr = xr[i - 1], pi = xi[i - 1]; xr[i] += l1r * pr - l1i * pi; xi[i] += l1r * pi + l1i * pr; }
    float cinr[4], cini[4];
#pragma unroll
    for (int G = 0; G < 4; ++G) {
        const float er = xr[4 * G + 3], ei = xi[4 * G + 3];
        const float orr = __shfl_xor(er, 32), oi = __shfl_xor(ei, 32);
        const float e0r = hi ? orr : er, e0i = hi ? oi : ei, e1r = hi ? er : orr, e1i = hi ? ei : oi;
        const float c1r = l4r * cr - l4i * ci + e0r, c1i = l4r * ci + l4i * cr + e0i;
        cinr[G] = hi ? c1r : cr; cini[G] = hi ? c1i : ci;
        const float c2r = l4r * c1r - l4i * c1i + e1r, c2i = l4r * c1i + l4i * c1r + e1i;
        cr = c2r; ci = c2i;
    }
    if (FULL) {
#pragma unroll
        for (int G = 0; G < 4; ++G)
#pragma unroll
            for (int j = 0; j < 4; ++j) { const int i = 4 * G + j; xr[i] += pw[j][0] * cinr[G] - pw[j][1] * cini[G]; xi[i] += pw[j][0] * cini[G] + pw[j][1] * cinr[G]; }
    }
}
constexpr int SSM_ROWB = 272;
__device__ __forceinline__ void ssm_item(LAS unsigned char* lds, const bf16_t* P, bf16_t* ZB, const float* a_re, const float* a_im, const float* log_dt, const float* b_re, const float* b_im,
                                         const float* c_re, const float* c_im, const float* d_skip, int item, int tid, int wid, int lane) {
    const int b = item >> 4, g = item & 15;
    const int r32 = lane & 31, h = lane >> 5; const bool hi = h != 0;
    LAS f32x2v* EW = (LAS f32x2v*)lds;
    LAS unsigned char* SBW = lds + 4096 + wid * (32 * SSM_ROWB);
    __syncthreads();
    float pw[2][4][2]; bf16x8 bfr[2][2];
#pragma unroll
    for (int tp = 0; tp < 2; ++tp) {
        const int p = r32 + 32 * tp;
        const float dt = __expf(log_dt[g]);
        const float ar = a_re[g * 64 + p], ai = a_im[g * 64 + p];
        const float mag = __expf(ar * dt);
        const float lr = mag * cosf(ai * dt), li = mag * sinf(ai * dt);
        const float den = ar * ar + ai * ai, nr = lr - 1.f, ni = li;
        const float fr = (nr * ar + ni * ai) / den, fi = (ni * ar - nr * ai) / den;
        const f32x4* br4 = (const f32x4*)(b_re + (size_t)(g * 64 + p) * 16 + 8 * h); const f32x4* bi4 = (const f32x4*)(b_im + (size_t)(g * 64 + p) * 16 + 8 * h);
        const f32x4 r0 = br4[0], r1 = br4[1], i0 = bi4[0], i1 = bi4[1];
        const f32x4 re0 = fr * r0 - fi * i0, re1 = fr * r1 - fi * i1, im0 = fr * i0 + fi * r0, im1 = fr * i1 + fi * r1;
        u32x4 wre, wim;
        wre.x = pk2(re0[0], re0[1]); wre.y = pk2(re0[2], re0[3]); wre.z = pk2(re1[0], re1[1]); wre.w = pk2(re1[2], re1[3]);
        wim.x = pk2(im0[0], im0[1]); wim.y = pk2(im0[2], im0[3]); wim.z = pk2(im1[0], im1[1]); wim.w = pk2(im1[2], im1[3]);
        bfr[tp][0] = __builtin_bit_cast(bf16x8, wre); bfr[tp][1] = __builtin_bit_cast(bf16x8, wim);
        pw[tp][0][0] = lr; pw[tp][0][1] = li;
#pragma unroll
        for (int j = 1; j < 4; ++j) { pw[tp][j][0] = pw[tp][j - 1][0] * lr - pw[tp][j - 1][1] * li; pw[tp][j][1] = pw[tp][j - 1][0] * li + pw[tp][j - 1][1] * lr; }
    }
    const int t16 = lane & 15, quad = lane >> 4;
    bf16x8 cfr[4];
#pragma unroll
    for (int s = 0; s < 4; ++s) {
        const f32x4 cr4 = *(const f32x4*)(c_re + (size_t)(g * 16 + t16) * 64 + 4 * quad + 16 * s), ci4 = *(const f32x4*)(c_im + (size_t)(g * 16 + t16) * 64 + 4 * quad + 16 * s);
        u32x4 w; w.x = pk2(cr4[0], -ci4[0]); w.y = pk2(cr4[1], -ci4[1]); w.z = pk2(cr4[2], -ci4[2]); w.w = pk2(cr4[3], -ci4[3]);
        cfr[s] = __builtin_bit_cast(bf16x8, w);
    }
    const f32x4 dsk = *(const f32x4*)(d_skip + g * 16 + 4 * quad);
    const size_t tok0 = (size_t)b * SEQ + (size_t)wid * 512;
    const bf16_t* ubase = P + tok0 * NIN + 1280 + g * 16;
    f32x16 zero16;
#pragma unroll
    for (int q = 0; q < 16; ++q) zero16[q] = 0.f;
    float cr[2] = {0.f, 0.f}, ci[2] = {0.f, 0.f};
    {
        bf16x8 ua = *(const bf16x8*)(ubase + (size_t)r32 * NIN + 8 * h);
        for (int mt = 0; mt < 16; ++mt) {
            const bf16x8 un = *(const bf16x8*)(ubase + (size_t)((mt < 15 ? mt + 1 : mt) * 32 + r32) * NIN + 8 * h);
#pragma unroll
            for (int tp = 0; tp < 2; ++tp) {
                f32x16 xr = __builtin_amdgcn_mfma_f32_32x32x16_bf16(ua, bfr[tp][0], zero16, 0, 0, 0);
                f32x16 xi = __builtin_amdgcn_mfma_f32_32x32x16_bf16(ua, bfr[tp][1], zero16, 0, 0, 0);
                ssm_tile_scan<false>(xr, xi, pw[tp], cr[tp], ci[tp], hi);
            }
            ua = un;
        }
    }
    if (!hi) { f32x2v e0 = {cr[0], ci[0]}, e1 = {cr[1], ci[1]}; EW[wid * 64 + r32] = e0; EW[wid * 64 + 32 + r32] = e1; }
    __syncthreads();
#pragma unroll
    for (int tp = 0; tp < 2; ++tp) {
        float qr = pw[tp][3][0], qi = pw[tp][3][1];
#pragma unroll
        for (int q = 0; q < 7; ++q) { const float nr = qr * qr - qi * qi, ni = 2.f * qr * qi; qr = nr; qi = ni; }
        float sr = 0.f, si = 0.f;
        for (int w = 0; w < wid; ++w) { const f32x2v e = EW[w * 64 + r32 + 32 * tp]; const float nr = qr * sr - qi * si + e.x, ni = qr * si + qi * sr + e.y; sr = nr; si = ni; }
        cr[tp] = sr; ci[tp] = si;
    }
    {
        bf16x8 ua = *(const bf16x8*)(ubase + (size_t)r32 * NIN + 8 * h);
        for (int mt = 0; mt < 16; ++mt) {
            const bf16x8 un = *(const bf16x8*)(ubase + (size_t)((mt < 15 ? mt + 1 : mt) * 32 + r32) * NIN + 8 * h);
            u32x2 uwv[2];
#pragma unroll
            for (int tt = 0; tt < 2; ++tt) uwv[tt] = *(const u32x2*)(P + (tok0 + mt * 32 + tt * 16 + t16) * NIN + 1280 + g * 16 + 4 * quad);
#pragma unroll
            for (int tp = 0; tp < 2; ++tp) {
                f32x16 xr = __builtin_amdgcn_mfma_f32_32x32x16_bf16(ua, bfr[tp][0], zero16, 0, 0, 0);
                f32x16 xi = __builtin_amdgcn_mfma_f32_32x32x16_bf16(ua, bfr[tp][1], zero16, 0, 0, 0);
                ssm_tile_scan<true>(xr, xi, pw[tp], cr[tp], ci[tp], hi);
#pragma unroll
                for (int i = 0; i < 16; ++i) {
                    const int t = (i & 3) + 8 * (i >> 2) + 4 * h;
                    *(LAS unsigned*)(SBW + t * SSM_ROWB + 4 * (r32 + 32 * tp)) = pk2(xr[i], xi[i]);
                }
            }
            WAVE_LDS_SYNC();
#pragma unroll
            for (int tt = 0; tt < 2; ++tt) {
                f32x4 acc = {0.f, 0.f, 0.f, 0.f};
#pragma unroll
                for (int s = 0; s < 4; ++s) {
                    const bf16x8 sf = *(const LAS bf16x8*)(SBW + (tt * 16 + t16) * SSM_ROWB + quad * 16 + 64 * s);
                    acc = __builtin_amdgcn_mfma_f32_16x16x32_bf16(cfr[s], sf, acc, 0, 0, 0);
                }
                const size_t tok = tok0 + mt * 32 + tt * 16 + t16;
                const u32x2 uw = uwv[tt];
                const f32x4 uu = {bflo(uw.x), bfhi(uw.x), bflo(uw.y), bfhi(uw.y)};
                const f32x4 y = acc + dsk * uu;
                u32x2 w; w.x = pk2(gelu_tanh(y.x), gelu_tanh(y.y)); w.y = pk2(gelu_tanh(y.z), gelu_tanh(y.w));
                *(u32x2*)(ZB + tok * 256 + g * 16 + 4 * quad) = w;
            }
            WAVE_LDS_SYNC();
            ua = un;
        }
    }
}

constexpr int AT_ROWB = 144, AT_KOFF = 0, AT_VOFF = 384 * AT_ROWB;
__device__ __forceinline__ s16x4 vtr(const LAS unsigned char* p) { return __builtin_bit_cast(s16x4, __builtin_amdgcn_ds_read_tr16_b64_v4i16((LAS s16x4*)p)); }
struct AttnU { int pat, head, d, ub; size_t rowbase; };
__device__ __forceinline__ AttnU attn_decode(int u) {
    AttnU U; const int rem = u & 1023, b = rem >> 6, ru = rem & 15; U.pat = u >> 10; U.head = (rem >> 4) & 3;
    int r;
    if (U.pat == 0) { U.d = 1; r = 0; U.ub = ru; } else if (U.pat == 1) { U.d = 4; r = ru >> 2; U.ub = ru & 3; } else { U.d = 16; r = ru; U.ub = 0; }
    U.rowbase = (size_t)b * SEQ + r; return U;
}
__device__ __forceinline__ void attn_issue(const bf16_t* P, const AttnU& U, int tid, int wid, int lane, u32x4 (&kreg)[6], u32x4 (&vreg)[6], bf16x8 (&qf)[4]) {
    const int i0 = U.ub * 256 - 128;
#pragma unroll
    for (int k = 0; k < 6; ++k) {
        const int e = tid + NTHREADS * k, row = e >> 3, c = e & 7; int si = i0 + row; si = si < 0 ? 0 : si;
        const bf16_t* src = P + (U.rowbase + (size_t)si * U.d) * NIN + U.head * 64 + c * 8;
        kreg[k] = *(const u32x4*)(src + 1792); vreg[k] = *(const u32x4*)(src + 2048);
    }
    const int r32 = lane & 31, h = lane >> 5;
    const size_t qtok = U.rowbase + (size_t)(U.ub * 256 + 32 * wid + r32) * U.d;
    const bf16_t* qp = P + qtok * NIN + 1536 + U.head * 64 + 8 * h;
#pragma unroll
    for (int s = 0; s < 4; ++s) qf[s] = *(const bf16x8*)(qp + 16 * s);
}
__device__ __forceinline__ void attn_to_lds(LAS unsigned char* lds, int tid, const u32x4 (&kreg)[6], const u32x4 (&vreg)[6]) {
#pragma unroll
    for (int k = 0; k < 6; ++k) {
        const int e = tid + NTHREADS * k, row = e >> 3, c = e & 7;
        *(LAS u32x4*)(lds + AT_KOFF + row * AT_ROWB + c * 16) = kreg[k];
        *(LAS u32x4*)(lds + AT_VOFF + row * AT_ROWB + c * 16) = vreg[k];
    }
}
__device__ __forceinline__ void attn_compute(LAS unsigned char* lds, const AttnU& U, const bf16x8 (&qf)[4], bf16_t* OB, f32x2v* ST, int wid, int lane) {
    const int pat = U.pat, head = U.head, ub = U.ub;
    const int r32 = lane & 31, h = lane >> 5;
    const size_t qtok = U.rowbase + (size_t)(ub * 256 + 32 * wid + r32) * U.d;
    f32x16 sc[5];
    float mx = -1e30f;
    const float r32f = (float)r32, h4f = (float)(4 * h);
#pragma unroll
    for (int i = 0; i < 5; ++i) {
        const bool tv = (ub > 0) || (wid + i >= 4);
        f32x16 a;
        if (tv) {
#pragma unroll
            for (int q = 0; q < 16; ++q) a[q] = 0.f;
            const LAS unsigned char* kp = lds + AT_KOFF + (32 * wid + 32 * i + r32) * AT_ROWB + 16 * h;
#pragma unroll
            for (int s = 0; s < 4; ++s) { const bf16x8 kf = *(const LAS bf16x8*)(kp + 32 * s); a = __builtin_amdgcn_mfma_f32_32x32x16_bf16(kf, qf[s], a, 0, 0, 0); }
            if (i == 0 || i == 4) {
#pragma unroll
                for (int q = 0; q < 16; ++q) {
                    const float diff = ((float)((q & 3) + 8 * (q >> 2)) + h4f) - r32f;
                    a[q] = (i == 0) ? __builtin_fmaf(fminf(diff, 0.f), 1e30f, a[q]) : __builtin_fmaf(fmaxf(diff, 0.f), -1e30f, a[q]);
                }
            }
#pragma unroll
            for (int q = 0; q < 16; ++q) mx = fmaxf(mx, a[q]);
        } else {
#pragma unroll
            for (int q = 0; q < 16; ++q) a[q] = -1e30f;
        }
        sc[i] = a;
    }
    mx = fmaxf(mx, __shfl_xor(mx, 32));
    float l = 0.f;
#pragma unroll
    for (int i = 0; i < 5; ++i)
#pragma unroll
        for (int q = 0; q < 16; ++q) { const float pv = __builtin_amdgcn_exp2f(sc[i][q] - mx); sc[i][q] = pv; l += pv; }
    l += __shfl_xor(l, 32);
    f32x16 o0, o1;
#pragma unroll
    for (int q = 0; q < 16; ++q) { o0[q] = 0.f; o1[q] = 0.f; }
    const int i16 = lane & 15, q4 = i16 >> 2, p4raw = i16 & 3, p4 = (p4raw == 1) ? 2 : (p4raw == 2) ? 1 : p4raw, blk = (lane >> 4) & 1;
#pragma unroll
    for (int i = 0; i < 5; ++i) {
        const bool tv = (ub > 0) || (wid + i >= 4);
        if (tv) {
#pragma unroll
            for (int s2 = 0; s2 < 2; ++s2) {
                u32x4 pw; pw.x = pk2(sc[i][8 * s2], sc[i][8 * s2 + 1]); pw.y = pk2(sc[i][8 * s2 + 2], sc[i][8 * s2 + 3]); pw.z = pk2(sc[i][8 * s2 + 4], sc[i][8 * s2 + 5]); pw.w = pk2(sc[i][8 * s2 + 6], sc[i][8 * s2 + 7]);
                const bf16x8 pb = __builtin_bit_cast(bf16x8, pw);
                const LAS unsigned char* vp = lds + AT_VOFF + (32 * wid + 32 * i + 16 * s2 + 4 * h + q4) * AT_ROWB + 32 * blk + 8 * p4;
                const s16x4 lo0 = vtr(vp), hi0 = vtr(vp + 8 * AT_ROWB), lo1 = vtr(vp + 64), hi1 = vtr(vp + 8 * AT_ROWB + 64);
                const bf16x8 va0 = __builtin_shufflevector(lo0, hi0, 0, 1, 2, 3, 4, 5, 6, 7), va1 = __builtin_shufflevector(lo1, hi1, 0, 1, 2, 3, 4, 5, 6, 7);
                o0 = __builtin_amdgcn_mfma_f32_32x32x16_bf16(va0, pb, o0, 0, 0, 0);
                o1 = __builtin_amdgcn_mfma_f32_32x32x16_bf16(va1, pb, o1, 0, 0, 0);
            }
        }
    }
    const float inv = __builtin_amdgcn_rcpf(l);
    bf16_t* op = OB + ((size_t)pat * NT + qtok) * 256 + head * 64 + 8 * h;
#pragma unroll
    for (int g = 0; g < 2; ++g) {
        u32x4 w0, w1;
        w0.x = pk2(o0[8 * g] * inv, o0[8 * g + 1] * inv); w0.y = pk2(o0[8 * g + 2] * inv, o0[8 * g + 3] * inv); w0.z = pk2(o0[8 * g + 4] * inv, o0[8 * g + 5] * inv); w0.w = pk2(o0[8 * g + 6] * inv, o0[8 * g + 7] * inv);
        w1.x = pk2(o1[8 * g] * inv, o1[8 * g + 1] * inv); w1.y = pk2(o1[8 * g + 2] * inv, o1[8 * g + 3] * inv); w1.z = pk2(o1[8 * g + 4] * inv, o1[8 * g + 5] * inv); w1.w = pk2(o1[8 * g + 6] * inv, o1[8 * g + 7] * inv);
        *(u32x4*)(op + 16 * g) = w0; *(u32x4*)(op + 32 + 16 * g) = w1;
    }
    if (h == 0) { f32x2v st = {mx, l}; ST[(qtok * 4 + head) * 3 + pat] = st; }
}

__device__ __forceinline__ void combine_rows(const bf16_t* YC, const bf16_t* OB, const f32x2v* ST, const float* gn, bf16_t* H, int gw, int ngw, int lane) {
    f32x4 gv[2];
#pragma unroll
    for (int j = 0; j < 2; ++j) gv[j] = ((const f32x4*)gn)[lane + 64 * (j + 2)];
    const int head = lane >> 4;
    for (int m0 = gw * 4; m0 < NT; m0 += ngw * 4) {
        u32x2 yw[4], a0[4], a1[4], a2[4]; f32x2v s0[4], s1[4], s2[4];
#pragma unroll
        for (int r = 0; r < 4; ++r) {
            const size_t m = (size_t)m0 + r;
            yw[r] = *((const u32x2*)(YC + m * 768 + 512) + lane);
            s0[r] = ST[(m * 4 + head) * 3 + 0]; s1[r] = ST[(m * 4 + head) * 3 + 1]; s2[r] = ST[(m * 4 + head) * 3 + 2];
            a0[r] = *((const u32x2*)(OB + m * 256) + lane); a1[r] = *((const u32x2*)(OB + ((size_t)NT + m) * 256) + lane); a2[r] = *((const u32x2*)(OB + ((size_t)2 * NT + m) * 256) + lane);
        }
#pragma unroll
        for (int r = 0; r < 4; ++r) {
            const size_t m = (size_t)m0 + r;
            f32x4 v[2];
            v[0] = (f32x4){bflo(yw[r].x), bfhi(yw[r].x), bflo(yw[r].y), bfhi(yw[r].y)};
            {
                const float M = fmaxf(s0[r].x, fmaxf(s1[r].x, s2[r].x));
                const float w0 = __builtin_amdgcn_exp2f(s0[r].x - M) * s0[r].y, w1 = __builtin_amdgcn_exp2f(s1[r].x - M) * s1[r].y, w2 = __builtin_amdgcn_exp2f(s2[r].x - M) * s2[r].y;
                const float iw = __builtin_amdgcn_rcpf(w0 + w1 + w2);
                f32x4 o;
                o.x = (w0 * bflo(a0[r].x) + w1 * bflo(a1[r].x) + w2 * bflo(a2[r].x)) * iw; o.y = (w0 * bfhi(a0[r].x) + w1 * bfhi(a1[r].x) + w2 * bfhi(a2[r].x)) * iw;
                o.z = (w0 * bflo(a0[r].y) + w1 * bflo(a1[r].y) + w2 * bflo(a2[r].y)) * iw; o.w = (w0 * bfhi(a0[r].y) + w1 * bfhi(a1[r].y) + w2 * bfhi(a2[r].y)) * iw;
                v[1] = o;
            }
#pragma unroll
            for (int j = 0; j < 2; ++j) {
                const float ss = wave_sum((v[j].x * v[j].x + v[j].y * v[j].y) + (v[j].z * v[j].z + v[j].w * v[j].w));
                const float rs = rsqrtf(ss * (1.f / 256.f) + EPS);
                u32x2 w; w.x = pk2(v[j].x * rs * gv[j].x, v[j].y * rs * gv[j].y); w.y = pk2(v[j].z * rs * gv[j].z, v[j].w * rs * gv[j].w);
                *((u32x2*)(H + m * DMODEL + 256 * (j + 2)) + lane) = w;
            }
        }
    }
}

#define XB_TMO      128
#define XB_XCNT(j)  (256  + 64 * (j))
#define XB_XSUB(j)  (1280 + 64 * (j))
#define XB_XGEN(j)  (2304 + 64 * (j))
#define XB_TOP      3328
#define XB_TOPGEN   3392
#define XCD_BAR_WORDS 3456
#define XB_SPIN_CAP (1u << 18)

__device__ __forceinline__ unsigned xb_ld(unsigned* p)              { return __hip_atomic_load(p, __ATOMIC_RELAXED, __HIP_MEMORY_SCOPE_AGENT); }
__device__ __forceinline__ unsigned xb_add(unsigned* p, unsigned v) { return __hip_atomic_fetch_add(p, v, __ATOMIC_RELAXED, __HIP_MEMORY_SCOPE_AGENT); }
__device__ __forceinline__ unsigned xb_xcc_id() { return (unsigned)__builtin_amdgcn_s_getreg((3 << 11) | 20) & 0xFu; }
#define XB_SPIN(cond, bar) do { unsigned _sp = 0; while (cond) { __builtin_amdgcn_s_sleep(1); \
    if ((++_sp & 255u) == 0u) { if (xb_ld(&(bar)[XB_TMO])) break; if (_sp > XB_SPIN_CAP) { atomicAdd(&(bar)[XB_TMO], 1u); break; } } } } while (0)

struct XcdBarrier {
    unsigned* bar; unsigned x;
    volatile LAS unsigned* st;
};

__device__ __forceinline__ XcdBarrier xcd_barrier_post(unsigned* bar, volatile LAS unsigned* st) {
    XcdBarrier b; b.bar = bar; b.x = xb_xcc_id(); b.st = st;
    if (threadIdx.x == 0) (void)xb_add(&bar[XB_XCNT(b.x)], 1u);
    return b;
}
__device__ __forceinline__ void xcd_barrier_complete(unsigned* bar, unsigned x, unsigned& nloc, unsigned& nx) {
    const unsigned G = gridDim.x * gridDim.y * gridDim.z;
    unsigned sum, cnt, mine, sp = 0u;
    for (;;) {
        sum = 0u; cnt = 0u; mine = 0u;
#pragma unroll
        for (unsigned j = 0; j < 16; ++j) { const unsigned c = xb_ld(&bar[XB_XCNT(j)]); sum += c; cnt += (c > 0u) ? 1u : 0u; mine = (j == x) ? c : mine; }
        if (sum == G) break;
        __builtin_amdgcn_s_sleep(1);
        if ((++sp & 255u) == 0u) { if (xb_ld(&bar[XB_TMO])) break; if (sp > XB_SPIN_CAP) { atomicAdd(&bar[XB_TMO], 1u); break; } }
    }
    nloc = mine > 0u ? mine : 1u; nx = cnt > 0u ? cnt : 1u;
}

__device__ __forceinline__ void xcd_barrier(const XcdBarrier& b) {
    asm volatile("s_waitcnt vmcnt(0)" ::: "memory");
    __syncthreads();
    if (threadIdx.x == 0) {
        unsigned* bar = b.bar;
        __builtin_amdgcn_s_waitcnt(0);
        unsigned nloc = b.st[0], nx = b.st[1];
        if (nloc == 0u) { xcd_barrier_complete(bar, b.x, nloc, nx); b.st[0] = nloc; b.st[1] = nx; }
        const unsigned old = xb_add(&bar[XB_XSUB(b.x)], 1u);
        const unsigned gen = old / nloc;
        if (old + 1u == (gen + 1u) * nloc) {
            __builtin_amdgcn_fence(__ATOMIC_RELEASE, "agent");
            asm volatile("s_waitcnt vmcnt(0)" ::: "memory");
            const unsigned og = xb_add(&bar[XB_TOP], 1u);
            const unsigned tg = og / nx;
            if (og + 1u == (tg + 1u) * nx) xb_add(&bar[XB_TOPGEN], 1u);
            else XB_SPIN(xb_ld(&bar[XB_TOPGEN]) == tg, bar);
            __builtin_amdgcn_fence(__ATOMIC_ACQUIRE, "agent");
            xb_add(&bar[XB_XGEN(b.x)], 1u);
            asm volatile("s_waitcnt vmcnt(0)" ::: "memory");
        } else {
            XB_SPIN(xb_ld(&bar[XB_XGEN(b.x)]) == gen, bar);
            __builtin_amdgcn_fence(__ATOMIC_ACQUIRE, "agent");
            asm volatile("s_waitcnt vmcnt(0)" ::: "memory");
        }
    }
    __syncthreads();
}

constexpr int NPHASE = 16;
struct Ctx { const Args* args; LAS unsigned char* lds; int tid, lane, wid, G, bx, gw, ngw; };
#define LAUNDER(p) asm volatile("" : "+s"(p))
__device__ __forceinline__ void phase_body(const int ph, const CAS Args* ap, LAS unsigned char* lds, const int tid, const int lane, const int wid, const int G, const int bx) {
    const int gw = bx * 8 + wid, ngw = G * 8;
    unsigned char* ws = ap->ws;
    const float* x_in = ap->in[0];
    float* X = ap->out;
    bf16_t* Hb = (bf16_t*)(ws + WS_H); bf16_t* Pb = (bf16_t*)(ws + WS_P); bf16_t* YC = (bf16_t*)(ws + WS_YC); bf16_t* ZB = (bf16_t*)(ws + WS_ZB); bf16_t* OB = (bf16_t*)(ws + WS_OB);
    f32x2v* ST = (f32x2v*)(ws + WS_ST);
    float* ropec = (float*)(ws + WS_ROPE); float* ropes = ropec + SEQ * 32;
    bf16_t* XB = (bf16_t*)(ws + WS_XB); float* SS = (float*)(ws + WS_SS);
    if (ph == 0) {
        {
            LAS float* wt = (LAS float*)(lds + wid * (64 * 65 * 4));
            for (int it = gw; it < 2 * 2976; it += ngw) { int t = 0; const WMat w = wmat_of(ap, ws, it, t); wconv_wave(wt, w, t, lane); }
        }
        xb_rows(x_in, XB, SS, gw, ngw, lane);
        return;
    }
    if (ph == 15) {
        float tscale = 1.f;
#ifdef TIMED
        { const unsigned long long* ts = (const unsigned long long*)(ws + WS_BAR) + 1800; tscale = 1.f + (float)(ts[1] - ts[0]) * 1e-5f; }
#endif
        final_rows(XB, SS + (size_t)4 * NT * 4, ap->in[23], X, gw, ngw, lane, tscale); return; }
    const int layer = (ph - 1) / 7, sub = (ph - 1) % 7;
    unsigned char* wb = ws + WS_W + (size_t)layer * W_LAYER;
    if (sub == 0) {
        pg8::Gemm g{XB, (const bf16_t*)(wb + W_IN), NT, NIN, 1024}; pg8::StaticOrder S; S.init(NT, NIN, G, bx);
        EpiIn E{Pb, ropec, ropes, RowScale{SS + (size_t)(layer == 0 ? 0 : 2) * NT * 4, (LAS float*)(lds + 131072 + 4096)}};
        pg8::gemm_phase<EpiIn, pg8::StaticOrder, true, true>(lds, g, S, E);
    } else if (sub == 1) {
        const int rot = bx % 3;
#define RUN_S do { LAUNDER(ap); for (int it = bx; it < 256; it += G) \
            ssm_item(lds, Pb, ZB, ap->in[8] + layer * 1024, ap->in[9] + layer * 1024, ap->in[10] + layer * 16, ap->in[11] + (size_t)layer * 16384, ap->in[12] + (size_t)layer * 16384, \
                     ap->in[13] + (size_t)layer * 16384, ap->in[14] + (size_t)layer * 16384, ap->in[15] + layer * 256, it, tid, wid, lane); __syncthreads(); } while (0)
#define RUN_C do { LAUNDER(ap); conv3_phase(Pb, Hb, ap->in[3] + layer * 768, ap->in[17] + layer * 1024, bx, G, tid); \
            cfm_phase(lds, Pb, Hb, ap->in[4] + layer * 31 * 256, ap->in[5] + layer * 256, ap->in[6] + layer * 256, ap->in[7] + layer * 256, ap->in[17] + layer * 1024, bx, G, tid, wid, lane); __syncthreads(); } while (0)
        if (rot == 0) RUN_S;
        if (rot <= 1) RUN_C;
        {
            const int per = (3072 + G - 1) / G, it0 = bx * per, it1 = (it0 + per < 3072) ? it0 + per : 3072;
            u32x4 kreg[6], vreg[6]; bf16x8 qn[4], qc[4];
            int it = it0;
            AttnU U = attn_decode(it < it1 ? it : 0);
            if (it < it1) attn_issue(Pb, U, tid, wid, lane, kreg, vreg, qn);
            for (; it < it1; ++it) {
                __syncthreads();
                attn_to_lds(lds, tid, kreg, vreg);
#pragma unroll
                for (int s = 0; s < 4; ++s) qc[s] = qn[s];
                __syncthreads();
                const AttnU Uc = U;
                if (it + 1 < it1) { U = attn_decode(it + 1); attn_issue(Pb, U, tid, wid, lane, kreg, vreg, qn); }
                attn_compute(lds, Uc, qc, OB, ST, wid, lane);
            }
            __syncthreads();
        }
        if (rot >= 1) RUN_S;
        if (rot == 2) RUN_C;
#undef RUN_S
#undef RUN_C
    } else if (sub == 2) {
        pg8::Gemm g{ZB, (const bf16_t*)(wb + W_GLU), NT, 512, 256}; pg8::StaticOrder S; S.init(NT, 512, G, bx);
        EpiGate<1> E{YC, 768, 512, RowScale{nullptr, nullptr}};
        pg8::gemm_phase<EpiGate<1>, pg8::StaticOrder, true, true>(lds, g, S, E);
    } else if (sub == 3) {
        combine_rows(YC, OB, ST, ap->in[17] + layer * 1024, Hb, gw, ngw, lane);
    } else if (sub == 4) {
        pg8::Gemm g{Hb, (const bf16_t*)(wb + W_OUT), NT, 1024, 1024}; pg8::StaticOrder S; S.init(NT, 1024, G, bx);
        EpiRes E{XB, SS + (size_t)(layer == 0 ? 1 : 3) * NT * 4, (LAS float*)(lds + 131072)};
        pg8::gemm_phase<EpiRes, pg8::StaticOrder, true, true>(lds, g, S, E);
    } else if (sub == 5) {
#ifdef STAGGER_GU
        { const int st = (bx >> 3) & 7; for (int q = 0; q < st; ++q) __builtin_amdgcn_s_sleep(127); }
#endif
        pg8::Gemm g{XB, (const bf16_t*)(wb + W_GU), NT, 2 * DFF, 1024}; pg8::StaticOrder S; S.init(NT, 2 * DFF, G, bx);
        EpiGate<0> E{Pb, DFF, 0, RowScale{SS + (size_t)(layer == 0 ? 1 : 3) * NT * 4, (LAS float*)(lds + 131072 + 4096)}};
        pg8::gemm_phase<EpiGate<0>, pg8::StaticOrder, true, true>(lds, g, S, E);
    } else {
        pg8::Gemm g{Pb, (const bf16_t*)(wb + W_DN), NT, 1024, DFF}; pg8::StaticOrder S; S.init(NT, 1024, G, bx);
        EpiRes E{XB, SS + (size_t)(layer == 0 ? 2 : 4) * NT * 4, (LAS float*)(lds + 131072)};
        pg8::gemm_phase<EpiRes, pg8::StaticOrder, true, true>(lds, g, S, E);
    }
}
__global__ void __launch_bounds__(NTHREADS, 2) fwd_megakernel(Args args) {
    extern __shared__ __attribute__((aligned(16))) unsigned char lds_raw[];
    LAS unsigned char* lds = (LAS unsigned char*)lds_raw;
    cg::grid_group grid = cg::this_grid();
    const int tid = threadIdx.x, lane = tid & 63, wid = __builtin_amdgcn_readfirstlane(tid >> 6);
    const int G = gridDim.x, bx = blockIdx.x;
    const int lo = args.ph_lo, hi = args.ph_hi;
    const CAS Args* ap = (const CAS Args*)__builtin_amdgcn_kernarg_segment_ptr();
    volatile LAS unsigned* bst = (volatile LAS unsigned*)(lds + LDS_BYTES - 64);
    if (tid == 0) { bst[0] = 0u; bst[1] = 0u; }
    __syncthreads();
    XcdBarrier xbar = xcd_barrier_post((unsigned*)(args.ws + WS_BAR), bst);
#define GSYNC(k) do { if ((k) == 1) grid.sync(); else xcd_barrier(xbar); } while (0)
#ifdef TIMED
#define TSTAMP(k) do { if (bx == 0 && tid == 0) { if ((k) == TIMED) ((unsigned long long*)(args.ws + WS_BAR))[1800] = __builtin_amdgcn_s_memrealtime(); \
        if ((k) == TIMED + TIMED_N) ((unsigned long long*)(args.ws + WS_BAR))[1801] = __builtin_amdgcn_s_memrealtime(); } } while (0)
#else
#define TSTAMP(k) do { } while (0)
#endif
#define PHASE(k) if (lo <= (k) && (k) < hi) { if ((k) > lo) GSYNC(k); TSTAMP(k); LAUNDER(ap); phase_body((k), ap, lds, tid, lane, wid, G, bx); }
    PHASE(0) PHASE(1) PHASE(2) PHASE(3) PHASE(4) PHASE(5) PHASE(6) PHASE(7) PHASE(8) PHASE(9)
    PHASE(10) PHASE(11) PHASE(12) PHASE(13) PHASE(14) PHASE(15)
#undef PHASE
}

extern "C" void kernel_launch(void* const* d_in, const int* in_sizes, int n_in, void* d_out, int out_size, void* d_ws, size_t ws_size, hipStream_t stream) {
    static int grid_blocks = 0;
    if (grid_blocks == 0) {
        if (n_in != 24 || ws_size < WS_END) { fprintf(stderr, "kernel_launch: unexpected n_in %d / ws_size %zu\n", n_in, ws_size); grid_blocks = -1; return; }
        int dev = 0, cus = 0, per_cu = 0;
        hipGetDevice(&dev);
        hipDeviceGetAttribute(&cus, hipDeviceAttributeMultiprocessorCount, dev);
        if (hipFuncSetAttribute((const void*)fwd_megakernel, hipFuncAttributeMaxDynamicSharedMemorySize, LDS_BYTES) != hipSuccess) { fprintf(stderr, "kernel_launch: hipFuncSetAttribute failed\n"); grid_blocks = -1; return; }
        if (hipOccupancyMaxActiveBlocksPerMultiprocessor(&per_cu, (const void*)fwd_megakernel, NTHREADS, LDS_BYTES) != hipSuccess || per_cu < 1) { fprintf(stderr, "kernel_launch: occupancy query %d\n", per_cu); per_cu = 1; }
        (void)hipGetLastError();
        grid_blocks = cus * per_cu;
    }
    if (grid_blocks < 0) return;
    Args a{};
    for (int i = 0; i < 24; ++i) a.in[i] = (const float*)d_in[i];
    a.out = (float*)d_out; a.ws = (unsigned char*)d_ws; a.ph_lo = 0; a.ph_hi = NPHASE;
    if (hipMemsetAsync((char*)d_ws + WS_BAR, 0, 16384, stream) != hipSuccess) { fprintf(stderr, "kernel_launch: memset failed\n"); return; }
    void* kargs[] = {&a};
    hipError_t e = hipLaunchCooperativeKernel((const void*)fwd_megakernel, dim3(grid_blocks), dim3(NTHREADS), kargs, LDS_BYTES, stream);
    if (e != hipSuccess) fprintf(stderr, "cooperative launch failed: %s (grid %d)\n", hipGetErrorString(e), grid_blocks);
}
```
